# Optimizing an MI355X kernel written in HIP

```python
import math
import jax, jax.numpy as jnp
from jax import lax
import numpy as np


D_MODEL = 1024
BATCH = 2
SEQ = 8192
DEPTH = 2
DEC_BATCH = 128
DEC_SEQ = 8
PAST_LEN = 8192
PAGE_SIZE = 128

N_A_LAYERS = DEPTH // 2
N_B_LAYERS = DEPTH - N_A_LAYERS
GLA_HEADS = 4
GLA_DK = D_MODEL // 2 // GLA_HEADS
GLA_DV = D_MODEL // GLA_HEADS
GLA_RANK = 16
GLA_TAU = 16.0
GLA_CHUNK = 64
IN_A_COLS = 2 * GLA_HEADS * GLA_DK + 2 * GLA_HEADS * GLA_DV + GLA_RANK
SWA_HEADS = 16
SWA_KV_HEADS = 4
SWA_GROUP = SWA_HEADS // SWA_KV_HEADS
SWA_HEAD_DIM = 64
WINDOW = 128
REL_BUCKETS = 32
REL_MAX_DIST = 128
D_FF = 4 * D_MODEL
PLE_DIM = 256
EPS = 1e-6

kernel_name = 'yoco_gla_swa_sink_decoder_step'


def rmsnorm(x, gain):
    xf = x.astype(jnp.float32)
    xf = xf * lax.rsqrt(jnp.mean(xf * xf, axis=-1, keepdims=True) + EPS)
    return (xf * gain.astype(jnp.float32)).astype(x.dtype)


def rel_bucket(d):
    max_exact = REL_BUCKETS // 2
    df = jnp.maximum(d, 1).astype(jnp.float32)
    large = max_exact + (jnp.log(df / max_exact) / math.log(REL_MAX_DIST / max_exact)
                         * (REL_BUCKETS - max_exact)).astype(jnp.int32)
    large = jnp.minimum(large, REL_BUCKETS - 1)
    return jnp.where(d < max_exact, d, large)


def gla_recurrence(q, k, v, lg, s0):
    b, s = q.shape[:2]
    c = GLA_CHUNK if s % GLA_CHUNK == 0 else s
    nc = s // c

    def to_chunks(t):
        return t.reshape(b, nc, c, GLA_HEADS, t.shape[-1]).transpose(1, 0, 3, 2, 4)

    causal = jnp.tril(jnp.ones((c, c), bool))[:, :, None]

    def step(state, inp):
        qc, kc, vc, lc = [t.astype(jnp.float32) for t in inp]
        bc = jnp.cumsum(lc, axis=-2)
        diff = bc[:, :, :, None, :] - bc[:, :, None, :, :]
        decay = jnp.where(causal, jnp.exp(jnp.where(causal, diff, 0.0)), 0.0)
        attn = jnp.einsum('bhid,bhjd,bhijd->bhij', qc, kc, decay)
        o = jnp.einsum('bhij,bhje->bhie', attn, vc) + jnp.einsum('bhid,bhde->bhie', qc * jnp.exp(bc), state)
        last = bc[:, :, -1:, :]
        new_state = (jnp.exp(last[:, :, 0, :])[..., None] * state
                     + jnp.einsum('bhjd,bhje->bhde', kc * jnp.exp(last - bc), vc))
        return new_state, o

    s_fin, o = lax.scan(step, s0.astype(jnp.float32),
                        (to_chunks(q), to_chunks(k), to_chunks(v), to_chunks(lg)))
    o = o.transpose(1, 0, 3, 2, 4).reshape(b, s, GLA_HEADS, GLA_DV)
    return o, s_fin


def gla_mixer(hn, s0, w_in, w_a2, b_a2, o_gain, w_out):
    b, s, _ = hn.shape
    nq = GLA_HEADS * GLA_DK
    nv = GLA_HEADS * GLA_DV
    proj = hn @ w_in
    q, k, v, g, a = jnp.split(proj, [nq, 2 * nq, 2 * nq + nv, 2 * nq + 2 * nv], axis=-1)
    lg = jax.nn.log_sigmoid((a @ w_a2 + b_a2).astype(jnp.float32)) / GLA_TAU
    o, s_fin = gla_recurrence(q.reshape(b, s, GLA_HEADS, GLA_DK) * GLA_DK ** -0.5,
                              k.reshape(b, s, GLA_HEADS, GLA_DK),
                              v.reshape(b, s, GLA_HEADS, GLA_DV),
                              lg.reshape(b, s, GLA_HEADS, GLA_DK), s0)
    o = rmsnorm(o.astype(hn.dtype), o_gain).reshape(b, s, nv)
    return (o * jax.nn.silu(g)) @ w_out, s_fin.astype(hn.dtype)


def swa_core(q, k, v, qpos, kpos, rel_bias, sinks):
    n, nq = qpos.shape
    nk = kpos.shape[1]
    d = qpos[:, :, None] - kpos[:, None, :]
    valid = (d >= 0) & (d < WINDOW) & (kpos[:, None, :] >= 0)
    bias = rel_bias.astype(jnp.float32).T[:, rel_bucket(jnp.maximum(d, 0))]
    bias = bias.reshape(SWA_KV_HEADS, SWA_GROUP, n, nq, nk).transpose(2, 0, 1, 3, 4)
    logits = jnp.einsum('bnqhgd,bnshd->bnhgqs', q, k).astype(jnp.float32) * SWA_HEAD_DIM ** -0.5 + bias
    logits = jnp.where(valid[None, :, None, None], logits, -jnp.inf)
    sink = sinks.astype(jnp.float32).reshape(SWA_KV_HEADS, SWA_GROUP)[:, :, None, None]
    m = jnp.maximum(jnp.max(logits, axis=-1, keepdims=True), sink)
    e = jnp.exp(logits - m)
    p = e / (jnp.sum(e, axis=-1, keepdims=True) + jnp.exp(sink - m))
    return jnp.einsum('bnhgqs,bnshd->bnqhgd', p.astype(v.dtype), v)


def swa_mixer(hn, k_new, v_new, past_k, past_v, w_q, w_o, sinks, rel_bias):
    b, s, _ = hn.shape
    q = (hn @ w_q).reshape(b, s, SWA_KV_HEADS, SWA_GROUP, SWA_HEAD_DIM)
    if past_k is None:
        nb = s // WINDOW
        q = q.reshape(b, nb, WINDOW, SWA_KV_HEADS, SWA_GROUP, SWA_HEAD_DIM)

        def band(t):
            tb = jnp.concatenate([jnp.zeros_like(t[:, :WINDOW]), t], axis=1)
            tb = tb.reshape(b, nb + 1, WINDOW, SWA_KV_HEADS, SWA_HEAD_DIM)
            return jnp.concatenate([tb[:, :-1], tb[:, 1:]], axis=2)

        kb, vb = band(k_new), band(v_new)
        qpos = jnp.arange(s, dtype=jnp.int32).reshape(nb, WINDOW)
        kpos = ((jnp.arange(nb, dtype=jnp.int32)[:, None] - 1) * WINDOW
                + jnp.arange(2 * WINDOW, dtype=jnp.int32)[None, :])
    else:
        n_past = past_k.shape[1]
        kb = jnp.concatenate([past_k, k_new], axis=1)[:, None]
        vb = jnp.concatenate([past_v, v_new], axis=1)[:, None]
        q = q[:, None]
        qpos = (PAST_LEN + jnp.arange(s, dtype=jnp.int32))[None]
        kpos = (PAST_LEN - n_past + jnp.arange(n_past + s, dtype=jnp.int32))[None]
    o = swa_core(q, kb, vb, qpos, kpos, rel_bias, sinks)
    return o.reshape(b, s, SWA_HEADS * SWA_HEAD_DIM) @ w_o


def sq_relu_mlp(hn, w_up, w_down):
    return jnp.square(jax.nn.relu(hn @ w_up)) @ w_down


def trunk(x, p, gla_state, past_k, past_v, w):
    h = x
    b, s, _ = x.shape
    gla_states = []
    k_sh = v_sh = None
    for i in range(DEPTH):
        hn = rmsnorm(h, w['norm_mix'][i])
        if i < N_A_LAYERS:
            y, s_fin = gla_mixer(hn, gla_state[i], w['w_in_a'][i], w['w_a2'][i], w['b_a2'][i],
                                 w['gla_o_gain'][i], w['w_out_a'][i])
            gla_states.append(s_fin)
        else:
            j = i - N_A_LAYERS
            y = swa_mixer(hn, k_sh, v_sh, past_k, past_v, w['w_q_b'][j], w['w_o_b'][j],
                          w['sinks'][j], w['rel_bias'])
        h = h + y
        h = h + sq_relu_mlp(rmsnorm(h, w['norm_mlp'][i]), w['w_up'][i], w['w_down'][i])
        gate = jax.nn.sigmoid(rmsnorm(h, w['norm_ple'][i]) @ w['w_ple_gate'][i])
        h = h + gate * (p[i] @ w['w_ple'][i])
        if i == N_A_LAYERS - 1:
            kv = rmsnorm(h, w['norm_kv']) @ w['w_kv']
            k_sh, v_sh = jnp.split(kv, 2, axis=-1)
            k_sh = k_sh.reshape(b, s, SWA_KV_HEADS, SWA_HEAD_DIM)
            v_sh = v_sh.reshape(b, s, SWA_KV_HEADS, SWA_HEAD_DIM)
    y = rmsnorm(h, w['norm_final'])
    if past_k is None:
        keep = min(WINDOW, s)
        new_k, new_v = k_sh[:, s - keep:], v_sh[:, s - keep:]
    else:
        n_past = past_k.shape[1]
        new_k = jnp.concatenate([past_k, k_sh], axis=1)[:, -n_past:]
        new_v = jnp.concatenate([past_v, v_sh], axis=1)[:, -n_past:]
    return y, jnp.stack(gla_states), new_k, new_v


def setup_inputs(seed: int = 0) -> dict:
    key = jax.random.key(seed)
    ks = iter(jax.random.split(key, 32))

    def nrm(shape, scale):
        return jax.random.normal(next(ks), shape, jnp.float32) * scale

    def gain(shape):
        return 1.0 + nrm(shape, 0.02)

    n_win = min(WINDOW, PAST_LEN)
    return {
        'x_prompt': nrm((BATCH, SEQ, D_MODEL), 1.0),
        'x_sample': nrm((DEC_BATCH, DEC_SEQ, D_MODEL), 1.0),
        'state_gla': nrm((N_A_LAYERS, DEC_BATCH, GLA_HEADS, GLA_DK, GLA_DV), 0.5),
        'cache_win_k': nrm((DEC_BATCH, n_win, SWA_KV_HEADS, SWA_HEAD_DIM), 1.0),
        'cache_win_v': nrm((DEC_BATCH, n_win, SWA_KV_HEADS, SWA_HEAD_DIM), 1.0),
        'p_prompt': nrm((DEPTH, BATCH, SEQ, PLE_DIM), 1.0),
        'p_sample': nrm((DEPTH, DEC_BATCH, DEC_SEQ, PLE_DIM), 1.0),
        'norm_mix': gain((DEPTH, D_MODEL)),
        'norm_mlp': gain((DEPTH, D_MODEL)),
        'norm_ple': gain((DEPTH, D_MODEL)),
        'norm_kv': gain((D_MODEL,)),
        'norm_final': gain((D_MODEL,)),
        'w_in_a': nrm((N_A_LAYERS, D_MODEL, IN_A_COLS), D_MODEL ** -0.5),
        'w_a2': nrm((N_A_LAYERS, GLA_RANK, GLA_HEADS * GLA_DK), GLA_RANK ** -0.5),
        'b_a2': nrm((N_A_LAYERS, GLA_HEADS * GLA_DK), 0.1),
        'gla_o_gain': gain((N_A_LAYERS, GLA_DV)),
        'w_out_a': nrm((N_A_LAYERS, GLA_HEADS * GLA_DV, D_MODEL), (GLA_HEADS * GLA_DV) ** -0.5),
        'w_kv': nrm((D_MODEL, 2 * SWA_KV_HEADS * SWA_HEAD_DIM), D_MODEL ** -0.5),
        'w_q_b': nrm((N_B_LAYERS, D_MODEL, SWA_HEADS * SWA_HEAD_DIM), D_MODEL ** -0.5),
        'w_o_b': nrm((N_B_LAYERS, SWA_HEADS * SWA_HEAD_DIM, D_MODEL), (SWA_HEADS * SWA_HEAD_DIM) ** -0.5),
        'sinks': nrm((N_B_LAYERS, SWA_HEADS), 0.5),
        'rel_bias': nrm((REL_BUCKETS, SWA_HEADS), 0.5),
        'w_up': nrm((DEPTH, D_MODEL, D_FF), D_MODEL ** -0.5),
        'w_down': nrm((DEPTH, D_FF, D_MODEL), D_FF ** -0.5),
        'w_ple': nrm((DEPTH, PLE_DIM, D_MODEL), PLE_DIM ** -0.5),
        'w_ple_gate': nrm((DEPTH, D_MODEL, D_MODEL), D_MODEL ** -0.5),
    }


def reference(x_prompt, x_sample, state_gla, cache_win_k, cache_win_v, p_prompt, p_sample,
              norm_mix, norm_mlp, norm_ple, norm_kv, norm_final,
              w_in_a, w_a2, b_a2, gla_o_gain, w_out_a,
              w_kv, w_q_b, w_o_b, sinks, rel_bias,
              w_up, w_down, w_ple, w_ple_gate):
    w = dict(norm_mix=norm_mix, norm_mlp=norm_mlp, norm_ple=norm_ple, norm_kv=norm_kv,
             norm_final=norm_final, w_in_a=w_in_a, w_a2=w_a2, b_a2=b_a2, gla_o_gain=gla_o_gain,
             w_out_a=w_out_a, w_kv=w_kv, w_q_b=w_q_b, w_o_b=w_o_b, sinks=sinks, rel_bias=rel_bias,
             w_up=w_up, w_down=w_down, w_ple=w_ple, w_ple_gate=w_ple_gate)
    b = x_prompt.shape[0]
    gla0_prompt = jnp.zeros((N_A_LAYERS, b, GLA_HEADS, GLA_DK, GLA_DV), x_prompt.dtype)
    y_prompt, state_gla_prompt, cache_win_k_prompt, cache_win_v_prompt = trunk(
        x_prompt, p_prompt, gla0_prompt, None, None, w)
    y_sample, state_gla_sample, cache_win_k_sample, cache_win_v_sample = trunk(
        x_sample, p_sample, state_gla, cache_win_k, cache_win_v, w)
    return (y_prompt, y_sample, state_gla_prompt, state_gla_sample,
            cache_win_k_prompt, cache_win_v_prompt, cache_win_k_sample, cache_win_v_sample)
```

```cpp
#include <hip/hip_runtime.h>
#include <hip/hip_cooperative_groups.h>
#include <cstdio>
#include <cstdint>
namespace cg = cooperative_groups;

#define LAS __attribute__((address_space(3)))
#define GAS __attribute__((address_space(1)))
typedef unsigned short bf16_t;
typedef short bf16x8 __attribute__((ext_vector_type(8)));
typedef short s16x4 __attribute__((ext_vector_type(4)));
typedef float f32x4 __attribute__((ext_vector_type(4)));
typedef float f32x2 __attribute__((ext_vector_type(2)));
typedef unsigned u32x4 __attribute__((ext_vector_type(4)));
typedef unsigned u32x2 __attribute__((ext_vector_type(2)));

#ifndef MK_SPLIT
#define MK_SPLIT 0
#endif

constexpr int DM = 1024, SEQ = 8192, NBATCH = 2, MP = NBATCH * SEQ, SB = 128, SS = 8, MS = SB * SS, M = MP + MS, NPAN = M / 256;
constexpr int NQK = 512, NV = 1024, N_IN = 3584, FF = 4096, PLE = 256, NKVQ = 1536, IN_A_COLS = 3088;
constexpr int NCHUNK = 128, NBH = 8, NCH_ALL = NBH * NCHUNK;
constexpr float EPS = 1e-6f, LOG2E = 1.4426950408889634f;
constexpr int HID_SPLIT = 51;

constexpr size_t O_Y = 0, O_SP = (size_t)M * DM, O_SS = O_SP + 262144, O_CKP = O_SS + 16777216, O_CVP = O_CKP + 65536, O_CKS = O_CVP + 65536, O_CVS = O_CKS + 4194304, O_END = O_CVS + 4194304;

constexpr size_t al256(size_t x) { return (x + 255) & ~(size_t)255; }
constexpr size_t WS_CTL = 0, CTL_BYTES = 1u << 20;
constexpr size_t WS_W_IN = CTL_BYTES;
constexpr size_t WS_W_OUT = WS_W_IN + (size_t)N_IN * DM * 2;
constexpr size_t WS_W_UP0 = WS_W_OUT + (size_t)DM * DM * 2;
constexpr size_t WS_W_DN0 = WS_W_UP0 + (size_t)FF * DM * 2;
constexpr size_t WS_W_UP1 = WS_W_DN0 + (size_t)FF * DM * 2;
constexpr size_t WS_W_DN1 = WS_W_UP1 + (size_t)FF * DM * 2;
constexpr size_t WS_W_G0 = WS_W_DN1 + (size_t)FF * DM * 2;
constexpr size_t WS_W_G1 = WS_W_G0 + (size_t)DM * DM * 2;
constexpr size_t WS_W_P0 = WS_W_G1 + (size_t)DM * DM * 2;
constexpr size_t WS_W_P1 = WS_W_P0 + (size_t)DM * PLE * 2;
constexpr size_t WS_W_KVQ = WS_W_P1 + (size_t)DM * PLE * 2;
constexpr size_t WS_W_O = WS_W_KVQ + (size_t)NKVQ * DM * 2;
constexpr size_t WS_XB = WS_W_O + (size_t)DM * DM * 2;
constexpr size_t WS_PB = WS_XB + (size_t)M * DM * 2;
constexpr size_t WS_R1 = WS_PB + (size_t)M * PLE * 2;
constexpr size_t R1_BYTES = (size_t)HID_SPLIT * 256 * FF * 2;
constexpr size_t WS_Q1 = WS_R1, WS_K1 = WS_Q1 + (size_t)M * NQK * 2, WS_V1 = WS_K1 + (size_t)M * NQK * 2, WS_G1 = WS_V1 + (size_t)M * NV * 2;
static_assert(WS_G1 + (size_t)M * NV * 2 == WS_R1 + R1_BYTES, "R1 map");
constexpr size_t WS_R3 = WS_R1 + R1_BYTES;
static_assert((size_t)(NPAN - HID_SPLIT) * 256 * FF * 2 == (size_t)M * DM * 2, "R3 map");
constexpr size_t WS_KVR = WS_R3 + (size_t)M * DM * 2;
constexpr size_t WS_PLQ = WS_KVR + (size_t)M * NQK * 2;
constexpr size_t WS_SSQ = WS_PLQ + (size_t)M * DM * 2;
constexpr size_t WS_DV = WS_SSQ + (size_t)2 * M * 16 * 4;
constexpr size_t WS_END = WS_DV + (size_t)NCH_ALL * 128 * 4;

__device__ __forceinline__ float bf2f(unsigned short b) { return __uint_as_float((unsigned)b << 16); }
__device__ __forceinline__ float bflo(unsigned w) { return __uint_as_float(w << 16); }
__device__ __forceinline__ float bfhi(unsigned w) { return __uint_as_float(w & 0xffff0000u); }
typedef __bf16 bf16x2_t __attribute__((ext_vector_type(2)));
__device__ __forceinline__ unsigned pk2(float lo, float hi) { const f32x2 v = {lo, hi}; const bf16x2_t b = __builtin_convertvector(v, bf16x2_t); return __builtin_bit_cast(unsigned, b); }
__device__ __forceinline__ float fexp(float x) { return __builtin_amdgcn_exp2f(x * LOG2E); }
__device__ __forceinline__ float frcp(float x) { return __builtin_amdgcn_rcpf(x); }
__device__ __forceinline__ float frsq(float x) { return __builtin_amdgcn_rsqf(x); }
__device__ __forceinline__ float fsigmoid(float x) { return frcp(1.f + fexp(-x)); }
__device__ __forceinline__ float logsig(float x) { return fminf(x, 0.f) - __logf(1.f + fexp(-fabsf(x))); }
__device__ __forceinline__ s16x4 trd(const LAS bf16_t* p) { return __builtin_bit_cast(s16x4, __builtin_amdgcn_ds_read_tr16_b64_v4i16((LAS s16x4*)p)); }
__device__ __forceinline__ bf16x8 cat8(s16x4 lo, s16x4 hi) { return (bf16x8){lo[0], lo[1], lo[2], lo[3], hi[0], hi[1], hi[2], hi[3]}; }
__device__ __forceinline__ void st_wt(float* p, float v) { __hip_atomic_store(p, v, __ATOMIC_RELAXED, __HIP_MEMORY_SCOPE_AGENT); }
__device__ __forceinline__ float wave_sum(float v) {
#pragma unroll
    for (int o = 1; o < 64; o <<= 1) v += __shfl_xor(v, o);
    return v;
}
__device__ __forceinline__ float row_r(const float* ssq, int row) {
    const f32x4* p = (const f32x4*)(ssq + (size_t)row * 16);
    const f32x4 a = p[0], b = p[1], c = p[2], d = p[3];
    const f32x4 s = (a + b) + (c + d);
    return frsq(((s.x + s.y) + (s.z + s.w)) * (1.f / 1024.f) + EPS);
}

namespace pg8 {
constexpr int BM = 256, BK = 64, HALF = 128, HTB = HALF * BK * 2, STAGE_BYTES = 8 * HTB, NXCD = 8, WGM = 8;
__host__ __device__ __forceinline__ int lds_byte(int r, int c) { const int st = (r >> 4) * 2 + (c >> 5), rr = r & 15, cc = c & 31, ob = rr * 64 + cc * 2; return st * 1024 + (ob ^ (((ob >> 9) & 1) << 5)); }
__host__ __device__ __forceinline__ void stage_rc(int b, int& R, int& C) { const int st = b / 1024, sb = b % 1024, swz = sb ^ (((sb >> 9) & 1) << 5); R = (st >> 1) * 16 + swz / 64; C = (st & 1) * 32 + (swz % 64) / 2; }
__host__ __device__ __forceinline__ int perm32(int rho) { const int n = rho >> 4, i = rho & 15; return 8 * (i >> 2) + 4 * n + (i & 3); }
struct Unit { int pm, pn; };
struct Gemm { const bf16_t* A; const bf16_t* A2; int split; const bf16_t* Bt; int M, N, K; };
struct StaticOrder {
    int nM, nN, nwg, G, c;
    __device__ void init(int M_, int N, int G_, int c_) { nM = M_ / BM; nN = N / BM; nwg = nM * nN; G = G_; c = c_; }
    __device__ bool next(int i, Unit& u) const {
        const long L = (long)i * G + c; if (L >= nwg) return false;
        int wgid = (int)L; { const int q = nwg / NXCD, r = nwg % NXCD, xcd = wgid % NXCD, off = wgid / NXCD; wgid = (xcd < r ? xcd * (q + 1) : r * (q + 1) + (xcd - r) * q) + off; }
        const int nig = WGM * nN, gid = wgid / nig, fm = gid * WGM, gsz = (nM - fm) < WGM ? (nM - fm) : WGM;
        u.pm = fm + ((wgid % nig) % gsz); u.pn = (wgid % nig) / gsz; return true;
    }
};

template <class Epi>
__device__ __forceinline__ void gemm_phase(LAS unsigned char* lds, const Gemm g, const StaticOrder& S, const Epi& E) {
    const int tid = threadIdx.x, wid = __builtin_amdgcn_readfirstlane(tid >> 6), lane = tid & 63, wr = wid >> 2, wc = wid & 3, fr = lane & 15, fq = lane >> 4;
    const int K = g.K, nt = K / BK;
    unsigned voffA[2], voffB[2];
#pragma unroll
    for (int i = 0; i < 2; ++i) { int R, C; stage_rc(tid * 16 + i * 8192, R, C); const int Rb = (R & ~31) + perm32(R & 31);
        voffA[i] = (unsigned)(R * K + C) * 2u; voffB[i] = (unsigned)(Rb * K + C) * 2u; }
    const size_t kstep = (size_t)(BK * 2);
    const size_t hstep = (size_t)HALF * K * 2;
    const size_t tstep = 2 * hstep;
    const unsigned ldsw = (unsigned)wid * 1024u;
    const int aoff = lds_byte(wr * 64 + fr, fq * 8), boff = lds_byte(wc * 32 + fr, fq * 8);
#define PG8_APTR(pm) ((pm) < g.split ? (const char*)g.A + (size_t)(pm) * tstep : (const char*)g.A2 + (size_t)((pm) - g.split) * tstep)
#define PG8_SA(b, h) (((b) * 2 + (h)) * HTB)
#define PG8_SB(b, h) ((4 + (b) * 2 + (h)) * HTB)
#define PG8_STAGE(bufoff, gbase, voff) do { _Pragma("unroll") for (int _i = 0; _i < 2; ++_i) \
        __builtin_amdgcn_global_load_lds((const unsigned*)((const char*)(gbase) + (voff)[_i]), (LAS unsigned*)(lds + (bufoff) + ldsw + _i * 8192), 16, 0, 0); } while (0)
#define PG8_LDA(dst, b, h) do { _Pragma("unroll") for (int m = 0; m < 4; ++m) _Pragma("unroll") for (int k = 0; k < 2; ++k) dst[m][k] = *(const LAS bf16x8*)(lds + PG8_SA(b, h) + aoff + m * 2048 + k * 1024); } while (0)
#define PG8_LDB(dst, b, h) do { _Pragma("unroll") for (int n = 0; n < 2; ++n) _Pragma("unroll") for (int k = 0; k < 2; ++k) dst[n][k] = *(const LAS bf16x8*)(lds + PG8_SB(b, h) + boff + n * 2048 + k * 1024); } while (0)
#define PG8_MMA(ai, bj, At, Bt) do { __builtin_amdgcn_s_setprio(1); _Pragma("unroll") for (int m = 0; m < 4; ++m) _Pragma("unroll") for (int n = 0; n < 2; ++n) _Pragma("unroll") for (int k = 0; k < 2; ++k) \
        acc[ai][bj][m][n] = __builtin_amdgcn_mfma_f32_16x16x32_bf16(Bt[n][k], At[m][k], acc[ai][bj][m][n], 0, 0, 0); __builtin_amdgcn_s_setprio(0); } while (0)
#define PG8_WAIT_V(n) asm volatile("s_waitcnt vmcnt(" #n ")" ::: "memory")
#define PG8_WAIT_L(n) asm volatile("s_waitcnt lgkmcnt(" #n ")" ::: "memory")
#define PG8_BAR __builtin_amdgcn_s_barrier()
#define PG8_SCHED __builtin_amdgcn_sched_barrier(0)
    Unit cur, nxt; int ui = 0;
    if (!S.next(0, cur)) return;
    LAS float* rtab_all = (LAS float*)(lds + STAGE_BYTES);
    if (E.rsrc() != nullptr) { Unit uu; for (int i = 0; i < 8 && S.next(i, uu); ++i) if (tid < 256) rtab_all[i * 256 + tid] = row_r(E.rsrc(), uu.pm * BM + tid); }
    f32x4 acc[2][2][4][2];
#pragma unroll
    for (int a = 0; a < 2; ++a)
#pragma unroll
        for (int b = 0; b < 2; ++b)
#pragma unroll
            for (int m = 0; m < 4; ++m)
#pragma unroll
                for (int n = 0; n < 2; ++n) acc[a][b][m][n] = (f32x4){0.f, 0.f, 0.f, 0.f};
    bf16x8 At[4][2], B0[2][2], B1[2][2];
    const char* cA = PG8_APTR(cur.pm); const char* cB = (const char*)g.Bt + (size_t)cur.pn * tstep;
    PG8_STAGE(PG8_SB(0, 0), cB, voffB); PG8_STAGE(PG8_SB(0, 1), cB + hstep, voffB); PG8_STAGE(PG8_SA(0, 0), cA, voffA); PG8_STAGE(PG8_SA(0, 1), cA + hstep, voffA);
    PG8_WAIT_L(0);
    if (wr == 1) PG8_BAR;
    PG8_WAIT_V(2); PG8_BAR;
    PG8_STAGE(PG8_SB(1, 0), cB + kstep, voffB); PG8_STAGE(PG8_SA(1, 0), cA + kstep, voffA); PG8_STAGE(PG8_SB(1, 1), cB + hstep + kstep, voffB);
    PG8_WAIT_V(6); PG8_BAR;
    for (;;) {
        const bool has_next = S.next(ui + 1, nxt);
        const char* nA = has_next ? PG8_APTR(nxt.pm) : cA; const char* nB = has_next ? (const char*)g.Bt + (size_t)nxt.pn * tstep : cB;
#pragma clang loop unroll(disable)
        for (int t = 0; t < nt; t += 2) {
            const bool last = (t == nt - 2);
            const char* a1 = cA + (size_t)(t + 1) * kstep;
            const char* a2 = last ? nA : cA + (size_t)(t + 2) * kstep; const char* b2 = last ? nB : cB + (size_t)(t + 2) * kstep;
            const char* a3 = a2 + kstep; const char* b3 = b2 + kstep;
            PG8_LDB(B0, 0, 0); PG8_LDB(B1, 0, 1); PG8_SCHED; PG8_LDA(At, 0, 0); PG8_STAGE(PG8_SA(1, 1), a1 + hstep, voffA);
            PG8_WAIT_V(8); PG8_WAIT_L(0); PG8_BAR; PG8_MMA(0, 0, At, B0); PG8_MMA(0, 1, At, B1); PG8_BAR; PG8_SCHED;
            PG8_LDA(At, 0, 1); PG8_STAGE(PG8_SB(0, 0), b2, voffB); PG8_STAGE(PG8_SB(0, 1), b2 + hstep, voffB); PG8_STAGE(PG8_SA(0, 0), a2, voffA);
            PG8_WAIT_V(8); PG8_WAIT_L(0); PG8_BAR; PG8_MMA(1, 0, At, B0); PG8_MMA(1, 1, At, B1); PG8_BAR; PG8_SCHED;
            PG8_LDB(B0, 1, 0); PG8_LDB(B1, 1, 1); PG8_SCHED; PG8_LDA(At, 1, 0); PG8_STAGE(PG8_SA(0, 1), a2 + hstep, voffA);
            PG8_WAIT_V(8); PG8_WAIT_L(0); PG8_BAR; PG8_MMA(0, 0, At, B0); PG8_MMA(0, 1, At, B1); PG8_BAR; PG8_SCHED;
            PG8_LDA(At, 1, 1); PG8_STAGE(PG8_SB(1, 0), b3, voffB); PG8_STAGE(PG8_SB(1, 1), b3 + hstep, voffB); PG8_STAGE(PG8_SA(1, 0), a3, voffA);
            PG8_WAIT_V(8); PG8_WAIT_L(0); PG8_BAR; PG8_MMA(1, 0, At, B0); PG8_MMA(1, 1, At, B1); PG8_BAR; PG8_SCHED;
        }
        if (wr == 0) PG8_BAR;
        { int efr = fr, efq = fq, etid = tid; asm volatile("" : "+v"(efr), "+v"(efq), "+v"(etid));
          E(acc, cur, wr, wc, efr, efq, rtab_all + (ui & 7) * 256, etid); }
        if (!has_next) break;
#pragma unroll
        for (int a = 0; a < 2; ++a)
#pragma unroll
            for (int b = 0; b < 2; ++b)
#pragma unroll
                for (int m = 0; m < 4; ++m)
#pragma unroll
                    for (int n = 0; n < 2; ++n) acc[a][b][m][n] = (f32x4){0.f, 0.f, 0.f, 0.f};
        cur = nxt; cA = nA; cB = nB; ++ui;
        if (wr == 1) PG8_BAR;
    }
    PG8_WAIT_V(0);
    PG8_BAR;
#undef PG8_APTR
#undef PG8_SA
#undef PG8_SB
#undef PG8_STAGE
#undef PG8_LDA
#undef PG8_LDB
#undef PG8_MMA
#undef PG8_WAIT_V
#undef PG8_WAIT_L
#undef PG8_BAR
#undef PG8_SCHED
}

#define EPI_RTAB(ssqp) do { } while (0)
#define EPI_ROWLOOP _Pragma("unroll") for (int ai = 0; ai < 2; ++ai) _Pragma("unroll") for (int m = 0; m < 4; ++m)
__device__ __forceinline__ u32x4 pack8(const f32x4 v0, const f32x4 v1) { u32x4 w; w.x = pk2(v0[0], v0[1]); w.y = pk2(v0[2], v0[3]); w.z = pk2(v1[0], v1[1]); w.w = pk2(v1[2], v1[3]); return w; }

struct EpiIn {
    bf16_t *Q, *Kk, *V, *G, *LG; const float* ssq; const float* b_a2;
    __device__ __forceinline__ const float* rsrc() const { return ssq; }
    __device__ __forceinline__ void operator()(const f32x4 (&acc)[2][2][4][2], const Unit& u, int wr, int wc, int fr, int fq, LAS float* rtab, int tid) const {
        const int pn = u.pn; bf16_t* base; int ld, c0;
        if (pn < 2) { base = Q; ld = NQK; c0 = pn * 256; } else if (pn < 4) { base = Kk; ld = NQK; c0 = (pn - 2) * 256; }
        else if (pn < 8) { base = V; ld = NV; c0 = (pn - 4) * 256; } else if (pn < 12) { base = G; ld = NV; c0 = (pn - 8) * 256; }
        else { base = LG; ld = NQK; c0 = (pn - 12) * 256; }
        const bool is_lg = pn >= 12;
        const int col = c0 + wc * 32 + 8 * fq;
        f32x4 bb[2][2];
#pragma unroll
        for (int bj = 0; bj < 2; ++bj)
#pragma unroll
            for (int n = 0; n < 2; ++n) bb[bj][n] = is_lg ? *(const f32x4*)(b_a2 + col + bj * HALF + 4 * n) : (f32x4){0.f, 0.f, 0.f, 0.f};
        EPI_RTAB(ssq);
        EPI_ROWLOOP { const int lr = ai * HALF + wr * 64 + m * 16 + fr, row = u.pm * BM + lr; const float r = rtab[lr];
#pragma unroll
            for (int bj = 0; bj < 2; ++bj) { f32x4 v0 = acc[ai][bj][m][0] * r, v1 = acc[ai][bj][m][1] * r;
                if (is_lg) { v0 += bb[bj][0]; v1 += bb[bj][1];
#pragma unroll
                    for (int e = 0; e < 4; ++e) { v0[e] = logsig(v0[e]) * (1.f / 16.f); v1[e] = logsig(v1[e]) * (1.f / 16.f); } }
                *(u32x4*)(base + (size_t)row * ld + col + bj * HALF) = pack8(v0, v1); } }
    }
};
template <bool FROM_X> struct EpiRes {
    const float* X0; const float* X1; const bf16_t* BB; bf16_t* XO; float* ssq_out; float sc;
    __device__ __forceinline__ const float* rsrc() const { return nullptr; }
    __device__ __forceinline__ void operator()(const f32x4 (&acc)[2][2][4][2], const Unit& u, int wr, int wc, int fr, int fq, LAS float* rtab, int tid) const {
        const int col = u.pn * BM + wc * 32 + 8 * fq;
#pragma unroll
        for (int ai = 0; ai < 2; ++ai) {
            f32x4 b0[4][2], b1[4][2]; u32x4 bw[4][2];
#pragma unroll
            for (int m = 0; m < 4; ++m) { const int row = u.pm * BM + ai * HALF + wr * 64 + m * 16 + fr;
#pragma unroll
                for (int bj = 0; bj < 2; ++bj) {
                    if (FROM_X) { const float* src = (u.pm < MP / 256 ? X0 + (size_t)row * DM : X1 + (size_t)(row - MP) * DM) + col + bj * HALF; b0[m][bj] = *(const f32x4*)src; b1[m][bj] = *(const f32x4*)(src + 4); }
                    else bw[m][bj] = *(const u32x4*)(BB + (size_t)row * DM + col + bj * HALF); } }
            if (!FROM_X) asm volatile("" ::: "memory");
#pragma unroll
            for (int m = 0; m < 4; ++m) { const int row = u.pm * BM + ai * HALF + wr * 64 + m * 16 + fr; float s = 0.f;
#pragma unroll
                for (int bj = 0; bj < 2; ++bj) {
                    if (!FROM_X) { const u32x4 w = bw[m][bj]; b0[m][bj] = (f32x4){bflo(w.x), bfhi(w.x), bflo(w.y), bfhi(w.y)}; b1[m][bj] = (f32x4){bflo(w.z), bfhi(w.z), bflo(w.w), bfhi(w.w)}; }
                    const f32x4 v0 = acc[ai][bj][m][0] * sc + b0[m][bj], v1 = acc[ai][bj][m][1] * sc + b1[m][bj];
                    *(u32x4*)(XO + (size_t)row * DM + col + bj * HALF) = pack8(v0, v1);
                    s += (v0[0] * v0[0] + v0[1] * v0[1]) + (v0[2] * v0[2] + v0[3] * v0[3]) + (v1[0] * v1[0] + v1[1] * v1[1]) + (v1[2] * v1[2] + v1[3] * v1[3]); }
                s += __shfl_xor(s, 16); s += __shfl_xor(s, 32);
                if (fq == 0) st_wt(ssq_out + (size_t)row * 16 + u.pn * 4 + wc, s); }
        }
    }
};
struct EpiUp {
    bf16_t* HA; bf16_t* HB; const float* ssq;
    __device__ __forceinline__ const float* rsrc() const { return ssq; }
    __device__ __forceinline__ void operator()(const f32x4 (&acc)[2][2][4][2], const Unit& u, int wr, int wc, int fr, int fq, LAS float* rtab, int tid) const {
        bf16_t* base = u.pm < HID_SPLIT ? HA + (size_t)u.pm * 256 * FF : HB + (size_t)(u.pm - HID_SPLIT) * 256 * FF;
        const int col = u.pn * BM + wc * 32 + 8 * fq;
        EPI_RTAB(ssq);
        EPI_ROWLOOP { const int lr = ai * HALF + wr * 64 + m * 16 + fr; const float r = rtab[lr];
#pragma unroll
            for (int bj = 0; bj < 2; ++bj) { f32x4 v0 = acc[ai][bj][m][0] * r, v1 = acc[ai][bj][m][1] * r;
#pragma unroll
                for (int e = 0; e < 4; ++e) { const float a = fmaxf(v0[e], 0.f), b = fmaxf(v1[e], 0.f); v0[e] = a * a; v1[e] = b * b; }
                *(u32x4*)(base + (size_t)lr * FF + col + bj * HALF) = pack8(v0, v1); } }
    }
};
struct EpiPl {
    bf16_t* PL;
    __device__ __forceinline__ const float* rsrc() const { return nullptr; }
    __device__ __forceinline__ void operator()(const f32x4 (&acc)[2][2][4][2], const Unit& u, int wr, int wc, int fr, int fq, LAS float* rtab, int tid) const {
        const int col = u.pn * BM + wc * 32 + 8 * fq;
        EPI_ROWLOOP { const int row = u.pm * BM + ai * HALF + wr * 64 + m * 16 + fr;
#pragma unroll
            for (int bj = 0; bj < 2; ++bj) *(u32x4*)(PL + (size_t)row * DM + col + bj * HALF) = pack8(acc[ai][bj][m][0], acc[ai][bj][m][1]); }
    }
};
template <bool LAST> struct EpiGate {
    float* HO; const bf16_t* BB; const bf16_t* PL; bf16_t* OB; const float* ssq_in; float* ssq_out; float sc;
    __device__ __forceinline__ const float* rsrc() const { return ssq_in; }
    __device__ __forceinline__ void operator()(const f32x4 (&acc)[2][2][4][2], const Unit& u, int wr, int wc, int fr, int fq, LAS float* rtab, int tid) const {
        const int col = u.pn * BM + wc * 32 + 8 * fq;
        EPI_RTAB(ssq_in);
#pragma unroll
        for (int ai = 0; ai < 2; ++ai) {
            u32x4 bw[4][2], pw[4][2];
#pragma unroll
            for (int m = 0; m < 4; ++m) { const size_t off0 = (size_t)(u.pm * BM + ai * HALF + wr * 64 + m * 16 + fr) * DM + col;
#pragma unroll
                for (int bj = 0; bj < 2; ++bj) { bw[m][bj] = *(const u32x4*)(BB + off0 + bj * HALF); pw[m][bj] = *(const u32x4*)(PL + off0 + bj * HALF); } }
#pragma unroll
            for (int m = 0; m < 4; ++m) { const int lr = ai * HALF + wr * 64 + m * 16 + fr, row = u.pm * BM + lr; const float r = rtab[lr];
                float s = 0.f;
#pragma unroll
                for (int bj = 0; bj < 2; ++bj) { const size_t off = (size_t)row * DM + col + bj * HALF; const u32x4 b_ = bw[m][bj], p_ = pw[m][bj];
                    const f32x4 b0 = {bflo(b_.x), bfhi(b_.x), bflo(b_.y), bfhi(b_.y)}, b1 = {bflo(b_.z), bfhi(b_.z), bflo(b_.w), bfhi(b_.w)};
                    const f32x4 p0 = {bflo(p_.x), bfhi(p_.x), bflo(p_.y), bfhi(p_.y)}, p1 = {bflo(p_.z), bfhi(p_.z), bflo(p_.w), bfhi(p_.w)};
                    f32x4 v0 = acc[ai][bj][m][0] * r, v1 = acc[ai][bj][m][1] * r;
#pragma unroll
                    for (int e = 0; e < 4; ++e) { v0[e] = b0[e] + fsigmoid(v0[e]) * p0[e] * sc; v1[e] = b1[e] + fsigmoid(v1[e]) * p1[e] * sc; }
                    if (LAST) { *(f32x4*)(HO + off) = v0; *(f32x4*)(HO + off + 4) = v1; }
                    else { *(u32x4*)(OB + off) = pack8(v0, v1);
                        s += (v0[0] * v0[0] + v0[1] * v0[1]) + (v0[2] * v0[2] + v0[3] * v0[3]) + (v1[0] * v1[0] + v1[1] * v1[1]) + (v1[2] * v1[2] + v1[3] * v1[3]); } }
                if (!LAST) { s += __shfl_xor(s, 16); s += __shfl_xor(s, 32); if (fq == 0) st_wt(ssq_out + (size_t)row * 16 + u.pn * 4 + wc, s); } }
        }
    }
};
struct EpiKvq {
    bf16_t* KV; bf16_t* Qb; const float* ssq; float *CKP, *CVP, *CKS, *CVS;
    __device__ __forceinline__ const float* rsrc() const { return ssq; }
    __device__ __forceinline__ void operator()(const f32x4 (&acc)[2][2][4][2], const Unit& u, int wr, int wc, int fr, int fq, LAS float* rtab, int tid) const {
        const int pn = u.pn, c = wc * 32 + 8 * fq;
        EPI_RTAB(ssq);
        EPI_ROWLOOP { const int lr = ai * HALF + wr * 64 + m * 16 + fr, row = u.pm * BM + lr; const float r = rtab[lr];
            float* cdst = nullptr;
            if (pn < 2) {
                if (row < MP) { const int b = row >> 13, t = row & (SEQ - 1); if (t >= SEQ - 128) cdst = (pn == 0 ? CKP : CVP) + ((size_t)(b * 128 + t - (SEQ - 128)) * 256 + c); }
                else { const int rs = row - MP, sb = rs >> 3, i = rs & 7; cdst = (pn == 0 ? CKS : CVS) + ((size_t)(sb * 128 + 120 + i) * 256 + c); }
            }
            bf16_t* dst = pn < 2 ? KV + (size_t)row * 512 + pn * 256 + c : Qb + (size_t)row * DM + (pn - 2) * 256 + c;
#pragma unroll
            for (int bj = 0; bj < 2; ++bj) { const f32x4 v0 = acc[ai][bj][m][0] * r, v1 = acc[ai][bj][m][1] * r;
                *(u32x4*)(dst + bj * HALF) = pack8(v0, v1);
                if (cdst) { *(f32x4*)(cdst + bj * HALF) = v0; *(f32x4*)(cdst + bj * HALF + 4) = v1; } } }
    }
};
}


namespace mg {
constexpr int KT = 256, LDT = KT + 8, TILE_B = 64 * LDT * 2;
template <class Epi>
__device__ __forceinline__ void mini_gemm(LAS unsigned char* lds, const bf16_t* A  , const bf16_t* Bt  , int N, int K, int G, int bx, const Epi& E) {
    const int tid = threadIdx.x, lane = tid & 63, wave = __builtin_amdgcn_readfirstlane(tid >> 6), l15 = lane & 15, g = lane >> 4;
    const int rt = wave & 3, chh = wave >> 2, nk = K / KT, units = 16 * (N / 64);
    LAS float* red = (LAS float*)(lds + 4 * TILE_B);
    for (int u = bx; u < units; u += G) {
        const int rm = u & 15, cn = u >> 4;
        const bf16_t* Ag = A + (size_t)(rm * 64) * K; const bf16_t* Bg = Bt + (size_t)(cn * 64) * K;
        u32x4 ra0[4], rb0[4], ra1[4], rb1[4];
#define MG_LOAD(ra, rb, kt) do { _Pragma("unroll") for (int i = 0; i < 4; ++i) { const int c = tid + 512 * i, row = c >> 5, ch = c & 31; \
            ra[i] = *(const u32x4*)(Ag + (size_t)row * K + (kt) * KT + ch * 8); rb[i] = *(const u32x4*)(Bg + (size_t)row * K + (kt) * KT + ch * 8); } } while (0)
#define MG_STORE(ra, rb, b) do { _Pragma("unroll") for (int i = 0; i < 4; ++i) { const int c = tid + 512 * i, row = c >> 5, ch = c & 31; \
            *(LAS u32x4*)(lds + (b) * 2 * TILE_B + (row * LDT + ch * 8) * 2) = ra[i]; *(LAS u32x4*)(lds + (b) * 2 * TILE_B + TILE_B + (row * LDT + ch * 8) * 2) = rb[i]; } } while (0)
#define MG_COMPUTE(b) do { const LAS bf16_t* Al = (const LAS bf16_t*)(lds + (b) * 2 * TILE_B); const LAS bf16_t* Bl = (const LAS bf16_t*)(lds + (b) * 2 * TILE_B + TILE_B); \
            _Pragma("unroll") for (int ks = 0; ks < KT / 32; ++ks) { const bf16x8 Af = *(const LAS bf16x8*)(Al + (16 * rt + l15) * LDT + 32 * ks + 8 * g); \
                _Pragma("unroll") for (int t = 0; t < 2; ++t) { const bf16x8 Bf = *(const LAS bf16x8*)(Bl + (16 * (2 * chh + t) + l15) * LDT + 32 * ks + 8 * g); \
                    acc[t] = __builtin_amdgcn_mfma_f32_16x16x32_bf16(Bf, Af, acc[t], 0, 0, 0); } } } while (0)
        f32x4 acc[2] = {(f32x4){0.f, 0.f, 0.f, 0.f}, (f32x4){0.f, 0.f, 0.f, 0.f}};
#define MG_BAR() do { asm volatile("s_waitcnt lgkmcnt(0)" ::: "memory"); __builtin_amdgcn_s_barrier(); asm volatile("" ::: "memory"); } while (0)
        MG_LOAD(ra0, rb0, 0); if (nk > 1) MG_LOAD(ra1, rb1, 1);
        MG_STORE(ra0, rb0, 0); MG_BAR();
        for (int kt = 0; kt < nk; kt += 2) {
            if (kt + 2 < nk) MG_LOAD(ra0, rb0, kt + 2);
            MG_COMPUTE(0);
            if (kt + 1 < nk) MG_STORE(ra1, rb1, 1);
            MG_BAR();
            if (kt + 1 < nk) {
                if (kt + 3 < nk) MG_LOAD(ra1, rb1, kt + 3);
                MG_COMPUTE(1);
                if (kt + 2 < nk) MG_STORE(ra0, rb0, 0);
                MG_BAR();
            }
        }
#undef MG_BAR
        const int row = MP + rm * 64 + 16 * rt + l15; float s = 0.f;
#pragma unroll
        for (int t = 0; t < 2; ++t) { const f32x4 o = E(row, cn * 64 + 16 * (2 * chh + t) + 4 * g, acc[t]); s += (o[0] * o[0] + o[1] * o[1]) + (o[2] * o[2] + o[3] * o[3]); }
        if (Epi::SSQ) { s += __shfl_xor(s, 16); s += __shfl_xor(s, 32); if (g == 0) red[(16 * rt + l15) * 2 + chh] = s;
            __syncthreads();
            if (tid < 64) st_wt(E.ssq_out + (size_t)(MP + rm * 64 + tid) * 16 + cn, red[tid * 2] + red[tid * 2 + 1]);
            __syncthreads(); }
#undef MG_LOAD
#undef MG_STORE
#undef MG_COMPUTE
    }
}
__device__ __forceinline__ u32x2 pack4(const f32x4 v) { u32x2 w; w.x = pk2(v[0], v[1]); w.y = pk2(v[2], v[3]); return w; }
template <bool FROM_X> struct MRes {
    static constexpr bool SSQ = true; const float* X1; const bf16_t* BB; bf16_t* XO; float* ssq_out; float sc;
    __device__ __forceinline__ f32x4 operator()(int row, int col, const f32x4 v) const {
        f32x4 b; if (FROM_X) b = *(const f32x4*)(X1 + (size_t)(row - MP) * DM + col); else { const u32x2 w = *(const u32x2*)(BB + (size_t)row * DM + col); b = (f32x4){bflo(w.x), bfhi(w.x), bflo(w.y), bfhi(w.y)}; }
        const f32x4 o = b + v * sc; *(u32x2*)(XO + (size_t)row * DM + col) = pack4(o); return o; }
};
struct MPl { static constexpr bool SSQ = false; bf16_t* PL; float* ssq_out;
    __device__ __forceinline__ f32x4 operator()(int row, int col, const f32x4 v) const { *(u32x2*)(PL + (size_t)row * DM + col) = pack4(v); return v; } };
struct MUp { static constexpr bool SSQ = false; bf16_t* HS  ; const float* ssq; float* ssq_out;
    __device__ __forceinline__ f32x4 operator()(int row, int col, const f32x4 v) const { const float r = row_r(ssq, row); f32x4 o;
#pragma unroll
        for (int e = 0; e < 4; ++e) { const float a = fmaxf(v[e] * r, 0.f); o[e] = a * a; }
        *(u32x2*)(HS + (size_t)(row - MP) * FF + col) = pack4(o); return o; } };
template <bool LAST> struct MGate { static constexpr bool SSQ = !LAST; float* HO; const bf16_t* BB; const bf16_t* PL; bf16_t* OB; const float* ssq_in; float* ssq_out; float sc;
    __device__ __forceinline__ f32x4 operator()(int row, int col, const f32x4 v) const { const float r = row_r(ssq_in, row); const size_t off = (size_t)row * DM + col;
        const u32x2 bw = *(const u32x2*)(BB + off), pw = *(const u32x2*)(PL + off);
        const f32x4 b = {bflo(bw.x), bfhi(bw.x), bflo(bw.y), bfhi(bw.y)}, p = {bflo(pw.x), bfhi(pw.x), bflo(pw.y), bfhi(pw.y)}; f32x4 o;
#pragma unroll
        for (int e = 0; e < 4; ++e) o[e] = b[e] + fsigmoid(v[e] * r) * p[e] * sc;
        if (LAST) *(f32x4*)(HO + off) = o; else *(u32x2*)(OB + off) = pack4(o); return o; } };
}

constexpr int NWAVES = 8, NTHREADS = 512;
constexpr int RING_BYTES = 131072, LDS_BYTES = 147456;
struct Args { const float* in[26]; float* out; unsigned char* ws; int ph_lo, ph_hi; };

struct TJob { const float* src; int ldw, kk, nblk; bf16_t* dst; const float* gain; float scale; int item; };
__device__ __forceinline__ void p0_tload(const TJob& J, float (&r)[32], int lane) {
    const int kb = J.item / J.nblk, nb = J.item % J.nblk, k0 = 64 * kb, n0 = 32 * nb;
#pragma unroll
    for (int i = 0; i < 32; ++i) r[i] = J.src[(size_t)(k0 + 2 * i + (lane >> 5)) * J.ldw + n0 + (lane & 31)];
}
__device__ __forceinline__ void p0_tfinish(const TJob& J, const float (&r)[32], LAS float* scr, int lane) {
    const int kb = J.item / J.nblk, nb = J.item % J.nblk, k0 = 64 * kb, n0 = 32 * nb, c = lane & 7;
    f32x4 g0 = {1.f, 1.f, 1.f, 1.f}, g1 = g0;
    if (J.gain) { g0 = *(const f32x4*)(J.gain + k0 + 8 * c); g1 = *(const f32x4*)(J.gain + k0 + 8 * c + 4); }
    g0 *= J.scale; g1 *= J.scale;
#pragma unroll
    for (int i = 0; i < 32; ++i) scr[(2 * i + (lane >> 5)) * 33 + (lane & 31)] = r[i];
    asm volatile("s_waitcnt lgkmcnt(0)" ::: "memory");
#pragma unroll
    for (int j = 0; j < 4; ++j) { const int n = (lane >> 3) + 8 * j; const LAS float* sp = scr + (8 * c) * 33 + n;
        u32x4 o; o.x = pk2(sp[0 * 33] * g0.x, sp[1 * 33] * g0.y); o.y = pk2(sp[2 * 33] * g0.z, sp[3 * 33] * g0.w); o.z = pk2(sp[4 * 33] * g1.x, sp[5 * 33] * g1.y); o.w = pk2(sp[6 * 33] * g1.z, sp[7 * 33] * g1.w);
        *(u32x4*)(J.dst + (size_t)(n0 + n) * J.kk + k0 + 8 * c) = o; }
    asm volatile("s_waitcnt lgkmcnt(0)" ::: "memory");
}
__device__ __forceinline__ void cvt_row256(const float* src, bf16_t* dst, int lane) {
    const f32x4 v = *((const f32x4*)src + lane);
    u32x2 w; w.x = pk2(v.x, v.y); w.y = pk2(v.z, v.w);
    *((u32x2*)dst + lane) = w;
}

constexpr int T128 = 144, T256 = 272, TP = 80;
#define LDS_BAR() do { asm volatile("s_waitcnt lgkmcnt(0)" ::: "memory"); __builtin_amdgcn_s_barrier(); asm volatile("" ::: "memory"); } while (0)
struct GlaRegs { u32x4 lg[2], v[4], k[2], q[2]; };
template <bool WITH_Q, bool DO_LKQ = true, bool DO_V = true>
__device__ __forceinline__ void gla_fetch(GlaRegs& R, int item, const bf16_t* Q1, const bf16_t* K1, const bf16_t* V1, const bf16_t* LGp, int tid) {
    const int bh = item >> 7, c = item & 127, b = bh >> 2, h = bh & 3; const size_t row0 = (size_t)b * SEQ + c * 64;
    if (DO_LKQ) {
#pragma unroll
        for (int i = 0; i < 2; ++i) { const int x = tid + NTHREADS * i, j = x >> 4, d8 = (x & 15) * 8; const size_t off = (row0 + j) * NQK + h * 128 + d8;
            R.lg[i] = *(const u32x4*)(LGp + off); R.k[i] = *(const u32x4*)(K1 + off); if (WITH_Q) R.q[i] = *(const u32x4*)(Q1 + off); } }
    if (DO_V) {
#pragma unroll
        for (int i = 0; i < 4; ++i) { const int x = tid + NTHREADS * i, j = x >> 5, e8 = (x & 31) * 8; R.v[i] = *(const u32x4*)(V1 + (row0 + j) * NV + h * 256 + e8); } }
}
__device__ __forceinline__ void gla_stage_lg_v(const GlaRegs& R, LAS float* bc, LAS bf16_t* vt, int tid) {
#pragma unroll
    for (int i = 0; i < 2; ++i) { const int x = tid + NTHREADS * i, j = x >> 4, d8 = (x & 15) * 8; const u32x4 w = R.lg[i];
        *(LAS f32x4*)(bc + j * 128 + d8) = (f32x4){bflo(w.x), bfhi(w.x), bflo(w.y), bfhi(w.y)}; *(LAS f32x4*)(bc + j * 128 + d8 + 4) = (f32x4){bflo(w.z), bfhi(w.z), bflo(w.w), bfhi(w.w)}; }
#pragma unroll
    for (int i = 0; i < 4; ++i) { const int x = tid + NTHREADS * i, j = x >> 5, e8 = (x & 31) * 8; *(LAS u32x4*)(vt + j * T256 + e8) = R.v[i]; }
    LDS_BAR();
    if (tid < 128) { float s = 0.f;
#pragma unroll 8
        for (int j = 0; j < 64; ++j) { s += bc[j * 128 + tid]; bc[j * 128 + tid] = s; } }
    LDS_BAR();
}
constexpr int NSUP = 32, NSUP_ALL = NBH * NSUP;
template <bool OUT>
__device__ __forceinline__ void gla_super_phase(LAS unsigned char* lds, int G, int bx, const bf16_t* Q1, const bf16_t* K1, const bf16_t* V1, const bf16_t* G1, const bf16_t* LGp, bf16_t* US, float* DVS,
                                                const float* ogain, bf16_t* OG, int tid, int lane, int wave) {
    LAS float* bc = (LAS float*)lds;
    LAS bf16_t* Pm = (LAS bf16_t*)lds;
    LAS bf16_t* qt = (LAS bf16_t*)(lds + 32768);
    LAS bf16_t* kt = qt + 64 * T128;
    LAS bf16_t* kd = kt + 64 * T128;
    LAS bf16_t* vt = kd + 64 * T128;
    LAS float* red = (LAS float*)(lds + 32768 + 3 * 64 * T128 * 2 + 64 * T256 * 2);
    LAS float* em = red + 512;
    LAS float* dvl = em + 128;
    const int l15 = lane & 15, g = lane >> 4, q = l15 >> 2, p = l15 & 3;
    float gn[2] = {0.f, 0.f};
    if (OUT) {
#pragma unroll
        for (int t = 0; t < 2; ++t) gn[t] = ogain[16 * (2 * wave + t) + l15]; }
    GlaRegs R;
    if (bx < NSUP_ALL) gla_fetch<OUT>(R, (bx >> 5) * NCHUNK + (bx & 31) * 4, Q1, K1, V1, LGp, tid);
    for (int item = bx; item < NSUP_ALL; item += G) {
        const int bh = item >> 5, sc = item & 31, b = bh >> 2, h = bh & 3;
        f32x4 S[8][2];
        if (OUT) {
#pragma unroll
            for (int dt = 0; dt < 8; ++dt)
#pragma unroll
                for (int t = 0; t < 2; ++t) { const u32x2 w = *(const u32x2*)(US + ((size_t)item * 256 + 16 * (2 * wave + t) + l15) * 128 + 16 * dt + 4 * g); S[dt][t] = (f32x4){bflo(w.x), bfhi(w.x), bflo(w.y), bfhi(w.y)}; }
        } else {
#pragma unroll
            for (int dt = 0; dt < 8; ++dt) { S[dt][0] = (f32x4){0.f, 0.f, 0.f, 0.f}; S[dt][1] = (f32x4){0.f, 0.f, 0.f, 0.f}; } }
        float lsum = 0.f;
        for (int cc = 0; cc < 4; ++cc) {
            const int c = sc * 4 + cc; const size_t row0 = (size_t)b * SEQ + c * 64;
            gla_stage_lg_v(R, bc, vt, tid);
#pragma unroll
            for (int i = 0; i < 2; ++i) { const int x = tid + NTHREADS * i, j = x >> 4, d8 = (x & 15) * 8; const u32x4 wk = R.k[i];
                float kv[8] = {bflo(wk.x), bfhi(wk.x), bflo(wk.y), bfhi(wk.y), bflo(wk.z), bfhi(wk.z), bflo(wk.w), bfhi(wk.w)};
                float cur[8], dd[8];
#pragma unroll
                for (int t = 0; t < 8; ++t) { cur[t] = bc[j * 128 + d8 + t]; dd[t] = kv[t] * fexp(bc[63 * 128 + d8 + t] - cur[t]); }
                u32x4 o; o.x = pk2(dd[0], dd[1]); o.y = pk2(dd[2], dd[3]); o.z = pk2(dd[4], dd[5]); o.w = pk2(dd[6], dd[7]); *(LAS u32x4*)(kd + j * T128 + d8) = o;
                if (OUT) { const u32x4 wq = R.q[i];
                    float qv[8] = {bflo(wq.x), bfhi(wq.x), bflo(wq.y), bfhi(wq.y), bflo(wq.z), bfhi(wq.z), bflo(wq.w), bfhi(wq.w)};
                    float a[8], bb[8];
#pragma unroll
                    for (int t = 0; t < 8; ++t) { const float mid = bc[31 * 128 + d8 + t]; a[t] = qv[t] * fexp(cur[t] - mid); bb[t] = kv[t] * fexp(mid - cur[t]); }
                    o.x = pk2(a[0], a[1]); o.y = pk2(a[2], a[3]); o.z = pk2(a[4], a[5]); o.w = pk2(a[6], a[7]); *(LAS u32x4*)(qt + j * T128 + d8) = o;
                    o.x = pk2(bb[0], bb[1]); o.y = pk2(bb[2], bb[3]); o.z = pk2(bb[4], bb[5]); o.w = pk2(bb[6], bb[7]); *(LAS u32x4*)(kt + j * T128 + d8) = o; } }
            if (tid < 128) { const float last = bc[63 * 128 + tid]; dvl[tid] = fexp(last); lsum += last; if (OUT) em[tid] = fexp(bc[31 * 128 + tid]); }
            const int nxt_ = (cc < 3) ? bh * NCHUNK + c + 1 : (item + G < NSUP_ALL ? ((item + G) >> 5) * NCHUNK + ((item + G) & 31) * 4 : -1);
            if (nxt_ >= 0) gla_fetch<OUT, true, false>(R, nxt_, Q1, K1, V1, LGp, tid);
            LDS_BAR();
            if (OUT) {
#pragma unroll
                for (int t = 0; t < 2; ++t) { const int id = 2 * wave + t, ti = id >> 2, tj = id & 3;
                    f32x4 a = {0.f, 0.f, 0.f, 0.f};
                    if (tj <= ti) {
#pragma unroll
                        for (int ks = 0; ks < 4; ++ks) { const bf16x8 Af = *(const LAS bf16x8*)(qt + (16 * ti + l15) * T128 + 32 * ks + 8 * g), Bf = *(const LAS bf16x8*)(kt + (16 * tj + l15) * T128 + 32 * ks + 8 * g);
                            a = __builtin_amdgcn_mfma_f32_16x16x32_bf16(Af, Bf, a, 0, 0, 0); } }
#pragma unroll
                    for (int r = 0; r < 4; ++r) { const int i = 16 * ti + 4 * g + r, j = 16 * tj + l15; const float v = (j <= i) ? a[r] : 0.f; Pm[i * TP + j] = (bf16_t)(pk2(v, 0.f) & 0xffffu); }
                }
                LDS_BAR();
                f32x4 o[4][2];
#pragma unroll
                for (int ti = 0; ti < 4; ++ti) { o[ti][0] = (f32x4){0.f, 0.f, 0.f, 0.f}; o[ti][1] = (f32x4){0.f, 0.f, 0.f, 0.f}; }
#pragma unroll
                for (int ks = 0; ks < 2; ++ks) {
                    bf16x8 Bf[2];
#pragma unroll
                    for (int t = 0; t < 2; ++t) { const LAS bf16_t* a0 = vt + (32 * ks + 8 * g + q) * T256 + 16 * (2 * wave + t) + 4 * p; Bf[t] = cat8(trd(a0), trd(a0 + 4 * T256)); }
#pragma unroll
                    for (int ti = 2 * ks; ti < 4; ++ti) { const bf16x8 Af = *(const LAS bf16x8*)(Pm + (16 * ti + l15) * TP + 32 * ks + 8 * g);
#pragma unroll
                        for (int t = 0; t < 2; ++t) o[ti][t] = __builtin_amdgcn_mfma_f32_16x16x32_bf16(Af, Bf[t], o[ti][t], 0, 0, 0); }
                }
#pragma unroll
                for (int ks = 0; ks < 4; ++ks) {
                    const f32x4 e0 = *(LAS f32x4*)(em + 32 * ks + 4 * g), e1 = *(LAS f32x4*)(em + 32 * ks + 16 + 4 * g);
                    bf16x8 Bf[2];
#pragma unroll
                    for (int t = 0; t < 2; ++t) { const f32x4 s0 = S[2 * ks][t] * e0, s1 = S[2 * ks + 1][t] * e1; u32x4 w; w.x = pk2(s0[0], s0[1]); w.y = pk2(s0[2], s0[3]); w.z = pk2(s1[0], s1[1]); w.w = pk2(s1[2], s1[3]); Bf[t] = __builtin_bit_cast(bf16x8, w); }
#pragma unroll
                    for (int ti = 0; ti < 4; ++ti) { const LAS bf16_t* ap = qt + (16 * ti + l15) * T128 + 32 * ks + 4 * g;
                        const u32x2 a0 = *(const LAS u32x2*)ap, a1 = *(const LAS u32x2*)(ap + 16); u32x4 aw; aw.x = a0.x; aw.y = a0.y; aw.z = a1.x; aw.w = a1.y; const bf16x8 Af = __builtin_bit_cast(bf16x8, aw);
#pragma unroll
                        for (int t = 0; t < 2; ++t) o[ti][t] = __builtin_amdgcn_mfma_f32_16x16x32_bf16(Af, Bf[t], o[ti][t], 0, 0, 0); }
                }
#pragma unroll
                for (int ti = 0; ti < 4; ++ti)
#pragma unroll
                    for (int r = 0; r < 4; ++r) { float s = o[ti][0][r] * o[ti][0][r] + o[ti][1][r] * o[ti][1][r];
                        s += __shfl_xor(s, 1); s += __shfl_xor(s, 2); s += __shfl_xor(s, 4); s += __shfl_xor(s, 8);
                        if (l15 == 0) red[(16 * ti + 4 * g + r) * 8 + wave] = s; }
                LDS_BAR();
#pragma unroll
                for (int ti = 0; ti < 4; ++ti)
#pragma unroll
                    for (int r = 0; r < 4; ++r) { const int i = 16 * ti + 4 * g + r; const f32x4 r0 = *(LAS f32x4*)(red + i * 8), r1 = *(LAS f32x4*)(red + i * 8 + 4);
                        const float rms = frsq(((r0.x + r0.y) + (r0.z + r0.w) + (r1.x + r1.y) + (r1.z + r1.w)) * (1.f / 256.f) + EPS);
#pragma unroll
                        for (int t = 0; t < 2; ++t) { const size_t off = (row0 + i) * NV + h * 256 + 16 * (2 * wave + t) + l15; const float gv = bf2f(G1[off]);
                            OG[off] = (bf16_t)(pk2(o[ti][t][r] * rms * gn[t] * gv * fsigmoid(gv), 0.f) & 0xffffu); } }
            }
            if (nxt_ >= 0) gla_fetch<OUT, false, true>(R, nxt_, Q1, K1, V1, LGp, tid);
#pragma unroll
            for (int dt = 0; dt < 8; ++dt) { const f32x4 dvv = *(LAS f32x4*)(dvl + 16 * dt + 4 * g); S[dt][0] *= dvv; S[dt][1] *= dvv; }
#pragma unroll
            for (int ks = 0; ks < 2; ++ks) {
                bf16x8 Bf[2];
#pragma unroll
                for (int t = 0; t < 2; ++t) { const LAS bf16_t* a0 = vt + (32 * ks + 8 * g + q) * T256 + 16 * (2 * wave + t) + 4 * p; Bf[t] = cat8(trd(a0), trd(a0 + 4 * T256)); }
#pragma unroll
                for (int dt = 0; dt < 8; ++dt) { const LAS bf16_t* a0 = kd + (32 * ks + 8 * g + q) * T128 + 16 * dt + 4 * p; const bf16x8 Af = cat8(trd(a0), trd(a0 + 4 * T128));
#pragma unroll
                    for (int t = 0; t < 2; ++t) S[dt][t] = __builtin_amdgcn_mfma_f32_16x16x32_bf16(Af, Bf[t], S[dt][t], 0, 0, 0); }
            }
            LDS_BAR();
        }
        if (!OUT) {
#pragma unroll
            for (int dt = 0; dt < 8; ++dt)
#pragma unroll
                for (int t = 0; t < 2; ++t) { u32x2 w; w.x = pk2(S[dt][t][0], S[dt][t][1]); w.y = pk2(S[dt][t][2], S[dt][t][3]);
                    *(u32x2*)(US + ((size_t)item * 256 + 16 * (2 * wave + t) + l15) * 128 + 16 * dt + 4 * g) = w; }
            if (tid < 128) DVS[(size_t)item * 128 + tid] = fexp(lsum);
        }
    }
}
template <int NSTEP>
__device__ __forceinline__ void gla_scan(bf16_t* UT, const float* DV, float* state_out, int gtid, int gthreads) {
    for (int idx = gtid; idx < NBH * 256 * 64; idx += gthreads) {
        const int bh = idx >> 14, rem = idx & 16383, e = rem >> 6, dp = rem & 63;
        unsigned* base = (unsigned*)UT + (size_t)bh * NSTEP * 16384 + e * 64 + dp;
        const float* dv = DV + (size_t)bh * NSTEP * 128 + 2 * dp;
        float s0 = 0.f, s1 = 0.f;
        for (int c0 = 0; c0 < NSTEP; c0 += 32) {
            unsigned uu[32]; f32x2 dd[32];
#pragma unroll
            for (int k = 0; k < 32; ++k) { uu[k] = base[(size_t)(c0 + k) * 16384]; dd[k] = *(const f32x2*)(dv + (size_t)(c0 + k) * 128); }
#pragma unroll
            for (int k = 0; k < 32; ++k) { base[(size_t)(c0 + k) * 16384] = pk2(s0, s1); s0 = dd[k].x * s0 + bflo(uu[k]); s1 = dd[k].y * s1 + bfhi(uu[k]); }
        }
        float* so = state_out + ((size_t)bh * 128 + 2 * dp) * 256 + e;
        st_wt(so, s0); st_wt(so + 256, s1);
    }
}
__device__ __forceinline__ void gla_sample_pair(LAS unsigned char* lds, int base_item, const bf16_t* Q1, const bf16_t* K1, const bf16_t* V1, const bf16_t* G1, const bf16_t* LGp,
                                                const float* S0in, float* Sout, const float* ogain, bf16_t* OG, int tid) {
    const int hb = tid >> 8, t = tid & 255, item = base_item + hb, sb = item >> 2, h = item & 3; const size_t r0 = (size_t)MP + sb * 8;
    LAS float* qaT = (LAS float*)(lds + hb * 16384);
    LAS float* qsT = qaT + 1024, *kdT = qsT + 1024, *dvs = kdT + 1024, *att = dvs + 128, *red = att + 64;
    if (t < 128) { const int d = t; float bcv[8], s = 0.f;
#pragma unroll
        for (int i = 0; i < 8; ++i) { s += bf2f(LGp[(r0 + i) * NQK + h * 128 + d]); bcv[i] = s; }
#pragma unroll
        for (int i = 0; i < 8; ++i) { const float qv = bf2f(Q1[(r0 + i) * NQK + h * 128 + d]), kv = bf2f(K1[(r0 + i) * NQK + h * 128 + d]);
            qaT[d * 8 + i] = qv * fexp(bcv[i] - bcv[7]); qsT[d * 8 + i] = qv * fexp(bcv[i]); kdT[d * 8 + i] = kv * fexp(bcv[7] - bcv[i]); }
        dvs[d] = fexp(bcv[7]); }
    __syncthreads();
    if (t < 64) { const int i = t >> 3, j = t & 7; float s = 0.f;
        for (int d = 0; d < 128; ++d) s += qaT[d * 8 + i] * kdT[d * 8 + j];
        att[t] = (j <= i) ? s : 0.f; }
    __syncthreads();
    const int e = t; float v[8], o[8];
#pragma unroll
    for (int j = 0; j < 8; ++j) { v[j] = bf2f(V1[(r0 + j) * NV + h * 256 + e]); o[j] = 0.f; }
    const float* S0 = S0in + ((size_t)item * 128) * 256 + e; float* SO = Sout + ((size_t)item * 128) * 256 + e;
    for (int d0 = 0; d0 < 128; d0 += 32) { float sv[32];
#pragma unroll
        for (int k = 0; k < 32; ++k) sv[k] = __builtin_nontemporal_load(S0 + (size_t)(d0 + k) * 256);
#pragma unroll
        for (int k = 0; k < 32; ++k) { const int d = d0 + k; const f32x4 qa = *(LAS f32x4*)(qsT + d * 8), qb = *(LAS f32x4*)(qsT + d * 8 + 4), ka = *(LAS f32x4*)(kdT + d * 8), kb = *(LAS f32x4*)(kdT + d * 8 + 4);
            o[0] += qa.x * sv[k]; o[1] += qa.y * sv[k]; o[2] += qa.z * sv[k]; o[3] += qa.w * sv[k]; o[4] += qb.x * sv[k]; o[5] += qb.y * sv[k]; o[6] += qb.z * sv[k]; o[7] += qb.w * sv[k];
            __builtin_nontemporal_store(dvs[d] * sv[k] + ((ka.x * v[0] + ka.y * v[1]) + (ka.z * v[2] + ka.w * v[3])) + ((kb.x * v[4] + kb.y * v[5]) + (kb.z * v[6] + kb.w * v[7])), SO + (size_t)d * 256); }
    }
#pragma unroll
    for (int i = 0; i < 8; ++i)
#pragma unroll
        for (int j = 0; j <= i; ++j) o[i] += att[i * 8 + j] * v[j];
    const int wv = t >> 6;
#pragma unroll
    for (int i = 0; i < 8; ++i) { const float s = wave_sum(o[i] * o[i]); if ((t & 63) == 0) red[i * 4 + wv] = s; }
    __syncthreads();
    const float gn = ogain[e];
#pragma unroll
    for (int i = 0; i < 8; ++i) { const f32x4 rr = *(LAS f32x4*)(red + i * 4); const float rms = frsq(((rr.x + rr.y) + (rr.z + rr.w)) * (1.f / 256.f) + EPS);
        const size_t off = (r0 + i) * NV + h * 256 + e; const float gv = bf2f(G1[off]);
        OG[off] = (bf16_t)(pk2(o[i] * rms * gn * gv * fsigmoid(gv), 0.f) & 0xffffu); }
    __syncthreads();
}

constexpr int VT_LD = 72;
struct AttnP { const bf16_t* KV; const bf16_t* Qb; bf16_t* AO; const float* pk; const float* pv; float* ock; float* ocv; const float* sinks; const float* relb; };
constexpr int ATT_BUF = 32768 + 256 * VT_LD * 2 + 2048;
struct AttnRegs { u32x4 a[12]; };
#define ATT_DECODE(item) const bool smp = (item) >= 512; int b, kh, qblk, sb = 0; \
    if (!smp) { b = (item) >> 8; kh = ((item) >> 6) & 3; qblk = (item) & 63; } else { const int it_ = (item) - 512; sb = it_ >> 2; kh = it_ & 3; b = 0; qblk = 1; } \
    const long s0 = (long)b * SEQ + (long)qblk * 128; (void)s0; (void)sb
__device__ __forceinline__ void attn_load(int item, const AttnP& P, AttnRegs& R, int tid) {
    ATT_DECODE(item);
    if (!smp) {
#pragma unroll
        for (int j = 0; j < 4; ++j) { const int i = tid + NTHREADS * j, row = i >> 3, ch = i & 7; u32x4 wk = {0u, 0u, 0u, 0u}, wv = {0u, 0u, 0u, 0u};
            if (qblk > 0 || row >= 128) { const bf16_t* src = P.KV + (size_t)(s0 - 128 + row) * 512 + kh * 64 + ch * 8; wk = *(const u32x4*)src; wv = *(const u32x4*)(src + 256); }
            R.a[j] = wk; R.a[4 + j] = wv; }
    } else {
#pragma unroll
        for (int j = 0; j < 3; ++j) { const int i = tid + NTHREADS * j, row = i >> 3, ch = i & 7;
            u32x4 z = {0u, 0u, 0u, 0u}; R.a[4 * j] = z; R.a[4 * j + 1] = z; R.a[4 * j + 2] = z; R.a[4 * j + 3] = z;
            if (row < 128) { const size_t so = ((size_t)(sb * 128 + row) * 4 + kh) * 64 + ch * 8;
                R.a[4 * j] = *(const u32x4*)(P.pk + so); R.a[4 * j + 1] = *(const u32x4*)(P.pk + so + 4); R.a[4 * j + 2] = *(const u32x4*)(P.pv + so); R.a[4 * j + 3] = *(const u32x4*)(P.pv + so + 4); }
            else if (row < 136) { const bf16_t* src = P.KV + (size_t)(MP + sb * 8 + row - 128) * 512 + kh * 64 + ch * 8; R.a[4 * j] = *(const u32x4*)src; R.a[4 * j + 1] = *(const u32x4*)(src + 256); } }
    }
}
__device__ __forceinline__ void attn_stage(LAS unsigned char* lds, int item, const AttnP& P, const AttnRegs& R, int tid) {
    LAS unsigned char* Kt = lds; LAS bf16_t* Vt = (LAS bf16_t*)(lds + 32768); LAS float* bias2 = (LAS float*)(lds + 32768 + 256 * VT_LD * 2);
    ATT_DECODE(item);
    if (!smp) {
#pragma unroll
        for (int j = 0; j < 4; ++j) { const int i = tid + NTHREADS * j, row = i >> 3, ch = i & 7;
            *(LAS u32x4*)(Kt + row * 128 + ((ch ^ (row & 7)) << 4)) = R.a[j]; *(LAS u32x4*)(Vt + row * VT_LD + ch * 8) = R.a[4 + j]; }
    } else {
#pragma unroll
        for (int j = 0; j < 3; ++j) { const int i = tid + NTHREADS * j, row = i >> 3, ch = i & 7;
            if (i < 144 * 8) { u32x4 wk = R.a[4 * j], wv = R.a[4 * j + 1];
                if (row < 128) { const f32x4 k0 = __builtin_bit_cast(f32x4, R.a[4 * j]), k1 = __builtin_bit_cast(f32x4, R.a[4 * j + 1]), v0 = __builtin_bit_cast(f32x4, R.a[4 * j + 2]), v1 = __builtin_bit_cast(f32x4, R.a[4 * j + 3]);
                    wk = pg8::pack8(k0, k1); wv = pg8::pack8(v0, v1);
                    if (row >= 8) { const size_t oo = ((size_t)(sb * 128 + row - 8) * 4 + kh) * 64 + ch * 8;
                        *(f32x4*)(P.ock + oo) = k0; *(f32x4*)(P.ock + oo + 4) = k1; *(f32x4*)(P.ocv + oo) = v0; *(f32x4*)(P.ocv + oo + 4) = v1; } }
                *(LAS u32x4*)(Kt + row * 128 + ((ch ^ (row & 7)) << 4)) = wk; *(LAS u32x4*)(Vt + row * VT_LD + ch * 8) = wv; } }
    }
    { const int hl = tid >> 7, dist = tid & 127; int bk = dist;
      if (dist >= 16) { bk = 16 + (int)(__logf((float)dist * (1.f / 16.f)) * (16.f / 2.0794415416798357f)); bk = bk > 31 ? 31 : bk; }
      bias2[tid] = P.relb[bk * 16 + kh * 4 + hl] * LOG2E; }
}
__device__ __forceinline__ void attn_compute(LAS unsigned char* lds, int item, const AttnP& P, int lane, int wave) {
    LAS unsigned char* Kt = lds; LAS bf16_t* Vt = (LAS bf16_t*)(lds + 32768); LAS float* bias2 = (LAS float*)(lds + 32768 + 256 * VT_LD * 2);
    ATT_DECODE(item);
    const int l15 = lane & 15, g = lane >> 4, q = l15 >> 2, p = l15 & 3;
    const int ntq = smp ? (wave < 2 ? 1 : 0) : 4;
    for (int tq = 0; tq < ntq; ++tq) {
        const int qtile = smp ? 0 : (wave & 1) * 4 + tq;
        int hl_q, ioff; size_t qrow;
        if (!smp) { hl_q = wave >> 1; ioff = l15; qrow = (size_t)(s0 + 16 * qtile + l15); }
        else { hl_q = 2 * wave + (l15 >> 3); ioff = l15 & 7; qrow = (size_t)MP + sb * 8 + (l15 & 7); }
        const bf16_t* qp = P.Qb + qrow * DM + (kh * 4 + hl_q) * 64 + 8 * g;
        const bf16x8 Qf0 = *(const bf16x8*)qp, Qf1 = *(const bf16x8*)(qp + 32);
        f32x4 st[9];
#pragma unroll
        for (int j = 0; j < 9; ++j) { const int row = 16 * (qtile + j) + l15; const LAS unsigned char* kr = Kt + row * 128;
            const bf16x8 K0 = *(const LAS bf16x8*)(kr + ((g ^ (row & 7)) << 4)), K1f = *(const LAS bf16x8*)(kr + (((4 + g) ^ (row & 7)) << 4));
            f32x4 a = {0.f, 0.f, 0.f, 0.f};
            a = __builtin_amdgcn_mfma_f32_16x16x32_bf16(K0, Qf0, a, 0, 0, 0); a = __builtin_amdgcn_mfma_f32_16x16x32_bf16(K1f, Qf1, a, 0, 0, 0);
            st[j] = a; }
        const float sink2 = P.sinks[kh * 4 + hl_q] * LOG2E;
        float mx = sink2;
#pragma unroll
        for (int j = 0; j < 9; ++j)
#pragma unroll
            for (int r = 0; r < 4; ++r) { const int dist = 128 + ioff - 16 * j - 4 * g - r; const bool ok = (dist >= 0) && (dist < 128) && (smp || qblk > 0 || (16 * (qtile + j) + 4 * g + r) >= 128);
                const float v = ok ? st[j][r] + bias2[hl_q * 128 + (dist & 127)] : -INFINITY; st[j][r] = v; mx = fmaxf(mx, v); }
        mx = fmaxf(mx, __shfl_xor(mx, 16)); mx = fmaxf(mx, __shfl_xor(mx, 32));
        float sum = 0.f;
#pragma unroll
        for (int j = 0; j < 9; ++j)
#pragma unroll
            for (int r = 0; r < 4; ++r) { const float e = __builtin_amdgcn_exp2f(st[j][r] - mx); st[j][r] = e; sum += e; }
        sum += __shfl_xor(sum, 16); sum += __shfl_xor(sum, 32);
        const float inv = frcp(sum + __builtin_amdgcn_exp2f(sink2 - mx));
        f32x4 o[4];
#pragma unroll
        for (int dt = 0; dt < 4; ++dt) o[dt] = (f32x4){0.f, 0.f, 0.f, 0.f};
#pragma unroll
        for (int kk = 0; kk < 5; ++kk) {
            u32x4 pw; pw.x = pk2(st[2 * kk][0], st[2 * kk][1]); pw.y = pk2(st[2 * kk][2], st[2 * kk][3]);
            if (kk < 4) { pw.z = pk2(st[2 * kk + 1][0], st[2 * kk + 1][1]); pw.w = pk2(st[2 * kk + 1][2], st[2 * kk + 1][3]); } else { pw.z = 0u; pw.w = 0u; }
            const bf16x8 Pf = __builtin_bit_cast(bf16x8, pw);
            const LAS bf16_t* v0p = Vt + (16 * (qtile + 2 * kk) + 4 * g + q) * VT_LD + 4 * p;
#pragma unroll
            for (int dt = 0; dt < 4; ++dt) { const s16x4 lo = trd(v0p + 16 * dt); const s16x4 hi = (kk < 4) ? trd(v0p + 16 * VT_LD + 16 * dt) : (s16x4){0, 0, 0, 0};
                o[dt] = __builtin_amdgcn_mfma_f32_16x16x32_bf16(Pf, cat8(lo, hi), o[dt], 0, 0, 0); }
        }
#pragma unroll
        for (int r = 0; r < 4; ++r) { const int ql = 4 * g + r; const float iv = __shfl(inv, ql);
            size_t orow; int hh;
            if (!smp) { orow = (size_t)(s0 + 16 * qtile + ql); hh = kh * 4 + (wave >> 1); } else { orow = (size_t)MP + sb * 8 + (ql & 7); hh = kh * 4 + 2 * wave + (ql >> 3); }
            bf16_t* op = P.AO + orow * DM + hh * 64 + l15;
#pragma unroll
            for (int dt = 0; dt < 4; ++dt) op[16 * dt] = (bf16_t)(pk2(o[dt][r] * iv, 0.f) & 0xffffu); }
    }
}


#define XB_TMO      128
#define XB_XCNT(j)  (256  + 64 * (j))
#define XB_XSUB(j)  (1280 + 64 * (j))
#define XB_XGEN(j)  (2304 + 64 * (j))
#define XB_TOP      3328
#define XB_TOPGEN   3392
#define XCD_BAR_WORDS 3456
#define XB_SPIN_CAP (1u << 20)
__device__ __forceinline__ unsigned xb_ld(unsigned* p)              { return __hip_atomic_load(p, __ATOMIC_RELAXED, __HIP_MEMORY_SCOPE_AGENT); }
__device__ __forceinline__ unsigned xb_add(unsigned* p, unsigned v) { return __hip_atomic_fetch_add(p, v, __ATOMIC_RELAXED, __HIP_MEMORY_SCOPE_AGENT); }
__device__ __forceinline__ unsigned xb_xcc_id() { return (unsigned)__builtin_amdgcn_s_getreg((3 << 11) | 20) & 0xFu; }
#define XB_SPIN(cond, bar) do { unsigned _sp = 0; while (cond) { __builtin_amdgcn_s_sleep(1); \
    if ((++_sp & 255u) == 0u) { if (xb_ld(&(bar)[XB_TMO])) break; if (_sp > XB_SPIN_CAP) { atomicAdd(&(bar)[XB_TMO], 1u); break; } } } } while (0)
struct XcdBarrier { unsigned* bar; unsigned x; volatile LAS unsigned* st; };
__device__ __forceinline__ XcdBarrier xcd_barrier_post(unsigned* bar, volatile LAS unsigned* st) {
    XcdBarrier b; b.bar = bar; b.x = xb_xcc_id(); b.st = st;
    if (threadIdx.x == 0) (void)xb_add(&bar[XB_XCNT(b.x)], 1u);
    return b;
}
__device__ __forceinline__ void xcd_barrier_complete(unsigned* bar, unsigned x, unsigned& nloc, unsigned& nx) {
    const unsigned G = gridDim.x * gridDim.y * gridDim.z;
    unsigned sum, cnt, mine, sp = 0u;
    for (;;) {
        sum = 0u; cnt = 0u; mine = 0u;
#pragma unroll
        for (unsigned j = 0; j < 16; ++j) { const unsigned c = xb_ld(&bar[XB_XCNT(j)]); sum += c; cnt += (c > 0u) ? 1u : 0u; mine = (j == x) ? c : mine; }
        if (sum == G) break;
        __builtin_amdgcn_s_sleep(1);
        if ((++sp & 255u) == 0u) { if (xb_ld(&bar[XB_TMO])) break; if (sp > XB_SPIN_CAP) { atomicAdd(&bar[XB_TMO], 1u); break; } }
    }
    nloc = mine > 0u ? mine : 1u; nx = cnt > 0u ? cnt : 1u;
}
__device__ __forceinline__ void xcd_barrier(const XcdBarrier& b) {
    asm volatile("s_waitcnt vmcnt(0)" ::: "memory");
    __syncthreads();
    if (threadIdx.x == 0) {
        unsigned* bar = b.bar;
        __builtin_amdgcn_s_waitcnt(0);
        unsigned nloc = b.st[0], nx = b.st[1];
        if (nloc == 0u) { xcd_barrier_complete(bar, b.x, nloc, nx); b.st[0] = nloc; b.st[1] = nx; }
        const unsigned old = xb_add(&bar[XB_XSUB(b.x)], 1u);
        const unsigned gen = old / nloc;
        if (old + 1u == (gen + 1u) * nloc) {
            __builtin_amdgcn_fence(__ATOMIC_RELEASE, "agent");
            asm volatile("s_waitcnt vmcnt(0)" ::: "memory");
            const unsigned og = xb_add(&bar[XB_TOP], 1u);
            const unsigned tg = og / nx;
            if (og + 1u == (tg + 1u) * nx) xb_add(&bar[XB_TOPGEN], 1u);
            else XB_SPIN(xb_ld(&bar[XB_TOPGEN]) == tg, bar);
            __builtin_amdgcn_fence(__ATOMIC_ACQUIRE, "agent");
            xb_add(&bar[XB_XGEN(b.x)], 1u);
            asm volatile("s_waitcnt vmcnt(0)" ::: "memory");
        } else {
            XB_SPIN(xb_ld(&bar[XB_XGEN(b.x)]) == gen, bar);
            __builtin_amdgcn_fence(__ATOMIC_ACQUIRE, "agent");
            asm volatile("s_waitcnt vmcnt(0)" ::: "memory");
        }
    }
    __syncthreads();
}

__global__ void __launch_bounds__(NTHREADS, 2) yoco_fwd(Args args) {
    extern __shared__ __attribute__((aligned(16))) unsigned char lds_raw[];
    LAS unsigned char* lds = (LAS unsigned char*)lds_raw;
    const int tid = threadIdx.x, lane = tid & 63, wave = __builtin_amdgcn_readfirstlane(tid >> 6), G = gridDim.x, bx = blockIdx.x;
    const int gw = bx * NWAVES + wave, NGW = G * NWAVES;
    typedef const __attribute__((address_space(4))) Args* KArgsP;
    const KArgsP kp0 = (KArgsP)__builtin_amdgcn_kernarg_segment_ptr();
#define KARG(field) ({ KArgsP q_ = kp0; asm volatile("" : "+s"(q_)); q_->field; })
#define ws KARG(ws)
#define out KARG(out)
#define x_prompt KARG(in[0])
#define x_sample KARG(in[1])
#define state_gla KARG(in[2])
#define cache_k KARG(in[3])
#define cache_v KARG(in[4])
#define p_prompt KARG(in[5])
#define p_sample KARG(in[6])
#define norm_mix KARG(in[7])
#define norm_mlp KARG(in[8])
#define norm_ple KARG(in[9])
#define norm_kv KARG(in[10])
#define norm_final KARG(in[11])
#define w_in_a KARG(in[12])
#define w_a2 KARG(in[13])
#define b_a2 KARG(in[14])
#define gla_o_gain KARG(in[15])
#define w_out_a KARG(in[16])
#define w_kv KARG(in[17])
#define w_q_b KARG(in[18])
#define w_o_b KARG(in[19])
#define sinks KARG(in[20])
#define rel_bias KARG(in[21])
#define w_up KARG(in[22])
#define w_down KARG(in[23])
#define w_ple KARG(in[24])
#define w_ple_gate KARG(in[25])
#define W_IN ((bf16_t*)(ws + WS_W_IN))
#define W_OUT ((bf16_t*)(ws + WS_W_OUT))
#define W_KVQ ((bf16_t*)(ws + WS_W_KVQ))
#define W_O ((bf16_t*)(ws + WS_W_O))
#define XB ((bf16_t*)(ws + WS_XB))
#define PB ((bf16_t*)(ws + WS_PB))
#define Q1 ((bf16_t*)(ws + WS_Q1))
#define K1 ((bf16_t*)(ws + WS_K1))
#define V1 ((bf16_t*)(ws + WS_V1))
#define G1 ((bf16_t*)(ws + WS_G1))
#define HIDA ((bf16_t*)(ws + WS_R1))
#define H3B ((bf16_t*)(ws + WS_R1))
#define R3 ((bf16_t*)(ws + WS_R3))
#define HIDS (R3 + (size_t)(64 - HID_SPLIT) * 256 * FF)
#define KVR ((bf16_t*)(ws + WS_KVR))
#define PLQ ((bf16_t*)(ws + WS_PLQ))
#define SSQ0 ((float*)(ws + WS_SSQ))
#define SSQ1 ((float*)(ws + WS_SSQ) + (size_t)M * 16)
#define DV ((float*)(ws + WS_DV))
#define H (out + O_Y)
#define UT ((bf16_t*)(out + O_Y))
    cg::grid_group grid = cg::this_grid();
    volatile LAS unsigned* bst = (volatile LAS unsigned*)(lds + LDS_BYTES - 64);
    if (tid < 2) bst[tid] = 0u;
    __syncthreads();
    XcdBarrier xbar; xbar.bar = nullptr; xbar.x = 0; xbar.st = bst;
#if !MK_SPLIT
    xbar = xcd_barrier_post((unsigned*)(ws + WS_CTL), bst);
#endif
    const int lo = KARG(ph_lo), hi = KARG(ph_hi);
#define IN(k) (lo <= (k) && (k) < hi)
#define SEAM(k) do { if (IN(k) && IN((k) + 1)) { if (MK_SPLIT) grid.sync(); else xcd_barrier(xbar); } } while (0)
    if (lo < 0) grid.sync();

    if (IN(0)) {
        LAS float* scr = (LAS float*)(lds + wave * 16384);
#define TJ_LIST(X) \
        X(w_in_a, IN_A_COLS, DM, 512, W_IN, norm_mix, 0.08838834764831845f)                                     \
        X(w_in_a + 512, IN_A_COLS, DM, 2560, W_IN + (size_t)512 * DM, norm_mix, 1.f)                            \
        X(w_out_a, DM, DM, DM, W_OUT, (const float*)nullptr, 1.f) \
        X(w_up, FF, DM, FF, (bf16_t*)(ws + WS_W_UP0), norm_mlp, 1.f) \
        X(w_up + (size_t)DM * FF, FF, DM, FF, (bf16_t*)(ws + WS_W_UP1), norm_mlp + DM, 1.f) \
        X(w_down, DM, FF, DM, (bf16_t*)(ws + WS_W_DN0), (const float*)nullptr, 1.f) \
        X(w_down + (size_t)DM * FF, DM, FF, DM, (bf16_t*)(ws + WS_W_DN1), (const float*)nullptr, 1.f) \
        X(w_ple_gate, DM, DM, DM, (bf16_t*)(ws + WS_W_G0), norm_ple, 1.f) \
        X(w_ple_gate + (size_t)DM * DM, DM, DM, DM, (bf16_t*)(ws + WS_W_G1), norm_ple + DM, 1.f) \
        X(w_ple, DM, PLE, DM, (bf16_t*)(ws + WS_W_P0), (const float*)nullptr, 1.f) \
        X(w_ple + (size_t)PLE * DM, DM, PLE, DM, (bf16_t*)(ws + WS_W_P1), (const float*)nullptr, 1.f) \
        X(w_kv, 512, DM, 512, W_KVQ, norm_kv, 1.f) \
        X(w_q_b, DM, DM, DM, W_KVQ + (size_t)512 * DM, norm_mix + DM, 0.125f * LOG2E)                          \
        X(w_o_b, DM, DM, DM, W_O, (const float*)nullptr, 1.f)
#define TJ_COUNT(W, LDW, KK, NCOLS, DST, GAIN, SCALE) + ((KK) / 64) * ((NCOLS) / 32)
        constexpr int TJ_TOTAL = 0 TJ_LIST(TJ_COUNT);
#define TJ_DECODE(WP, LDW, KK, NCOLS, DSTP, GAINP, SCALEV) if (!done_ && r_ < ((KK) / 64) * ((NCOLS) / 32)) { jt_.src = (WP); jt_.ldw = (LDW); jt_.kk = (KK); jt_.nblk = (NCOLS) / 32; jt_.dst = (DSTP); jt_.gain = (GAINP); jt_.scale = (SCALEV); jt_.item = r_; done_ = true; } else if (!done_) r_ -= ((KK) / 64) * ((NCOLS) / 32);
#define TJ_GET(JOUT, it) do { int r_ = (it); bool done_ = false; TJob jt_; jt_.src = nullptr; jt_.ldw = 0; jt_.kk = 0; jt_.nblk = 1; jt_.dst = nullptr; jt_.gain = nullptr; jt_.scale = 1.f; jt_.item = 0; TJ_LIST(TJ_DECODE) JOUT = jt_; } while (0)
        { float ra_[32], rb_[32]; TJob Ja, Jb; int it = gw;
          if (it < TJ_TOTAL) { TJ_GET(Ja, it); p0_tload(Ja, ra_, lane); }
          while (it < TJ_TOTAL) {
              const int it1 = it + NGW; if (it1 < TJ_TOTAL) { TJ_GET(Jb, it1); p0_tload(Jb, rb_, lane); }
              p0_tfinish(Ja, ra_, scr, lane);
              if (it1 >= TJ_TOTAL) break;
              const int it2 = it1 + NGW; if (it2 < TJ_TOTAL) { TJ_GET(Ja, it2); p0_tload(Ja, ra_, lane); }
              p0_tfinish(Jb, rb_, scr, lane);
              it = it2; } }
#undef TJ_LIST
#undef TJ_COUNT
#undef TJ_DECODE
#undef TJ_GET
        for (int idx = bx * NTHREADS + tid; idx < 512 * 128; idx += G * NTHREADS) { const int n = idx >> 7, k8 = (idx & 127) * 8; float wa[16];
#pragma unroll
            for (int r = 0; r < 16; ++r) wa[r] = w_a2[r * 512 + n];
            float o8[8];
#pragma unroll
            for (int kk = 0; kk < 8; ++kk) { const float* wr_ = w_in_a + (size_t)(k8 + kk) * IN_A_COLS + 3072; float s = 0.f;
#pragma unroll
                for (int r = 0; r < 16; ++r) s += wr_[r] * wa[r];
                o8[kk] = s * norm_mix[k8 + kk]; }
            u32x4 o; o.x = pk2(o8[0], o8[1]); o.y = pk2(o8[2], o8[3]); o.z = pk2(o8[4], o8[5]); o.w = pk2(o8[6], o8[7]);
            *(u32x4*)(W_IN + (size_t)(3072 + n) * DM + k8) = o; }
        for (int m0 = gw * 4; m0 < M; m0 += NGW * 4) { f32x4 v[4][4]; float s[4];
#pragma unroll
            for (int q = 0; q < 4; ++q) { const int m = m0 + q; const float* xr = m < MP ? x_prompt + (size_t)m * DM : x_sample + (size_t)(m - MP) * DM;
#pragma unroll
                for (int j = 0; j < 4; ++j) v[q][j] = *((const f32x4*)xr + lane + 64 * j); }
#pragma unroll
            for (int q = 0; q < 4; ++q) { const int m = m0 + q; float ss = 0.f;
#pragma unroll
                for (int j = 0; j < 4; ++j) { ss += (v[q][j].x * v[q][j].x + v[q][j].y * v[q][j].y) + (v[q][j].z * v[q][j].z + v[q][j].w * v[q][j].w);
                    u32x2 w; w.x = pk2(v[q][j].x, v[q][j].y); w.y = pk2(v[q][j].z, v[q][j].w); *((u32x2*)(XB + (size_t)m * DM) + lane + 64 * j) = w; }
                s[q] = wave_sum(ss);
                if (lane < 16) SSQ0[(size_t)m * 16 + lane] = lane == 0 ? s[q] : 0.f; } }
        for (int m0 = gw * 8; m0 < M; m0 += NGW * 8) { f32x4 v[8];
#pragma unroll
            for (int q = 0; q < 8; ++q) { const int m = m0 + q; v[q] = *((const f32x4*)(m < MP ? p_prompt + (size_t)m * PLE : p_sample + (size_t)(m - MP) * PLE) + lane); }
#pragma unroll
            for (int q = 0; q < 8; ++q) { u32x2 w; w.x = pk2(v[q].x, v[q].y); w.y = pk2(v[q].z, v[q].w); *((u32x2*)(PB + (size_t)(m0 + q) * PLE) + lane) = w; } }
    }
    SEAM(0);
    if (IN(1)) { pg8::Gemm g{XB, XB, NPAN, W_IN, M, N_IN, DM}; pg8::StaticOrder S; S.init(M, N_IN, G, bx);
        pg8::EpiIn E{Q1, K1, V1, G1, KVR, SSQ0, b_a2}; pg8::gemm_phase(lds, g, S, E); }
    SEAM(1);
    if (IN(2)) {
        for (int base = bx * 2; base < SB * 4; base += G * 2) gla_sample_pair(lds, base, Q1, K1, V1, G1, KVR, state_gla, out + O_SS, gla_o_gain, R3, tid);
        gla_super_phase<false>(lds, G, bx, nullptr, K1, V1, nullptr, KVR, UT, DV, nullptr, nullptr, tid, lane, wave);
    }
    SEAM(2);
    if (IN(3)) gla_scan<NSUP>(UT, DV, out + O_SP, bx * NTHREADS + tid, G * NTHREADS);
    SEAM(3);
    if (IN(4)) { gla_super_phase<true>(lds, G, bx, Q1, K1, V1, G1, KVR, UT, nullptr, gla_o_gain, R3, tid, lane, wave); }
    SEAM(4);
    if (IN(5)) {
        { pg8::Gemm g{R3, R3, NPAN, W_OUT, MP, DM, DM}; pg8::StaticOrder S; S.init(MP, DM, G, bx); pg8::EpiRes<false> E{nullptr, nullptr, XB, XB, SSQ1, 1.f}; pg8::gemm_phase(lds, g, S, E); }
        { pg8::Gemm g{PB, PB, NPAN, (const bf16_t*)(ws + WS_W_P0), MP, DM, PLE}; pg8::StaticOrder S; S.init(MP, DM, G, bx); pg8::EpiPl E{PLQ}; pg8::gemm_phase(lds, g, S, E); }
        { mg::MRes<false> E{nullptr, XB, XB, SSQ1, 1.f}; mg::mini_gemm(lds, R3 + (size_t)MP * DM, W_OUT, DM, DM, G, bx, E); }
        { mg::MPl E{PLQ, nullptr}; mg::mini_gemm(lds, PB + (size_t)MP * PLE, (const bf16_t*)(ws + WS_W_P0), DM, PLE, G, bx, E); }
    }
    SEAM(5);
    if (IN(6)) { { pg8::Gemm g{XB, XB, NPAN, (const bf16_t*)(ws + WS_W_UP0), MP, FF, DM}; pg8::StaticOrder S; S.init(MP, FF, G, bx); pg8::EpiUp E{HIDA, R3, SSQ1}; pg8::gemm_phase(lds, g, S, E); }
        { mg::MUp E{HIDS, SSQ1, nullptr}; mg::mini_gemm(lds, XB + (size_t)MP * DM, (const bf16_t*)(ws + WS_W_UP0), FF, DM, G, bx, E); } }
    SEAM(6);
    if (IN(7)) { { pg8::Gemm g{HIDA, R3, HID_SPLIT, (const bf16_t*)(ws + WS_W_DN0), MP, DM, FF}; pg8::StaticOrder S; S.init(MP, DM, G, bx); pg8::EpiRes<false> E{nullptr, nullptr, XB, XB, SSQ0, 1.f}; pg8::gemm_phase(lds, g, S, E); }
        { mg::MRes<false> E{nullptr, XB, XB, SSQ0, 1.f}; mg::mini_gemm(lds, HIDS, (const bf16_t*)(ws + WS_W_DN0), DM, FF, G, bx, E); } }
    SEAM(7);
    if (IN(8)) { { pg8::Gemm g{XB, XB, NPAN, (const bf16_t*)(ws + WS_W_G0), MP, DM, DM}; pg8::StaticOrder S; S.init(MP, DM, G, bx); pg8::EpiGate<false> E{nullptr, XB, PLQ, H3B, SSQ0, SSQ1, 1.f}; pg8::gemm_phase(lds, g, S, E); }
        { mg::MGate<false> E{nullptr, XB, PLQ, H3B, SSQ0, SSQ1, 1.f}; mg::mini_gemm(lds, XB + (size_t)MP * DM, (const bf16_t*)(ws + WS_W_G0), DM, DM, G, bx, E); } }
    SEAM(8);
    if (IN(9)) { pg8::Gemm g{H3B, H3B, NPAN, W_KVQ, M, NKVQ, DM}; pg8::StaticOrder S; S.init(M, NKVQ, G, bx);
        pg8::EpiKvq E{KVR, PLQ, SSQ1, out + O_CKP, out + O_CVP, out + O_CKS, out + O_CVS}; pg8::gemm_phase(lds, g, S, E); }
    SEAM(9);
    if (IN(10)) {
        const AttnP AP{KVR, PLQ, R3, cache_k, cache_v, out + O_CKS, out + O_CVS, sinks, rel_bias};
        { AttnRegs AR; int buf = 0;
          if (bx < 1024) { attn_load(bx, AP, AR, tid); attn_stage(lds, bx, AP, AR, tid); }
          LDS_BAR();
          for (int it = bx; it < 1024; it += G) { const int nx = it + G;
              if (nx < 1024) attn_load(nx, AP, AR, tid);
              attn_compute(lds + buf * ATT_BUF, it, AP, lane, wave);
              if (nx < 1024) attn_stage(lds + (buf ^ 1) * ATT_BUF, nx, AP, AR, tid);
              LDS_BAR(); buf ^= 1; } }
        for (int m0 = gw * 8; m0 < M; m0 += NGW * 8) { f32x4 v[8];
#pragma unroll
            for (int q = 0; q < 8; ++q) { const int m = m0 + q; v[q] = *((const f32x4*)(m < MP ? p_prompt + (size_t)(MP + m) * PLE : p_sample + (size_t)(MS + m - MP) * PLE) + lane); }
#pragma unroll
            for (int q = 0; q < 8; ++q) { u32x2 w; w.x = pk2(v[q].x, v[q].y); w.y = pk2(v[q].z, v[q].w); *((u32x2*)(PB + (size_t)(m0 + q) * PLE) + lane) = w; } }
    }
    SEAM(10);
    if (IN(11)) {
        { pg8::Gemm g{R3, R3, NPAN, W_O, MP, DM, DM}; pg8::StaticOrder S; S.init(MP, DM, G, bx); pg8::EpiRes<false> E{nullptr, nullptr, H3B, XB, SSQ0, 1.f}; pg8::gemm_phase(lds, g, S, E); }
        { pg8::Gemm g{PB, PB, NPAN, (const bf16_t*)(ws + WS_W_P1), MP, DM, PLE}; pg8::StaticOrder S; S.init(MP, DM, G, bx); pg8::EpiPl E{PLQ}; pg8::gemm_phase(lds, g, S, E); }
        { mg::MRes<false> E{nullptr, H3B, XB, SSQ0, 1.f}; mg::mini_gemm(lds, R3 + (size_t)MP * DM, W_O, DM, DM, G, bx, E); }
        { mg::MPl E{PLQ, nullptr}; mg::mini_gemm(lds, PB + (size_t)MP * PLE, (const bf16_t*)(ws + WS_W_P1), DM, PLE, G, bx, E); }
    }
    SEAM(11);
    if (IN(12)) { { pg8::Gemm g{XB, XB, NPAN, (const bf16_t*)(ws + WS_W_UP1), MP, FF, DM}; pg8::StaticOrder S; S.init(MP, FF, G, bx); pg8::EpiUp E{HIDA, R3, SSQ0}; pg8::gemm_phase(lds, g, S, E); }
        { mg::MUp E{HIDS, SSQ0, nullptr}; mg::mini_gemm(lds, XB + (size_t)MP * DM, (const bf16_t*)(ws + WS_W_UP1), FF, DM, G, bx, E); } }
    SEAM(12);
    if (IN(13)) { { pg8::Gemm g{HIDA, R3, HID_SPLIT, (const bf16_t*)(ws + WS_W_DN1), MP, DM, FF}; pg8::StaticOrder S; S.init(MP, DM, G, bx); pg8::EpiRes<false> E{nullptr, nullptr, XB, XB, SSQ1, 1.f}; pg8::gemm_phase(lds, g, S, E); }
        { mg::MRes<false> E{nullptr, XB, XB, SSQ1, 1.f}; mg::mini_gemm(lds, HIDS, (const bf16_t*)(ws + WS_W_DN1), DM, FF, G, bx, E); } }
    SEAM(13);
    if (IN(14)) { { pg8::Gemm g{XB, XB, NPAN, (const bf16_t*)(ws + WS_W_G1), MP, DM, DM}; pg8::StaticOrder S; S.init(MP, DM, G, bx); pg8::EpiGate<false> E{nullptr, XB, PLQ, H3B, SSQ1, SSQ0, 1.f}; pg8::gemm_phase(lds, g, S, E); }
        { mg::MGate<false> E{nullptr, XB, PLQ, H3B, SSQ1, SSQ0, 1.f}; mg::mini_gemm(lds, XB + (size_t)MP * DM, (const bf16_t*)(ws + WS_W_G1), DM, DM, G, bx, E); } }
    SEAM(14);
    if (IN(15)) {
        f32x4 gn[4];
#pragma unroll
        for (int j = 0; j < 4; ++j) gn[j] = *((const f32x4*)norm_final + lane + 64 * j);
        for (int m0 = gw * 4; m0 < M; m0 += NGW * 4) { u32x2 w[4][4]; float r[4];
#pragma unroll
            for (int q = 0; q < 4; ++q) { r[q] = row_r(SSQ0, m0 + q);
#pragma unroll
                for (int j = 0; j < 4; ++j) w[q][j] = *((const u32x2*)(H3B + (size_t)(m0 + q) * DM) + lane + 64 * j); }
#pragma unroll
            for (int q = 0; q < 4; ++q)
#pragma unroll
                for (int j = 0; j < 4; ++j) { const f32x4 v = {bflo(w[q][j].x), bfhi(w[q][j].x), bflo(w[q][j].y), bfhi(w[q][j].y)};
                    *((f32x4*)(H + (size_t)(m0 + q) * DM) + lane + 64 * j) = v * r[q] * gn[j]; } }
    }
#undef IN
#undef SEAM
}
#undef ws
#undef out
#undef x_prompt
#undef x_sample
#undef state_gla
#undef cache_k
#undef cache_v
#undef p_prompt
#undef p_sample
#undef norm_mix
#undef norm_mlp
#undef norm_ple
#undef norm_kv
#undef norm_final
#undef w_in_a
#undef w_a2
#undef b_a2
#undef gla_o_gain
#undef w_out_a
#undef w_kv
#undef w_q_b
#undef w_o_b
#undef sinks
#undef rel_bias
#undef w_up
#undef w_down
#undef w_ple
#undef w_ple_gate
#undef W_IN
#undef W_OUT
#undef W_KVQ
#undef W_O
#undef XB
#undef PB
#undef Q1
#undef K1
#undef V1
#undef G1
#undef HIDA
#undef H3B
#undef R3
#undef HIDS
#undef KVR
#undef PLQ
#undef SSQ0
#undef SSQ1
#undef DV
#undef H
#undef UT
#undef KARG

extern "C" void kernel_launch(void* const* d_in, const int* in_sizes, int n_in, void* d_out, int out_size, void* d_ws, size_t ws_size, hipStream_t stream) {
    static int grid = 0;
    if (grid == 0) {
        if (n_in != 26 || (size_t)out_size != O_END || ws_size < WS_END) { fprintf(stderr, "kernel_launch: unexpected shapes (n_in %d out %d ws %zu need %zu)\n", n_in, out_size, ws_size, (size_t)WS_END); grid = -1; return; }
        int dev = 0, cus = 0, per_cu = 0;
        hipGetDevice(&dev); hipDeviceGetAttribute(&cus, hipDeviceAttributeMultiprocessorCount, dev);
        hipFuncSetAttribute((const void*)yoco_fwd, hipFuncAttributeMaxDynamicSharedMemorySize, LDS_BYTES);
        hipOccupancyMaxActiveBlocksPerMultiprocessor(&per_cu, (const void*)yoco_fwd, NTHREADS, LDS_BYTES);
        if (per_cu < 1) { fprintf(stderr, "kernel_launch: occupancy query says %d blocks per CU\n", per_cu); per_cu = 1; }
        (void)hipGetLastError();
        grid = cus * 1;
    }
    if (grid < 0) return;
    if (hipMemsetAsync((char*)d_ws + WS_CTL, 0, 65536, stream) != hipSuccess) { fprintf(stderr, "kernel_launch: memset failed\n"); return; }
    Args a{};
    for (int i = 0; i < 26; ++i) a.in[i] = (const float*)d_in[i];
    a.out = (float*)d_out; a.ws = (unsigned char*)d_ws;
#if MK_SPLIT
    for (int ph = 0; ph < 16; ++ph) { a.ph_lo = ph; a.ph_hi = ph + 1; hipLaunchKernelGGL(yoco_fwd, dim3(grid), dim3(NTHREADS), LDS_BYTES, stream, a); }
#else
    a.ph_lo = 0; a.ph_hi = 16;
    void* kargs[] = {&a};
    hipError_t e = hipLaunchCooperativeKernel((const void*)yoco_fwd, dim3(grid), dim3(NTHREADS), kargs, LDS_BYTES, stream);
    if (e != hipSuccess) fprintf(stderr, "cooperative launch failed: %s (grid %d)\n", hipGetErrorString(e), grid);
#endif
}
```

```cpp
#include <hip/hip_runtime.h>
#include <hip/hip_cooperative_groups.h>
#include <cstdio>
#include <cstdint>
namespace cg = cooperative_groups;

#define LAS __attribute__((address_space(3)))
#define GAS __attribute__((address_space(1)))
typedef unsigned short bf16_t;
typedef short bf16x8 __attribute__((ext_vector_type(8)));
typedef short s16x4 __attribute__((ext_vector_type(4)));
typedef float f32x4 __attribute__((ext_vector_type(4)));
typedef float f32x2 __attribute__((ext_vector_type(2)));
typedef unsigned u32x4 __attribute__((ext_vector_type(4)));
typedef unsigned u32x2 __attribute__((ext_vector_type(2)));

#ifndef MK_SPLIT
#define MK_SPLIT 0
#endif

constexpr int DM = 1024, SEQ = 8192, NBATCH = 2, MP = NBATCH * SEQ, SB = 128, SS = 8, MS = SB * SS, M = MP + MS, NPAN = M / 256;
constexpr int NQK = 512, NV = 1024, N_IN = 3584, FF = 4096, PLE = 256, NKVQ = 1536, IN_A_COLS = 3088;
constexpr int NCHUNK = 128, NBH = 8, NCH_ALL = NBH * NCHUNK;
constexpr float EPS = 1e-6f, LOG2E = 1.4426950408889634f;
constexpr int HID_SPLIT = 51;

constexpr size_t O_Y = 0, O_SP = (size_t)M * DM, O_SS = O_SP + 262144, O_CKP = O_SS + 16777216, O_CVP = O_CKP + 65536, O_CKS = O_CVP + 65536, O_CVS = O_CKS + 4194304, O_END = O_CVS + 4194304;

constexpr size_t al256(size_t x) { return (x + 255) & ~(size_t)255; }
constexpr size_t WS_CTL = 0, CTL_BYTES = 1u << 20;
constexpr size_t WS_W_IN = CTL_BYTES;
constexpr size_t WS_W_OUT = WS_W_IN + (size_t)N_IN * DM * 2;
constexpr size_t WS_W_UP0 = WS_W_OUT + (size_t)DM * DM * 2;
constexpr size_t WS_W_DN0 = WS_W_UP0 + (size_t)FF * DM * 2;
constexpr size_t WS_W_UP1 = WS_W_DN0 + (size_t)FF * DM * 2;
constexpr size_t WS_W_DN1 = WS_W_UP1 + (size_t)FF * DM * 2;
constexpr size_t WS_W_G0 = WS_W_DN1 + (size_t)FF * DM * 2;
constexpr size_t WS_W_G1 = WS_W_G0 + (size_t)DM * DM * 2;
constexpr size_t WS_W_P0 = WS_W_G1 + (size_t)DM * DM * 2;
constexpr size_t WS_W_P1 = WS_W_P0 + (size_t)DM * PLE * 2;
constexpr size_t WS_W_KVQ = WS_W_P1 + (size_t)DM * PLE * 2;
constexpr size_t WS_W_O = WS_W_KVQ + (size_t)NKVQ * DM * 2;
constexpr size_t WS_XB = WS_W_O + (size_t)DM * DM * 2;
constexpr size_t WS_PB = WS_XB + (size_t)M * DM * 2;
constexpr size_t WS_R1 = WS_PB + (size_t)M * PLE * 2;
constexpr size_t R1_BYTES = (size_t)HID_SPLIT * 256 * FF * 2;
constexpr size_t WS_Q1 = WS_R1, WS_K1 = WS_Q1 + (size_t)M * NQK * 2, WS_V1 = WS_K1 + (size_t)M * NQK * 2, WS_G1 = WS_V1 + (size_t)M * NV * 2;
static_assert(WS_G1 + (size_t)M * NV * 2 == WS_R1 + R1_BYTES, "R1 map");
constexpr size_t WS_R3 = WS_R1 + R1_BYTES;
static_assert((size_t)(NPAN - HID_SPLIT) * 256 * FF * 2 == (size_t)M * DM * 2, "R3 map");
constexpr size_t WS_KVR = WS_R3 + (size_t)M * DM * 2;
constexpr size_t WS_PLQ = WS_KVR + (size_t)M * NQK * 2;
constexpr size_t WS_SSQ = WS_PLQ + (size_t)M * DM * 2;
constexpr size_t WS_DV = WS_SSQ + (size_t)2 * M * 16 * 4;
constexpr size_t WS_END = WS_DV + (size_t)NCH_ALL * 128 * 4;

__device__ __forceinline__ float bf2f(unsigned short b) { return __uint_as_float((unsigned)b << 16); }
__device__ __forceinline__ float bflo(unsigned w) { return __uint_as_float(w << 16); }
__device__ __forceinline__ float bfhi(unsigned w) { return __uint_as_float(w & 0xffff0000u); }
typedef __bf16 bf16x2_t __attribute__((ext_vector_type(2)));
__device__ __forceinline__ unsigned pk2(float lo, float hi) { const f32x2 v = {lo, hi}; const bf16x2_t b = __builtin_convertvector(v, bf16x2_t); return __builtin_bit_cast(unsigned, b); }
__device__ __forceinline__ float fexp(float x) { return __builtin_amdgcn_exp2f(x * LOG2E); }
__device__ __forceinline__ float frcp(float x) { return __builtin_amdgcn_rcpf(x); }
__device__ __forceinline__ float frsq(float x) { return __builtin_amdgcn_rsqf(x); }
__device__ __forceinline__ float fsigmoid(float x) { return frcp(1.f + fexp(-x)); }
__device__ __forceinline__ float logsig(float x) { return fminf(x, 0.f) - __logf(1.f + fexp(-fabsf(x))); }
__device__ __forceinline__ s16x4 trd(const LAS bf16_t* p) { return __builtin_bit_cast(s16x4, __builtin_amdgcn_ds_read_tr16_b64_v4i16((LAS s16x4*)p)); }
__device__ __forceinline__ bf16x8 cat8(s16x4 lo, s16x4 hi) { return (bf16x8){lo[0], lo[1], lo[2], lo[3], hi[0], hi[1], hi[2], hi[3]}; }
__device__ __forceinline__ void st_wt(float* p, float v) { __hip_atomic_store(p, v, __ATOMIC_RELAXED, __HIP_MEMORY_SCOPE_AGENT); }
__device__ __forceinline__ float wave_sum(float v) {
#pragma unroll
    for (int o = 1; o < 64; o <<= 1) v += __shfl_xor(v, o);
    return v;
}
__device__ __forceinline__ float row_r(const float* ssq, int row) {
    const f32x4* p = (const f32x4*)(ssq + (size_t)row * 16);
    const f32x4 a = p[0], b = p[1], c = p[2], d = p[3];
    const f32x4 s = (a + b) + (c + d);
    return frsq(((s.x + s.y) + (s.z + s.w)) * (1.f / 1024.f) + EPS);
}

namespace pg8 {
constexpr int BM = 256, BK = 64, HALF = 128, HTB = HALF * BK * 2, STAGE_BYTES = 8 * HTB, NXCD = 8, WGM = 8;
__host__ __device__ __forceinline__ int lds_byte(int r, int c) { const int st = (r >> 4) * 2 + (c >> 5), rr = r & 15, cc = c & 31, ob = rr * 64 + cc * 2; return st * 1024 + (ob ^ (((ob >> 9) & 1) << 5)); }
__host__ __device__ __forceinline__ void stage_rc(int b, int& R, int& C) { const int st = b / 1024, sb = b % 1024, swz = sb ^ (((sb >> 9) & 1) << 5); R = (st >> 1) * 16 + swz / 64; C = (st & 1) * 32 + (swz % 64) / 2; }
__host__ __device__ __forceinline__ int perm32(int rho) { const int n = rho >> 4, i = rho & 15; return 8 * (i >> 2) + 4 * n + (i & 3); }
struct Unit { int pm, pn; };
struct Gemm { const bf16_t* A; const bf16_t* A2; int split; const bf16_t* Bt; int M, N, K; };
struct StaticOrder {
    int nM, nN, nwg, G, c;
    __device__ void init(int M_, int N, int G_, int c_) { nM = M_ / BM; nN = N / BM; nwg = nM * nN; G = G_; c = c_; }
    __device__ bool next(int i, Unit& u) const {
        const long L = (long)i * G + c; if (L >= nwg) return false;
        int wgid = (int)L; { const int q = nwg / NXCD, r = nwg % NXCD, xcd = wgid % NXCD, off = wgid / NXCD; wgid = (xcd < r ? xcd * (q + 1) : r * (q + 1) + (xcd - r) * q) + off; }
        const int nig = WGM * nN, gid = wgid / nig, fm = gid * WGM, gsz = (nM - fm) < WGM ? (nM - fm) : WGM;
        u.pm = fm + ((wgid % nig) % gsz); u.pn = (wgid % nig) / gsz; return true;
    }
};

template <class Epi>
__device__ __forceinline__ void gemm_phase(LAS unsigned char* lds, const Gemm g, const StaticOrder& S, const Epi& E) {
    const int tid = threadIdx.x, wid = __builtin_amdgcn_readfirstlane(tid >> 6), lane = tid & 63, wr = wid >> 2, wc = wid & 3, fr = lane & 15, fq = lane >> 4;
    const int K = g.K, nt = K / BK;
    unsigned voffA[2], voffB[2];
#pragma unroll
    for (int i = 0; i < 2; ++i) { int R, C; stage_rc(tid * 16 + i * 8192, R, C); const int Rb = (R & ~31) + perm32(R & 31);
        voffA[i] = (unsigned)(R * K + C) * 2u; voffB[i] = (unsigned)(Rb * K + C) * 2u; }
    const size_t kstep = (size_t)(BK * 2);
    const size_t hstep = (size_t)HALF * K * 2;
    const size_t tstep = 2 * hstep;
    const unsigned ldsw = (unsigned)wid * 1024u;
    const int aoff = lds_byte(wr * 64 + fr, fq * 8), boff = lds_byte(wc * 32 + fr, fq * 8);
#define PG8_APTR(pm) ((pm) < g.split ? (const char*)g.A + (size_t)(pm) * tstep : (const char*)g.A2 + (size_t)((pm) - g.split) * tstep)
#define PG8_SA(b, h) (((b) * 2 + (h)) * HTB)
#define PG8_SB(b, h) ((4 + (b) * 2 + (h)) * HTB)
#define PG8_STAGE(bufoff, gbase, voff) do { _Pragma("unroll") for (int _i = 0; _i < 2; ++_i) \
        __builtin_amdgcn_global_load_lds((const unsigned*)((const char*)(gbase) + (voff)[_i]), (LAS unsigned*)(lds + (bufoff) + ldsw + _i * 8192), 16, 0, 0); } while (0)
#define PG8_LDA(dst, b, h) do { _Pragma("unroll") for (int m = 0; m < 4; ++m) _Pragma("unroll") for (int k = 0; k < 2; ++k) dst[m][k] = *(const LAS bf16x8*)(lds + PG8_SA(b, h) + aoff + m * 2048 + k * 1024); } while (0)
#define PG8_LDB(dst, b, h) do { _Pragma("unroll") for (int n = 0; n < 2; ++n) _Pragma("unroll") for (int k = 0; k < 2; ++k) dst[n][k] = *(const LAS bf16x8*)(lds + PG8_SB(b, h) + boff + n * 2048 + k * 1024); } while (0)
#define PG8_MMA(ai, bj, At, Bt) do { __builtin_amdgcn_s_setprio(1); _Pragma("unroll") for (int m = 0; m < 4; ++m) _Pragma("unroll") for (int n = 0; n < 2; ++n) _Pragma("unroll") for (int k = 0; k < 2; ++k) \
        acc[ai][bj][m][n] = __builtin_amdgcn_mfma_f32_16x16x32_bf16(Bt[n][k], At[m][k], acc[ai][bj][m][n], 0, 0, 0); __builtin_amdgcn_s_setprio(0); } while (0)
#define PG8_WAIT_V(n) asm volatile("s_waitcnt vmcnt(" #n ")" ::: "memory")
#define PG8_WAIT_L(n) asm volatile("s_waitcnt lgkmcnt(" #n ")" ::: "memory")
#define PG8_BAR __builtin_amdgcn_s_barrier()
#define PG8_SCHED __builtin_amdgcn_sched_barrier(0)
    Unit cur, nxt; int ui = 0;
    if (!S.next(0, cur)) return;
    LAS float* rtab_all = (LAS float*)(lds + STAGE_BYTES);
    if (E.rsrc() != nullptr) { Unit uu; for (int i = 0; i < 8 && S.next(i, uu); ++i) if (tid < 256) rtab_all[i * 256 + tid] = row_r(E.rsrc(), uu.pm * BM + tid); }
    f32x4 acc[2][2][4][2];
#pragma unroll
    for (int a = 0; a < 2; ++a)
#pragma unroll
        for (int b = 0; b < 2; ++b)
#pragma unroll
            for (int m = 0; m < 4; ++m)
#pragma unroll
                for (int n = 0; n < 2; ++n) acc[a][b][m][n] = (f32x4){0.f, 0.f, 0.f, 0.f};
    bf16x8 At[4][2], B0[2][2], B1[2][2];
    const char* cA = PG8_APTR(cur.pm); const char* cB = (const char*)g.Bt + (size_t)cur.pn * tstep;
    PG8_STAGE(PG8_SB(0, 0), cB, voffB); PG8_STAGE(PG8_SB(0, 1), cB + hstep, voffB); PG8_STAGE(PG8_SA(0, 0), cA, voffA); PG8_STAGE(PG8_SA(0, 1), cA + hstep, voffA);
    PG8_WAIT_L(0);
    if (wr == 1) PG8_BAR;
    PG8_WAIT_V(2); PG8_BAR;
    PG8_STAGE(PG8_SB(1, 0), cB + kstep, voffB); PG8_STAGE(PG8_SA(1, 0), cA + kstep, voffA); PG8_STAGE(PG8_SB(1, 1), cB + hstep + kstep, voffB);
    PG8_WAIT_V(6); PG8_BAR;
    for (;;) {
        const bool has_next = S.next(ui + 1, nxt);
        const char* nA = has_next ? PG8_APTR(nxt.pm) : cA; const char* nB = has_next ? (const char*)g.Bt + (size_t)nxt.pn * tstep : cB;
#pragma clang loop unroll(disable)
        for (int t = 0; t < nt; t += 2) {
            const bool last = (t == nt - 2);
            const char* a1 = cA + (size_t)(t + 1) * kstep;
            const char* a2 = last ? nA : cA + (size_t)(t + 2) * kstep; const char* b2 = last ? nB : cB + (size_t)(t + 2) * kstep;
            const char* a3 = a2 + kstep; const char* b3 = b2 + kstep;
            PG8_LDB(B0, 0, 0); PG8_LDB(B1, 0, 1); PG8_SCHED; PG8_LDA(At, 0, 0); PG8_STAGE(PG8_SA(1, 1), a1 + hstep, voffA);
            PG8_WAIT_V(8); PG8_WAIT_L(0); PG8_BAR; PG8_MMA(0, 0, At, B0); PG8_MMA(0, 1, At, B1); PG8_BAR; PG8_SCHED;
            PG8_LDA(At, 0, 1); PG8_STAGE(PG8_SB(0, 0), b2, voffB); PG8_STAGE(PG8_SB(0, 1), b2 + hstep, voffB); PG8_STAGE(PG8_SA(0, 0), a2, voffA);
            PG8_WAIT_V(8); PG8_WAIT_L(0); PG8_BAR; PG8_MMA(1, 0, At, B0); PG8_MMA(1, 1, At, B1); PG8_BAR; PG8_SCHED;
            PG8_LDB(B0, 1, 0); PG8_LDB(B1, 1, 1); PG8_SCHED; PG8_LDA(At, 1, 0); PG8_STAGE(PG8_SA(0, 1), a2 + hstep, voffA);
            PG8_WAIT_V(8); PG8_WAIT_L(0); PG8_BAR; PG8_MMA(0, 0, At, B0); PG8_MMA(0, 1, At, B1); PG8_BAR; PG8_SCHED;
            PG8_LDA(At, 1, 1); PG8_STAGE(PG8_SB(1, 0), b3, voffB); PG8_STAGE(PG8_SB(1, 1), b3 + hstep, voffB); PG8_STAGE(PG8_SA(1, 0), a3, voffA);
            PG8_WAIT_V(8); PG8_WAIT_L(0); PG8_BAR; PG8_MMA(1, 0, At, B0); PG8_MMA(1, 1, At, B1); PG8_BAR; PG8_SCHED;
        }
        if (wr == 0) PG8_BAR;
        { int efr = fr, efq = fq, etid = tid; asm volatile("" : "+v"(efr), "+v"(efq), "+v"(etid));
          E(acc, cur, wr, wc, efr, efq, rtab_all + (ui & 7) * 256, etid); }
        if (!has_next) break;
#pragma unroll
        for (int a = 0; a < 2; ++a)
#pragma unroll
            for (int b = 0; b < 2; ++b)
#pragma unroll
                for (int m = 0; m < 4; ++m)
#pragma unroll
                    for (int n = 0; n < 2; ++n) acc[a][b][m][n] = (f32x4){0.f, 0.f, 0.f, 0.f};
        cur = nxt; cA = nA; cB = nB; ++ui;
        if (wr == 1) PG8_BAR;
    }
    PG8_WAIT_V(0);
    PG8_BAR;
#undef PG8_APTR
#undef PG8_SA
#undef PG8_SB
#undef PG8_STAGE
#undef PG8_LDA
#undef PG8_LDB
#undef PG8_MMA
#undef PG8_WAIT_V
#undef PG8_WAIT_L
#undef PG8_BAR
#undef PG8_SCHED
}

#define EPI_ROWLOOP _Pragma("unroll") for (int ai = 0; ai < 2; ++ai) _Pragma("unroll") for (int m = 0; m < 4; ++m)
__device__ __forceinline__ u32x4 pack8(const f32x4 v0, const f32x4 v1) { u32x4 w; w.x = pk2(v0[0], v0[1]); w.y = pk2(v0[2], v0[3]); w.z = pk2(v1[0], v1[1]); w.w = pk2(v1[2], v1[3]); return w; }

struct EpiIn {
    bf16_t *Q, *Kk, *V, *G, *LG; const float* ssq; const float* b_a2;
    __device__ __forceinline__ const float* rsrc() const { return ssq; }
    __device__ __forceinline__ void operator()(const f32x4 (&acc)[2][2][4][2], const Unit& u, int wr, int wc, int fr, int fq, LAS float* rtab, int tid) const {
        const int pn = u.pn; bf16_t* base; int ld, c0;
        if (pn < 2) { base = Q; ld = NQK; c0 = pn * 256; } else if (pn < 4) { base = Kk; ld = NQK; c0 = (pn - 2) * 256; }
        else if (pn < 8) { base = V; ld = NV; c0 = (pn - 4) * 256; } else if (pn < 12) { base = G; ld = NV; c0 = (pn - 8) * 256; }
        else { base = LG; ld = NQK; c0 = (pn - 12) * 256; }
        const bool is_lg = pn >= 12;
        const int col = c0 + wc * 32 + 8 * fq;
        f32x4 bb[2][2];
#pragma unroll
        for (int bj = 0; bj < 2; ++bj)
#pragma unroll
            for (int n = 0; n < 2; ++n) bb[bj][n] = is_lg ? *(const f32x4*)(b_a2 + col + bj * HALF + 4 * n) : (f32x4){0.f, 0.f, 0.f, 0.f};
        EPI_ROWLOOP { const int lr = ai * HALF + wr * 64 + m * 16 + fr, row = u.pm * BM + lr; const float r = rtab[lr];
#pragma unroll
            for (int bj = 0; bj < 2; ++bj) { f32x4 v0 = acc[ai][bj][m][0] * r, v1 = acc[ai][bj][m][1] * r;
                if (is_lg) { v0 += bb[bj][0]; v1 += bb[bj][1];
#pragma unroll
                    for (int e = 0; e < 4; ++e) { v0[e] = logsig(v0[e]) * (1.f / 16.f); v1[e] = logsig(v1[e]) * (1.f / 16.f); } }
                *(u32x4*)(base + (size_t)row * ld + col + bj * HALF) = pack8(v0, v1); } }
    }
};
template <bool FROM_X> struct EpiRes {
    const float* X0; const float* X1; const bf16_t* BB; bf16_t* XO; float* ssq_out; float sc;
    __device__ __forceinline__ const float* rsrc() const { return nullptr; }
    __device__ __forceinline__ void operator()(const f32x4 (&acc)[2][2][4][2], const Unit& u, int wr, int wc, int fr, int fq, LAS float* rtab, int tid) const {
        const int col = u.pn * BM + wc * 32 + 8 * fq;
#pragma unroll
        for (int ai = 0; ai < 2; ++ai) {
            f32x4 b0[4][2], b1[4][2]; u32x4 bw[4][2];
#pragma unroll
            for (int m = 0; m < 4; ++m) { const int row = u.pm * BM + ai * HALF + wr * 64 + m * 16 + fr;
#pragma unroll
                for (int bj = 0; bj < 2; ++bj) {
                    if (FROM_X) { const float* src = (u.pm < MP / 256 ? X0 + (size_t)row * DM : X1 + (size_t)(row - MP) * DM) + col + bj * HALF; b0[m][bj] = *(const f32x4*)src; b1[m][bj] = *(const f32x4*)(src + 4); }
                    else bw[m][bj] = *(const u32x4*)(BB + (size_t)row * DM + col + bj * HALF); } }
            if (!FROM_X) asm volatile("" ::: "memory");
#pragma unroll
            for (int m = 0; m < 4; ++m) { const int row = u.pm * BM + ai * HALF + wr * 64 + m * 16 + fr; float s = 0.f;
#pragma unroll
                for (int bj = 0; bj < 2; ++bj) {
                    if (!FROM_X) { const u32x4 w = bw[m][bj]; b0[m][bj] = (f32x4){bflo(w.x), bfhi(w.x), bflo(w.y), bfhi(w.y)}; b1[m][bj] = (f32x4){bflo(w.z), bfhi(w.z), bflo(w.w), bfhi(w.w)}; }
                    const f32x4 v0 = acc[ai][bj][m][0] * sc + b0[m][bj], v1 = acc[ai][bj][m][1] * sc + b1[m][bj];
                    *(u32x4*)(XO + (size_t)row * DM + col + bj * HALF) = pack8(v0, v1);
                    s += (v0[0] * v0[0] + v0[1] * v0[1]) + (v0[2] * v0[2] + v0[3] * v0[3]) + (v1[0] * v1[0] + v1[1] * v1[1]) + (v1[2] * v1[2] + v1[3] * v1[3]); }
                s += __shfl_xor(s, 16); s += __shfl_xor(s, 32);
                if (fq == 0) st_wt(ssq_out + (size_t)row * 16 + u.pn * 4 + wc, s); }
        }
    }
};
struct EpiUp {
    bf16_t* HA; bf16_t* HB; const float* ssq;
    __device__ __forceinline__ const float* rsrc() const { return ssq; }
    __device__ __forceinline__ void operator()(const f32x4 (&acc)[2][2][4][2], const Unit& u, int wr, int wc, int fr, int fq, LAS float* rtab, int tid) const {
        bf16_t* base = u.pm < HID_SPLIT ? HA + (size_t)u.pm * 256 * FF : HB + (size_t)(u.pm - HID_SPLIT) * 256 * FF;
        const int col = u.pn * BM + wc * 32 + 8 * fq;
        EPI_ROWLOOP { const int lr = ai * HALF + wr * 64 + m * 16 + fr; const float r = rtab[lr];
#pragma unroll
            for (int bj = 0; bj < 2; ++bj) { f32x4 v0 = acc[ai][bj][m][0] * r, v1 = acc[ai][bj][m][1] * r;
#pragma unroll
                for (int e = 0; e < 4; ++e) { const float a = fmaxf(v0[e], 0.f), b = fmaxf(v1[e], 0.f); v0[e] = a * a; v1[e] = b * b; }
                *(u32x4*)(base + (size_t)lr * FF + col + bj * HALF) = pack8(v0, v1); } }
    }
};
struct EpiPl {
    bf16_t* PL;
    __device__ __forceinline__ const float* rsrc() const { return nullptr; }
    __device__ __forceinline__ void operator()(const f32x4 (&acc)[2][2][4][2], const Unit& u, int wr, int wc, int fr, int fq, LAS float* rtab, int tid) const {
        const int col = u.pn * BM + wc * 32 + 8 * fq;
        EPI_ROWLOOP { const int row = u.pm * BM + ai * HALF + wr * 64 + m * 16 + fr;
#pragma unroll
            for (int bj = 0; bj < 2; ++bj) *(u32x4*)(PL + (size_t)row * DM + col + bj * HALF) = pack8(acc[ai][bj][m][0], acc[ai][bj][m][1]); }
    }
};
template <bool LAST> struct EpiGate {
    float* HO; const bf16_t* BB; const bf16_t* PL; bf16_t* OB; const float* ssq_in; float* ssq_out; float sc;
    __device__ __forceinline__ const float* rsrc() const { return ssq_in; }
    __device__ __forceinline__ void operator()(const f32x4 (&acc)[2][2][4][2], const Unit& u, int wr, int wc, int fr, int fq, LAS float* rtab, int tid) const {
        const int col = u.pn * BM + wc * 32 + 8 * fq;
#pragma unroll
        for (int ai = 0; ai < 2; ++ai) {
            u32x4 bw[4][2], pw[4][2];
#pragma unroll
            for (int m = 0; m < 4; ++m) { const size_t off0 = (size_t)(u.pm * BM + ai * HALF + wr * 64 + m * 16 + fr) * DM + col;
#pragma unroll
                for (int bj = 0; bj < 2; ++bj) { bw[m][bj] = *(const u32x4*)(BB + off0 + bj * HALF); pw[m][bj] = *(const u32x4*)(PL + off0 + bj * HALF); } }
#pragma unroll
            for (int m = 0; m < 4; ++m) { const int lr = ai * HALF + wr * 64 + m * 16 + fr, row = u.pm * BM + lr; const float r = rtab[lr];
                float s = 0.f;
#pragma unroll
                for (int bj = 0; bj < 2; ++bj) { const size_t off = (size_t)row * DM + col + bj * HALF; const u32x4 b_ = bw[m][bj], p_ = pw[m][bj];
                    const f32x4 b0 = {bflo(b_.x), bfhi(b_.x), bflo(b_.y), bfhi(b_.y)}, b1 = {bflo(b_.z), bfhi(b_.z), bflo(b_.w), bfhi(b_.w)};
                    const f32x4 p0 = {bflo(p_.x), bfhi(p_.x), bflo(p_.y), bfhi(p_.y)}, p1 = {bflo(p_.z), bfhi(p_.z), bflo(p_.w), bfhi(p_.w)};
                    f32x4 v0 = acc[ai][bj][m][0] * r, v1 = acc[ai][bj][m][1] * r;
#pragma unroll
                    for (int e = 0; e < 4; ++e) { v0[e] = b0[e] + fsigmoid(v0[e]) * p0[e] * sc; v1[e] = b1[e] + fsigmoid(v1[e]) * p1[e] * sc; }
                    if (LAST) { *(f32x4*)(HO + off) = v0; *(f32x4*)(HO + off + 4) = v1; }
                    else { *(u32x4*)(OB + off) = pack8(v0, v1);
                        s += (v0[0] * v0[0] + v0[1] * v0[1]) + (v0[2] * v0[2] + v0[3] * v0[3]) + (v1[0] * v1[0] + v1[1] * v1[1]) + (v1[2] * v1[2] + v1[3] * v1[3]); } }
                if (!LAST) { s += __shfl_xor(s, 16); s += __shfl_xor(s, 32); if (fq == 0) st_wt(ssq_out + (size_t)row * 16 + u.pn * 4 + wc, s); } }
        }
    }
};
struct EpiKvq {
    bf16_t* KV; bf16_t* Qb; const float* ssq; float *CKP, *CVP, *CKS, *CVS;
    __device__ __forceinline__ const float* rsrc() const { return ssq; }
    __device__ __forceinline__ void operator()(const f32x4 (&acc)[2][2][4][2], const Unit& u, int wr, int wc, int fr, int fq, LAS float* rtab, int tid) const {
        const int pn = u.pn, c = wc * 32 + 8 * fq;
        EPI_ROWLOOP { const int lr = ai * HALF + wr * 64 + m * 16 + fr, row = u.pm * BM + lr; const float r = rtab[lr];
            float* cdst = nullptr;
            if (pn < 2) {
                if (row < MP) { const int b = row >> 13, t = row & (SEQ - 1); if (t >= SEQ - 128) cdst = (pn == 0 ? CKP : CVP) + ((size_t)(b * 128 + t - (SEQ - 128)) * 256 + c); }
                else { const int rs = row - MP, sb = rs >> 3, i = rs & 7; cdst = (pn == 0 ? CKS : CVS) + ((size_t)(sb * 128 + 120 + i) * 256 + c); }
            }
            bf16_t* dst = pn < 2 ? KV + (size_t)row * 512 + pn * 256 + c : Qb + (size_t)row * DM + (pn - 2) * 256 + c;
#pragma unroll
            for (int bj = 0; bj < 2; ++bj) { const f32x4 v0 = acc[ai][bj][m][0] * r, v1 = acc[ai][bj][m][1] * r;
                *(u32x4*)(dst + bj * HALF) = pack8(v0, v1);
                if (cdst) { *(f32x4*)(cdst + bj * HALF) = v0; *(f32x4*)(cdst + bj * HALF + 4) = v1; } } }
    }
};
}


namespace mg {
constexpr int KT = 256, LDT = KT + 8, TILE_B = 64 * LDT * 2;
template <class Epi>
__device__ __forceinline__ void mini_gemm(LAS unsigned char* lds, const bf16_t* A  , const bf16_t* Bt  , int N, int K, int G, int bx, const Epi& E) {
    const int tid = threadIdx.x, lane = tid & 63, wave = __builtin_amdgcn_readfirstlane(tid >> 6), l15 = lane & 15, g = lane >> 4;
    const int rt = wave & 3, chh = wave >> 2, nk = K / KT, units = 16 * (N / 64);
    LAS float* red = (LAS float*)(lds + 4 * TILE_B);
    for (int u = bx; u < units; u += G) {
        const int rm = u & 15, cn = u >> 4;
        const bf16_t* Ag = A + (size_t)(rm * 64) * K; const bf16_t* Bg = Bt + (size_t)(cn * 64) * K;
        u32x4 ra0[4], rb0[4], ra1[4], rb1[4];
#define MG_LOAD(ra, rb, kt) do { _Pragma("unroll") for (int i = 0; i < 4; ++i) { const int c = tid + 512 * i, row = c >> 5, ch = c & 31; \
            ra[i] = *(const u32x4*)(Ag + (size_t)row * K + (kt) * KT + ch * 8); rb[i] = *(const u32x4*)(Bg + (size_t)row * K + (kt) * KT + ch * 8); } } while (0)
#define MG_STORE(ra, rb, b) do { _Pragma("unroll") for (int i = 0; i < 4; ++i) { const int c = tid + 512 * i, row = c >> 5, ch = c & 31; \
            *(LAS u32x4*)(lds + (b) * 2 * TILE_B + (row * LDT + ch * 8) * 2) = ra[i]; *(LAS u32x4*)(lds + (b) * 2 * TILE_B + TILE_B + (row * LDT + ch * 8) * 2) = rb[i]; } } while (0)
#define MG_COMPUTE(b) do { const LAS bf16_t* Al = (const LAS bf16_t*)(lds + (b) * 2 * TILE_B); const LAS bf16_t* Bl = (const LAS bf16_t*)(lds + (b) * 2 * TILE_B + TILE_B); \
            _Pragma("unroll") for (int ks = 0; ks < KT / 32; ++ks) { const bf16x8 Af = *(const LAS bf16x8*)(Al + (16 * rt + l15) * LDT + 32 * ks + 8 * g); \
                _Pragma("unroll") for (int t = 0; t < 2; ++t) { const bf16x8 Bf = *(const LAS bf16x8*)(Bl + (16 * (2 * chh + t) + l15) * LDT + 32 * ks + 8 * g); \
                    acc[t] = __builtin_amdgcn_mfma_f32_16x16x32_bf16(Bf, Af, acc[t], 0, 0, 0); } } } while (0)
        f32x4 acc[2] = {(f32x4){0.f, 0.f, 0.f, 0.f}, (f32x4){0.f, 0.f, 0.f, 0.f}};
#define MG_BAR() do { asm volatile("s_waitcnt lgkmcnt(0)" ::: "memory"); __builtin_amdgcn_s_barrier(); asm volatile("" ::: "memory"); } while (0)
        MG_LOAD(ra0, rb0, 0); if (nk > 1) MG_LOAD(ra1, rb1, 1);
        MG_STORE(ra0, rb0, 0); MG_BAR();
        for (int kt = 0; kt < nk; kt += 2) {
            if (kt + 2 < nk) MG_LOAD(ra0, rb0, kt + 2);
            MG_COMPUTE(0);
            if (kt + 1 < nk) MG_STORE(ra1, rb1, 1);
            MG_BAR();
            if (kt + 1 < nk) {
                if (kt + 3 < nk) MG_LOAD(ra1, rb1, kt + 3);
                MG_COMPUTE(1);
                if (kt + 2 < nk) MG_STORE(ra0, rb0, 0);
                MG_BAR();
            }
        }
#undef MG_BAR
        const int row = MP + rm * 64 + 16 * rt + l15; float s = 0.f;
#pragma unroll
        for (int t = 0; t < 2; ++t) { const f32x4 o = E(row, cn * 64 + 16 * (2 * chh + t) + 4 * g, acc[t]); s += (o[0] * o[0] + o[1] * o[1]) + (o[2] * o[2] + o[3] * o[3]); }
        if (Epi::SSQ) { s += __shfl_xor(s, 16); s += __shfl_xor(s, 32); if (g == 0) red[(16 * rt + l15) * 2 + chh] = s;
            __syncthreads();
            if (tid < 64) st_wt(E.ssq_out + (size_t)(MP + rm * 64 + tid) * 16 + cn, red[tid * 2] + red[tid * 2 + 1]);
            __syncthreads(); }
#undef MG_LOAD
#undef MG_STORE
#undef MG_COMPUTE
    }
}
__device__ __forceinline__ u32x2 pack4(const f32x4 v) { u32x2 w; w.x = pk2(v[0], v[1]); w.y = pk2(v[2], v[3]); return w; }
template <bool FROM_X> struct MRes {
    static constexpr bool SSQ = true; const float* X1; const bf16_t* BB; bf16_t* XO; float* ssq_out; float sc;
    __device__ __forceinline__ f32x4 operator()(int row, int col, const f32x4 v) const {
        f32x4 b; if (FROM_X) b = *(const f32x4*)(X1 + (size_t)(row - MP) * DM + col); else { const u32x2 w = *(const u32x2*)(BB + (size_t)row * DM + col); b = (f32x4){bflo(w.x), bfhi(w.x), bflo(w.y), bfhi(w.y)}; }
        const f32x4 o = b + v * sc; *(u32x2*)(XO + (size_t)row * DM + col) = pack4(o); return o; }
};
struct MPl { static constexpr bool SSQ = false; bf16_t* PL; float* ssq_out;
    __device__ __forceinline__ f32x4 operator()(int row, int col, const f32x4 v) const { *(u32x2*)(PL + (size_t)row * DM + col) = pack4(v); return v; } };
struct MUp { static constexpr bool SSQ = false; bf16_t* HS  ; const float* ssq; float* ssq_out;
    __device__ __forceinline__ f32x4 operator()(int row, int col, const f32x4 v) const { const float r = row_r(ssq, row); f32x4 o;
#pragma unroll
        for (int e = 0; e < 4; ++e) { const float a = fmaxf(v[e] * r, 0.f); o[e] = a * a; }
        *(u32x2*)(HS + (size_t)(row - MP) * FF + col) = pack4(o); return o; } };
template <bool LAST> struct MGate { static constexpr bool SSQ = !LAST; float* HO; const bf16_t* BB; const bf16_t* PL; bf16_t* OB; const float* ssq_in; float* ssq_out; float sc;
    __device__ __forceinline__ f32x4 operator()(int row, int col, const f32x4 v) const { const float r = row_r(ssq_in, row); const size_t off = (size_t)row * DM + col;
        const u32x2 bw = *(const u32x2*)(BB + off), pw = *(const u32x2*)(PL + off);
        const f32x4 b = {bflo(bw.x), bfhi(bw.x), bflo(bw.y), bfhi(bw.y)}, p = {bflo(pw.x), bfhi(pw.x), bflo(pw.y), bfhi(pw.y)}; f32x4 o;
#pragma unroll
        for (int e = 0; e < 4; ++e) o[e] = b[e] + fsigmoid(v[e] * r) * p[e] * sc;
        if (LAST) *(f32x4*)(HO + off) = o; else *(u32x2*)(OB + off) = pack4(o); return o; } };
}

constexpr int NWAVES = 8, NTHREADS = 512;
constexpr int RING_BYTES = 131072, LDS_BYTES = 147456;
struct Args { const float* in[26]; float* out; unsigned char* ws; int ph_lo, ph_hi; };

struct TJob { const float* src; int ldw, kk, nblk; bf16_t* dst; const float* gain; float scale; int item; };
__device__ __forceinline__ void p0_tload(const TJob& J, float (&r)[32], int lane) {
    const int kb = J.item / J.nblk, nb = J.item % J.nblk, k0 = 64 * kb, n0 = 32 * nb;
#pragma unroll
    for (int i = 0; i < 32; ++i) r[i] = J.src[(size_t)(k0 + 2 * i + (lane >> 5)) * J.ldw + n0 + (lane & 31)];
}
__device__ __forceinline__ void p0_tfinish(const TJob& J, const float (&r)[32], LAS float* scr, int lane) {
    const int kb = J.item / J.nblk, nb = J.item % J.nblk, k0 = 64 * kb, n0 = 32 * nb, c = lane & 7;
    f32x4 g0 = {1.f, 1.f, 1.f, 1.f}, g1 = g0;
    if (J.gain) { g0 = *(const f32x4*)(J.gain + k0 + 8 * c); g1 = *(const f32x4*)(J.gain + k0 + 8 * c + 4); }
    g0 *= J.scale; g1 *= J.scale;
#pragma unroll
    for (int i = 0; i < 32; ++i) scr[(2 * i + (lane >> 5)) * 33 + (lane & 31)] = r[i];
    asm volatile("s_waitcnt lgkmcnt(0)" ::: "memory");
#pragma unroll
    for (int j = 0; j < 4; ++j) { const int n = (lane >> 3) + 8 * j; const LAS float* sp = scr + (8 * c) * 33 + n;
        u32x4 o; o.x = pk2(sp[0 * 33] * g0.x, sp[1 * 33] * g0.y); o.y = pk2(sp[2 * 33] * g0.z, sp[3 * 33] * g0.w); o.z = pk2(sp[4 * 33] * g1.x, sp[5 * 33] * g1.y); o.w = pk2(sp[6 * 33] * g1.z, sp[7 * 33] * g1.w);
        *(u32x4*)(J.dst + (size_t)(n0 + n) * J.kk + k0 + 8 * c) = o; }
    asm volatile("s_waitcnt lgkmcnt(0)" ::: "memory");
}

constexpr int T128 = 144, T256 = 272, TP = 80;
#define LDS_BAR() do { asm volatile("s_waitcnt lgkmcnt(0)" ::: "memory"); __builtin_amdgcn_s_barrier(); asm volatile("" ::: "memory"); } while (0)
struct GlaRegs { u32x4 lg[2], v[4], k[2], q[2]; };
template <bool WITH_Q, bool DO_LKQ = true, bool DO_V = true>
__device__ __forceinline__ void gla_fetch(GlaRegs& R, int item, const bf16_t* Q1, const bf16_t* K1, const bf16_t* V1, const bf16_t* LGp, int tid) {
    const int bh = item >> 7, c = item & 127, b = bh >> 2, h = bh & 3; const size_t row0 = (size_t)b * SEQ + c * 64;
    if (DO_LKQ) {
#pragma unroll
        for (int i = 0; i < 2; ++i) { const int x = tid + NTHREADS * i, j = x >> 4, d8 = (x & 15) * 8; const size_t off = (row0 + j) * NQK + h * 128 + d8;
            R.lg[i] = *(const u32x4*)(LGp + off); R.k[i] = *(const u32x4*)(K1 + off); if (WITH_Q) R.q[i] = *(const u32x4*)(Q1 + off); } }
    if (DO_V) {
#pragma unroll
        for (int i = 0; i < 4; ++i) { const int x = tid + NTHREADS * i, j = x >> 5, e8 = (x & 31) * 8; R.v[i] = *(const u32x4*)(V1 + (row0 + j) * NV + h * 256 + e8); } }
}
__device__ __forceinline__ void gla_stage_lg_v(const GlaRegs& R, LAS float* bc, LAS bf16_t* vt, int tid) {
#pragma unroll
    for (int i = 0; i < 2; ++i) { const int x = tid + NTHREADS * i, j = x >> 4, d8 = (x & 15) * 8; const u32x4 w = R.lg[i];
        *(LAS f32x4*)(bc + j * 128 + d8) = (f32x4){bflo(w.x), bfhi(w.x), bflo(w.y), bfhi(w.y)}; *(LAS f32x4*)(bc + j * 128 + d8 + 4) = (f32x4){bflo(w.z), bfhi(w.z), bflo(w.w), bfhi(w.w)}; }
#pragma unroll
    for (int i = 0; i < 4; ++i) { const int x = tid + NTHREADS * i, j = x >> 5, e8 = (x & 31) * 8; *(LAS u32x4*)(vt + j * T256 + e8) = R.v[i]; }
    LDS_BAR();
    if (tid < 128) { float s = 0.f;
#pragma unroll 8
        for (int j = 0; j < 64; ++j) { s += bc[j * 128 + tid]; bc[j * 128 + tid] = s; } }
    LDS_BAR();
}
constexpr int NSUP = 32, NSUP_ALL = NBH * NSUP;
template <bool OUT>
__device__ __forceinline__ void gla_super_phase(LAS unsigned char* lds, int G, int bx, const bf16_t* Q1, const bf16_t* K1, const bf16_t* V1, const bf16_t* G1, const bf16_t* LGp, bf16_t* US, float* DVS,
                                                const float* ogain, bf16_t* OG, int tid, int lane, int wave) {
    LAS float* bc = (LAS float*)lds;
    LAS bf16_t* Pm = (LAS bf16_t*)lds;
    LAS bf16_t* qt = (LAS bf16_t*)(lds + 32768);
    LAS bf16_t* kt = qt + 64 * T128;
    LAS bf16_t* kd = kt + 64 * T128;
    LAS bf16_t* vt = kd + 64 * T128;
    LAS float* red = (LAS float*)(lds + 32768 + 3 * 64 * T128 * 2 + 64 * T256 * 2);
    LAS float* em = red + 512;
    LAS float* dvl = em + 128;
    const int l15 = lane & 15, g = lane >> 4, q = l15 >> 2, p = l15 & 3;
    float gn[2] = {0.f, 0.f};
    if (OUT) {
#pragma unroll
        for (int t = 0; t < 2; ++t) gn[t] = ogain[16 * (2 * wave + t) + l15]; }
    GlaRegs R;
    if (bx < NSUP_ALL) gla_fetch<OUT>(R, (bx >> 5) * NCHUNK + (bx & 31) * 4, Q1, K1, V1, LGp, tid);
    for (int item = bx; item < NSUP_ALL; item += G) {
        const int bh = item >> 5, sc = item & 31, b = bh >> 2, h = bh & 3;
        f32x4 S[8][2];
        if (OUT) {
#pragma unroll
            for (int dt = 0; dt < 8; ++dt)
#pragma unroll
                for (int t = 0; t < 2; ++t) { const u32x2 w = *(const u32x2*)(US + ((size_t)item * 256 + 16 * (2 * wave + t) + l15) * 128 + 16 * dt + 4 * g); S[dt][t] = (f32x4){bflo(w.x), bfhi(w.x), bflo(w.y), bfhi(w.y)}; }
        } else {
#pragma unroll
            for (int dt = 0; dt < 8; ++dt) { S[dt][0] = (f32x4){0.f, 0.f, 0.f, 0.f}; S[dt][1] = (f32x4){0.f, 0.f, 0.f, 0.f}; } }
        float lsum = 0.f;
        for (int cc = 0; cc < 4; ++cc) {
            const int c = sc * 4 + cc; const size_t row0 = (size_t)b * SEQ + c * 64;
            gla_stage_lg_v(R, bc, vt, tid);
#pragma unroll
            for (int i = 0; i < 2; ++i) { const int x = tid + NTHREADS * i, j = x >> 4, d8 = (x & 15) * 8; const u32x4 wk = R.k[i];
                float kv[8] = {bflo(wk.x), bfhi(wk.x), bflo(wk.y), bfhi(wk.y), bflo(wk.z), bfhi(wk.z), bflo(wk.w), bfhi(wk.w)};
                float cur[8], dd[8];
#pragma unroll
                for (int t = 0; t < 8; ++t) { cur[t] = bc[j * 128 + d8 + t]; dd[t] = kv[t] * fexp(bc[63 * 128 + d8 + t] - cur[t]); }
                u32x4 o; o.x = pk2(dd[0], dd[1]); o.y = pk2(dd[2], dd[3]); o.z = pk2(dd[4], dd[5]); o.w = pk2(dd[6], dd[7]); *(LAS u32x4*)(kd + j * T128 + d8) = o;
                if (OUT) { const u32x4 wq = R.q[i];
                    float qv[8] = {bflo(wq.x), bfhi(wq.x), bflo(wq.y), bfhi(wq.y), bflo(wq.z), bfhi(wq.z), bflo(wq.w), bfhi(wq.w)};
                    float a[8], bb[8];
#pragma unroll
                    for (int t = 0; t < 8; ++t) { const float mid = bc[31 * 128 + d8 + t]; a[t] = qv[t] * fexp(cur[t] - mid); bb[t] = kv[t] * fexp(mid - cur[t]); }
                    o.x = pk2(a[0], a[1]); o.y = pk2(a[2], a[3]); o.z = pk2(a[4], a[5]); o.w = pk2(a[6], a[7]); *(LAS u32x4*)(qt + j * T128 + d8) = o;
                    o.x = pk2(bb[0], bb[1]); o.y = pk2(bb[2], bb[3]); o.z = pk2(bb[4], bb[5]); o.w = pk2(bb[6], bb[7]); *(LAS u32x4*)(kt + j * T128 + d8) = o; } }
            if (tid < 128) { const float last = bc[63 * 128 + tid]; dvl[tid] = fexp(last); lsum += last; if (OUT) em[tid] = fexp(bc[31 * 128 + tid]); }
            const int nxt_ = (cc < 3) ? bh * NCHUNK + c + 1 : (item + G < NSUP_ALL ? ((item + G) >> 5) * NCHUNK + ((item + G) & 31) * 4 : -1);
            if (nxt_ >= 0) gla_fetch<OUT, true, false>(R, nxt_, Q1, K1, V1, LGp, tid);
            LDS_BAR();
            if (OUT) {
#pragma unroll
                for (int t = 0; t < 2; ++t) { const int id = 2 * wave + t, ti = id >> 2, tj = id & 3;
                    f32x4 a = {0.f, 0.f, 0.f, 0.f};
                    if (tj <= ti) {
#pragma unroll
                        for (int ks = 0; ks < 4; ++ks) { const bf16x8 Af = *(const LAS bf16x8*)(qt + (16 * ti + l15) * T128 + 32 * ks + 8 * g), Bf = *(const LAS bf16x8*)(kt + (16 * tj + l15) * T128 + 32 * ks + 8 * g);
                            a = __builtin_amdgcn_mfma_f32_16x16x32_bf16(Af, Bf, a, 0, 0, 0); } }
#pragma unroll
                    for (int r = 0; r < 4; ++r) { const int i = 16 * ti + 4 * g + r, j = 16 * tj + l15; const float v = (j <= i) ? a[r] : 0.f; Pm[i * TP + j] = (bf16_t)(pk2(v, 0.f) & 0xffffu); }
                }
                LDS_BAR();
                f32x4 o[4][2];
#pragma unroll
                for (int ti = 0; ti < 4; ++ti) { o[ti][0] = (f32x4){0.f, 0.f, 0.f, 0.f}; o[ti][1] = (f32x4){0.f, 0.f, 0.f, 0.f}; }
#pragma unroll
                for (int ks = 0; ks < 2; ++ks) {
                    bf16x8 Bf[2];
#pragma unroll
                    for (int t = 0; t < 2; ++t) { const LAS bf16_t* a0 = vt + (32 * ks + 8 * g + q) * T256 + 16 * (2 * wave + t) + 4 * p; Bf[t] = cat8(trd(a0), trd(a0 + 4 * T256)); }
#pragma unroll
                    for (int ti = 2 * ks; ti < 4; ++ti) { const bf16x8 Af = *(const LAS bf16x8*)(Pm + (16 * ti + l15) * TP + 32 * ks + 8 * g);
#pragma unroll
                        for (int t = 0; t < 2; ++t) o[ti][t] = __builtin_amdgcn_mfma_f32_16x16x32_bf16(Af, Bf[t], o[ti][t], 0, 0, 0); }
                }
#pragma unroll
                for (int ks = 0; ks < 4; ++ks) {
                    const f32x4 e0 = *(LAS f32x4*)(em + 32 * ks + 4 * g), e1 = *(LAS f32x4*)(em + 32 * ks + 16 + 4 * g);
                    bf16x8 Bf[2];
#pragma unroll
                    for (int t = 0; t < 2; ++t) { const f32x4 s0 = S[2 * ks][t] * e0, s1 = S[2 * ks + 1][t] * e1; u32x4 w; w.x = pk2(s0[0], s0[1]); w.y = pk2(s0[2], s0[3]); w.z = pk2(s1[0], s1[1]); w.w = pk2(s1[2], s1[3]); Bf[t] = __builtin_bit_cast(bf16x8, w); }
#pragma unroll
                    for (int ti = 0; ti < 4; ++ti) { const LAS bf16_t* ap = qt + (16 * ti + l15) * T128 + 32 * ks + 4 * g;
                        const u32x2 a0 = *(const LAS u32x2*)ap, a1 = *(const LAS u32x2*)(ap + 16); u32x4 aw; aw.x = a0.x; aw.y = a0.y; aw.z = a1.x; aw.w = a1.y; const bf16x8 Af = __builtin_bit_cast(bf16x8, aw);
#pragma unroll
                        for (int t = 0; t < 2; ++t) o[ti][t] = __builtin_amdgcn_mfma_f32_16x16x32_bf16(Af, Bf[t], o[ti][t], 0, 0, 0); }
                }
#pragma unroll
                for (int ti = 0; ti < 4; ++ti)
#pragma unroll
                    for (int r = 0; r < 4; ++r) { float s = o[ti][0][r] * o[ti][0][r] + o[ti][1][r] * o[ti][1][r];
                        s += __shfl_xor(s, 1); s += __shfl_xor(s, 2); s += __shfl_xor(s, 4); s += __shfl_xor(s, 8);
                        if (l15 == 0) red[(16 * ti + 4 * g + r) * 8 + wave] = s; }
                LDS_BAR();
#pragma unroll
                for (int ti = 0; ti < 4; ++ti)
#pragma unroll
                    for (int r = 0; r < 4; ++r) { const int i = 16 * ti + 4 * g + r; const f32x4 r0 = *(LAS f32x4*)(red + i * 8), r1 = *(LAS f32x4*)(red + i * 8 + 4);
                        const float rms = frsq(((r0.x + r0.y) + (r0.z + r0.w) + (r1.x + r1.y) + (r1.z + r1.w)) * (1.f / 256.f) + EPS);
#pragma unroll
                        for (int t = 0; t < 2; ++t) { const size_t off = (row0 + i) * NV + h * 256 + 16 * (2 * wave + t) + l15; const float gv = bf2f(G1[off]);
                            OG[off] = (bf16_t)(pk2(o[ti][t][r] * rms * gn[t] * gv * fsigmoid(gv), 0.f) & 0xffffu); } }
            }
            if (nxt_ >= 0) gla_fetch<OUT, false, true>(R, nxt_, Q1, K1, V1, LGp, tid);
#pragma unroll
            for (int dt = 0; dt < 8; ++dt) { const f32x4 dvv = *(LAS f32x4*)(dvl + 16 * dt + 4 * g); S[dt][0] *= dvv; S[dt][1] *= dvv; }
#pragma unroll
            for (int ks = 0; ks < 2; ++ks) {
                bf16x8 Bf[2];
#pragma unroll
                for (int t = 0; t < 2; ++t) { const LAS bf16_t* a0 = vt + (32 * ks + 8 * g + q) * T256 + 16 * (2 * wave + t) + 4 * p; Bf[t] = cat8(trd(a0), trd(a0 + 4 * T256)); }
#pragma unroll
                for (int dt = 0; dt < 8; ++dt) { const LAS bf16_t* a0 = kd + (32 * ks + 8 * g + q) * T128 + 16 * dt + 4 * p; const bf16x8 Af = cat8(trd(a0), trd(a0 + 4 * T128));
#pragma unroll
                    for (int t = 0; t < 2; ++t) S[dt][t] = __builtin_amdgcn_mfma_f32_16x16x32_bf16(Af, Bf[t], S[dt][t], 0, 0, 0); }
            }
            LDS_BAR();
        }
        if (!OUT) {
#pragma unroll
            for (int dt = 0; dt < 8; ++dt)
#pragma unroll
                for (int t = 0; t < 2; ++t) { u32x2 w; w.x = pk2(S[dt][t][0], S[dt][t][1]); w.y = pk2(S[dt][t][2], S[dt][t][3]);
                    *(u32x2*)(US + ((size_t)item * 256 + 16 * (2 * wave + t) + l15) * 128 + 16 * dt + 4 * g) = w; }
            if (tid < 128) DVS[(size_t)item * 128 + tid] = fexp(lsum);
        }
    }
}
template <int NSTEP>
__device__ __forceinline__ void gla_scan(bf16_t* UT, const float* DV, float* state_out, int gtid, int gthreads) {
    for (int idx = gtid; idx < NBH * 256 * 64; idx += gthreads) {
        const int bh = idx >> 14, rem = idx & 16383, e = rem >> 6, dp = rem & 63;
        unsigned* base = (unsigned*)UT + (size_t)bh * NSTEP * 16384 + e * 64 + dp;
        const float* dv = DV + (size_t)bh * NSTEP * 128 + 2 * dp;
        float s0 = 0.f, s1 = 0.f;
        for (int c0 = 0; c0 < NSTEP; c0 += 32) {
            unsigned uu[32]; f32x2 dd[32];
#pragma unroll
            for (int k = 0; k < 32; ++k) { uu[k] = base[(size_t)(c0 + k) * 16384]; dd[k] = *(const f32x2*)(dv + (size_t)(c0 + k) * 128); }
#pragma unroll
            for (int k = 0; k < 32; ++k) { base[(size_t)(c0 + k) * 16384] = pk2(s0, s1); s0 = dd[k].x * s0 + bflo(uu[k]); s1 = dd[k].y * s1 + bfhi(uu[k]); }
        }
        float* so = state_out + ((size_t)bh * 128 + 2 * dp) * 256 + e;
        st_wt(so, s0); st_wt(so + 256, s1);
    }
}
__device__ __forceinline__ void gla_sample_pair(LAS unsigned char* lds, int base_item, const bf16_t* Q1, const bf16_t* K1, const bf16_t* V1, const bf16_t* G1, const bf16_t* LGp,
                                                const float* S0in, float* Sout, const float* ogain, bf16_t* OG, int tid) {
    const int hb = tid >> 8, t = tid & 255, item = base_item + hb, sb = item >> 2, h = item & 3; const size_t r0 = (size_t)MP + sb * 8;
    LAS float* qaT = (LAS float*)(lds + hb * 16384);
    LAS float* qsT = qaT + 1024, *kdT = qsT + 1024, *dvs = kdT + 1024, *att = dvs + 128, *red = att + 64;
    if (t < 128) { const int d = t; float bcv[8], s = 0.f;
#pragma unroll
        for (int i = 0; i < 8; ++i) { s += bf2f(LGp[(r0 + i) * NQK + h * 128 + d]); bcv[i] = s; }
#pragma unroll
        for (int i = 0; i < 8; ++i) { const float qv = bf2f(Q1[(r0 + i) * NQK + h * 128 + d]), kv = bf2f(K1[(r0 + i) * NQK + h * 128 + d]);
            qaT[d * 8 + i] = qv * fexp(bcv[i] - bcv[7]); qsT[d * 8 + i] = qv * fexp(bcv[i]); kdT[d * 8 + i] = kv * fexp(bcv[7] - bcv[i]); }
        dvs[d] = fexp(bcv[7]); }
    __syncthreads();
    if (t < 64) { const int i = t >> 3, j = t & 7; float s = 0.f;
        for (int d = 0; d < 128; ++d) s += qaT[d * 8 + i] * kdT[d * 8 + j];
        att[t] = (j <= i) ? s : 0.f; }
    __syncthreads();
    const int e = t; float v[8], o[8];
#pragma unroll
    for (int j = 0; j < 8; ++j) { v[j] = bf2f(V1[(r0 + j) * NV + h * 256 + e]); o[j] = 0.f; }
    const float* S0 = S0in + ((size_t)item * 128) * 256 + e; float* SO = Sout + ((size_t)item * 128) * 256 + e;
    for (int d0 = 0; d0 < 128; d0 += 32) { float sv[32];
#pragma unroll
        for (int k = 0; k < 32; ++k) sv[k] = __builtin_nontemporal_load(S0 + (size_t)(d0 + k) * 256);
#pragma unroll
        for (int k = 0; k < 32; ++k) { const int d = d0 + k; const f32x4 qa = *(LAS f32x4*)(qsT + d * 8), qb = *(LAS f32x4*)(qsT + d * 8 + 4), ka = *(LAS f32x4*)(kdT + d * 8), kb = *(LAS f32x4*)(kdT + d * 8 + 4);
            o[0] += qa.x * sv[k]; o[1] += qa.y * sv[k]; o[2] += qa.z * sv[k]; o[3] += qa.w * sv[k]; o[4] += qb.x * sv[k]; o[5] += qb.y * sv[k]; o[6] += qb.z * sv[k]; o[7] += qb.w * sv[k];
            __builtin_nontemporal_store(dvs[d] * sv[k] + ((ka.x * v[0] + ka.y * v[1]) + (ka.z * v[2] + ka.w * v[3])) + ((kb.x * v[4] + kb.y * v[5]) + (kb.z * v[6] + kb.w * v[7])), SO + (size_t)d * 256); }
    }
#pragma unroll
    for (int i = 0; i < 8; ++i)
#pragma unroll
        for (int j = 0; j <= i; ++j) o[i] += att[i * 8 + j] * v[j];
    const int wv = t >> 6;
#pragma unroll
    for (int i = 0; i < 8; ++i) { const float s = wave_sum(o[i] * o[i]); if ((t & 63) == 0) red[i * 4 + wv] = s; }
    __syncthreads();
    const float gn = ogain[e];
#pragma unroll
    for (int i = 0; i < 8; ++i) { const f32x4 rr = *(LAS f32x4*)(red + i * 4); const float rms = frsq(((rr.x + rr.y) + (rr.z + rr.w)) * (1.f / 256.f) + EPS);
        const size_t off = (r0 + i) * NV + h * 256 + e; const float gv = bf2f(G1[off]);
        OG[off] = (bf16_t)(pk2(o[i] * rms * gn * gv * fsigmoid(gv), 0.f) & 0xffffu); }
    __syncthreads();
}

constexpr int VT_LD = 72;
struct AttnP { const bf16_t* KV; const bf16_t* Qb; bf16_t* AO; const float* pk; const float* pv; float* ock; float* ocv; const float* sinks; const float* relb; };
constexpr int ATT_BUF = 32768 + 256 * VT_LD * 2 + 2048;
struct AttnRegs { u32x4 a[12]; };
#define ATT_DECODE(item) const bool smp = (item) >= 512; int b, kh, qblk, sb = 0; \
    if (!smp) { b = (item) >> 8; kh = ((item) >> 6) & 3; qblk = (item) & 63; } else { const int it_ = (item) - 512; sb = it_ >> 2; kh = it_ & 3; b = 0; qblk = 1; } \
    const long s0 = (long)b * SEQ + (long)qblk * 128; (void)s0; (void)sb
__device__ __forceinline__ void attn_load(int item, const AttnP& P, AttnRegs& R, int tid) {
    ATT_DECODE(item);
    if (!smp) {
#pragma unroll
        for (int j = 0; j < 4; ++j) { const int i = tid + NTHREADS * j, row = i >> 3, ch = i & 7; u32x4 wk = {0u, 0u, 0u, 0u}, wv = {0u, 0u, 0u, 0u};
            if (qblk > 0 || row >= 128) { const bf16_t* src = P.KV + (size_t)(s0 - 128 + row) * 512 + kh * 64 + ch * 8; wk = *(const u32x4*)src; wv = *(const u32x4*)(src + 256); }
            R.a[j] = wk; R.a[4 + j] = wv; }
    } else {
#pragma unroll
        for (int j = 0; j < 3; ++j) { const int i = tid + NTHREADS * j, row = i >> 3, ch = i & 7;
            u32x4 z = {0u, 0u, 0u, 0u}; R.a[4 * j] = z; R.a[4 * j + 1] = z; R.a[4 * j + 2] = z; R.a[4 * j + 3] = z;
            if (row < 128) { const size_t so = ((size_t)(sb * 128 + row) * 4 + kh) * 64 + ch * 8;
                R.a[4 * j] = *(const u32x4*)(P.pk + so); R.a[4 * j + 1] = *(const u32x4*)(P.pk + so + 4); R.a[4 * j + 2] = *(const u32x4*)(P.pv + so); R.a[4 * j + 3] = *(const u32x4*)(P.pv + so + 4); }
            else if (row < 136) { const bf16_t* src = P.KV + (size_t)(MP + sb * 8 + row - 128) * 512 + kh * 64 + ch * 8; R.a[4 * j] = *(const u32x4*)src; R.a[4 * j + 1] = *(const u32x4*)(src + 256); } }
    }
}
__device__ __forceinline__ void attn_stage(LAS unsigned char* lds, int item, const AttnP& P, const AttnRegs& R, int tid) {
    LAS unsigned char* Kt = lds; LAS bf16_t* Vt = (LAS bf16_t*)(lds + 32768); LAS float* bias2 = (LAS float*)(lds + 32768 + 256 * VT_LD * 2);
    ATT_DECODE(item);
    if (!smp) {
#pragma unroll
        for (int j = 0; j < 4; ++j) { const int i = tid + NTHREADS * j, row = i >> 3, ch = i & 7;
            *(LAS u32x4*)(Kt + row * 128 + ((ch ^ (row & 7)) << 4)) = R.a[j]; *(LAS u32x4*)(Vt + row * VT_LD + ch * 8) = R.a[4 + j]; }
    } else {
#pragma unroll
        for (int j = 0; j < 3; ++j) { const int i = tid + NTHREADS * j, row = i >> 3, ch = i & 7;
            if (i < 144 * 8) { u32x4 wk = R.a[4 * j], wv = R.a[4 * j + 1];
                if (row < 128) { const f32x4 k0 = __builtin_bit_cast(f32x4, R.a[4 * j]), k1 = __builtin_bit_cast(f32x4, R.a[4 * j + 1]), v0 = __builtin_bit_cast(f32x4, R.a[4 * j + 2]), v1 = __builtin_bit_cast(f32x4, R.a[4 * j + 3]);
                    wk = pg8::pack8(k0, k1); wv = pg8::pack8(v0, v1);
                    if (row >= 8) { const size_t oo = ((size_t)(sb * 128 + row - 8) * 4 + kh) * 64 + ch * 8;
                        *(f32x4*)(P.ock + oo) = k0; *(f32x4*)(P.ock + oo + 4) = k1; *(f32x4*)(P.ocv + oo) = v0; *(f32x4*)(P.ocv + oo + 4) = v1; } }
                *(LAS u32x4*)(Kt + row * 128 + ((ch ^ (row & 7)) << 4)) = wk; *(LAS u32x4*)(Vt + row * VT_LD + ch * 8) = wv; } }
    }
    { const int hl = tid >> 7, dist = tid & 127; int bk = dist;
      if (dist >= 16) { bk = 16 + (int)(__logf((float)dist * (1.f / 16.f)) * (16.f / 2.0794415416798357f)); bk = bk > 31 ? 31 : bk; }
      bias2[tid] = P.relb[bk * 16 + kh * 4 + hl] * LOG2E; }
}
__device__ __forceinline__ void attn_compute(LAS unsigned char* lds, int item, const AttnP& P, int lane, int wave) {
    LAS unsigned char* Kt = lds; LAS bf16_t* Vt = (LAS bf16_t*)(lds + 32768); LAS float* bias2 = (LAS float*)(lds + 32768 + 256 * VT_LD * 2);
    ATT_DECODE(item);
    const int l15 = lane & 15, g = lane >> 4, q = l15 >> 2, p = l15 & 3;
    const int ntq = smp ? (wave < 2 ? 1 : 0) : 4;
    for (int tq = 0; tq < ntq; ++tq) {
        const int qtile = smp ? 0 : (wave & 1) * 4 + tq;
        int hl_q, ioff; size_t qrow;
        if (!smp) { hl_q = wave >> 1; ioff = l15; qrow = (size_t)(s0 + 16 * qtile + l15); }
        else { hl_q = 2 * wave + (l15 >> 3); ioff = l15 & 7; qrow = (size_t)MP + sb * 8 + (l15 & 7); }
        const bf16_t* qp = P.Qb + qrow * DM + (kh * 4 + hl_q) * 64 + 8 * g;
        const bf16x8 Qf0 = *(const bf16x8*)qp, Qf1 = *(const bf16x8*)(qp + 32);
        f32x4 st[9];
#pragma unroll
        for (int j = 0; j < 9; ++j) { const int row = 16 * (qtile + j) + l15; const LAS unsigned char* kr = Kt + row * 128;
            const bf16x8 K0 = *(const LAS bf16x8*)(kr + ((g ^ (row & 7)) << 4)), K1f = *(const LAS bf16x8*)(kr + (((4 + g) ^ (row & 7)) << 4));
            f32x4 a = {0.f, 0.f, 0.f, 0.f};
            a = __builtin_amdgcn_mfma_f32_16x16x32_bf16(K0, Qf0, a, 0, 0, 0); a = __builtin_amdgcn_mfma_f32_16x16x32_bf16(K1f, Qf1, a, 0, 0, 0);
            st[j] = a; }
        const float sink2 = P.sinks[kh * 4 + hl_q] * LOG2E;
        float mx = sink2;
#pragma unroll
        for (int j = 0; j < 9; ++j)
#pragma unroll
            for (int r = 0; r < 4; ++r) { const int dist = 128 + ioff - 16 * j - 4 * g - r; const bool ok = (dist >= 0) && (dist < 128) && (smp || qblk > 0 || (16 * (qtile + j) + 4 * g + r) >= 128);
                const float v = ok ? st[j][r] + bias2[hl_q * 128 + (dist & 127)] : -INFINITY; st[j][r] = v; mx = fmaxf(mx, v); }
        mx = fmaxf(mx, __shfl_xor(mx, 16)); mx = fmaxf(mx, __shfl_xor(mx, 32));
        float sum = 0.f;
#pragma unroll
        for (int j = 0; j < 9; ++j)
#pragma unroll
            for (int r = 0; r < 4; ++r) { const float e = __builtin_amdgcn_exp2f(st[j][r] - mx); st[j][r] = e; sum += e; }
        sum += __shfl_xor(sum, 16); sum += __shfl_xor(sum, 32);
        const float inv = frcp(sum + __builtin_amdgcn_exp2f(sink2 - mx));
        f32x4 o[4];
#pragma unroll
        for (int dt = 0; dt < 4; ++dt) o[dt] = (f32x4){0.f, 0.f, 0.f, 0.f};
#pragma unroll
        for (int kk = 0; kk < 5; ++kk) {
            u32x4 pw; pw.x = pk2(st[2 * kk][0], st[2 * kk][1]); pw.y = pk2(st[2 * kk][2], st[2 * kk][3]);
            if (kk < 4) { pw.z = pk2(st[2 * kk + 1][0], st[2 * kk + 1][1]); pw.w = pk2(st[2 * kk + 1][2], st[2 * kk + 1][3]); } else { pw.z = 0u; pw.w = 0u; }
            const bf16x8 Pf = __builtin_bit_cast(bf16x8, pw);
            const LAS bf16_t* v0p = Vt + (16 * (qtile + 2 * kk) + 4 * g + q) * VT_LD + 4 * p;
#pragma unroll
            for (int dt = 0; dt < 4; ++dt) { const s16x4 lo = trd(v0p + 16 * dt); const s16x4 hi = (kk < 4) ? trd(v0p + 16 * VT_LD + 16 * dt) : (s16x4){0, 0, 0, 0};
                o[dt] = __builtin_amdgcn_mfma_f32_16x16x32_bf16(Pf, cat8(lo, hi), o[dt], 0, 0, 0); }
        }
#pragma unroll
        for (int r = 0; r < 4; ++r) { const int ql = 4 * g + r; const float iv = __shfl(inv, ql);
            size_t orow; int hh;
            if (!smp) { orow = (size_t)(s0 + 16 * qtile + ql); hh = kh * 4 + (wave >> 1); } else { orow = (size_t)MP + sb * 8 + (ql & 7); hh = kh * 4 + 2 * wave + (ql >> 3); }
            bf16_t* op = P.AO + orow * DM + hh * 64 + l15;
#pragma unroll
            for (int dt = 0; dt < 4; ++dt) op[16 * dt] = (bf16_t)(pk2(o[dt][r] * iv, 0.f) & 0xffffu); }
    }
}


#define XB_TMO      128
#define XB_XCNT(j)  (256  + 64 * (j))
#define XB_XSUB(j)  (1280 + 64 * (j))
#define XB_XGEN(j)  (2304 + 64 * (j))
#define XB_TOP      3328
#define XB_TOPGEN   3392
#define XCD_BAR_WORDS 3456
#define XB_SPIN_CAP (1u << 20)
__device__ __forceinline__ unsigned xb_ld(unsigned* p)              { return __hip_atomic_load(p, __ATOMIC_RELAXED, __HIP_MEMORY_SCOPE_AGENT); }
__device__ __forceinline__ unsigned xb_add(unsigned* p, unsigned v) { return __hip_atomic_fetch_add(p, v, __ATOMIC_RELAXED, __HIP_MEMORY_SCOPE_AGENT); }
__device__ __forceinline__ unsigned xb_xcc_id() { return (unsigned)__builtin_amdgcn_s_getreg((3 << 11) | 20) & 0xFu; }
#define XB_SPIN(cond, bar) do { unsigned _sp = 0; while (cond) { __builtin_amdgcn_s_sleep(1); \
    if ((++_sp & 255u) == 0u) { if (xb_ld(&(bar)[XB_TMO])) break; if (_sp > XB_SPIN_CAP) { atomicAdd(&(bar)[XB_TMO], 1u); break; } } } } while (0)
struct XcdBarrier { unsigned* bar; unsigned x; volatile LAS unsigned* st; };
__device__ __forceinline__ XcdBarrier xcd_barrier_post(unsigned* bar, volatile LAS unsigned* st) {
    XcdBarrier b; b.bar = bar; b.x = xb_xcc_id(); b.st = st;
    if (threadIdx.x == 0) (void)xb_add(&bar[XB_XCNT(b.x)], 1u);
    return b;
}
__device__ __forceinline__ void xcd_barrier_complete(unsigned* bar, unsigned x, unsigned& nloc, unsigned& nx) {
    const unsigned G = gridDim.x * gridDim.y * gridDim.z;
    unsigned sum, cnt, mine, sp = 0u;
    for (;;) {
        sum = 0u; cnt = 0u; mine = 0u;
#pragma unroll
        for (unsigned j = 0; j < 16; ++j) { const unsigned c = xb_ld(&bar[XB_XCNT(j)]); sum += c; cnt += (c > 0u) ? 1u : 0u; mine = (j == x) ? c : mine; }
        if (sum == G) break;
        __builtin_amdgcn_s_sleep(1);
        if ((++sp & 255u) == 0u) { if (xb_ld(&bar[XB_TMO])) break; if (sp > XB_SPIN_CAP) { atomicAdd(&bar[XB_TMO], 1u); break; } }
    }
    nloc = mine > 0u ? mine : 1u; nx = cnt > 0u ? cnt : 1u;
}
__device__ __forceinline__ void xcd_barrier(const XcdBarrier& b) {
    asm volatile("s_waitcnt vmcnt(0)" ::: "memory");
    __syncthreads();
    if (threadIdx.x == 0) {
        unsigned* bar = b.bar;
        __builtin_amdgcn_s_waitcnt(0);
        unsigned nloc = b.st[0], nx = b.st[1];
        if (nloc == 0u) { xcd_barrier_complete(bar, b.x, nloc, nx); b.st[0] = nloc; b.st[1] = nx; }
        const unsigned old = xb_add(&bar[XB_XSUB(b.x)], 1u);
        const unsigned gen = old / nloc;
        if (old + 1u == (gen + 1u) * nloc) {
            __builtin_amdgcn_fence(__ATOMIC_RELEASE, "agent");
            asm volatile("s_waitcnt vmcnt(0)" ::: "memory");
            const unsigned og = xb_add(&bar[XB_TOP], 1u);
            const unsigned tg = og / nx;
            if (og + 1u == (tg + 1u) * nx) xb_add(&bar[XB_TOPGEN], 1u);
            else XB_SPIN(xb_ld(&bar[XB_TOPGEN]) == tg, bar);
            __builtin_amdgcn_fence(__ATOMIC_ACQUIRE, "agent");
            xb_add(&bar[XB_XGEN(b.x)], 1u);
            asm volatile("s_waitcnt vmcnt(0)" ::: "memory");
        } else {
            XB_SPIN(xb_ld(&bar[XB_XGEN(b.x)]) == gen, bar);
            __builtin_amdgcn_fence(__ATOMIC_ACQUIRE, "agent");
            asm volatile("s_waitcnt vmcnt(0)" ::: "memory");
        }
    }
    __syncthreads();
}

__global__ void __launch_bounds__(NTHREADS, 2) yoco_fwd(Args args) {
    extern __shared__ __attribute__((aligned(16))) unsigned char lds_raw[];
    LAS unsigned char* lds = (LAS unsigned char*)lds_raw;
    const int tid = threadIdx.x, lane = tid & 63, wave = __builtin_amdgcn_readfirstlane(tid >> 6), G = gridDim.x, bx = blockIdx.x;
    const int gw = bx * NWAVES + wave, NGW = G * NWAVES;
    typedef const __attribute__((address_space(4))) Args* KArgsP;
    const KArgsP kp0 = (KArgsP)__builtin_amdgcn_kernarg_segment_ptr();
#define KARG(field) ({ KArgsP q_ = kp0; asm volatile("" : "+s"(q_)); q_->field; })
#define ws KARG(ws)
#define out KARG(out)
#define x_prompt KARG(in[0])
#define x_sample KARG(in[1])
#define state_gla KARG(in[2])
#define cache_k KARG(in[3])
#define cache_v KARG(in[4])
#define p_prompt KARG(in[5])
#define p_sample KARG(in[6])
#define norm_mix KARG(in[7])
#define norm_mlp KARG(in[8])
#define norm_ple KARG(in[9])
#define norm_kv KARG(in[10])
#define norm_final KARG(in[11])
#define w_in_a KARG(in[12])
#define w_a2 KARG(in[13])
#define b_a2 KARG(in[14])
#define gla_o_gain KARG(in[15])
#define w_out_a KARG(in[16])
#define w_kv KARG(in[17])
#define w_q_b KARG(in[18])
#define w_o_b KARG(in[19])
#define sinks KARG(in[20])
#define rel_bias KARG(in[21])
#define w_up KARG(in[22])
#define w_down KARG(in[23])
#define w_ple KARG(in[24])
#define w_ple_gate KARG(in[25])
#define W_IN ((bf16_t*)(ws + WS_W_IN))
#define W_OUT ((bf16_t*)(ws + WS_W_OUT))
#define W_KVQ ((bf16_t*)(ws + WS_W_KVQ))
#define W_O ((bf16_t*)(ws + WS_W_O))
#define XB ((bf16_t*)(ws + WS_XB))
#define PB ((bf16_t*)(ws + WS_PB))
#define Q1 ((bf16_t*)(ws + WS_Q1))
#define K1 ((bf16_t*)(ws + WS_K1))
#define V1 ((bf16_t*)(ws + WS_V1))
#define G1 ((bf16_t*)(ws + WS_G1))
#define HIDA ((bf16_t*)(ws + WS_R1))
#define H3B ((bf16_t*)(ws + WS_R1))
#define R3 ((bf16_t*)(ws + WS_R3))
#define HIDS (R3 + (size_t)(64 - HID_SPLIT) * 256 * FF)
#define KVR ((bf16_t*)(ws + WS_KVR))
#define PLQ ((bf16_t*)(ws + WS_PLQ))
#define SSQ0 ((float*)(ws + WS_SSQ))
#define SSQ1 ((float*)(ws + WS_SSQ) + (size_t)M * 16)
#define DV ((float*)(ws + WS_DV))
#define H (out + O_Y)
#define UT ((bf16_t*)(out + O_Y))
    cg::grid_group grid = cg::this_grid();
    volatile LAS unsigned* bst = (volatile LAS unsigned*)(lds + LDS_BYTES - 64);
    if (tid < 2) bst[tid] = 0u;
    __syncthreads();
    XcdBarrier xbar; xbar.bar = nullptr; xbar.x = 0; xbar.st = bst;
#if !MK_SPLIT
    xbar = xcd_barrier_post((unsigned*)(ws + WS_CTL), bst);
#endif
    const int lo = KARG(ph_lo), hi = KARG(ph_hi);
#define IN(k) (lo <= (k) && (k) < hi)
#define SEAM(k) do { if (IN(k) && IN((k) + 1)) { if (MK_SPLIT) grid.sync(); else xcd_barrier(xbar); } } while (0)
    if (lo < 0) grid.sync();

    if (IN(0)) {
        LAS float* scr = (LAS float*)(lds + wave * 16384);
#define TJ_LIST(X) \
        X(w_in_a, IN_A_COLS, DM, 512, W_IN, norm_mix, 0.08838834764831845f)                                     \
        X(w_in_a + 512, IN_A_COLS, DM, 2560, W_IN + (size_t)512 * DM, norm_mix, 1.f)                            \
        X(w_out_a, DM, DM, DM, W_OUT, (const float*)nullptr, 1.f) \
        X(w_up, FF, DM, FF, (bf16_t*)(ws + WS_W_UP0), norm_mlp, 1.f) \
        X(w_up + (size_t)DM * FF, FF, DM, FF, (bf16_t*)(ws + WS_W_UP1), norm_mlp + DM, 1.f) \
        X(w_down, DM, FF, DM, (bf16_t*)(ws + WS_W_DN0), (const float*)nullptr, 1.f) \
        X(w_down + (size_t)DM * FF, DM, FF, DM, (bf16_t*)(ws + WS_W_DN1), (const float*)nullptr, 1.f) \
        X(w_ple_gate, DM, DM, DM, (bf16_t*)(ws + WS_W_G0), norm_ple, 1.f) \
        X(w_ple_gate + (size_t)DM * DM, DM, DM, DM, (bf16_t*)(ws + WS_W_G1), norm_ple + DM, 1.f) \
        X(w_ple, DM, PLE, DM, (bf16_t*)(ws + WS_W_P0), (const float*)nullptr, 1.f) \
        X(w_ple + (size_t)PLE * DM, DM, PLE, DM, (bf16_t*)(ws + WS_W_P1), (const float*)nullptr, 1.f) \
        X(w_kv, 512, DM, 512, W_KVQ, norm_kv, 1.f) \
        X(w_q_b, DM, DM, DM, W_KVQ + (size_t)512 * DM, norm_mix + DM, 0.125f * LOG2E)                          \
        X(w_o_b, DM, DM, DM, W_O, (const float*)nullptr, 1.f)
#define TJ_COUNT(W, LDW, KK, NCOLS, DST, GAIN, SCALE) + ((KK) / 64) * ((NCOLS) / 32)
        constexpr int TJ_TOTAL = 0 TJ_LIST(TJ_COUNT);
#define TJ_DECODE(WP, LDW, KK, NCOLS, DSTP, GAINP, SCALEV) if (!done_ && r_ < ((KK) / 64) * ((NCOLS) / 32)) { jt_.src = (WP); jt_.ldw = (LDW); jt_.kk = (KK); jt_.nblk = (NCOLS) / 32; jt_.dst = (DSTP); jt_.gain = (GAINP); jt_.scale = (SCALEV); jt_.item = r_; done_ = true; } else if (!done_) r_ -= ((KK) / 64) * ((NCOLS) / 32);
#define TJ_GET(JOUT, it) do { int r_ = (it); bool done_ = false; TJob jt_; jt_.src = nullptr; jt_.ldw = 0; jt_.kk = 0; jt_.nblk = 1; jt_.dst = nullptr; jt_.gain = nullptr; jt_.scale = 1.f; jt_.item = 0; TJ_LIST(TJ_DECODE) JOUT = jt_; } while (0)
        { float ra_[32], rb_[32]; TJob Ja, Jb; int it = gw;
          if (it < TJ_TOTAL) { TJ_GET(Ja, it); p0_tload(Ja, ra_, lane); }
          while (it < TJ_TOTAL) {
              const int it1 = it + NGW; if (it1 < TJ_TOTAL) { TJ_GET(Jb, it1); p0_tload(Jb, rb_, lane); }
              p0_tfinish(Ja, ra_, scr, lane);
              if (it1 >= TJ_TOTAL) break;
              const int it2 = it1 + NGW; if (it2 < TJ_TOTAL) { TJ_GET(Ja, it2); p0_tload(Ja, ra_, lane); }
              p0_tfinish(Jb, rb_, scr, lane);
              it = it2; } }
#undef TJ_LIST
#undef TJ_COUNT
#undef TJ_DECODE
#undef TJ_GET
        for (int idx = bx * NTHREADS + tid; idx < 512 * 128; idx += G * NTHREADS) { const int n = idx >> 7, k8 = (idx & 127) * 8; float wa[16];
#pragma unroll
            for (int r = 0; r < 16; ++r) wa[r] = w_a2[r * 512 + n];
            float o8[8];
#pragma unroll
            for (int kk = 0; kk < 8; ++kk) { const float* wr_ = w_in_a + (size_t)(k8 + kk) * IN_A_COLS + 3072; float s = 0.f;
#pragma unroll
                for (int r = 0; r < 16; ++r) s += wr_[r] * wa[r];
                o8[kk] = s * norm_mix[k8 + kk]; }
            u32x4 o; o.x = pk2(o8[0], o8[1]); o.y = pk2(o8[2], o8[3]); o.z = pk2(o8[4], o8[5]); o.w = pk2(o8[6], o8[7]);
            *(u32x4*)(W_IN + (size_t)(3072 + n) * DM + k8) = o; }
        for (int m0 = gw * 4; m0 < M; m0 += NGW * 4) { f32x4 v[4][4]; float s[4];
#pragma unroll
            for (int q = 0; q < 4; ++q) { const int m = m0 + q; const float* xr = m < MP ? x_prompt + (size_t)m * DM : x_sample + (size_t)(m - MP) * DM;
#pragma unroll
                for (int j = 0; j < 4; ++j) v[q][j] = *((const f32x4*)xr + lane + 64 * j); }
#pragma unroll
            for (int q = 0; q < 4; ++q) { const int m = m0 + q; float ss = 0.f;
#pragma unroll
                for (int j = 0; j < 4; ++j) { ss += (v[q][j].x * v[q][j].x + v[q][j].y * v[q][j].y) + (v[q][j].z * v[q][j].z + v[q][j].w * v[q][j].w);
                    u32x2 w; w.x = pk2(v[q][j].x, v[q][j].y); w.y = pk2(v[q][j].z, v[q][j].w); *((u32x2*)(XB + (size_t)m * DM) + lane + 64 * j) = w; }
                s[q] = wave_sum(ss);
                if (lane < 16) SSQ0[(size_t)m * 16 + lane] = lane == 0 ? s[q] : 0.f; } }
        for (int m0 = gw * 8; m0 < M; m0 += NGW * 8) { f32x4 v[8];
#pragma unroll
            for (int q = 0; q < 8; ++q) { const int m = m0 + q; v[q] = *((const f32x4*)(m < MP ? p_prompt + (size_t)m * PLE : p_sample + (size_t)(m - MP) * PLE) + lane); }
#pragma unroll
            for (int q = 0; q < 8; ++q) { u32x2 w; w.x = pk2(v[q].x, v[q].y); w.y = pk2(v[q].z, v[q].w); *((u32x2*)(PB + (size_t)(m0 + q) * PLE) + lane) = w; } }
    }
    SEAM(0);
    if (IN(1)) { pg8::Gemm g{XB, XB, NPAN, W_IN, M, N_IN, DM}; pg8::StaticOrder S; S.init(M, N_IN, G, bx);
        pg8::EpiIn E{Q1, K1, V1, G1, KVR, SSQ0, b_a2}; pg8::gemm_phase(lds, g, S, E); }
    SEAM(1);
    if (IN(2)) {
        for (int base = bx * 2; base < SB * 4; base += G * 2) gla_sample_pair(lds, base, Q1, K1, V1, G1, KVR, state_gla, out + O_SS, gla_o_gain, R3, tid);
        gla_super_phase<false>(lds, G, bx, nullptr, K1, V1, nullptr, KVR, UT, DV, nullptr, nullptr, tid, lane, wave);
    }
    SEAM(2);
    if (IN(3)) gla_scan<NSUP>(UT, DV, out + O_SP, bx * NTHREADS + tid, G * NTHREADS);
    SEAM(3);
    if (IN(4)) { gla_super_phase<true>(lds, G, bx, Q1, K1, V1, G1, KVR, UT, nullptr, gla_o_gain, R3, tid, lane, wave); }
    SEAM(4);
    if (IN(5)) {
        { pg8::Gemm g{R3, R3, NPAN, W_OUT, MP, DM, DM}; pg8::StaticOrder S; S.init(MP, DM, G, bx); pg8::EpiRes<false> E{nullptr, nullptr, XB, XB, SSQ1, 1.f}; pg8::gemm_phase(lds, g, S, E); }
        { pg8::Gemm g{PB, PB, NPAN, (const bf16_t*)(ws + WS_W_P0), MP, DM, PLE}; pg8::StaticOrder S; S.init(MP, DM, G, bx); pg8::EpiPl E{PLQ}; pg8::gemm_phase(lds, g, S, E); }
        { mg::MRes<false> E{nullptr, XB, XB, SSQ1, 1.f}; mg::mini_gemm(lds, R3 + (size_t)MP * DM, W_OUT, DM, DM, G, bx, E); }
        { mg::MPl E{PLQ, nullptr}; mg::mini_gemm(lds, PB + (size_t)MP * PLE, (const bf16_t*)(ws + WS_W_P0), DM, PLE, G, bx, E); }
    }
    SEAM(5);
    if (IN(6)) { { pg8::Gemm g{XB, XB, NPAN, (const bf16_t*)(ws + WS_W_UP0), MP, FF, DM}; pg8::StaticOrder S; S.init(MP, FF, G, bx); pg8::EpiUp E{HIDA, R3, SSQ1}; pg8::gemm_phase(lds, g, S, E); }
        { mg::MUp E{HIDS, SSQ1, nullptr}; mg::mini_gemm(lds, XB + (size_t)MP * DM, (const bf16_t*)(ws + WS_W_UP0), FF, DM, G, bx, E); } }
    SEAM(6);
    if (IN(7)) { { pg8::Gemm g{HIDA, R3, HID_SPLIT, (const bf16_t*)(ws + WS_W_DN0), MP, DM, FF}; pg8::StaticOrder S; S.init(MP, DM, G, bx); pg8::EpiRes<false> E{nullptr, nullptr, XB, XB, SSQ0, 1.f}; pg8::gemm_phase(lds, g, S, E); }
        { mg::MRes<false> E{nullptr, XB, XB, SSQ0, 1.f}; mg::mini_gemm(lds, HIDS, (const bf16_t*)(ws + WS_W_DN0), DM, FF, G, bx, E); } }
    SEAM(7);
    if (IN(8)) { { pg8::Gemm g{XB, XB, NPAN, (const bf16_t*)(ws + WS_W_G0), MP, DM, DM}; pg8::StaticOrder S; S.init(MP, DM, G, bx); pg8::EpiGate<false> E{nullptr, XB, PLQ, H3B, SSQ0, SSQ1, 1.f}; pg8::gemm_phase(lds, g, S, E); }
        { mg::MGate<false> E{nullptr, XB, PLQ, H3B, SSQ0, SSQ1, 1.f}; mg::mini_gemm(lds, XB + (size_t)MP * DM, (const bf16_t*)(ws + WS_W_G0), DM, DM, G, bx, E); } }
    SEAM(8);
    if (IN(9)) { pg8::Gemm g{H3B, H3B, NPAN, W_KVQ, M, NKVQ, DM}; pg8::StaticOrder S; S.init(M, NKVQ, G, bx);
        pg8::EpiKvq E{KVR, PLQ, SSQ1, out + O_CKP, out + O_CVP, out + O_CKS, out + O_CVS}; pg8::gemm_phase(lds, g, S, E); }
    SEAM(9);
    if (IN(10)) {
        const AttnP AP{KVR, PLQ, R3, cache_k, cache_v, out + O_CKS, out + O_CVS, sinks, rel_bias};
        { AttnRegs AR; int buf = 0;
          if (bx < 1024) { attn_load(bx, AP, AR, tid); attn_stage(lds, bx, AP, AR, tid); }
          LDS_BAR();
          for (int it = bx; it < 1024; it += G) { const int nx = it + G;
              if (nx < 1024) attn_load(nx, AP, AR, tid);
              attn_compute(lds + buf * ATT_BUF, it, AP, lane, wave);
              if (nx < 1024) attn_stage(lds + (buf ^ 1) * ATT_BUF, nx, AP, AR, tid);
              LDS_BAR(); buf ^= 1; } }
        for (int m0 = gw * 8; m0 < M; m0 += NGW * 8) { f32x4 v[8];
#pragma unroll
            for (int q = 0; q < 8; ++q) { const int m = m0 + q; v[q] = *((const f32x4*)(m < MP ? p_prompt + (size_t)(MP + m) * PLE : p_sample + (size_t)(MS + m - MP) * PLE) + lane); }
#pragma unroll
            for (int q = 0; q < 8; ++q) { u32x2 w; w.x = pk2(v[q].x, v[q].y); w.y = pk2(v[q].z, v[q].w); *((u32x2*)(PB + (size_t)(m0 + q) * PLE) + lane) = w; } }
    }
    SEAM(10);
    if (IN(11)) {
        { pg8::Gemm g{R3, R3, NPAN, W_O, MP, DM, DM}; pg8::StaticOrder S; S.init(MP, DM, G, bx); pg8::EpiRes<false> E{nullptr, nullptr, H3B, XB, SSQ0, 1.f}; pg8::gemm_phase(lds, g, S, E); }
        { pg8::Gemm g{PB, PB, NPAN, (const bf16_t*)(ws + WS_W_P1), MP, DM, PLE}; pg8::StaticOrder S; S.init(MP, DM, G, bx); pg8::EpiPl E{PLQ}; pg8::gemm_phase(lds, g, S, E); }
        { mg::MRes<false> E{nullptr, H3B, XB, SSQ0, 1.f}; mg::mini_gemm(lds, R3 + (size_t)MP * DM, W_O, DM, DM, G, bx, E); }
        { mg::MPl E{PLQ, nullptr}; mg::mini_gemm(lds, PB + (size_t)MP * PLE, (const bf16_t*)(ws + WS_W_P1), DM, PLE, G, bx, E); }
    }
    SEAM(11);
    if (IN(12)) { { pg8::Gemm g{XB, XB, NPAN, (const bf16_t*)(ws + WS_W_UP1), MP, FF, DM}; pg8::StaticOrder S; S.init(MP, FF, G, bx); pg8::EpiUp E{HIDA, R3, SSQ0}; pg8::gemm_phase(lds, g, S, E); }
        { mg::MUp E{HIDS, SSQ0, nullptr}; mg::mini_gemm(lds, XB + (size_t)MP * DM, (const bf16_t*)(ws + WS_W_UP1), FF, DM, G, bx, E); } }
    SEAM(12);
    if (IN(13)) { { pg8::Gemm g{HIDA, R3, HID_SPLIT, (const bf16_t*)(ws + WS_W_DN1), MP, DM, FF}; pg8::StaticOrder S; S.init(MP, DM, G, bx); pg8::EpiRes<false> E{nullptr, nullptr, XB, XB, SSQ1, 1.f}; pg8::gemm_phase(lds, g, S, E); }
        { mg::MRes<false> E{nullptr, XB, XB, SSQ1, 1.f}; mg::mini_gemm(lds, HIDS, (const bf16_t*)(ws + WS_W_DN1), DM, FF, G, bx, E); } }
    SEAM(13);
    if (IN(14)) { { pg8::Gemm g{XB, XB, NPAN, (const bf16_t*)(ws + WS_W_G1), MP, DM, DM}; pg8::StaticOrder S; S.init(MP, DM, G, bx); pg8::EpiGate<false> E{nullptr, XB, PLQ, H3B, SSQ1, SSQ0, 1.f}; pg8::gemm_phase(lds, g, S, E); }
        { mg::MGate<false> E{nullptr, XB, PLQ, H3B, SSQ1, SSQ0, 1.f}; mg::mini_gemm(lds, XB + (size_t)MP * DM, (const bf16_t*)(ws + WS_W_G1), DM, DM, G, bx, E); } }
    SEAM(14);
    if (IN(15)) {
        f32x4 gn[4];
#pragma unroll
        for (int j = 0; j < 4; ++j) gn[j] = *((const f32x4*)norm_final + lane + 64 * j);
        for (int m0 = gw * 4; m0 < M; m0 += NGW * 4) { u32x2 w[4][4]; float r[4];
#pragma unroll
            for (int q = 0; q < 4; ++q) { r[q] = row_r(SSQ0, m0 + q);
#pragma unroll
                for (int j = 0; j < 4; ++j) w[q][j] = *((const u32x2*)(H3B + (size_t)(m0 + q) * DM) + lane + 64 * j); }
#pragma unroll
            for (int q = 0; q < 4; ++q)
#pragma unroll
                for (int j = 0; j < 4; ++j) { const f32x4 v = {bflo(w[q][j].x), bfhi(w[q][j].x), bflo(w[q][j].y), bfhi(w[q][j].y)};
                    *((f32x4*)(H + (size_t)(m0 + q) * DM) + lane + 64 * j) = v * r[q] * gn[j]; } }
    }
#undef IN
#undef SEAM
}
#undef ws
#undef out
#undef x_prompt
#undef x_sample
#undef state_gla
#undef cache_k
#undef cache_v
#undef p_prompt
#undef p_sample
#undef norm_mix
#undef norm_mlp
#undef norm_ple
#undef norm_kv
#undef norm_final
#undef w_in_a
#undef w_a2
#undef b_a2
#undef gla_o_gain
#undef w_out_a
#undef w_kv
#undef w_q_b
#undef w_o_b
#undef sinks
#undef rel_bias
#undef w_up
#undef w_down
#undef w_ple
#undef w_ple_gate
#undef W_IN
#undef W_OUT
#undef W_KVQ
#undef W_O
#undef XB
#undef PB
#undef Q1
#undef K1
#undef V1
#undef G1
#undef HIDA
#undef H3B
#undef R3
#undef HIDS
#undef KVR
#undef PLQ
#undef SSQ0
#undef SSQ1
#undef DV
#undef H
#undef UT
#undef KARG

extern "C" void kernel_launch(void* const* d_in, const int* in_sizes, int n_in, void* d_out, int out_size, void* d_ws, size_t ws_size, hipStream_t stream) {
    static int grid = 0;
    if (grid == 0) {
        if (n_in != 26 || (size_t)out_size != O_END || ws_size < WS_END) { fprintf(stderr, "kernel_launch: unexpected shapes (n_in %d out %d ws %zu need %zu)\n", n_in, out_size, ws_size, (size_t)WS_END); grid = -1; return; }
        int dev = 0, cus = 0, per_cu = 0;
        hipGetDevice(&dev); hipDeviceGetAttribute(&cus, hipDeviceAttributeMultiprocessorCount, dev);
        hipFuncSetAttribute((const void*)yoco_fwd, hipFuncAttributeMaxDynamicSharedMemorySize, LDS_BYTES);
        hipOccupancyMaxActiveBlocksPerMultiprocessor(&per_cu, (const void*)yoco_fwd, NTHREADS, LDS_BYTES);
        if (per_cu < 1) { fprintf(stderr, "kernel_launch: occupancy query says %d blocks per CU\n", per_cu); per_cu = 1; }
        (void)hipGetLastError();
        grid = cus * 1;
    }
    if (grid < 0) return;
    if (hipMemsetAsync((char*)d_ws + WS_CTL, 0, 65536, stream) != hipSuccess) { fprintf(stderr, "kernel_launch: memset failed\n"); return; }
    Args a{};
    for (int i = 0; i < 26; ++i) a.in[i] = (const float*)d_in[i];
    a.out = (float*)d_out; a.ws = (unsigned char*)d_ws;
#if MK_SPLIT
    for (int ph = 0; ph < 16; ++ph) { a.ph_lo = ph; a.ph_hi = ph + 1; hipLaunchKernelGGL(yoco_fwd, dim3(grid), dim3(NTHREADS), LDS_BYTES, stream, a); }
#else
    a.ph_lo = 0; a.ph_hi = 16;
    void* kargs[] = {&a};
    hipError_t e = hipLaunchCooperativeKernel((const void*)yoco_fwd, dim3(grid), dim3(NTHREADS), kargs, LDS_BYTES, stream);
    if (e != hipSuccess) fprintf(stderr, "cooperative launch failed: %s (grid %d)\n", hipGetErrorString(e), grid);
#endif
}
```

```cpp
#include <hip/hip_runtime.h>
#include <hip/hip_cooperative_groups.h>
#include <cstdio>
#include <cstdint>
namespace cg = cooperative_groups;

#define LAS __attribute__((address_space(3)))
#define GAS __attribute__((address_space(1)))
typedef unsigned short bf16_t;
typedef short bf16x8 __attribute__((ext_vector_type(8)));
typedef short s16x4 __attribute__((ext_vector_type(4)));
typedef float f32x4 __attribute__((ext_vector_type(4)));
typedef float f32x2 __attribute__((ext_vector_type(2)));
typedef unsigned u32x4 __attribute__((ext_vector_type(4)));
typedef unsigned u32x2 __attribute__((ext_vector_type(2)));

#ifndef MK_SPLIT
#define MK_SPLIT 0
#endif

constexpr int DM = 1024, SEQ = 8192, NBATCH = 2, MP = NBATCH * SEQ, SB = 128, SS = 8, MS = SB * SS, M = MP + MS, NPAN = M / 256;
constexpr int NQK = 512, NV = 1024, N_IN = 3584, FF = 4096, PLE = 256, NKVQ = 1536, IN_A_COLS = 3088;
constexpr int NCHUNK = 128, NBH = 8, NCH_ALL = NBH * NCHUNK;
constexpr float EPS = 1e-6f, LOG2E = 1.4426950408889634f;
constexpr int HID_SPLIT = 51;

constexpr size_t O_Y = 0, O_SP = (size_t)M * DM, O_SS = O_SP + 262144, O_CKP = O_SS + 16777216, O_CVP = O_CKP + 65536, O_CKS = O_CVP + 65536, O_CVS = O_CKS + 4194304, O_END = O_CVS + 4194304;

constexpr size_t al256(size_t x) { return (x + 255) & ~(size_t)255; }
constexpr size_t WS_CTL = 0, CTL_BYTES = 1u << 20;
constexpr size_t WS_W_IN = CTL_BYTES;
constexpr size_t WS_W_OUT = WS_W_IN + (size_t)N_IN * DM * 2;
constexpr size_t WS_W_UP0 = WS_W_OUT + (size_t)DM * DM * 2;
constexpr size_t WS_W_DN0 = WS_W_UP0 + (size_t)FF * DM * 2;
constexpr size_t WS_W_UP1 = WS_W_DN0 + (size_t)FF * DM * 2;
constexpr size_t WS_W_DN1 = WS_W_UP1 + (size_t)FF * DM * 2;
constexpr size_t WS_W_G0 = WS_W_DN1 + (size_t)FF * DM * 2;
constexpr size_t WS_W_G1 = WS_W_G0 + (size_t)DM * DM * 2;
constexpr size_t WS_W_P0 = WS_W_G1 + (size_t)DM * DM * 2;
constexpr size_t WS_W_P1 = WS_W_P0 + (size_t)DM * PLE * 2;
constexpr size_t WS_W_KVQ = WS_W_P1 + (size_t)DM * PLE * 2;
constexpr size_t WS_W_O = WS_W_KVQ + (size_t)NKVQ * DM * 2;
constexpr size_t WS_XB = WS_W_O + (size_t)DM * DM * 2;
constexpr size_t WS_PB = WS_XB + (size_t)M * DM * 2;
constexpr size_t WS_R1 = WS_PB + (size_t)M * PLE * 2;
constexpr size_t R1_BYTES = (size_t)HID_SPLIT * 256 * FF * 2;
constexpr size_t WS_Q1 = WS_R1, WS_K1 = WS_Q1 + (size_t)M * NQK * 2, WS_V1 = WS_K1 + (size_t)M * NQK * 2, WS_G1 = WS_V1 + (size_t)M * NV * 2;
static_assert(WS_G1 + (size_t)M * NV * 2 == WS_R1 + R1_BYTES, "R1 map");
constexpr size_t WS_R3 = WS_R1 + R1_BYTES;
static_assert((size_t)(NPAN - HID_SPLIT) * 256 * FF * 2 == (size_t)M * DM * 2, "R3 map");
constexpr size_t WS_KVR = WS_R3 + (size_t)M * DM * 2;
constexpr size_t WS_PLQ = WS_KVR + (size_t)M * NQK * 2;
constexpr size_t WS_SSQ = WS_PLQ + (size_t)M * DM * 2;
constexpr size_t WS_DV = WS_SSQ + (size_t)2 * M * 16 * 4;
constexpr size_t WS_END = WS_DV + (size_t)NCH_ALL * 128 * 4;

__device__ __forceinline__ float bf2f(unsigned short b) { return __uint_as_float((unsigned)b << 16); }
__device__ __forceinline__ float bflo(unsigned w) { return __uint_as_float(w << 16); }
__device__ __forceinline__ float bfhi(unsigned w) { return __uint_as_float(w & 0xffff0000u); }
typedef __bf16 bf16x2_t __attribute__((ext_vector_type(2)));
__device__ __forceinline__ unsigned pk2(float lo, float hi) { const f32x2 v = {lo, hi}; const bf16x2_t b = __builtin_convertvector(v, bf16x2_t); return __builtin_bit_cast(unsigned, b); }
__device__ __forceinline__ float fexp(float x) { return __builtin_amdgcn_exp2f(x * LOG2E); }
__device__ __forceinline__ float frcp(float x) { return __builtin_amdgcn_rcpf(x); }
__device__ __forceinline__ float frsq(float x) { return __builtin_amdgcn_rsqf(x); }
__device__ __forceinline__ float fsigmoid(float x) { return frcp(1.f + fexp(-x)); }
__device__ __forceinline__ float logsig(float x) { return fminf(x, 0.f) - __logf(1.f + fexp(-fabsf(x))); }
__device__ __forceinline__ s16x4 trd(const LAS bf16_t* p) { return __builtin_bit_cast(s16x4, __builtin_amdgcn_ds_read_tr16_b64_v4i16((LAS s16x4*)p)); }
__device__ __forceinline__ bf16x8 cat8(s16x4 lo, s16x4 hi) { return (bf16x8){lo[0], lo[1], lo[2], lo[3], hi[0], hi[1], hi[2], hi[3]}; }
__device__ __forceinline__ void st_wt(float* p, float v) { __hip_atomic_store(p, v, __ATOMIC_RELAXED, __HIP_MEMORY_SCOPE_AGENT); }
__device__ __forceinline__ float wave_sum(float v) {
#pragma unroll
    for (int o = 1; o < 64; o <<= 1) v += __shfl_xor(v, o);
    return v;
}
__device__ __forceinline__ float row_r(const float* ssq, int row) {
    const f32x4* p = (const f32x4*)(ssq + (size_t)row * 16);
    const f32x4 a = p[0], b = p[1], c = p[2], d = p[3];
    const f32x4 s = (a + b) + (c + d);
    return frsq(((s.x + s.y) + (s.z + s.w)) * (1.f / 1024.f) + EPS);
}

namespace pg8 {
constexpr int BM = 256, BK = 64, HALF = 128, HTB = HALF * BK * 2, STAGE_BYTES = 8 * HTB, NXCD = 8, WGM = 8;
__host__ __device__ __forceinline__ int lds_byte(int r, int c) { const int st = (r >> 4) * 2 + (c >> 5), rr = r & 15, cc = c & 31, ob = rr * 64 + cc * 2; return st * 1024 + (ob ^ (((ob >> 9) & 1) << 5)); }
__host__ __device__ __forceinline__ void stage_rc(int b, int& R, int& C) { const int st = b / 1024, sb = b % 1024, swz = sb ^ (((sb >> 9) & 1) << 5); R = (st >> 1) * 16 + swz / 64; C = (st & 1) * 32 + (swz % 64) / 2; }
__host__ __device__ __forceinline__ int perm32(int rho) { const int n = rho >> 4, i = rho & 15; return 8 * (i >> 2) + 4 * n + (i & 3); }
struct Unit { int pm, pn; };
struct Gemm { const bf16_t* A; const bf16_t* A2; int split; const bf16_t* Bt; int M, N, K; };
struct StaticOrder {
    int nM, nN, nwg, G, c;
    __device__ void init(int M_, int N, int G_, int c_) { nM = M_ / BM; nN = N / BM; nwg = nM * nN; G = G_; c = c_; }
    __device__ bool next(int i, Unit& u) const {
        const long L = (long)i * G + c; if (L >= nwg) return false;
        int wgid = (int)L; { const int q = nwg / NXCD, r = nwg % NXCD, xcd = wgid % NXCD, off = wgid / NXCD; wgid = (xcd < r ? xcd * (q + 1) : r * (q + 1) + (xcd - r) * q) + off; }
        const int nig = WGM * nN, gid = wgid / nig, fm = gid * WGM, gsz = (nM - fm) < WGM ? (nM - fm) : WGM;
        u.pm = fm + ((wgid % nig) % gsz); u.pn = (wgid % nig) / gsz; return true;
    }
};

template <class Epi>
__device__ __forceinline__ void gemm_phase(LAS unsigned char* lds, const Gemm g, const StaticOrder& S, const Epi& E) {
    const int tid = threadIdx.x, wid = __builtin_amdgcn_readfirstlane(tid >> 6), lane = tid & 63, wr = wid >> 2, wc = wid & 3, fr = lane & 15, fq = lane >> 4;
    const int K = g.K, nt = K / BK;
    unsigned voffA[2], voffB[2];
#pragma unroll
    for (int i = 0; i < 2; ++i) { int R, C; stage_rc(tid * 16 + i * 8192, R, C); const int Rb = (R & ~31) + perm32(R & 31);
        voffA[i] = (unsigned)(R * K + C) * 2u; voffB[i] = (unsigned)(Rb * K + C) * 2u; }
    const size_t kstep = (size_t)(BK * 2);
    const size_t hstep = (size_t)HALF * K * 2;
    const size_t tstep = 2 * hstep;
    const unsigned ldsw = (unsigned)wid * 1024u;
    const int aoff = lds_byte(wr * 64 + fr, fq * 8), boff = lds_byte(wc * 32 + fr, fq * 8);
#define PG8_APTR(pm) ((pm) < g.split ? (const char*)g.A + (size_t)(pm) * tstep : (const char*)g.A2 + (size_t)((pm) - g.split) * tstep)
#define PG8_SA(b, h) (((b) * 2 + (h)) * HTB)
#define PG8_SB(b, h) ((4 + (b) * 2 + (h)) * HTB)
#define PG8_STAGE(bufoff, gbase, voff) do { _Pragma("unroll") for (int _i = 0; _i < 2; ++_i) \
        __builtin_amdgcn_global_load_lds((const unsigned*)((const char*)(gbase) + (voff)[_i]), (LAS unsigned*)(lds + (bufoff) + ldsw + _i * 8192), 16, 0, 0); } while (0)
#define PG8_LDA(dst, b, h) do { _Pragma("unroll") for (int m = 0; m < 4; ++m) _Pragma("unroll") for (int k = 0; k < 2; ++k) dst[m][k] = *(const LAS bf16x8*)(lds + PG8_SA(b, h) + aoff + m * 2048 + k * 1024); } while (0)
#define PG8_LDB(dst, b, h) do { _Pragma("unroll") for (int n = 0; n < 2; ++n) _Pragma("unroll") for (int k = 0; k < 2; ++k) dst[n][k] = *(const LAS bf16x8*)(lds + PG8_SB(b, h) + boff + n * 2048 + k * 1024); } while (0)
#define PG8_MMA(ai, bj, At, Bt) do { __builtin_amdgcn_s_setprio(1); _Pragma("unroll") for (int m = 0; m < 4; ++m) _Pragma("unroll") for (int n = 0; n < 2; ++n) _Pragma("unroll") for (int k = 0; k < 2; ++k) \
        acc[ai][bj][m][n] = __builtin_amdgcn_mfma_f32_16x16x32_bf16(Bt[n][k], At[m][k], acc[ai][bj][m][n], 0, 0, 0); __builtin_amdgcn_s_setprio(0); } while (0)
#define PG8_WAIT_V(n) asm volatile("s_waitcnt vmcnt(" #n ")" ::: "memory")
#define PG8_WAIT_L(n) asm volatile("s_waitcnt lgkmcnt(" #n ")" ::: "memory")
#define PG8_BAR __builtin_amdgcn_s_barrier()
#define PG8_SCHED __builtin_amdgcn_sched_barrier(0)
    Unit cur, nxt; int ui = 0;
    if (!S.next(0, cur)) return;
    LAS float* rtab_all = (LAS float*)(lds + STAGE_BYTES);
    if (E.rsrc() != nullptr) { Unit uu; for (int i = 0; i < 8 && S.next(i, uu); ++i) if (tid < 256) rtab_all[i * 256 + tid] = row_r(E.rsrc(), uu.pm * BM + tid); }
    f32x4 acc[2][2][4][2];
#pragma unroll
    for (int a = 0; a < 2; ++a)
#pragma unroll
        for (int b = 0; b < 2; ++b)
#pragma unroll
            for (int m = 0; m < 4; ++m)
#pragma unroll
                for (int n = 0; n < 2; ++n) acc[a][b][m][n] = (f32x4){0.f, 0.f, 0.f, 0.f};
    bf16x8 At[4][2], B0[2][2], B1[2][2];
    const char* cA = PG8_APTR(cur.pm); const char* cB = (const char*)g.Bt + (size_t)cur.pn * tstep;
    PG8_STAGE(PG8_SB(0, 0), cB, voffB); PG8_STAGE(PG8_SB(0, 1), cB + hstep, voffB); PG8_STAGE(PG8_SA(0, 0), cA, voffA); PG8_STAGE(PG8_SA(0, 1), cA + hstep, voffA);
    PG8_WAIT_L(0);
    if (wr == 1) PG8_BAR;
    PG8_WAIT_V(2); PG8_BAR;
    PG8_STAGE(PG8_SB(1, 0), cB + kstep, voffB); PG8_STAGE(PG8_SA(1, 0), cA + kstep, voffA); PG8_STAGE(PG8_SB(1, 1), cB + hstep + kstep, voffB);
    PG8_WAIT_V(6); PG8_BAR;
    for (;;) {
        const bool has_next = S.next(ui + 1, nxt);
        const char* nA = has_next ? PG8_APTR(nxt.pm) : cA; const char* nB = has_next ? (const char*)g.Bt + (size_t)nxt.pn * tstep : cB;
#pragma clang loop unroll(disable)
        for (int t = 0; t < nt; t += 2) {
            const bool last = (t == nt - 2);
            const char* a1 = cA + (size_t)(t + 1) * kstep;
            const char* a2 = last ? nA : cA + (size_t)(t + 2) * kstep; const char* b2 = last ? nB : cB + (size_t)(t + 2) * kstep;
            const char* a3 = a2 + kstep; const char* b3 = b2 + kstep;
            PG8_LDB(B0, 0, 0); PG8_LDB(B1, 0, 1); PG8_SCHED; PG8_LDA(At, 0, 0); PG8_STAGE(PG8_SA(1, 1), a1 + hstep, voffA);
            PG8_WAIT_V(8); PG8_WAIT_L(0); PG8_BAR; PG8_MMA(0, 0, At, B0); PG8_MMA(0, 1, At, B1); PG8_BAR; PG8_SCHED;
            PG8_LDA(At, 0, 1); PG8_STAGE(PG8_SB(0, 0), b2, voffB); PG8_STAGE(PG8_SB(0, 1), b2 + hstep, voffB); PG8_STAGE(PG8_SA(0, 0), a2, voffA);
            PG8_WAIT_V(8); PG8_WAIT_L(0); PG8_BAR; PG8_MMA(1, 0, At, B0); PG8_MMA(1, 1, At, B1); PG8_BAR; PG8_SCHED;
            PG8_LDB(B0, 1, 0); PG8_LDB(B1, 1, 1); PG8_SCHED; PG8_LDA(At, 1, 0); PG8_STAGE(PG8_SA(0, 1), a2 + hstep, voffA);
            PG8_WAIT_V(8); PG8_WAIT_L(0); PG8_BAR; PG8_MMA(0, 0, At, B0); PG8_MMA(0, 1, At, B1); PG8_BAR; PG8_SCHED;
            PG8_LDA(At, 1, 1); PG8_STAGE(PG8_SB(1, 0), b3, voffB); PG8_STAGE(PG8_SB(1, 1), b3 + hstep, voffB); PG8_STAGE(PG8_SA(1, 0), a3, voffA);
            PG8_WAIT_V(8); PG8_WAIT_L(0); PG8_BAR; PG8_MMA(1, 0, At, B0); PG8_MMA(1, 1, At, B1); PG8_BAR; PG8_SCHED;
        }
        if (wr == 0) PG8_BAR;
        { int efr = fr, efq = fq, etid = tid; asm volatile("" : "+v"(efr), "+v"(efq), "+v"(etid));
          E(acc, cur, wr, wc, efr, efq, rtab_all + (ui & 7) * 256, etid); }
        if (!has_next) break;
#pragma unroll
        for (int a = 0; a < 2; ++a)
#pragma unroll
            for (int b = 0; b < 2; ++b)
#pragma unroll
                for (int m = 0; m < 4; ++m)
#pragma unroll
                    for (int n = 0; n < 2; ++n) acc[a][b][m][n] = (f32x4){0.f, 0.f, 0.f, 0.f};
        cur = nxt; cA = nA; cB = nB; ++ui;
        if (wr == 1) PG8_BAR;
    }
    PG8_WAIT_V(0);
    PG8_BAR;
#undef PG8_APTR
#undef PG8_SA
#undef PG8_SB
#undef PG8_STAGE
#undef PG8_LDA
#undef PG8_LDB
#undef PG8_MMA
#undef PG8_WAIT_V
#undef PG8_WAIT_L
#undef PG8_BAR
#undef PG8_SCHED
}

#define EPI_ROWLOOP _Pragma("unroll") for (int ai = 0; ai < 2; ++ai) _Pragma("unroll") for (int m = 0; m < 4; ++m)
__device__ __forceinline__ u32x4 pack8(const f32x4 v0, const f32x4 v1) { u32x4 w; w.x = pk2(v0[0], v0[1]); w.y = pk2(v0[2], v0[3]); w.z = pk2(v1[0], v1[1]); w.w = pk2(v1[2], v1[3]); return w; }

struct EpiIn {
    bf16_t *Q, *Kk, *V, *G, *LG; const float* ssq; const float* b_a2;
    __device__ __forceinline__ const float* rsrc() const { return ssq; }
    __device__ __forceinline__ void operator()(const f32x4 (&acc)[2][2][4][2], const Unit& u, int wr, int wc, int fr, int fq, LAS float* rtab, int tid) const {
        const int pn = u.pn; bf16_t* base; int ld, c0;
        if (pn < 2) { base = Q; ld = NQK; c0 = pn * 256; } else if (pn < 4) { base = Kk; ld = NQK; c0 = (pn - 2) * 256; }
        else if (pn < 8) { base = V; ld = NV; c0 = (pn - 4) * 256; } else if (pn < 12) { base = G; ld = NV; c0 = (pn - 8) * 256; }
        else { base = LG; ld = NQK; c0 = (pn - 12) * 256; }
        const bool is_lg = pn >= 12;
        const int col = c0 + wc * 32 + 8 * fq;
        f32x4 bb[2][2];
#pragma unroll
        for (int bj = 0; bj < 2; ++bj)
#pragma unroll
            for (int n = 0; n < 2; ++n) bb[bj][n] = is_lg ? *(const f32x4*)(b_a2 + col + bj * HALF + 4 * n) : (f32x4){0.f, 0.f, 0.f, 0.f};
        EPI_ROWLOOP { const int lr = ai * HALF + wr * 64 + m * 16 + fr, row = u.pm * BM + lr; const float r = rtab[lr];
#pragma unroll
            for (int bj = 0; bj < 2; ++bj) { f32x4 v0 = acc[ai][bj][m][0] * r, v1 = acc[ai][bj][m][1] * r;
                if (is_lg) { v0 += bb[bj][0]; v1 += bb[bj][1];
#pragma unroll
                    for (int e = 0; e < 4; ++e) { v0[e] = logsig(v0[e]) * (1.f / 16.f); v1[e] = logsig(v1[e]) * (1.f / 16.f); } }
                *(u32x4*)(base + (size_t)row * ld + col + bj * HALF) = pack8(v0, v1); } }
    }
};
template <bool FROM_X> struct EpiRes {
    const float* X0; const float* X1; const bf16_t* BB; bf16_t* XO; float* ssq_out; float sc;
    __device__ __forceinline__ const float* rsrc() const { return nullptr; }
    __device__ __forceinline__ void operator()(const f32x4 (&acc)[2][2][4][2], const Unit& u, int wr, int wc, int fr, int fq, LAS float* rtab, int tid) const {
        const int col = u.pn * BM + wc * 32 + 8 * fq;
#pragma unroll
        for (int ai = 0; ai < 2; ++ai) {
            f32x4 b0[4][2], b1[4][2]; u32x4 bw[4][2];
#pragma unroll
            for (int m = 0; m < 4; ++m) { const int row = u.pm * BM + ai * HALF + wr * 64 + m * 16 + fr;
#pragma unroll
                for (int bj = 0; bj < 2; ++bj) {
                    if (FROM_X) { const float* src = (u.pm < MP / 256 ? X0 + (size_t)row * DM : X1 + (size_t)(row - MP) * DM) + col + bj * HALF; b0[m][bj] = *(const f32x4*)src; b1[m][bj] = *(const f32x4*)(src + 4); }
                    else bw[m][bj] = *(const u32x4*)(BB + (size_t)row * DM + col + bj * HALF); } }
            if (!FROM_X) asm volatile("" ::: "memory");
#pragma unroll
            for (int m = 0; m < 4; ++m) { const int row = u.pm * BM + ai * HALF + wr * 64 + m * 16 + fr; float s = 0.f;
#pragma unroll
                for (int bj = 0; bj < 2; ++bj) {
                    if (!FROM_X) { const u32x4 w = bw[m][bj]; b0[m][bj] = (f32x4){bflo(w.x), bfhi(w.x), bflo(w.y), bfhi(w.y)}; b1[m][bj] = (f32x4){bflo(w.z), bfhi(w.z), bflo(w.w), bfhi(w.w)}; }
                    const f32x4 v0 = acc[ai][bj][m][0] * sc + b0[m][bj], v1 = acc[ai][bj][m][1] * sc + b1[m][bj];
                    *(u32x4*)(XO + (size_t)row * DM + col + bj * HALF) = pack8(v0, v1);
                    s += (v0[0] * v0[0] + v0[1] * v0[1]) + (v0[2] * v0[2] + v0[3] * v0[3]) + (v1[0] * v1[0] + v1[1] * v1[1]) + (v1[2] * v1[2] + v1[3] * v1[3]); }
                s += __shfl_xor(s, 16); s += __shfl_xor(s, 32);
                if (fq == 0) st_wt(ssq_out + (size_t)row * 16 + u.pn * 4 + wc, s); }
        }
    }
};
struct EpiUp {
    bf16_t* HA; bf16_t* HB; const float* ssq;
    __device__ __forceinline__ const float* rsrc() const { return ssq; }
    __device__ __forceinline__ void operator()(const f32x4 (&acc)[2][2][4][2], const Unit& u, int wr, int wc, int fr, int fq, LAS float* rtab, int tid) const {
        bf16_t* base = u.pm < HID_SPLIT ? HA + (size_t)u.pm * 256 * FF : HB + (size_t)(u.pm - HID_SPLIT) * 256 * FF;
        const int col = u.pn * BM + wc * 32 + 8 * fq;
        EPI_ROWLOOP { const int lr = ai * HALF + wr * 64 + m * 16 + fr; const float r = rtab[lr];
#pragma unroll
            for (int bj = 0; bj < 2; ++bj) { f32x4 v0 = acc[ai][bj][m][0] * r, v1 = acc[ai][bj][m][1] * r;
#pragma unroll
                for (int e = 0; e < 4; ++e) { const float a = fmaxf(v0[e], 0.f), b = fmaxf(v1[e], 0.f); v0[e] = a * a; v1[e] = b * b; }
                *(u32x4*)(base + (size_t)lr * FF + col + bj * HALF) = pack8(v0, v1); } }
    }
};
struct EpiPl {
    bf16_t* PL;
    __device__ __forceinline__ const float* rsrc() const { return nullptr; }
    __device__ __forceinline__ void operator()(const f32x4 (&acc)[2][2][4][2], const Unit& u, int wr, int wc, int fr, int fq, LAS float* rtab, int tid) const {
        const int col = u.pn * BM + wc * 32 + 8 * fq;
        EPI_ROWLOOP { const int row = u.pm * BM + ai * HALF + wr * 64 + m * 16 + fr;
#pragma unroll
            for (int bj = 0; bj < 2; ++bj) *(u32x4*)(PL + (size_t)row * DM + col + bj * HALF) = pack8(acc[ai][bj][m][0], acc[ai][bj][m][1]); }
    }
};
template <bool LAST> struct EpiGate {
    float* HO; const bf16_t* BB; const bf16_t* PL; bf16_t* OB; const float* ssq_in; float* ssq_out; float sc;
    __device__ __forceinline__ const float* rsrc() const { return ssq_in; }
    __device__ __forceinline__ void operator()(const f32x4 (&acc)[2][2][4][2], const Unit& u, int wr, int wc, int fr, int fq, LAS float* rtab, int tid) const {
        const int col = u.pn * BM + wc * 32 + 8 * fq;
#pragma unroll
        for (int ai = 0; ai < 2; ++ai) {
            u32x4 bw[4][2], pw[4][2];
#pragma unroll
            for (int m = 0; m < 4; ++m) { const size_t off0 = (size_t)(u.pm * BM + ai * HALF + wr * 64 + m * 16 + fr) * DM + col;
#pragma unroll
                for (int bj = 0; bj < 2; ++bj) { bw[m][bj] = *(const u32x4*)(BB + off0 + bj * HALF); pw[m][bj] = *(const u32x4*)(PL + off0 + bj * HALF); } }
#pragma unroll
            for (int m = 0; m < 4; ++m) { const int lr = ai * HALF + wr * 64 + m * 16 + fr, row = u.pm * BM + lr; const float r = rtab[lr];
                float s = 0.f;
#pragma unroll
                for (int bj = 0; bj < 2; ++bj) { const size_t off = (size_t)row * DM + col + bj * HALF; const u32x4 b_ = bw[m][bj], p_ = pw[m][bj];
                    const f32x4 b0 = {bflo(b_.x), bfhi(b_.x), bflo(b_.y), bfhi(b_.y)}, b1 = {bflo(b_.z), bfhi(b_.z), bflo(b_.w), bfhi(b_.w)};
                    const f32x4 p0 = {bflo(p_.x), bfhi(p_.x), bflo(p_.y), bfhi(p_.y)}, p1 = {bflo(p_.z), bfhi(p_.z), bflo(p_.w), bfhi(p_.w)};
                    f32x4 v0 = acc[ai][bj][m][0] * r, v1 = acc[ai][bj][m][1] * r;
#pragma unroll
                    for (int e = 0; e < 4; ++e) { v0[e] = b0[e] + fsigmoid(v0[e]) * p0[e] * sc; v1[e] = b1[e] + fsigmoid(v1[e]) * p1[e] * sc; }
                    if (LAST) { *(f32x4*)(HO + off) = v0; *(f32x4*)(HO + off + 4) = v1; }
                    else { *(u32x4*)(OB + off) = pack8(v0, v1);
                        s += (v0[0] * v0[0] + v0[1] * v0[1]) + (v0[2] * v0[2] + v0[3] * v0[3]) + (v1[0] * v1[0] + v1[1] * v1[1]) + (v1[2] * v1[2] + v1[3] * v1[3]); } }
                if (!LAST) { s += __shfl_xor(s, 16); s += __shfl_xor(s, 32); if (fq == 0) st_wt(ssq_out + (size_t)row * 16 + u.pn * 4 + wc, s); } }
        }
    }
};
struct EpiKvq {
    bf16_t* KV; bf16_t* Qb; const float* ssq; float *CKP, *CVP, *CKS, *CVS;
    __device__ __forceinline__ const float* rsrc() const { return ssq; }
    __device__ __forceinline__ void operator()(const f32x4 (&acc)[2][2][4][2], const Unit& u, int wr, int wc, int fr, int fq, LAS float* rtab, int tid) const {
        const int pn = u.pn, c = wc * 32 + 8 * fq;
        EPI_ROWLOOP { const int lr = ai * HALF + wr * 64 + m * 16 + fr, row = u.pm * BM + lr; const float r = rtab[lr];
            float* cdst = nullptr;
            if (pn < 2) {
                if (row < MP) { const int b = row >> 13, t = row & (SEQ - 1); if (t >= SEQ - 128) cdst = (pn == 0 ? CKP : CVP) + ((size_t)(b * 128 + t - (SEQ - 128)) * 256 + c); }
                else { const int rs = row - MP, sb = rs >> 3, i = rs & 7; cdst = (pn == 0 ? CKS : CVS) + ((size_t)(sb * 128 + 120 + i) * 256 + c); }
            }
            bf16_t* dst = pn < 2 ? KV + (size_t)row * 512 + pn * 256 + c : Qb + (size_t)row * DM + (pn - 2) * 256 + c;
#pragma unroll
            for (int bj = 0; bj < 2; ++bj) { const f32x4 v0 = acc[ai][bj][m][0] * r, v1 = acc[ai][bj][m][1] * r;
                *(u32x4*)(dst + bj * HALF) = pack8(v0, v1);
                if (cdst) { *(f32x4*)(cdst + bj * HALF) = v0; *(f32x4*)(cdst + bj * HALF + 4) = v1; } } }
    }
};
}


namespace mg {
constexpr int KT = 256, LDT = KT + 8, TILE_B = 64 * LDT * 2;
template <class Epi>
__device__ __forceinline__ void mini_gemm(LAS unsigned char* lds, const bf16_t* A  , const bf16_t* Bt  , int N, int K, int G, int bx, const Epi& E) {
    const int tid = threadIdx.x, lane = tid & 63, wave = __builtin_amdgcn_readfirstlane(tid >> 6), l15 = lane & 15, g = lane >> 4;
    const int rt = wave & 3, chh = wave >> 2, nk = K / KT, units = 16 * (N / 64);
    LAS float* red = (LAS float*)(lds + 4 * TILE_B);
    for (int u = bx; u < units; u += G) {
        const int rm = u & 15, cn = u >> 4;
        const bf16_t* Ag = A + (size_t)(rm * 64) * K; const bf16_t* Bg = Bt + (size_t)(cn * 64) * K;
        u32x4 ra0[4], rb0[4], ra1[4], rb1[4];
#define MG_LOAD(ra, rb, kt) do { _Pragma("unroll") for (int i = 0; i < 4; ++i) { const int c = tid + 512 * i, row = c >> 5, ch = c & 31; \
            ra[i] = *(const u32x4*)(Ag + (size_t)row * K + (kt) * KT + ch * 8); rb[i] = *(const u32x4*)(Bg + (size_t)row * K + (kt) * KT + ch * 8); } } while (0)
#define MG_STORE(ra, rb, b) do { _Pragma("unroll") for (int i = 0; i < 4; ++i) { const int c = tid + 512 * i, row = c >> 5, ch = c & 31; \
            *(LAS u32x4*)(lds + (b) * 2 * TILE_B + (row * LDT + ch * 8) * 2) = ra[i]; *(LAS u32x4*)(lds + (b) * 2 * TILE_B + TILE_B + (row * LDT + ch * 8) * 2) = rb[i]; } } while (0)
#define MG_COMPUTE(b) do { const LAS bf16_t* Al = (const LAS bf16_t*)(lds + (b) * 2 * TILE_B); const LAS bf16_t* Bl = (const LAS bf16_t*)(lds + (b) * 2 * TILE_B + TILE_B); \
            _Pragma("unroll") for (int ks = 0; ks < KT / 32; ++ks) { const bf16x8 Af = *(const LAS bf16x8*)(Al + (16 * rt + l15) * LDT + 32 * ks + 8 * g); \
                _Pragma("unroll") for (int t = 0; t < 2; ++t) { const bf16x8 Bf = *(const LAS bf16x8*)(Bl + (16 * (2 * chh + t) + l15) * LDT + 32 * ks + 8 * g); \
                    acc[t] = __builtin_amdgcn_mfma_f32_16x16x32_bf16(Bf, Af, acc[t], 0, 0, 0); } } } while (0)
        f32x4 acc[2] = {(f32x4){0.f, 0.f, 0.f, 0.f}, (f32x4){0.f, 0.f, 0.f, 0.f}};
#define MG_BAR() do { asm volatile("s_waitcnt lgkmcnt(0)" ::: "memory"); __builtin_amdgcn_s_barrier(); asm volatile("" ::: "memory"); } while (0)
        MG_LOAD(ra0, rb0, 0); if (nk > 1) MG_LOAD(ra1, rb1, 1);
        MG_STORE(ra0, rb0, 0); MG_BAR();
        for (int kt = 0; kt < nk; kt += 2) {
            if (kt + 2 < nk) MG_LOAD(ra0, rb0, kt + 2);
            MG_COMPUTE(0);
            if (kt + 1 < nk) MG_STORE(ra1, rb1, 1);
            MG_BAR();
            if (kt + 1 < nk) {
                if (kt + 3 < nk) MG_LOAD(ra1, rb1, kt + 3);
                MG_COMPUTE(1);
                if (kt + 2 < nk) MG_STORE(ra0, rb0, 0);
                MG_BAR();
            }
        }
#undef MG_BAR
        const int row = MP + rm * 64 + 16 * rt + l15; float s = 0.f;
#pragma unroll
        for (int t = 0; t < 2; ++t) { const f32x4 o = E(row, cn * 64 + 16 * (2 * chh + t) + 4 * g, acc[t]); s += (o[0] * o[0] + o[1] * o[1]) + (o[2] * o[2] + o[3] * o[3]); }
        if (Epi::SSQ) { s += __shfl_xor(s, 16); s += __shfl_xor(s, 32); if (g == 0) red[(16 * rt + l15) * 2 + chh] = s;
            __syncthreads();
            if (tid < 64) st_wt(E.ssq_out + (size_t)(MP + rm * 64 + tid) * 16 + cn, red[tid * 2] + red[tid * 2 + 1]);
            __syncthreads(); }
#undef MG_LOAD
#undef MG_STORE
#undef MG_COMPUTE
    }
}
__device__ __forceinline__ u32x2 pack4(const f32x4 v) { u32x2 w; w.x = pk2(v[0], v[1]); w.y = pk2(v[2], v[3]); return w; }
template <bool FROM_X> struct MRes {
    static constexpr bool SSQ = true; const float* X1; const bf16_t* BB; bf16_t* XO; float* ssq_out; float sc;
    __device__ __forceinline__ f32x4 operator()(int row, int col, const f32x4 v) const {
        f32x4 b; if (FROM_X) b = *(const f32x4*)(X1 + (size_t)(row - MP) * DM + col); else { const u32x2 w = *(const u32x2*)(BB + (size_t)row * DM + col); b = (f32x4){bflo(w.x), bfhi(w.x), bflo(w.y), bfhi(w.y)}; }
        const f32x4 o = b + v * sc; *(u32x2*)(XO + (size_t)row * DM + col) = pack4(o); return o; }
};
struct MPl { static constexpr bool SSQ = false; bf16_t* PL; float* ssq_out;
    __device__ __forceinline__ f32x4 operator()(int row, int col, const f32x4 v) const { *(u32x2*)(PL + (size_t)row * DM + col) = pack4(v); return v; } };
struct MUp { static constexpr bool SSQ = false; bf16_t* HS  ; const float* ssq; float* ssq_out;
    __device__ __forceinline__ f32x4 operator()(int row, int col, const f32x4 v) const { const float r = row_r(ssq, row); f32x4 o;
#pragma unroll
        for (int e = 0; e < 4; ++e) { const float a = fmaxf(v[e] * r, 0.f); o[e] = a * a; }
        *(u32x2*)(HS + (size_t)(row - MP) * FF + col) = pack4(o); return o; } };
template <bool LAST> struct MGate { static constexpr bool SSQ = !LAST; float* HO; const bf16_t* BB; const bf16_t* PL; bf16_t* OB; const float* ssq_in; float* ssq_out; float sc;
    __device__ __forceinline__ f32x4 operator()(int row, int col, const f32x4 v) const { const float r = row_r(ssq_in, row); const size_t off = (size_t)row * DM + col;
        const u32x2 bw = *(const u32x2*)(BB + off), pw = *(const u32x2*)(PL + off);
        const f32x4 b = {bflo(bw.x), bfhi(bw.x), bflo(bw.y), bfhi(bw.y)}, p = {bflo(pw.x), bfhi(pw.x), bflo(pw.y), bfhi(pw.y)}; f32x4 o;
#pragma unroll
        for (int e = 0; e < 4; ++e) o[e] = b[e] + fsigmoid(v[e] * r) * p[e] * sc;
        if (LAST) *(f32x4*)(HO + off) = o; else *(u32x2*)(OB + off) = pack4(o); return o; } };
}

constexpr int NWAVES = 8, NTHREADS = 512;
constexpr int RING_BYTES = 131072, LDS_BYTES = 147456;
struct Args { const float* in[26]; float* out; unsigned char* ws; int ph_lo, ph_hi; };

struct TJob { const float* src; int ldw, kk, nblk; bf16_t* dst; const float* gain; float scale; int item; };
__device__ __forceinline__ void p0_tload(const TJob& J, float (&r)[32], int lane) {
    const int kb = J.item / J.nblk, nb = J.item % J.nblk, k0 = 64 * kb, n0 = 32 * nb;
#pragma unroll
    for (int i = 0; i < 32; ++i) r[i] = J.src[(size_t)(k0 + 2 * i + (lane >> 5)) * J.ldw + n0 + (lane & 31)];
}
__device__ __forceinline__ void p0_tfinish(const TJob& J, const float (&r)[32], LAS float* scr, int lane) {
    const int kb = J.item / J.nblk, nb = J.item % J.nblk, k0 = 64 * kb, n0 = 32 * nb, c = lane & 7;
    f32x4 g0 = {1.f, 1.f, 1.f, 1.f}, g1 = g0;
    if (J.gain) { g0 = *(const f32x4*)(J.gain + k0 + 8 * c); g1 = *(const f32x4*)(J.gain + k0 + 8 * c + 4); }
    g0 *= J.scale; g1 *= J.scale;
#pragma unroll
    for (int i = 0; i < 32; ++i) scr[(2 * i + (lane >> 5)) * 33 + (lane & 31)] = r[i];
    asm volatile("s_waitcnt lgkmcnt(0)" ::: "memory");
#pragma unroll
    for (int j = 0; j < 4; ++j) { const int n = (lane >> 3) + 8 * j; const LAS float* sp = scr + (8 * c) * 33 + n;
        u32x4 o; o.x = pk2(sp[0 * 33] * g0.x, sp[1 * 33] * g0.y); o.y = pk2(sp[2 * 33] * g0.z, sp[3 * 33] * g0.w); o.z = pk2(sp[4 * 33] * g1.x, sp[5 * 33] * g1.y); o.w = pk2(sp[6 * 33] * g1.z, sp[7 * 33] * g1.w);
        *(u32x4*)(J.dst + (size_t)(n0 + n) * J.kk + k0 + 8 * c) = o; }
    asm volatile("s_waitcnt lgkmcnt(0)" ::: "memory");
}

constexpr int T128 = 144, T256 = 272, TP = 80;
#define LDS_BAR() do { asm volatile("s_waitcnt lgkmcnt(0)" ::: "memory"); __builtin_amdgcn_s_barrier(); asm volatile("" ::: "memory"); } while (0)
struct GlaRegs { u32x4 lg[2], v[4], k[2], q[2]; };
template <bool WITH_Q, bool DO_LKQ = true, bool DO_V = true>
__device__ __forceinline__ void gla_fetch(GlaRegs& R, int item, const bf16_t* Q1, const bf16_t* K1, const bf16_t* V1, const bf16_t* LGp, int tid) {
    const int bh = item >> 7, c = item & 127, b = bh >> 2, h = bh & 3; const size_t row0 = (size_t)b * SEQ + c * 64;
    if (DO_LKQ) {
#pragma unroll
        for (int i = 0; i < 2; ++i) { const int x = tid + NTHREADS * i, j = x >> 4, d8 = (x & 15) * 8; const size_t off = (row0 + j) * NQK + h * 128 + d8;
            R.lg[i] = *(const u32x4*)(LGp + off); R.k[i] = *(const u32x4*)(K1 + off); if (WITH_Q) R.q[i] = *(const u32x4*)(Q1 + off); } }
    if (DO_V) {
#pragma unroll
        for (int i = 0; i < 4; ++i) { const int x = tid + NTHREADS * i, j = x >> 5, e8 = (x & 31) * 8; R.v[i] = *(const u32x4*)(V1 + (row0 + j) * NV + h * 256 + e8); } }
}
__device__ __forceinline__ void gla_stage_lg_v(const GlaRegs& R, LAS float* bc, LAS bf16_t* vt, int tid) {
#pragma unroll
    for (int i = 0; i < 2; ++i) { const int x = tid + NTHREADS * i, j = x >> 4, d8 = (x & 15) * 8; const u32x4 w = R.lg[i];
        *(LAS f32x4*)(bc + j * 128 + d8) = (f32x4){bflo(w.x), bfhi(w.x), bflo(w.y), bfhi(w.y)}; *(LAS f32x4*)(bc + j * 128 + d8 + 4) = (f32x4){bflo(w.z), bfhi(w.z), bflo(w.w), bfhi(w.w)}; }
#pragma unroll
    for (int i = 0; i < 4; ++i) { const int x = tid + NTHREADS * i, j = x >> 5, e8 = (x & 31) * 8; *(LAS u32x4*)(vt + j * T256 + e8) = R.v[i]; }
    LDS_BAR();
    if (tid < 128) { float s = 0.f;
#pragma unroll 8
        for (int j = 0; j < 64; ++j) { s += bc[j * 128 + tid]; bc[j * 128 + tid] = s; } }
    LDS_BAR();
}
constexpr int NSUP = 32, NSUP_ALL = NBH * NSUP;
template <bool OUT>
__device__ __forceinline__ void gla_super_phase(LAS unsigned char* lds, int G, int bx, const bf16_t* Q1, const bf16_t* K1, const bf16_t* V1, const bf16_t* G1, const bf16_t* LGp, bf16_t* US, float* DVS,
                                                const float* ogain, bf16_t* OG, int tid, int lane, int wave) {
    LAS float* bc = (LAS float*)lds;
    LAS bf16_t* Pm = (LAS bf16_t*)lds;
    LAS bf16_t* qt = (LAS bf16_t*)(lds + 32768);
    LAS bf16_t* kt = qt + 64 * T128;
    LAS bf16_t* kd = kt + 64 * T128;
    LAS bf16_t* vt = kd + 64 * T128;
    LAS float* red = (LAS float*)(lds + 32768 + 3 * 64 * T128 * 2 + 64 * T256 * 2);
    LAS float* em = red + 512;
    LAS float* dvl = em + 128;
    const int l15 = lane & 15, g = lane >> 4, q = l15 >> 2, p = l15 & 3;
    f32x4 gn[2] = {(f32x4){0.f, 0.f, 0.f, 0.f}, (f32x4){0.f, 0.f, 0.f, 0.f}};
    if (OUT) {
#pragma unroll
        for (int t = 0; t < 2; ++t) gn[t] = *(const f32x4*)(ogain + 16 * (2 * wave + t) + 4 * g); }
    GlaRegs R;
    if (bx < NSUP_ALL) gla_fetch<OUT>(R, (bx >> 5) * NCHUNK + (bx & 31) * 4, Q1, K1, V1, LGp, tid);
    for (int item = bx; item < NSUP_ALL; item += G) {
        const int bh = item >> 5, sc = item & 31, b = bh >> 2, h = bh & 3;
        f32x4 S[8][2];
        if (OUT) {
#pragma unroll
            for (int dt = 0; dt < 8; ++dt)
#pragma unroll
                for (int t = 0; t < 2; ++t) { const u32x2 w = *(const u32x2*)(US + ((size_t)item * 256 + 16 * (2 * wave + t) + l15) * 128 + 16 * dt + 4 * g); S[dt][t] = (f32x4){bflo(w.x), bfhi(w.x), bflo(w.y), bfhi(w.y)}; }
        } else {
#pragma unroll
            for (int dt = 0; dt < 8; ++dt) { S[dt][0] = (f32x4){0.f, 0.f, 0.f, 0.f}; S[dt][1] = (f32x4){0.f, 0.f, 0.f, 0.f}; } }
        float lsum = 0.f;
        for (int cc = 0; cc < 4; ++cc) {
            const int c = sc * 4 + cc; const size_t row0 = (size_t)b * SEQ + c * 64;
            gla_stage_lg_v(R, bc, vt, tid);
#pragma unroll
            for (int i = 0; i < 2; ++i) { const int x = tid + NTHREADS * i, j = x >> 4, d8 = (x & 15) * 8; const u32x4 wk = R.k[i];
                float kv[8] = {bflo(wk.x), bfhi(wk.x), bflo(wk.y), bfhi(wk.y), bflo(wk.z), bfhi(wk.z), bflo(wk.w), bfhi(wk.w)};
                float cur[8], dd[8];
#pragma unroll
                for (int t = 0; t < 8; ++t) { cur[t] = bc[j * 128 + d8 + t]; dd[t] = kv[t] * fexp(bc[63 * 128 + d8 + t] - cur[t]); }
                u32x4 o; o.x = pk2(dd[0], dd[1]); o.y = pk2(dd[2], dd[3]); o.z = pk2(dd[4], dd[5]); o.w = pk2(dd[6], dd[7]); *(LAS u32x4*)(kd + j * T128 + d8) = o;
                if (OUT) { const u32x4 wq = R.q[i];
                    float qv[8] = {bflo(wq.x), bfhi(wq.x), bflo(wq.y), bfhi(wq.y), bflo(wq.z), bfhi(wq.z), bflo(wq.w), bfhi(wq.w)};
                    float a[8], bb[8];
#pragma unroll
                    for (int t = 0; t < 8; ++t) { const float mid = bc[31 * 128 + d8 + t]; a[t] = qv[t] * fexp(cur[t] - mid); bb[t] = kv[t] * fexp(mid - cur[t]); }
                    o.x = pk2(a[0], a[1]); o.y = pk2(a[2], a[3]); o.z = pk2(a[4], a[5]); o.w = pk2(a[6], a[7]); *(LAS u32x4*)(qt + j * T128 + d8) = o;
                    o.x = pk2(bb[0], bb[1]); o.y = pk2(bb[2], bb[3]); o.z = pk2(bb[4], bb[5]); o.w = pk2(bb[6], bb[7]); *(LAS u32x4*)(kt + j * T128 + d8) = o; } }
            if (tid < 128) { const float last = bc[63 * 128 + tid]; dvl[tid] = fexp(last); lsum += last; if (OUT) em[tid] = fexp(bc[31 * 128 + tid]); }
            const int nxt_ = (cc < 3) ? bh * NCHUNK + c + 1 : (item + G < NSUP_ALL ? ((item + G) >> 5) * NCHUNK + ((item + G) & 31) * 4 : -1);
            if (nxt_ >= 0) gla_fetch<OUT, true, false>(R, nxt_, Q1, K1, V1, LGp, tid);
            LDS_BAR();
            if (OUT) {
#pragma unroll
                for (int t = 0; t < 2; ++t) { const int id = 2 * wave + t, ti = id >> 2, tj = id & 3;
                    f32x4 a = {0.f, 0.f, 0.f, 0.f};
                    if (tj <= ti) {
#pragma unroll
                        for (int ks = 0; ks < 4; ++ks) { const bf16x8 Af = *(const LAS bf16x8*)(qt + (16 * ti + l15) * T128 + 32 * ks + 8 * g), Bf = *(const LAS bf16x8*)(kt + (16 * tj + l15) * T128 + 32 * ks + 8 * g);
                            a = __builtin_amdgcn_mfma_f32_16x16x32_bf16(Af, Bf, a, 0, 0, 0); } }
#pragma unroll
                    for (int r = 0; r < 4; ++r) { const int i = 16 * ti + 4 * g + r, j = 16 * tj + l15; const float v = (j <= i) ? a[r] : 0.f; Pm[i * TP + j] = (bf16_t)(pk2(v, 0.f) & 0xffffu); }
                }
                LDS_BAR();
                f32x4 o[4][2];
#pragma unroll
                for (int ti = 0; ti < 4; ++ti) { o[ti][0] = (f32x4){0.f, 0.f, 0.f, 0.f}; o[ti][1] = (f32x4){0.f, 0.f, 0.f, 0.f}; }
#pragma unroll
                for (int ks = 0; ks < 2; ++ks) {
                    bf16x8 Bf[2];
#pragma unroll
                    for (int t = 0; t < 2; ++t) { const LAS bf16_t* a0 = vt + (32 * ks + 8 * g + q) * T256 + 16 * (2 * wave + t) + 4 * p; Bf[t] = cat8(trd(a0), trd(a0 + 4 * T256)); }
#pragma unroll
                    for (int ti = 2 * ks; ti < 4; ++ti) { const bf16x8 Af = *(const LAS bf16x8*)(Pm + (16 * ti + l15) * TP + 32 * ks + 8 * g);
#pragma unroll
                        for (int t = 0; t < 2; ++t) o[ti][t] = __builtin_amdgcn_mfma_f32_16x16x32_bf16(Bf[t], Af, o[ti][t], 0, 0, 0); }
                }
#pragma unroll
                for (int ks = 0; ks < 4; ++ks) {
                    const f32x4 e0 = *(LAS f32x4*)(em + 32 * ks + 4 * g), e1 = *(LAS f32x4*)(em + 32 * ks + 16 + 4 * g);
                    bf16x8 Bf[2];
#pragma unroll
                    for (int t = 0; t < 2; ++t) { const f32x4 s0 = S[2 * ks][t] * e0, s1 = S[2 * ks + 1][t] * e1; u32x4 w; w.x = pk2(s0[0], s0[1]); w.y = pk2(s0[2], s0[3]); w.z = pk2(s1[0], s1[1]); w.w = pk2(s1[2], s1[3]); Bf[t] = __builtin_bit_cast(bf16x8, w); }
#pragma unroll
                    for (int ti = 0; ti < 4; ++ti) { const LAS bf16_t* ap = qt + (16 * ti + l15) * T128 + 32 * ks + 4 * g;
                        const u32x2 a0 = *(const LAS u32x2*)ap, a1 = *(const LAS u32x2*)(ap + 16); u32x4 aw; aw.x = a0.x; aw.y = a0.y; aw.z = a1.x; aw.w = a1.y; const bf16x8 Af = __builtin_bit_cast(bf16x8, aw);
#pragma unroll
                        for (int t = 0; t < 2; ++t) o[ti][t] = __builtin_amdgcn_mfma_f32_16x16x32_bf16(Bf[t], Af, o[ti][t], 0, 0, 0); }
                }
#pragma unroll
                for (int ti = 0; ti < 4; ++ti) { float s = 0.f;
#pragma unroll
                    for (int t = 0; t < 2; ++t) s += (o[ti][t][0] * o[ti][t][0] + o[ti][t][1] * o[ti][t][1]) + (o[ti][t][2] * o[ti][t][2] + o[ti][t][3] * o[ti][t][3]);
                    s += __shfl_xor(s, 16); s += __shfl_xor(s, 32);
                    if (g == 0) red[(16 * ti + l15) * 8 + wave] = s; }
                LDS_BAR();
#pragma unroll
                for (int ti = 0; ti < 4; ++ti) { const int i = 16 * ti + l15; const f32x4 r0 = *(LAS f32x4*)(red + i * 8), r1 = *(LAS f32x4*)(red + i * 8 + 4);
                    const float rms = frsq(((r0.x + r0.y) + (r0.z + r0.w) + (r1.x + r1.y) + (r1.z + r1.w)) * (1.f / 256.f) + EPS);
#pragma unroll
                    for (int t = 0; t < 2; ++t) { const size_t off = (row0 + i) * NV + h * 256 + 16 * (2 * wave + t) + 4 * g; const u32x2 gw_ = *(const u32x2*)(G1 + off);
                        const f32x4 gv = {bflo(gw_.x), bfhi(gw_.x), bflo(gw_.y), bfhi(gw_.y)}; f32x4 ov;
#pragma unroll
                        for (int r = 0; r < 4; ++r) ov[r] = o[ti][t][r] * rms * gn[t][r] * gv[r] * fsigmoid(gv[r]);
                        u32x2 w; w.x = pk2(ov[0], ov[1]); w.y = pk2(ov[2], ov[3]); *(u32x2*)(OG + off) = w; } }
            }
            if (nxt_ >= 0) gla_fetch<OUT, false, true>(R, nxt_, Q1, K1, V1, LGp, tid);
#pragma unroll
            for (int dt = 0; dt < 8; ++dt) { const f32x4 dvv = *(LAS f32x4*)(dvl + 16 * dt + 4 * g); S[dt][0] *= dvv; S[dt][1] *= dvv; }
#pragma unroll
            for (int ks = 0; ks < 2; ++ks) {
                bf16x8 Bf[2];
#pragma unroll
                for (int t = 0; t < 2; ++t) { const LAS bf16_t* a0 = vt + (32 * ks + 8 * g + q) * T256 + 16 * (2 * wave + t) + 4 * p; Bf[t] = cat8(trd(a0), trd(a0 + 4 * T256)); }
#pragma unroll
                for (int dt = 0; dt < 8; ++dt) { const LAS bf16_t* a0 = kd + (32 * ks + 8 * g + q) * T128 + 16 * dt + 4 * p; const bf16x8 Af = cat8(trd(a0), trd(a0 + 4 * T128));
#pragma unroll
                    for (int t = 0; t < 2; ++t) S[dt][t] = __builtin_amdgcn_mfma_f32_16x16x32_bf16(Af, Bf[t], S[dt][t], 0, 0, 0); }
            }
            LDS_BAR();
        }
        if (!OUT) {
#pragma unroll
            for (int dt = 0; dt < 8; ++dt)
#pragma unroll
                for (int t = 0; t < 2; ++t) { u32x2 w; w.x = pk2(S[dt][t][0], S[dt][t][1]); w.y = pk2(S[dt][t][2], S[dt][t][3]);
                    *(u32x2*)(US + ((size_t)item * 256 + 16 * (2 * wave + t) + l15) * 128 + 16 * dt + 4 * g) = w; }
            if (tid < 128) DVS[(size_t)item * 128 + tid] = fexp(lsum);
        }
    }
}
template <int NSTEP>
__device__ __forceinline__ void gla_scan(bf16_t* UT, const float* DV, float* state_out, int gtid, int gthreads) {
    for (int idx = gtid; idx < NBH * 256 * 64; idx += gthreads) {
        const int bh = idx >> 14, rem = idx & 16383, e = rem >> 6, dp = rem & 63;
        unsigned* base = (unsigned*)UT + (size_t)bh * NSTEP * 16384 + e * 64 + dp;
        const float* dv = DV + (size_t)bh * NSTEP * 128 + 2 * dp;
        float s0 = 0.f, s1 = 0.f;
        for (int c0 = 0; c0 < NSTEP; c0 += 32) {
            unsigned uu[32]; f32x2 dd[32];
#pragma unroll
            for (int k = 0; k < 32; ++k) { uu[k] = base[(size_t)(c0 + k) * 16384]; dd[k] = *(const f32x2*)(dv + (size_t)(c0 + k) * 128); }
#pragma unroll
            for (int k = 0; k < 32; ++k) { base[(size_t)(c0 + k) * 16384] = pk2(s0, s1); s0 = dd[k].x * s0 + bflo(uu[k]); s1 = dd[k].y * s1 + bfhi(uu[k]); }
        }
        float* so = state_out + ((size_t)bh * 128 + 2 * dp) * 256 + e;
        st_wt(so, s0); st_wt(so + 256, s1);
    }
}
__device__ __forceinline__ void gla_sample_pair(LAS unsigned char* lds, int base_item, const bf16_t* Q1, const bf16_t* K1, const bf16_t* V1, const bf16_t* G1, const bf16_t* LGp,
                                                const float* S0in, float* Sout, const float* ogain, bf16_t* OG, int tid) {
    const int hb = tid >> 8, t = tid & 255, item = base_item + hb, sb = item >> 2, h = item & 3; const size_t r0 = (size_t)MP + sb * 8;
    LAS float* qaT = (LAS float*)(lds + hb * 16384);
    LAS float* qsT = qaT + 1024, *kdT = qsT + 1024, *dvs = kdT + 1024, *att = dvs + 128, *red = att + 64;
    if (t < 128) { const int d = t; float bcv[8], s = 0.f;
#pragma unroll
        for (int i = 0; i < 8; ++i) { s += bf2f(LGp[(r0 + i) * NQK + h * 128 + d]); bcv[i] = s; }
#pragma unroll
        for (int i = 0; i < 8; ++i) { const float qv = bf2f(Q1[(r0 + i) * NQK + h * 128 + d]), kv = bf2f(K1[(r0 + i) * NQK + h * 128 + d]);
            qaT[d * 8 + i] = qv * fexp(bcv[i] - bcv[7]); qsT[d * 8 + i] = qv * fexp(bcv[i]); kdT[d * 8 + i] = kv * fexp(bcv[7] - bcv[i]); }
        dvs[d] = fexp(bcv[7]); }
    __syncthreads();
    if (t < 64) { const int i = t >> 3, j = t & 7; float s = 0.f;
        for (int d = 0; d < 128; ++d) s += qaT[d * 8 + i] * kdT[d * 8 + j];
        att[t] = (j <= i) ? s : 0.f; }
    __syncthreads();
    const int e = t; float v[8], o[8];
#pragma unroll
    for (int j = 0; j < 8; ++j) { v[j] = bf2f(V1[(r0 + j) * NV + h * 256 + e]); o[j] = 0.f; }
    const float* S0 = S0in + ((size_t)item * 128) * 256 + e; float* SO = Sout + ((size_t)item * 128) * 256 + e;
    for (int d0 = 0; d0 < 128; d0 += 32) { float sv[32];
#pragma unroll
        for (int k = 0; k < 32; ++k) sv[k] = __builtin_nontemporal_load(S0 + (size_t)(d0 + k) * 256);
#pragma unroll
        for (int k = 0; k < 32; ++k) { const int d = d0 + k; const f32x4 qa = *(LAS f32x4*)(qsT + d * 8), qb = *(LAS f32x4*)(qsT + d * 8 + 4), ka = *(LAS f32x4*)(kdT + d * 8), kb = *(LAS f32x4*)(kdT + d * 8 + 4);
            o[0] += qa.x * sv[k]; o[1] += qa.y * sv[k]; o[2] += qa.z * sv[k]; o[3] += qa.w * sv[k]; o[4] += qb.x * sv[k]; o[5] += qb.y * sv[k]; o[6] += qb.z * sv[k]; o[7] += qb.w * sv[k];
            __builtin_nontemporal_store(dvs[d] * sv[k] + ((ka.x * v[0] + ka.y * v[1]) + (ka.z * v[2] + ka.w * v[3])) + ((kb.x * v[4] + kb.y * v[5]) + (kb.z * v[6] + kb.w * v[7])), SO + (size_t)d * 256); }
    }
#pragma unroll
    for (int i = 0; i < 8; ++i)
#pragma unroll
        for (int j = 0; j <= i; ++j) o[i] += att[i * 8 + j] * v[j];
    const int wv = t >> 6;
#pragma unroll
    for (int i = 0; i < 8; ++i) { const float s = wave_sum(o[i] * o[i]); if ((t & 63) == 0) red[i * 4 + wv] = s; }
    __syncthreads();
    const float gn = ogain[e];
#pragma unroll
    for (int i = 0; i < 8; ++i) { const f32x4 rr = *(LAS f32x4*)(red + i * 4); const float rms = frsq(((rr.x + rr.y) + (rr.z + rr.w)) * (1.f / 256.f) + EPS);
        const size_t off = (r0 + i) * NV + h * 256 + e; const float gv = bf2f(G1[off]);
        OG[off] = (bf16_t)(pk2(o[i] * rms * gn * gv * fsigmoid(gv), 0.f) & 0xffffu); }
    __syncthreads();
}

constexpr int VT_LD = 72;
struct AttnP { const bf16_t* KV; const bf16_t* Qb; bf16_t* AO; const float* pk; const float* pv; float* ock; float* ocv; const float* sinks; const float* relb; };
constexpr int ATT_BUF = 32768 + 256 * VT_LD * 2 + 2048;
struct AttnRegs { u32x4 a[12]; };
#define ATT_DECODE(item) const bool smp = (item) >= 512; int b, kh, qblk, sb = 0; \
    if (!smp) { b = (item) >> 8; kh = ((item) >> 6) & 3; qblk = (item) & 63; } else { const int it_ = (item) - 512; sb = it_ >> 2; kh = it_ & 3; b = 0; qblk = 1; } \
    const long s0 = (long)b * SEQ + (long)qblk * 128; (void)s0; (void)sb
__device__ __forceinline__ void attn_load(int item, const AttnP& P, AttnRegs& R, int tid) {
    ATT_DECODE(item);
    if (!smp) {
#pragma unroll
        for (int j = 0; j < 4; ++j) { const int i = tid + NTHREADS * j, row = i >> 3, ch = i & 7; u32x4 wk = {0u, 0u, 0u, 0u}, wv = {0u, 0u, 0u, 0u};
            if (qblk > 0 || row >= 128) { const bf16_t* src = P.KV + (size_t)(s0 - 128 + row) * 512 + kh * 64 + ch * 8; wk = *(const u32x4*)src; wv = *(const u32x4*)(src + 256); }
            R.a[j] = wk; R.a[4 + j] = wv; }
    } else {
#pragma unroll
        for (int j = 0; j < 3; ++j) { const int i = tid + NTHREADS * j, row = i >> 3, ch = i & 7;
            u32x4 z = {0u, 0u, 0u, 0u}; R.a[4 * j] = z; R.a[4 * j + 1] = z; R.a[4 * j + 2] = z; R.a[4 * j + 3] = z;
            if (row < 128) { const size_t so = ((size_t)(sb * 128 + row) * 4 + kh) * 64 + ch * 8;
                R.a[4 * j] = *(const u32x4*)(P.pk + so); R.a[4 * j + 1] = *(const u32x4*)(P.pk + so + 4); R.a[4 * j + 2] = *(const u32x4*)(P.pv + so); R.a[4 * j + 3] = *(const u32x4*)(P.pv + so + 4); }
            else if (row < 136) { const bf16_t* src = P.KV + (size_t)(MP + sb * 8 + row - 128) * 512 + kh * 64 + ch * 8; R.a[4 * j] = *(const u32x4*)src; R.a[4 * j + 1] = *(const u32x4*)(src + 256); } }
    }
}
__device__ __forceinline__ void attn_stage(LAS unsigned char* lds, int item, const AttnP& P, const AttnRegs& R, int tid) {
    LAS unsigned char* Kt = lds; LAS bf16_t* Vt = (LAS bf16_t*)(lds + 32768); LAS float* bias2 = (LAS float*)(lds + 32768 + 256 * VT_LD * 2);
    ATT_DECODE(item);
    if (!smp) {
#pragma unroll
        for (int j = 0; j < 4; ++j) { const int i = tid + NTHREADS * j, row = i >> 3, ch = i & 7;
            *(LAS u32x4*)(Kt + row * 128 + ((ch ^ (row & 7)) << 4)) = R.a[j]; *(LAS u32x4*)(Vt + row * VT_LD + ch * 8) = R.a[4 + j]; }
    } else {
#pragma unroll
        for (int j = 0; j < 3; ++j) { const int i = tid + NTHREADS * j, row = i >> 3, ch = i & 7;
            if (i < 144 * 8) { u32x4 wk = R.a[4 * j], wv = R.a[4 * j + 1];
                if (row < 128) { const f32x4 k0 = __builtin_bit_cast(f32x4, R.a[4 * j]), k1 = __builtin_bit_cast(f32x4, R.a[4 * j + 1]), v0 = __builtin_bit_cast(f32x4, R.a[4 * j + 2]), v1 = __builtin_bit_cast(f32x4, R.a[4 * j + 3]);
                    wk = pg8::pack8(k0, k1); wv = pg8::pack8(v0, v1);
                    if (row >= 8) { const size_t oo = ((size_t)(sb * 128 + row - 8) * 4 + kh) * 64 + ch * 8;
                        *(f32x4*)(P.ock + oo) = k0; *(f32x4*)(P.ock + oo + 4) = k1; *(f32x4*)(P.ocv + oo) = v0; *(f32x4*)(P.ocv + oo + 4) = v1; } }
                *(LAS u32x4*)(Kt + row * 128 + ((ch ^ (row & 7)) << 4)) = wk; *(LAS u32x4*)(Vt + row * VT_LD + ch * 8) = wv; } }
    }
    { const int hl = tid >> 7, dist = tid & 127; int bk = dist;
      if (dist >= 16) { bk = 16 + (int)(__logf((float)dist * (1.f / 16.f)) * (16.f / 2.0794415416798357f)); bk = bk > 31 ? 31 : bk; }
      bias2[tid] = P.relb[bk * 16 + kh * 4 + hl] * LOG2E; }
}
__device__ __forceinline__ void attn_compute(LAS unsigned char* lds, int item, const AttnP& P, int lane, int wave) {
    LAS unsigned char* Kt = lds; LAS bf16_t* Vt = (LAS bf16_t*)(lds + 32768); LAS float* bias2 = (LAS float*)(lds + 32768 + 256 * VT_LD * 2);
    ATT_DECODE(item);
    const int l15 = lane & 15, g = lane >> 4, q = l15 >> 2, p = l15 & 3;
    const int ntq = smp ? (wave < 2 ? 1 : 0) : 4;
    for (int tq = 0; tq < ntq; ++tq) {
        const int qtile = smp ? 0 : (wave & 1) * 4 + tq;
        int hl_q, ioff; size_t qrow;
        if (!smp) { hl_q = wave >> 1; ioff = l15; qrow = (size_t)(s0 + 16 * qtile + l15); }
        else { hl_q = 2 * wave + (l15 >> 3); ioff = l15 & 7; qrow = (size_t)MP + sb * 8 + (l15 & 7); }
        const bf16_t* qp = P.Qb + qrow * DM + (kh * 4 + hl_q) * 64 + 8 * g;
        const bf16x8 Qf0 = *(const bf16x8*)qp, Qf1 = *(const bf16x8*)(qp + 32);
        f32x4 st[9];
#pragma unroll
        for (int j = 0; j < 9; ++j) { const int row = 16 * (qtile + j) + l15; const LAS unsigned char* kr = Kt + row * 128;
            const bf16x8 K0 = *(const LAS bf16x8*)(kr + ((g ^ (row & 7)) << 4)), K1f = *(const LAS bf16x8*)(kr + (((4 + g) ^ (row & 7)) << 4));
            f32x4 a = {0.f, 0.f, 0.f, 0.f};
            a = __builtin_amdgcn_mfma_f32_16x16x32_bf16(K0, Qf0, a, 0, 0, 0); a = __builtin_amdgcn_mfma_f32_16x16x32_bf16(K1f, Qf1, a, 0, 0, 0);
            st[j] = a; }
        const float sink2 = P.sinks[kh * 4 + hl_q] * LOG2E;
        float mx = sink2;
#pragma unroll
        for (int j = 0; j < 9; ++j)
#pragma unroll
            for (int r = 0; r < 4; ++r) { const int dist = 128 + ioff - 16 * j - 4 * g - r; const bool ok = (dist >= 0) && (dist < 128) && (smp || qblk > 0 || (16 * (qtile + j) + 4 * g + r) >= 128);
                const float v = ok ? st[j][r] + bias2[hl_q * 128 + (dist & 127)] : -INFINITY; st[j][r] = v; mx = fmaxf(mx, v); }
        mx = fmaxf(mx, __shfl_xor(mx, 16)); mx = fmaxf(mx, __shfl_xor(mx, 32));
        float sum = 0.f;
#pragma unroll
        for (int j = 0; j < 9; ++j)
#pragma unroll
            for (int r = 0; r < 4; ++r) { const float e = __builtin_amdgcn_exp2f(st[j][r] - mx); st[j][r] = e; sum += e; }
        sum += __shfl_xor(sum, 16); sum += __shfl_xor(sum, 32);
        const float inv = frcp(sum + __builtin_amdgcn_exp2f(sink2 - mx));
        f32x4 o[4];
#pragma unroll
        for (int dt = 0; dt < 4; ++dt) o[dt] = (f32x4){0.f, 0.f, 0.f, 0.f};
#pragma unroll
        for (int kk = 0; kk < 5; ++kk) {
            u32x4 pw; pw.x = pk2(st[2 * kk][0], st[2 * kk][1]); pw.y = pk2(st[2 * kk][2], st[2 * kk][3]);
            if (kk < 4) { pw.z = pk2(st[2 * kk + 1][0], st[2 * kk + 1][1]); pw.w = pk2(st[2 * kk + 1][2], st[2 * kk + 1][3]); } else { pw.z = 0u; pw.w = 0u; }
            const bf16x8 Pf = __builtin_bit_cast(bf16x8, pw);
            const LAS bf16_t* v0p = Vt + (16 * (qtile + 2 * kk) + 4 * g + q) * VT_LD + 4 * p;
#pragma unroll
            for (int dt = 0; dt < 4; ++dt) { const s16x4 lo = trd(v0p + 16 * dt); const s16x4 hi = (kk < 4) ? trd(v0p + 16 * VT_LD + 16 * dt) : (s16x4){0, 0, 0, 0};
                o[dt] = __builtin_amdgcn_mfma_f32_16x16x32_bf16(cat8(lo, hi), Pf, o[dt], 0, 0, 0); }
        }
        { bf16_t* op = P.AO + qrow * DM + (kh * 4 + hl_q) * 64 + 4 * g;
#pragma unroll
          for (int dt = 0; dt < 4; ++dt) { u32x2 w; w.x = pk2(o[dt][0] * inv, o[dt][1] * inv); w.y = pk2(o[dt][2] * inv, o[dt][3] * inv); *(u32x2*)(op + 16 * dt) = w; } }
    }
}


#define XB_TMO      128
#define XB_XCNT(j)  (256  + 64 * (j))
#define XB_XSUB(j)  (1280 + 64 * (j))
#define XB_XGEN(j)  (2304 + 64 * (j))
#define XB_TOP      3328
#define XB_TOPGEN   3392
#define XCD_BAR_WORDS 3456
#define XB_SPIN_CAP (1u << 20)
__device__ __forceinline__ unsigned xb_ld(unsigned* p)              { return __hip_atomic_load(p, __ATOMIC_RELAXED, __HIP_MEMORY_SCOPE_AGENT); }
__device__ __forceinline__ unsigned xb_add(unsigned* p, unsigned v) { return __hip_atomic_fetch_add(p, v, __ATOMIC_RELAXED, __HIP_MEMORY_SCOPE_AGENT); }
__device__ __forceinline__ unsigned xb_xcc_id() { return (unsigned)__builtin_amdgcn_s_getreg((3 << 11) | 20) & 0xFu; }
#define XB_SPIN(cond, bar) do { unsigned _sp = 0; while (cond) { __builtin_amdgcn_s_sleep(1); \
    if ((++_sp & 255u) == 0u) { if (xb_ld(&(bar)[XB_TMO])) break; if (_sp > XB_SPIN_CAP) { atomicAdd(&(bar)[XB_TMO], 1u); break; } } } } while (0)
struct XcdBarrier { unsigned* bar; unsigned x; volatile LAS unsigned* st; };
__device__ __forceinline__ XcdBarrier xcd_barrier_post(unsigned* bar, volatile LAS unsigned* st) {
    XcdBarrier b; b.bar = bar; b.x = xb_xcc_id(); b.st = st;
    if (threadIdx.x == 0) (void)xb_add(&bar[XB_XCNT(b.x)], 1u);
    return b;
}
__device__ __forceinline__ void xcd_barrier_complete(unsigned* bar, unsigned x, unsigned& nloc, unsigned& nx) {
    const unsigned G = gridDim.x * gridDim.y * gridDim.z;
    unsigned sum, cnt, mine, sp = 0u;
    for (;;) {
        sum = 0u; cnt = 0u; mine = 0u;
#pragma unroll
        for (unsigned j = 0; j < 16; ++j) { const unsigned c = xb_ld(&bar[XB_XCNT(j)]); sum += c; cnt += (c > 0u) ? 1u : 0u; mine = (j == x) ? c : mine; }
        if (sum == G) break;
        __builtin_amdgcn_s_sleep(1);
        if ((++sp & 255u) == 0u) { if (xb_ld(&bar[XB_TMO])) break; if (sp > XB_SPIN_CAP) { atomicAdd(&bar[XB_TMO], 1u); break; } }
    }
    nloc = mine > 0u ? mine : 1u; nx = cnt > 0u ? cnt : 1u;
}
__device__ __forceinline__ void xcd_barrier(const XcdBarrier& b) {
    asm volatile("s_waitcnt vmcnt(0)" ::: "memory");
    __syncthreads();
    if (threadIdx.x == 0) {
        unsigned* bar = b.bar;
        __builtin_amdgcn_s_waitcnt(0);
        unsigned nloc = b.st[0], nx = b.st[1];
        if (nloc == 0u) { xcd_barrier_complete(bar, b.x, nloc, nx); b.st[0] = nloc; b.st[1] = nx; }
        const unsigned old = xb_add(&bar[XB_XSUB(b.x)], 1u);
        const unsigned gen = old / nloc;
        if (old + 1u == (gen + 1u) * nloc) {
            __builtin_amdgcn_fence(__ATOMIC_RELEASE, "agent");
            asm volatile("s_waitcnt vmcnt(0)" ::: "memory");
            const unsigned og = xb_add(&bar[XB_TOP], 1u);
            const unsigned tg = og / nx;
            if (og + 1u == (tg + 1u) * nx) xb_add(&bar[XB_TOPGEN], 1u);
            else XB_SPIN(xb_ld(&bar[XB_TOPGEN]) == tg, bar);
            __builtin_amdgcn_fence(__ATOMIC_ACQUIRE, "agent");
            xb_add(&bar[XB_XGEN(b.x)], 1u);
            asm volatile("s_waitcnt vmcnt(0)" ::: "memory");
        } else {
            XB_SPIN(xb_ld(&bar[XB_XGEN(b.x)]) == gen, bar);
            __builtin_amdgcn_fence(__ATOMIC_ACQUIRE, "agent");
            asm volatile("s_waitcnt vmcnt(0)" ::: "memory");
        }
    }
    __syncthreads();
}

__global__ void __launch_bounds__(NTHREADS, 2) yoco_fwd(Args args) {
    extern __shared__ __attribute__((aligned(16))) unsigned char lds_raw[];
    LAS unsigned char* lds = (LAS unsigned char*)lds_raw;
    const int tid = threadIdx.x, lane = tid & 63, wave = __builtin_amdgcn_readfirstlane(tid >> 6), G = gridDim.x, bx = blockIdx.x;
    const int gw = bx * NWAVES + wave, NGW = G * NWAVES;
    typedef const __attribute__((address_space(4))) Args* KArgsP;
    const KArgsP kp0 = (KArgsP)__builtin_amdgcn_kernarg_segment_ptr();
#define KARG(field) ({ KArgsP q_ = kp0; asm volatile("" : "+s"(q_)); q_->field; })
#define ws KARG(ws)
#define out KARG(out)
#define x_prompt KARG(in[0])
#define x_sample KARG(in[1])
#define state_gla KARG(in[2])
#define cache_k KARG(in[3])
#define cache_v KARG(in[4])
#define p_prompt KARG(in[5])
#define p_sample KARG(in[6])
#define norm_mix KARG(in[7])
#define norm_mlp KARG(in[8])
#define norm_ple KARG(in[9])
#define norm_kv KARG(in[10])
#define norm_final KARG(in[11])
#define w_in_a KARG(in[12])
#define w_a2 KARG(in[13])
#define b_a2 KARG(in[14])
#define gla_o_gain KARG(in[15])
#define w_out_a KARG(in[16])
#define w_kv KARG(in[17])
#define w_q_b KARG(in[18])
#define w_o_b KARG(in[19])
#define sinks KARG(in[20])
#define rel_bias KARG(in[21])
#define w_up KARG(in[22])
#define w_down KARG(in[23])
#define w_ple KARG(in[24])
#define w_ple_gate KARG(in[25])
#define W_IN ((bf16_t*)(ws + WS_W_IN))
#define W_OUT ((bf16_t*)(ws + WS_W_OUT))
#define W_KVQ ((bf16_t*)(ws + WS_W_KVQ))
#define W_O ((bf16_t*)(ws + WS_W_O))
#define XB ((bf16_t*)(ws + WS_XB))
#define PB ((bf16_t*)(ws + WS_PB))
#define Q1 ((bf16_t*)(ws + WS_Q1))
#define K1 ((bf16_t*)(ws + WS_K1))
#define V1 ((bf16_t*)(ws + WS_V1))
#define G1 ((bf16_t*)(ws + WS_G1))
#define HIDA ((bf16_t*)(ws + WS_R1))
#define H3B ((bf16_t*)(ws + WS_R1))
#define R3 ((bf16_t*)(ws + WS_R3))
#define HIDS (R3 + (size_t)(64 - HID_SPLIT) * 256 * FF)
#define KVR ((bf16_t*)(ws + WS_KVR))
#define PLQ ((bf16_t*)(ws + WS_PLQ))
#define SSQ0 ((float*)(ws + WS_SSQ))
#define SSQ1 ((float*)(ws + WS_SSQ) + (size_t)M * 16)
#define DV ((float*)(ws + WS_DV))
#define H (out + O_Y)
#define UT ((bf16_t*)(out + O_Y))
    cg::grid_group grid = cg::this_grid();
    volatile LAS unsigned* bst = (volatile LAS unsigned*)(lds + LDS_BYTES - 64);
    if (tid < 2) bst[tid] = 0u;
    __syncthreads();
    XcdBarrier xbar; xbar.bar = nullptr; xbar.x = 0; xbar.st = bst;
#if !MK_SPLIT
    xbar = xcd_barrier_post((unsigned*)(ws + WS_CTL), bst);
#endif
    const int lo = KARG(ph_lo), hi = KARG(ph_hi);
#define IN(k) (lo <= (k) && (k) < hi)
#define SEAM(k) do { if (IN(k) && IN((k) + 1)) { if (MK_SPLIT) grid.sync(); else xcd_barrier(xbar); } } while (0)
    if (lo < 0) grid.sync();

    if (IN(0)) {
        LAS float* scr = (LAS float*)(lds + wave * 16384);
#define TJ_LIST(X) \
        X(w_in_a, IN_A_COLS, DM, 512, W_IN, norm_mix, 0.08838834764831845f)                                     \
        X(w_in_a + 512, IN_A_COLS, DM, 2560, W_IN + (size_t)512 * DM, norm_mix, 1.f)                            \
        X(w_out_a, DM, DM, DM, W_OUT, (const float*)nullptr, 1.f) \
        X(w_up, FF, DM, FF, (bf16_t*)(ws + WS_W_UP0), norm_mlp, 1.f) \
        X(w_up + (size_t)DM * FF, FF, DM, FF, (bf16_t*)(ws + WS_W_UP1), norm_mlp + DM, 1.f) \
        X(w_down, DM, FF, DM, (bf16_t*)(ws + WS_W_DN0), (const float*)nullptr, 1.f) \
        X(w_down + (size_t)DM * FF, DM, FF, DM, (bf16_t*)(ws + WS_W_DN1), (const float*)nullptr, 1.f) \
        X(w_ple_gate, DM, DM, DM, (bf16_t*)(ws + WS_W_G0), norm_ple, 1.f) \
        X(w_ple_gate + (size_t)DM * DM, DM, DM, DM, (bf16_t*)(ws + WS_W_G1), norm_ple + DM, 1.f) \
        X(w_ple, DM, PLE, DM, (bf16_t*)(ws + WS_W_P0), (const float*)nullptr, 1.f) \
        X(w_ple + (size_t)PLE * DM, DM, PLE, DM, (bf16_t*)(ws + WS_W_P1), (const float*)nullptr, 1.f) \
        X(w_kv, 512, DM, 512, W_KVQ, norm_kv, 1.f) \
        X(w_q_b, DM, DM, DM, W_KVQ + (size_t)512 * DM, norm_mix + DM, 0.125f * LOG2E)                          \
        X(w_o_b, DM, DM, DM, W_O, (const float*)nullptr, 1.f)
#define TJ_COUNT(W, LDW, KK, NCOLS, DST, GAIN, SCALE) + ((KK) / 64) * ((NCOLS) / 32)
        constexpr int TJ_TOTAL = 0 TJ_LIST(TJ_COUNT);
#define TJ_DECODE(WP, LDW, KK, NCOLS, DSTP, GAINP, SCALEV) if (!done_ && r_ < ((KK) / 64) * ((NCOLS) / 32)) { jt_.src = (WP); jt_.ldw = (LDW); jt_.kk = (KK); jt_.nblk = (NCOLS) / 32; jt_.dst = (DSTP); jt_.gain = (GAINP); jt_.scale = (SCALEV); jt_.item = r_; done_ = true; } else if (!done_) r_ -= ((KK) / 64) * ((NCOLS) / 32);
#define TJ_GET(JOUT, it) do { int r_ = (it); bool done_ = false; TJob jt_; jt_.src = nullptr; jt_.ldw = 0; jt_.kk = 0; jt_.nblk = 1; jt_.dst = nullptr; jt_.gain = nullptr; jt_.scale = 1.f; jt_.item = 0; TJ_LIST(TJ_DECODE) JOUT = jt_; } while (0)
        { float ra_[32], rb_[32]; TJob Ja, Jb; int it = gw;
          if (it < TJ_TOTAL) { TJ_GET(Ja, it); p0_tload(Ja, ra_, lane); }
          while (it < TJ_TOTAL) {
              const int it1 = it + NGW; if (it1 < TJ_TOTAL) { TJ_GET(Jb, it1); p0_tload(Jb, rb_, lane); }
              p0_tfinish(Ja, ra_, scr, lane);
              if (it1 >= TJ_TOTAL) break;
              const int it2 = it1 + NGW; if (it2 < TJ_TOTAL) { TJ_GET(Ja, it2); p0_tload(Ja, ra_, lane); }
              p0_tfinish(Jb, rb_, scr, lane);
              it = it2; } }
#undef TJ_LIST
#undef TJ_COUNT
#undef TJ_DECODE
#undef TJ_GET
        for (int idx = bx * NTHREADS + tid; idx < 512 * 128; idx += G * NTHREADS) { const int n = idx >> 7, k8 = (idx & 127) * 8; float wa[16];
#pragma unroll
            for (int r = 0; r < 16; ++r) wa[r] = w_a2[r * 512 + n];
            float o8[8];
#pragma unroll
            for (int kk = 0; kk < 8; ++kk) { const float* wr_ = w_in_a + (size_t)(k8 + kk) * IN_A_COLS + 3072; float s = 0.f;
#pragma unroll
                for (int r = 0; r < 16; ++r) s += wr_[r] * wa[r];
                o8[kk] = s * norm_mix[k8 + kk]; }
            u32x4 o; o.x = pk2(o8[0], o8[1]); o.y = pk2(o8[2], o8[3]); o.z = pk2(o8[4], o8[5]); o.w = pk2(o8[6], o8[7]);
            *(u32x4*)(W_IN + (size_t)(3072 + n) * DM + k8) = o; }
        for (int m0 = gw * 4; m0 < M; m0 += NGW * 4) { f32x4 v[4][4]; float s[4];
#pragma unroll
            for (int q = 0; q < 4; ++q) { const int m = m0 + q; const float* xr = m < MP ? x_prompt + (size_t)m * DM : x_sample + (size_t)(m - MP) * DM;
#pragma unroll
                for (int j = 0; j < 4; ++j) v[q][j] = *((const f32x4*)xr + lane + 64 * j); }
#pragma unroll
            for (int q = 0; q < 4; ++q) { const int m = m0 + q; float ss = 0.f;
#pragma unroll
                for (int j = 0; j < 4; ++j) { ss += (v[q][j].x * v[q][j].x + v[q][j].y * v[q][j].y) + (v[q][j].z * v[q][j].z + v[q][j].w * v[q][j].w);
                    u32x2 w; w.x = pk2(v[q][j].x, v[q][j].y); w.y = pk2(v[q][j].z, v[q][j].w); *((u32x2*)(XB + (size_t)m * DM) + lane + 64 * j) = w; }
                s[q] = wave_sum(ss);
                if (lane < 16) SSQ0[(size_t)m * 16 + lane] = lane == 0 ? s[q] : 0.f; } }
        for (int m0 = gw * 8; m0 < M; m0 += NGW * 8) { f32x4 v[8];
#pragma unroll
            for (int q = 0; q < 8; ++q) { const int m = m0 + q; v[q] = *((const f32x4*)(m < MP ? p_prompt + (size_t)m * PLE : p_sample + (size_t)(m - MP) * PLE) + lane); }
#pragma unroll
            for (int q = 0; q < 8; ++q) { u32x2 w; w.x = pk2(v[q].x, v[q].y); w.y = pk2(v[q].z, v[q].w); *((u32x2*)(PB + (size_t)(m0 + q) * PLE) + lane) = w; } }
    }
    SEAM(0);
    if (IN(1)) { pg8::Gemm g{XB, XB, NPAN, W_IN, M, N_IN, DM}; pg8::StaticOrder S; S.init(M, N_IN, G, bx);
        pg8::EpiIn E{Q1, K1, V1, G1, KVR, SSQ0, b_a2}; pg8::gemm_phase(lds, g, S, E); }
    SEAM(1);
    if (IN(2)) {
        for (int base = bx * 2; base < SB * 4; base += G * 2) gla_sample_pair(lds, base, Q1, K1, V1, G1, KVR, state_gla, out + O_SS, gla_o_gain, R3, tid);
        gla_super_phase<false>(lds, G, bx, nullptr, K1, V1, nullptr, KVR, UT, DV, nullptr, nullptr, tid, lane, wave);
    }
    SEAM(2);
    if (IN(3)) gla_scan<NSUP>(UT, DV, out + O_SP, bx * NTHREADS + tid, G * NTHREADS);
    SEAM(3);
    if (IN(4)) { gla_super_phase<true>(lds, G, bx, Q1, K1, V1, G1, KVR, UT, nullptr, gla_o_gain, R3, tid, lane, wave); }
    SEAM(4);
    if (IN(5)) {
        { pg8::Gemm g{R3, R3, NPAN, W_OUT, MP, DM, DM}; pg8::StaticOrder S; S.init(MP, DM, G, bx); pg8::EpiRes<false> E{nullptr, nullptr, XB, XB, SSQ1, 1.f}; pg8::gemm_phase(lds, g, S, E); }
        { pg8::Gemm g{PB, PB, NPAN, (const bf16_t*)(ws + WS_W_P0), MP, DM, PLE}; pg8::StaticOrder S; S.init(MP, DM, G, bx); pg8::EpiPl E{PLQ}; pg8::gemm_phase(lds, g, S, E); }
        { mg::MRes<false> E{nullptr, XB, XB, SSQ1, 1.f}; mg::mini_gemm(lds, R3 + (size_t)MP * DM, W_OUT, DM, DM, G, bx, E); }
        { mg::MPl E{PLQ, nullptr}; mg::mini_gemm(lds, PB + (size_t)MP * PLE, (const bf16_t*)(ws + WS_W_P0), DM, PLE, G, bx, E); }
    }
    SEAM(5);
    if (IN(6)) { { pg8::Gemm g{XB, XB, NPAN, (const bf16_t*)(ws + WS_W_UP0), MP, FF, DM}; pg8::StaticOrder S; S.init(MP, FF, G, bx); pg8::EpiUp E{HIDA, R3, SSQ1}; pg8::gemm_phase(lds, g, S, E); }
        { mg::MUp E{HIDS, SSQ1, nullptr}; mg::mini_gemm(lds, XB + (size_t)MP * DM, (const bf16_t*)(ws + WS_W_UP0), FF, DM, G, bx, E); } }
    SEAM(6);
    if (IN(7)) { { pg8::Gemm g{HIDA, R3, HID_SPLIT, (const bf16_t*)(ws + WS_W_DN0), MP, DM, FF}; pg8::StaticOrder S; S.init(MP, DM, G, bx); pg8::EpiRes<false> E{nullptr, nullptr, XB, XB, SSQ0, 1.f}; pg8::gemm_phase(lds, g, S, E); }
        { mg::MRes<false> E{nullptr, XB, XB, SSQ0, 1.f}; mg::mini_gemm(lds, HIDS, (const bf16_t*)(ws + WS_W_DN0), DM, FF, G, bx, E); } }
    SEAM(7);
    if (IN(8)) { { pg8::Gemm g{XB, XB, NPAN, (const bf16_t*)(ws + WS_W_G0), MP, DM, DM}; pg8::StaticOrder S; S.init(MP, DM, G, bx); pg8::EpiGate<false> E{nullptr, XB, PLQ, H3B, SSQ0, SSQ1, 1.f}; pg8::gemm_phase(lds, g, S, E); }
        { mg::MGate<false> E{nullptr, XB, PLQ, H3B, SSQ0, SSQ1, 1.f}; mg::mini_gemm(lds, XB + (size_t)MP * DM, (const bf16_t*)(ws + WS_W_G0), DM, DM, G, bx, E); } }
    SEAM(8);
    if (IN(9)) { pg8::Gemm g{H3B, H3B, NPAN, W_KVQ, M, NKVQ, DM}; pg8::StaticOrder S; S.init(M, NKVQ, G, bx);
        pg8::EpiKvq E{KVR, PLQ, SSQ1, out + O_CKP, out + O_CVP, out + O_CKS, out + O_CVS}; pg8::gemm_phase(lds, g, S, E); }
    SEAM(9);
    if (IN(10)) {
        const AttnP AP{KVR, PLQ, R3, cache_k, cache_v, out + O_CKS, out + O_CVS, sinks, rel_bias};
        { AttnRegs AR; int buf = 0;
          if (bx < 1024) { attn_load(bx, AP, AR, tid); attn_stage(lds, bx, AP, AR, tid); }
          LDS_BAR();
          for (int it = bx; it < 1024; it += G) { const int nx = it + G;
              if (nx < 1024) attn_load(nx, AP, AR, tid);
              attn_compute(lds + buf * ATT_BUF, it, AP, lane, wave);
              if (nx < 1024) attn_stage(lds + (buf ^ 1) * ATT_BUF, nx, AP, AR, tid);
              LDS_BAR(); buf ^= 1; } }
        for (int m0 = gw * 8; m0 < M; m0 += NGW * 8) { f32x4 v[8];
#pragma unroll
            for (int q = 0; q < 8; ++q) { const int m = m0 + q; v[q] = *((const f32x4*)(m < MP ? p_prompt + (size_t)(MP + m) * PLE : p_sample + (size_t)(MS + m - MP) * PLE) + lane); }
#pragma unroll
            for (int q = 0; q < 8; ++q) { u32x2 w; w.x = pk2(v[q].x, v[q].y); w.y = pk2(v[q].z, v[q].w); *((u32x2*)(PB + (size_t)(m0 + q) * PLE) + lane) = w; } }
    }
    SEAM(10);
    if (IN(11)) {
        { pg8::Gemm g{R3, R3, NPAN, W_O, MP, DM, DM}; pg8::StaticOrder S; S.init(MP, DM, G, bx); pg8::EpiRes<false> E{nullptr, nullptr, H3B, XB, SSQ0, 1.f}; pg8::gemm_phase(lds, g, S, E); }
        { pg8::Gemm g{PB, PB, NPAN, (const bf16_t*)(ws + WS_W_P1), MP, DM, PLE}; pg8::StaticOrder S; S.init(MP, DM, G, bx); pg8::EpiPl E{PLQ}; pg8::gemm_phase(lds, g, S, E); }
        { mg::MRes<false> E{nullptr, H3B, XB, SSQ0, 1.f}; mg::mini_gemm(lds, R3 + (size_t)MP * DM, W_O, DM, DM, G, bx, E); }
        { mg::MPl E{PLQ, nullptr}; mg::mini_gemm(lds, PB + (size_t)MP * PLE, (const bf16_t*)(ws + WS_W_P1), DM, PLE, G, bx, E); }
    }
    SEAM(11);
    if (IN(12)) { { pg8::Gemm g{XB, XB, NPAN, (const bf16_t*)(ws + WS_W_UP1), MP, FF, DM}; pg8::StaticOrder S; S.init(MP, FF, G, bx); pg8::EpiUp E{HIDA, R3, SSQ0}; pg8::gemm_phase(lds, g, S, E); }
        { mg::MUp E{HIDS, SSQ0, nullptr}; mg::mini_gemm(lds, XB + (size_t)MP * DM, (const bf16_t*)(ws + WS_W_UP1), FF, DM, G, bx, E); } }
    SEAM(12);
    if (IN(13)) { { pg8::Gemm g{HIDA, R3, HID_SPLIT, (const bf16_t*)(ws + WS_W_DN1), MP, DM, FF}; pg8::StaticOrder S; S.init(MP, DM, G, bx); pg8::EpiRes<false> E{nullptr, nullptr, XB, XB, SSQ1, 1.f}; pg8::gemm_phase(lds, g, S, E); }
        { mg::MRes<false> E{nullptr, XB, XB, SSQ1, 1.f}; mg::mini_gemm(lds, HIDS, (const bf16_t*)(ws + WS_W_DN1), DM, FF, G, bx, E); } }
    SEAM(13);
    if (IN(14)) { { pg8::Gemm g{XB, XB, NPAN, (const bf16_t*)(ws + WS_W_G1), MP, DM, DM}; pg8::StaticOrder S; S.init(MP, DM, G, bx); pg8::EpiGate<false> E{nullptr, XB, PLQ, H3B, SSQ1, SSQ0, 1.f}; pg8::gemm_phase(lds, g, S, E); }
        { mg::MGate<false> E{nullptr, XB, PLQ, H3B, SSQ1, SSQ0, 1.f}; mg::mini_gemm(lds, XB + (size_t)MP * DM, (const bf16_t*)(ws + WS_W_G1), DM, DM, G, bx, E); } }
    SEAM(14);
    if (IN(15)) {
        f32x4 gn[4];
#pragma unroll
        for (int j = 0; j < 4; ++j) gn[j] = *((const f32x4*)norm_final + lane + 64 * j);
        for (int m0 = gw * 4; m0 < M; m0 += NGW * 4) { u32x2 w[4][4]; float r[4];
#pragma unroll
            for (int q = 0; q < 4; ++q) { r[q] = row_r(SSQ0, m0 + q);
#pragma unroll
                for (int j = 0; j < 4; ++j) w[q][j] = *((const u32x2*)(H3B + (size_t)(m0 + q) * DM) + lane + 64 * j); }
#pragma unroll
            for (int q = 0; q < 4; ++q)
#pragma unroll
                for (int j = 0; j < 4; ++j) { const f32x4 v = {bflo(w[q][j].x), bfhi(w[q][j].x), bflo(w[q][j].y), bfhi(w[q][j].y)};
                    *((f32x4*)(H + (size_t)(m0 + q) * DM) + lane + 64 * j) = v * r[q] * gn[j]; } }
    }
#undef IN
#undef SEAM
}
#undef ws
#undef out
#undef x_prompt
#undef x_sample
#undef state_gla
#undef cache_k
#undef cache_v
#undef p_prompt
#undef p_sample
#undef norm_mix
#undef norm_mlp
#undef norm_ple
#undef norm_kv
#undef norm_final
#undef w_in_a
#undef w_a2
#undef b_a2
#undef gla_o_gain
#undef w_out_a
#undef w_kv
#undef w_q_b
#undef w_o_b
#undef sinks
#undef rel_bias
#undef w_up
#undef w_down
#undef w_ple
#undef w_ple_gate
#undef W_IN
#undef W_OUT
#undef W_KVQ
#undef W_O
#undef XB
#undef PB
#undef Q1
#undef K1
#undef V1
#undef G1
#undef HIDA
#undef H3B
#undef R3
#undef HIDS
#undef KVR
#undef PLQ
#undef SSQ0
#undef SSQ1
#undef DV
#undef H
#undef UT
#undef KARG

extern "C" void kernel_launch(void* const* d_in, const int* in_sizes, int n_in, void* d_out, int out_size, void* d_ws, size_t ws_size, hipStream_t stream) {
    static int grid = 0;
    if (grid == 0) {
        if (n_in != 26 || (size_t)out_size != O_END || ws_size < WS_END) { fprintf(stderr, "kernel_launch: unexpected shapes (n_in %d out %d ws %zu need %zu)\n", n_in, out_size, ws_size, (size_t)WS_END); grid = -1; return; }
        int dev = 0, cus = 0, per_cu = 0;
        hipGetDevice(&dev); hipDeviceGetAttribute(&cus, hipDeviceAttributeMultiprocessorCount, dev);
        hipFuncSetAttribute((const void*)yoco_fwd, hipFuncAttributeMaxDynamicSharedMemorySize, LDS_BYTES);
        hipOccupancyMaxActiveBlocksPerMultiprocessor(&per_cu, (const void*)yoco_fwd, NTHREADS, LDS_BYTES);
        if (per_cu < 1) { fprintf(stderr, "kernel_launch: occupancy query says %d blocks per CU\n", per_cu); per_cu = 1; }
        (void)hipGetLastError();
        grid = cus * 1;
    }
    if (grid < 0) return;
    if (hipMemsetAsync((char*)d_ws + WS_CTL, 0, 65536, stream) != hipSuccess) { fprintf(stderr, "kernel_launch: memset failed\n"); return; }
    Args a{};
    for (int i = 0; i < 26; ++i) a.in[i] = (const float*)d_in[i];
    a.out = (float*)d_out; a.ws = (unsigned char*)d_ws;
#if MK_SPLIT
    for (int ph = 0; ph < 16; ++ph) { a.ph_lo = ph; a.ph_hi = ph + 1; hipLaunchKernelGGL(yoco_fwd, dim3(grid), dim3(NTHREADS), LDS_BYTES, stream, a); }
#else
    a.ph_lo = 0; a.ph_hi = 16;
    void* kargs[] = {&a};
    hipError_t e = hipLaunchCooperativeKernel((const void*)yoco_fwd, dim3(grid), dim3(NTHREADS), kargs, LDS_BYTES, stream);
    if (e != hipSuccess) fprintf(stderr, "cooperative launch failed: %s (grid %d)\n", hipGetErrorString(e), grid);
#endif
}
```

```cpp
#include <hip/hip_runtime.h>
#include <hip/hip_cooperative_groups.h>
#include <cstdio>
#include <cstdint>
namespace cg = cooperative_groups;

#define LAS __attribute__((address_space(3)))
#define GAS __attribute__((address_space(1)))
typedef unsigned short bf16_t;
typedef short bf16x8 __attribute__((ext_vector_type(8)));
typedef short s16x4 __attribute__((ext_vector_type(4)));
typedef float f32x4 __attribute__((ext_vector_type(4)));
typedef float f32x2 __attribute__((ext_vector_type(2)));
typedef unsigned u32x4 __attribute__((ext_vector_type(4)));
typedef unsigned u32x2 __attribute__((ext_vector_type(2)));

#ifndef MK_SPLIT
#define MK_SPLIT 0
#endif

constexpr int DM = 1024, SEQ = 8192, NBATCH = 2, MP = NBATCH * SEQ, SB = 128, SS = 8, MS = SB * SS, M = MP + MS, NPAN = M / 256;
constexpr int NQK = 512, NV = 1024, N_IN = 3584, FF = 4096, PLE = 256, NKVQ = 1536, IN_A_COLS = 3088;
constexpr int NCHUNK = 128, NBH = 8, NCH_ALL = NBH * NCHUNK;
constexpr float EPS = 1e-6f, LOG2E = 1.4426950408889634f;
constexpr int HID_SPLIT = 51;

constexpr size_t O_Y = 0, O_SP = (size_t)M * DM, O_SS = O_SP + 262144, O_CKP = O_SS + 16777216, O_CVP = O_CKP + 65536, O_CKS = O_CVP + 65536, O_CVS = O_CKS + 4194304, O_END = O_CVS + 4194304;

constexpr size_t al256(size_t x) { return (x + 255) & ~(size_t)255; }
constexpr size_t WS_CTL = 0, CTL_BYTES = 1u << 20;
constexpr size_t WS_W_IN = CTL_BYTES;
constexpr size_t WS_W_OUT = WS_W_IN + (size_t)N_IN * DM * 2;
constexpr size_t WS_W_UP0 = WS_W_OUT + (size_t)DM * DM * 2;
constexpr size_t WS_W_DN0 = WS_W_UP0 + (size_t)FF * DM * 2;
constexpr size_t WS_W_UP1 = WS_W_DN0 + (size_t)FF * DM * 2;
constexpr size_t WS_W_DN1 = WS_W_UP1 + (size_t)FF * DM * 2;
constexpr size_t WS_W_G0 = WS_W_DN1 + (size_t)FF * DM * 2;
constexpr size_t WS_W_G1 = WS_W_G0 + (size_t)DM * DM * 2;
constexpr size_t WS_W_P0 = WS_W_G1 + (size_t)DM * DM * 2;
constexpr size_t WS_W_P1 = WS_W_P0 + (size_t)DM * PLE * 2;
constexpr size_t WS_W_KVQ = WS_W_P1 + (size_t)DM * PLE * 2;
constexpr size_t WS_W_O = WS_W_KVQ + (size_t)NKVQ * DM * 2;
constexpr size_t WS_XB = WS_W_O + (size_t)DM * DM * 2;
constexpr size_t WS_PB = WS_XB + (size_t)M * DM * 2;
constexpr size_t WS_R1 = WS_PB + (size_t)M * PLE * 2;
constexpr size_t R1_BYTES = (size_t)HID_SPLIT * 256 * FF * 2;
constexpr size_t WS_Q1 = WS_R1, WS_K1 = WS_Q1 + (size_t)M * NQK * 2, WS_V1 = WS_K1 + (size_t)M * NQK * 2, WS_G1 = WS_V1 + (size_t)M * NV * 2;
static_assert(WS_G1 + (size_t)M * NV * 2 == WS_R1 + R1_BYTES, "R1 map");
constexpr size_t WS_R3 = WS_R1 + R1_BYTES;
static_assert((size_t)(NPAN - HID_SPLIT) * 256 * FF * 2 == (size_t)M * DM * 2, "R3 map");
constexpr size_t WS_KVR = WS_R3 + (size_t)M * DM * 2;
constexpr size_t WS_PLQ = WS_KVR + (size_t)M * NQK * 2;
constexpr size_t WS_SSQ = WS_PLQ + (size_t)M * DM * 2;
constexpr size_t WS_DV = WS_SSQ + (size_t)2 * M * 16 * 4;
constexpr size_t WS_END = WS_DV + (size_t)NCH_ALL * 128 * 4;

__device__ __forceinline__ float bf2f(unsigned short b) { return __uint_as_float((unsigned)b << 16); }
__device__ __forceinline__ float bflo(unsigned w) { return __uint_as_float(w << 16); }
__device__ __forceinline__ float bfhi(unsigned w) { return __uint_as_float(w & 0xffff0000u); }
typedef __bf16 bf16x2_t __attribute__((ext_vector_type(2)));
__device__ __forceinline__ unsigned pk2(float lo, float hi) { const f32x2 v = {lo, hi}; const bf16x2_t b = __builtin_convertvector(v, bf16x2_t); return __builtin_bit_cast(unsigned, b); }
__device__ __forceinline__ float fexp(float x) { return __builtin_amdgcn_exp2f(x * LOG2E); }
__device__ __forceinline__ float frcp(float x) { return __builtin_amdgcn_rcpf(x); }
__device__ __forceinline__ float frsq(float x) { return __builtin_amdgcn_rsqf(x); }
__device__ __forceinline__ float fsigmoid(float x) { return frcp(1.f + fexp(-x)); }
__device__ __forceinline__ float logsig(float x) { return fminf(x, 0.f) - __logf(1.f + fexp(-fabsf(x))); }
__device__ __forceinline__ s16x4 trd(const LAS bf16_t* p) { return __builtin_bit_cast(s16x4, __builtin_amdgcn_ds_read_tr16_b64_v4i16((LAS s16x4*)p)); }
__device__ __forceinline__ bf16x8 cat8(s16x4 lo, s16x4 hi) { return (bf16x8){lo[0], lo[1], lo[2], lo[3], hi[0], hi[1], hi[2], hi[3]}; }
__device__ __forceinline__ void st_wt(float* p, float v) { __hip_atomic_store(p, v, __ATOMIC_RELAXED, __HIP_MEMORY_SCOPE_AGENT); }
__device__ __forceinline__ float wave_sum(float v) {
#pragma unroll
    for (int o = 1; o < 64; o <<= 1) v += __shfl_xor(v, o);
    return v;
}
__device__ __forceinline__ size_t ssq_idx(int pn, int row, int wc) { return ((size_t)pn * M + row) * 4 + wc; }
__device__ __forceinline__ float row_r(const float* ssq, int row) {
    const f32x4 a = *(const f32x4*)(ssq + ssq_idx(0, row, 0)), b = *(const f32x4*)(ssq + ssq_idx(1, row, 0)), c = *(const f32x4*)(ssq + ssq_idx(2, row, 0)), d = *(const f32x4*)(ssq + ssq_idx(3, row, 0));
    const f32x4 s = (a + b) + (c + d);
    return frsq(((s.x + s.y) + (s.z + s.w)) * (1.f / 1024.f) + EPS);
}

namespace pg8 {
constexpr int BM = 256, BK = 64, HALF = 128, HTB = HALF * BK * 2, STAGE_BYTES = 8 * HTB, NXCD = 8, WGM = 8;
__host__ __device__ __forceinline__ int lds_byte(int r, int c) { const int st = (r >> 4) * 2 + (c >> 5), rr = r & 15, cc = c & 31, ob = rr * 64 + cc * 2; return st * 1024 + (ob ^ (((ob >> 9) & 1) << 5)); }
__host__ __device__ __forceinline__ void stage_rc(int b, int& R, int& C) { const int st = b / 1024, sb = b % 1024, swz = sb ^ (((sb >> 9) & 1) << 5); R = (st >> 1) * 16 + swz / 64; C = (st & 1) * 32 + (swz % 64) / 2; }
__host__ __device__ __forceinline__ int perm32(int rho) { const int n = rho >> 4, i = rho & 15; return 8 * (i >> 2) + 4 * n + (i & 3); }
struct Unit { int pm, pn; };
struct Gemm { const bf16_t* A; const bf16_t* A2; int split; const bf16_t* Bt; int M, N, K; };
struct StaticOrder {
    int nM, nN, nwg, G, c;
    __device__ void init(int M_, int N, int G_, int c_) { nM = M_ / BM; nN = N / BM; nwg = nM * nN; G = G_; c = c_; }
    __device__ bool next(int i, Unit& u) const {
        const long L = (long)i * G + c; if (L >= nwg) return false;
        int wgid = (int)L; { const int q = nwg / NXCD, r = nwg % NXCD, xcd = wgid % NXCD, off = wgid / NXCD; wgid = (xcd < r ? xcd * (q + 1) : r * (q + 1) + (xcd - r) * q) + off; }
        const int nig = WGM * nN, gid = wgid / nig, fm = gid * WGM, gsz = (nM - fm) < WGM ? (nM - fm) : WGM;
        u.pm = fm + ((wgid % nig) % gsz); u.pn = (wgid % nig) / gsz; return true;
    }
};

template <class Epi>
__device__ __forceinline__ void gemm_phase(LAS unsigned char* lds, const Gemm g, const StaticOrder& S, const Epi& E) {
    const int tid = threadIdx.x, wid = __builtin_amdgcn_readfirstlane(tid >> 6), lane = tid & 63, wr = wid >> 2, wc = wid & 3, fr = lane & 15, fq = lane >> 4;
    const int K = g.K, nt = K / BK;
    unsigned voffA[2], voffB[2];
#pragma unroll
    for (int i = 0; i < 2; ++i) { int R, C; stage_rc(tid * 16 + i * 8192, R, C); const int Rb = (R & ~31) + perm32(R & 31);
        voffA[i] = (unsigned)(R * K + C) * 2u; voffB[i] = (unsigned)(Rb * K + C) * 2u; }
    const size_t kstep = (size_t)(BK * 2);
    const size_t hstep = (size_t)HALF * K * 2;
    const size_t tstep = 2 * hstep;
    const unsigned ldsw = (unsigned)wid * 1024u;
    const int aoff = lds_byte(wr * 64 + fr, fq * 8), boff = lds_byte(wc * 32 + fr, fq * 8);
#define PG8_APTR(pm) ((pm) < g.split ? (const char*)g.A + (size_t)(pm) * tstep : (const char*)g.A2 + (size_t)((pm) - g.split) * tstep)
#define PG8_SA(b, h) (((b) * 2 + (h)) * HTB)
#define PG8_SB(b, h) ((4 + (b) * 2 + (h)) * HTB)
#define PG8_STAGE(bufoff, gbase, voff) do { _Pragma("unroll") for (int _i = 0; _i < 2; ++_i) \
        __builtin_amdgcn_global_load_lds((const unsigned*)((const char*)(gbase) + (voff)[_i]), (LAS unsigned*)(lds + (bufoff) + ldsw + _i * 8192), 16, 0, 0); } while (0)
#define PG8_LDA(dst, b, h) do { _Pragma("unroll") for (int m = 0; m < 4; ++m) _Pragma("unroll") for (int k = 0; k < 2; ++k) dst[m][k] = *(const LAS bf16x8*)(lds + PG8_SA(b, h) + aoff + m * 2048 + k * 1024); } while (0)
#define PG8_LDB(dst, b, h) do { _Pragma("unroll") for (int n = 0; n < 2; ++n) _Pragma("unroll") for (int k = 0; k < 2; ++k) dst[n][k] = *(const LAS bf16x8*)(lds + PG8_SB(b, h) + boff + n * 2048 + k * 1024); } while (0)
#define PG8_MMA(ai, bj, At, Bt) do { __builtin_amdgcn_s_setprio(1); _Pragma("unroll") for (int m = 0; m < 4; ++m) _Pragma("unroll") for (int n = 0; n < 2; ++n) _Pragma("unroll") for (int k = 0; k < 2; ++k) \
        acc[ai][bj][m][n] = __builtin_amdgcn_mfma_f32_16x16x32_bf16(Bt[n][k], At[m][k], acc[ai][bj][m][n], 0, 0, 0); __builtin_amdgcn_s_setprio(0); } while (0)
#define PG8_WAIT_V(n) asm volatile("s_waitcnt vmcnt(" #n ")" ::: "memory")
#define PG8_WAIT_L(n) asm volatile("s_waitcnt lgkmcnt(" #n ")" ::: "memory")
#define PG8_BAR __builtin_amdgcn_s_barrier()
#define PG8_SCHED __builtin_amdgcn_sched_barrier(0)
    Unit cur, nxt; int ui = 0;
    if (!S.next(0, cur)) return;
    LAS float* rtab_all = (LAS float*)(lds + STAGE_BYTES);
    if (E.rsrc() != nullptr) { Unit uu; for (int i = 0; i < 8 && S.next(i, uu); ++i) if (tid < 256) rtab_all[i * 256 + tid] = row_r(E.rsrc(), uu.pm * BM + tid); }
    f32x4 acc[2][2][4][2];
#pragma unroll
    for (int a = 0; a < 2; ++a)
#pragma unroll
        for (int b = 0; b < 2; ++b)
#pragma unroll
            for (int m = 0; m < 4; ++m)
#pragma unroll
                for (int n = 0; n < 2; ++n) acc[a][b][m][n] = (f32x4){0.f, 0.f, 0.f, 0.f};
    bf16x8 At[4][2], B0[2][2], B1[2][2];
    const char* cA = PG8_APTR(cur.pm); const char* cB = (const char*)g.Bt + (size_t)cur.pn * tstep;
    PG8_STAGE(PG8_SB(0, 0), cB, voffB); PG8_STAGE(PG8_SB(0, 1), cB + hstep, voffB); PG8_STAGE(PG8_SA(0, 0), cA, voffA); PG8_STAGE(PG8_SA(0, 1), cA + hstep, voffA);
    PG8_WAIT_L(0);
    if (wr == 1) PG8_BAR;
    PG8_WAIT_V(2); PG8_BAR;
    PG8_STAGE(PG8_SB(1, 0), cB + kstep, voffB); PG8_STAGE(PG8_SA(1, 0), cA + kstep, voffA); PG8_STAGE(PG8_SB(1, 1), cB + hstep + kstep, voffB);
    PG8_WAIT_V(6); PG8_BAR;
    for (;;) {
        const bool has_next = S.next(ui + 1, nxt);
        const char* nA = has_next ? PG8_APTR(nxt.pm) : cA; const char* nB = has_next ? (const char*)g.Bt + (size_t)nxt.pn * tstep : cB;
#pragma clang loop unroll(disable)
        for (int t = 0; t < nt; t += 2) {
            const bool last = (t == nt - 2);
            const char* a1 = cA + (size_t)(t + 1) * kstep;
            const char* a2 = last ? nA : cA + (size_t)(t + 2) * kstep; const char* b2 = last ? nB : cB + (size_t)(t + 2) * kstep;
            const char* a3 = a2 + kstep; const char* b3 = b2 + kstep;
            PG8_LDB(B0, 0, 0); PG8_LDB(B1, 0, 1); PG8_SCHED; PG8_LDA(At, 0, 0); PG8_STAGE(PG8_SA(1, 1), a1 + hstep, voffA);
            PG8_WAIT_V(8); PG8_WAIT_L(0); PG8_BAR; PG8_MMA(0, 0, At, B0); PG8_MMA(0, 1, At, B1); PG8_BAR; PG8_SCHED;
            PG8_LDA(At, 0, 1); PG8_STAGE(PG8_SB(0, 0), b2, voffB); PG8_STAGE(PG8_SB(0, 1), b2 + hstep, voffB); PG8_STAGE(PG8_SA(0, 0), a2, voffA);
            PG8_WAIT_V(8); PG8_WAIT_L(0); PG8_BAR; PG8_MMA(1, 0, At, B0); PG8_MMA(1, 1, At, B1); PG8_BAR; PG8_SCHED;
            PG8_LDB(B0, 1, 0); PG8_LDB(B1, 1, 1); PG8_SCHED; PG8_LDA(At, 1, 0); PG8_STAGE(PG8_SA(0, 1), a2 + hstep, voffA);
            PG8_WAIT_V(8); PG8_WAIT_L(0); PG8_BAR; PG8_MMA(0, 0, At, B0); PG8_MMA(0, 1, At, B1); PG8_BAR; PG8_SCHED;
            PG8_LDA(At, 1, 1); PG8_STAGE(PG8_SB(1, 0), b3, voffB); PG8_STAGE(PG8_SB(1, 1), b3 + hstep, voffB); PG8_STAGE(PG8_SA(1, 0), a3, voffA);
            PG8_WAIT_V(8); PG8_WAIT_L(0); PG8_BAR; PG8_MMA(1, 0, At, B0); PG8_MMA(1, 1, At, B1); PG8_BAR; PG8_SCHED;
        }
        if (wr == 0) PG8_BAR;
        { int efr = fr, efq = fq, etid = tid; asm volatile("" : "+v"(efr), "+v"(efq), "+v"(etid));
          E(acc, cur, wr, wc, efr, efq, rtab_all + (ui & 7) * 256, etid); }
        if (!has_next) break;
#pragma unroll
        for (int a = 0; a < 2; ++a)
#pragma unroll
            for (int b = 0; b < 2; ++b)
#pragma unroll
                for (int m = 0; m < 4; ++m)
#pragma unroll
                    for (int n = 0; n < 2; ++n) acc[a][b][m][n] = (f32x4){0.f, 0.f, 0.f, 0.f};
        cur = nxt; cA = nA; cB = nB; ++ui;
        if (wr == 1) PG8_BAR;
    }
    PG8_WAIT_V(0);
    PG8_BAR;
#undef PG8_APTR
#undef PG8_SA
#undef PG8_SB
#undef PG8_STAGE
#undef PG8_LDA
#undef PG8_LDB
#undef PG8_MMA
#undef PG8_WAIT_V
#undef PG8_WAIT_L
#undef PG8_BAR
#undef PG8_SCHED
}

#define EPI_ROWLOOP _Pragma("unroll") for (int ai = 0; ai < 2; ++ai) _Pragma("unroll") for (int m = 0; m < 4; ++m)
__device__ __forceinline__ u32x4 pack8(const f32x4 v0, const f32x4 v1) { u32x4 w; w.x = pk2(v0[0], v0[1]); w.y = pk2(v0[2], v0[3]); w.z = pk2(v1[0], v1[1]); w.w = pk2(v1[2], v1[3]); return w; }

struct EpiIn {
    bf16_t *Q, *Kk, *V, *G, *LG; const float* ssq; const float* b_a2;
    __device__ __forceinline__ const float* rsrc() const { return ssq; }
    __device__ __forceinline__ void operator()(const f32x4 (&acc)[2][2][4][2], const Unit& u, int wr, int wc, int fr, int fq, LAS float* rtab, int tid) const {
        const int pn = u.pn; bf16_t* base; int ld, c0;
        if (pn < 2) { base = Q; ld = NQK; c0 = pn * 256; } else if (pn < 4) { base = Kk; ld = NQK; c0 = (pn - 2) * 256; }
        else if (pn < 8) { base = V; ld = NV; c0 = (pn - 4) * 256; } else if (pn < 12) { base = G; ld = NV; c0 = (pn - 8) * 256; }
        else { base = LG; ld = NQK; c0 = (pn - 12) * 256; }
        const bool is_lg = pn >= 12;
        const int col = c0 + wc * 32 + 8 * fq;
        f32x4 bb[2][2];
#pragma unroll
        for (int bj = 0; bj < 2; ++bj)
#pragma unroll
            for (int n = 0; n < 2; ++n) bb[bj][n] = is_lg ? *(const f32x4*)(b_a2 + col + bj * HALF + 4 * n) : (f32x4){0.f, 0.f, 0.f, 0.f};
        EPI_ROWLOOP { const int lr = ai * HALF + wr * 64 + m * 16 + fr, row = u.pm * BM + lr; const float r = rtab[lr];
#pragma unroll
            for (int bj = 0; bj < 2; ++bj) { f32x4 v0 = acc[ai][bj][m][0] * r, v1 = acc[ai][bj][m][1] * r;
                if (is_lg) { v0 += bb[bj][0]; v1 += bb[bj][1];
#pragma unroll
                    for (int e = 0; e < 4; ++e) { v0[e] = logsig(v0[e]) * (1.f / 16.f); v1[e] = logsig(v1[e]) * (1.f / 16.f); } }
                *(u32x4*)(base + (size_t)row * ld + col + bj * HALF) = pack8(v0, v1); } }
    }
};
template <bool FROM_X> struct EpiRes {
    const float* X0; const float* X1; const bf16_t* BB; bf16_t* XO; float* ssq_out; float sc;
    __device__ __forceinline__ const float* rsrc() const { return nullptr; }
    __device__ __forceinline__ void operator()(const f32x4 (&acc)[2][2][4][2], const Unit& u, int wr, int wc, int fr, int fq, LAS float* rtab, int tid) const {
        const int col = u.pn * BM + wc * 32 + 8 * fq;
#pragma unroll
        for (int ai = 0; ai < 2; ++ai) {
            f32x4 b0[4][2], b1[4][2]; u32x4 bw[4][2];
#pragma unroll
            for (int m = 0; m < 4; ++m) { const int row = u.pm * BM + ai * HALF + wr * 64 + m * 16 + fr;
#pragma unroll
                for (int bj = 0; bj < 2; ++bj) {
                    if (FROM_X) { const float* src = (u.pm < MP / 256 ? X0 + (size_t)row * DM : X1 + (size_t)(row - MP) * DM) + col + bj * HALF; b0[m][bj] = *(const f32x4*)src; b1[m][bj] = *(const f32x4*)(src + 4); }
                    else bw[m][bj] = *(const u32x4*)(BB + (size_t)row * DM + col + bj * HALF); } }
            if (!FROM_X) asm volatile("" ::: "memory");
#pragma unroll
            for (int m = 0; m < 4; ++m) { const int row = u.pm * BM + ai * HALF + wr * 64 + m * 16 + fr; float s = 0.f;
#pragma unroll
                for (int bj = 0; bj < 2; ++bj) {
                    if (!FROM_X) { const u32x4 w = bw[m][bj]; b0[m][bj] = (f32x4){bflo(w.x), bfhi(w.x), bflo(w.y), bfhi(w.y)}; b1[m][bj] = (f32x4){bflo(w.z), bfhi(w.z), bflo(w.w), bfhi(w.w)}; }
                    const f32x4 v0 = acc[ai][bj][m][0] * sc + b0[m][bj], v1 = acc[ai][bj][m][1] * sc + b1[m][bj];
                    *(u32x4*)(XO + (size_t)row * DM + col + bj * HALF) = pack8(v0, v1);
                    s += (v0[0] * v0[0] + v0[1] * v0[1]) + (v0[2] * v0[2] + v0[3] * v0[3]) + (v1[0] * v1[0] + v1[1] * v1[1]) + (v1[2] * v1[2] + v1[3] * v1[3]); }
                s += __shfl_xor(s, 16); s += __shfl_xor(s, 32);
                if (fq == 0) ssq_out[ssq_idx(u.pn, row, wc)] = s; }
        }
    }
};
struct EpiUp {
    bf16_t* HA; bf16_t* HB; const float* ssq;
    __device__ __forceinline__ const float* rsrc() const { return ssq; }
    __device__ __forceinline__ void operator()(const f32x4 (&acc)[2][2][4][2], const Unit& u, int wr, int wc, int fr, int fq, LAS float* rtab, int tid) const {
        bf16_t* base = u.pm < HID_SPLIT ? HA + (size_t)u.pm * 256 * FF : HB + (size_t)(u.pm - HID_SPLIT) * 256 * FF;
        const int col = u.pn * BM + wc * 32 + 8 * fq;
        EPI_ROWLOOP { const int lr = ai * HALF + wr * 64 + m * 16 + fr; const float r = rtab[lr];
#pragma unroll
            for (int bj = 0; bj < 2; ++bj) { f32x4 v0 = acc[ai][bj][m][0] * r, v1 = acc[ai][bj][m][1] * r;
#pragma unroll
                for (int e = 0; e < 4; ++e) { const float a = fmaxf(v0[e], 0.f), b = fmaxf(v1[e], 0.f); v0[e] = a * a; v1[e] = b * b; }
                *(u32x4*)(base + (size_t)lr * FF + col + bj * HALF) = pack8(v0, v1); } }
    }
};
struct EpiPl {
    bf16_t* PL;
    __device__ __forceinline__ const float* rsrc() const { return nullptr; }
    __device__ __forceinline__ void operator()(const f32x4 (&acc)[2][2][4][2], const Unit& u, int wr, int wc, int fr, int fq, LAS float* rtab, int tid) const {
        const int col = u.pn * BM + wc * 32 + 8 * fq;
        EPI_ROWLOOP { const int row = u.pm * BM + ai * HALF + wr * 64 + m * 16 + fr;
#pragma unroll
            for (int bj = 0; bj < 2; ++bj) *(u32x4*)(PL + (size_t)row * DM + col + bj * HALF) = pack8(acc[ai][bj][m][0], acc[ai][bj][m][1]); }
    }
};
template <bool LAST> struct EpiGate {
    float* HO; const bf16_t* BB; const bf16_t* PL; bf16_t* OB; const float* ssq_in; float* ssq_out; float sc;
    __device__ __forceinline__ const float* rsrc() const { return ssq_in; }
    __device__ __forceinline__ void operator()(const f32x4 (&acc)[2][2][4][2], const Unit& u, int wr, int wc, int fr, int fq, LAS float* rtab, int tid) const {
        const int col = u.pn * BM + wc * 32 + 8 * fq;
#pragma unroll
        for (int ai = 0; ai < 2; ++ai) {
            u32x4 bw[4][2], pw[4][2];
#pragma unroll
            for (int m = 0; m < 4; ++m) { const size_t off0 = (size_t)(u.pm * BM + ai * HALF + wr * 64 + m * 16 + fr) * DM + col;
#pragma unroll
                for (int bj = 0; bj < 2; ++bj) { bw[m][bj] = *(const u32x4*)(BB + off0 + bj * HALF); pw[m][bj] = *(const u32x4*)(PL + off0 + bj * HALF); } }
#pragma unroll
            for (int m = 0; m < 4; ++m) { const int lr = ai * HALF + wr * 64 + m * 16 + fr, row = u.pm * BM + lr; const float r = rtab[lr];
                float s = 0.f;
#pragma unroll
                for (int bj = 0; bj < 2; ++bj) { const size_t off = (size_t)row * DM + col + bj * HALF; const u32x4 b_ = bw[m][bj], p_ = pw[m][bj];
                    const f32x4 b0 = {bflo(b_.x), bfhi(b_.x), bflo(b_.y), bfhi(b_.y)}, b1 = {bflo(b_.z), bfhi(b_.z), bflo(b_.w), bfhi(b_.w)};
                    const f32x4 p0 = {bflo(p_.x), bfhi(p_.x), bflo(p_.y), bfhi(p_.y)}, p1 = {bflo(p_.z), bfhi(p_.z), bflo(p_.w), bfhi(p_.w)};
                    f32x4 v0 = acc[ai][bj][m][0] * r, v1 = acc[ai][bj][m][1] * r;
#pragma unroll
                    for (int e = 0; e < 4; ++e) { v0[e] = b0[e] + fsigmoid(v0[e]) * p0[e] * sc; v1[e] = b1[e] + fsigmoid(v1[e]) * p1[e] * sc; }
                    if (LAST) { *(f32x4*)(HO + off) = v0; *(f32x4*)(HO + off + 4) = v1; }
                    else { *(u32x4*)(OB + off) = pack8(v0, v1);
                        s += (v0[0] * v0[0] + v0[1] * v0[1]) + (v0[2] * v0[2] + v0[3] * v0[3]) + (v1[0] * v1[0] + v1[1] * v1[1]) + (v1[2] * v1[2] + v1[3] * v1[3]); } }
                if (!LAST) { s += __shfl_xor(s, 16); s += __shfl_xor(s, 32); if (fq == 0) ssq_out[ssq_idx(u.pn, row, wc)] = s; } }
        }
    }
};
struct EpiKvq {
    bf16_t* KV; bf16_t* Qb; const float* ssq; float *CKP, *CVP, *CKS, *CVS;
    __device__ __forceinline__ const float* rsrc() const { return ssq; }
    __device__ __forceinline__ void operator()(const f32x4 (&acc)[2][2][4][2], const Unit& u, int wr, int wc, int fr, int fq, LAS float* rtab, int tid) const {
        const int pn = u.pn, c = wc * 32 + 8 * fq;
        EPI_ROWLOOP { const int lr = ai * HALF + wr * 64 + m * 16 + fr, row = u.pm * BM + lr; const float r = rtab[lr];
            float* cdst = nullptr;
            if (pn < 2) {
                if (row < MP) { const int b = row >> 13, t = row & (SEQ - 1); if (t >= SEQ - 128) cdst = (pn == 0 ? CKP : CVP) + ((size_t)(b * 128 + t - (SEQ - 128)) * 256 + c); }
                else { const int rs = row - MP, sb = rs >> 3, i = rs & 7; cdst = (pn == 0 ? CKS : CVS) + ((size_t)(sb * 128 + 120 + i) * 256 + c); }
            }
            bf16_t* dst = pn < 2 ? KV + (size_t)row * 512 + pn * 256 + c : Qb + (size_t)row * DM + (pn - 2) * 256 + c;
#pragma unroll
            for (int bj = 0; bj < 2; ++bj) { const f32x4 v0 = acc[ai][bj][m][0] * r, v1 = acc[ai][bj][m][1] * r;
                *(u32x4*)(dst + bj * HALF) = pack8(v0, v1);
                if (cdst) { *(f32x4*)(cdst + bj * HALF) = v0; *(f32x4*)(cdst + bj * HALF + 4) = v1; } } }
    }
};
}


namespace mg {
constexpr int KT = 256, LDT = KT + 8, TILE_B = 64 * LDT * 2;
template <class Epi>
__device__ __forceinline__ void mini_gemm(LAS unsigned char* lds, const bf16_t* A  , const bf16_t* Bt  , int N, int K, int G, int bx, const Epi& E) {
    const int tid = threadIdx.x, lane = tid & 63, wave = __builtin_amdgcn_readfirstlane(tid >> 6), l15 = lane & 15, g = lane >> 4;
    const int rt = wave & 3, chh = wave >> 2, nk = K / KT, units = 16 * (N / 64);
    LAS float* red = (LAS float*)(lds + 4 * TILE_B);
    for (int u = bx; u < units; u += G) {
        const int rm = u & 15, cn = u >> 4;
        const bf16_t* Ag = A + (size_t)(rm * 64) * K; const bf16_t* Bg = Bt + (size_t)(cn * 64) * K;
        u32x4 ra0[4], rb0[4], ra1[4], rb1[4];
#define MG_LOAD(ra, rb, kt) do { _Pragma("unroll") for (int i = 0; i < 4; ++i) { const int c = tid + 512 * i, row = c >> 5, ch = c & 31; \
            ra[i] = *(const u32x4*)(Ag + (size_t)row * K + (kt) * KT + ch * 8); rb[i] = *(const u32x4*)(Bg + (size_t)row * K + (kt) * KT + ch * 8); } } while (0)
#define MG_STORE(ra, rb, b) do { _Pragma("unroll") for (int i = 0; i < 4; ++i) { const int c = tid + 512 * i, row = c >> 5, ch = c & 31; \
            *(LAS u32x4*)(lds + (b) * 2 * TILE_B + (row * LDT + ch * 8) * 2) = ra[i]; *(LAS u32x4*)(lds + (b) * 2 * TILE_B + TILE_B + (row * LDT + ch * 8) * 2) = rb[i]; } } while (0)
#define MG_COMPUTE(b) do { const LAS bf16_t* Al = (const LAS bf16_t*)(lds + (b) * 2 * TILE_B); const LAS bf16_t* Bl = (const LAS bf16_t*)(lds + (b) * 2 * TILE_B + TILE_B); \
            _Pragma("unroll") for (int ks = 0; ks < KT / 32; ++ks) { const bf16x8 Af = *(const LAS bf16x8*)(Al + (16 * rt + l15) * LDT + 32 * ks + 8 * g); \
                _Pragma("unroll") for (int t = 0; t < 2; ++t) { const bf16x8 Bf = *(const LAS bf16x8*)(Bl + (16 * (2 * chh + t) + l15) * LDT + 32 * ks + 8 * g); \
                    acc[t] = __builtin_amdgcn_mfma_f32_16x16x32_bf16(Bf, Af, acc[t], 0, 0, 0); } } } while (0)
        f32x4 acc[2] = {(f32x4){0.f, 0.f, 0.f, 0.f}, (f32x4){0.f, 0.f, 0.f, 0.f}};
#define MG_BAR() do { asm volatile("s_waitcnt lgkmcnt(0)" ::: "memory"); __builtin_amdgcn_s_barrier(); asm volatile("" ::: "memory"); } while (0)
        MG_LOAD(ra0, rb0, 0); if (nk > 1) MG_LOAD(ra1, rb1, 1);
        MG_STORE(ra0, rb0, 0); MG_BAR();
        for (int kt = 0; kt < nk; kt += 2) {
            if (kt + 2 < nk) MG_LOAD(ra0, rb0, kt + 2);
            MG_COMPUTE(0);
            if (kt + 1 < nk) MG_STORE(ra1, rb1, 1);
            MG_BAR();
            if (kt + 1 < nk) {
                if (kt + 3 < nk) MG_LOAD(ra1, rb1, kt + 3);
                MG_COMPUTE(1);
                if (kt + 2 < nk) MG_STORE(ra0, rb0, 0);
                MG_BAR();
            }
        }
#undef MG_BAR
        const int row = MP + rm * 64 + 16 * rt + l15; float s = 0.f;
#pragma unroll
        for (int t = 0; t < 2; ++t) { const f32x4 o = E(row, cn * 64 + 16 * (2 * chh + t) + 4 * g, acc[t]); s += (o[0] * o[0] + o[1] * o[1]) + (o[2] * o[2] + o[3] * o[3]); }
        if (Epi::SSQ) { s += __shfl_xor(s, 16); s += __shfl_xor(s, 32); if (g == 0) red[(16 * rt + l15) * 2 + chh] = s;
            __syncthreads();
            if (tid < 64) st_wt(E.ssq_out + ssq_idx(cn >> 2, MP + rm * 64 + tid, cn & 3), red[tid * 2] + red[tid * 2 + 1]);
            __syncthreads(); }
#undef MG_LOAD
#undef MG_STORE
#undef MG_COMPUTE
    }
}
__device__ __forceinline__ u32x2 pack4(const f32x4 v) { u32x2 w; w.x = pk2(v[0], v[1]); w.y = pk2(v[2], v[3]); return w; }
template <bool FROM_X> struct MRes {
    static constexpr bool SSQ = true; const float* X1; const bf16_t* BB; bf16_t* XO; float* ssq_out; float sc;
    __device__ __forceinline__ f32x4 operator()(int row, int col, const f32x4 v) const {
        f32x4 b; if (FROM_X) b = *(const f32x4*)(X1 + (size_t)(row - MP) * DM + col); else { const u32x2 w = *(const u32x2*)(BB + (size_t)row * DM + col); b = (f32x4){bflo(w.x), bfhi(w.x), bflo(w.y), bfhi(w.y)}; }
        const f32x4 o = b + v * sc; *(u32x2*)(XO + (size_t)row * DM + col) = pack4(o); return o; }
};
struct MPl { static constexpr bool SSQ = false; bf16_t* PL; float* ssq_out;
    __device__ __forceinline__ f32x4 operator()(int row, int col, const f32x4 v) const { *(u32x2*)(PL + (size_t)row * DM + col) = pack4(v); return v; } };
struct MUp { static constexpr bool SSQ = false; bf16_t* HS  ; const float* ssq; float* ssq_out;
    __device__ __forceinline__ f32x4 operator()(int row, int col, const f32x4 v) const { const float r = row_r(ssq, row); f32x4 o;
#pragma unroll
        for (int e = 0; e < 4; ++e) { const float a = fmaxf(v[e] * r, 0.f); o[e] = a * a; }
        *(u32x2*)(HS + (size_t)(row - MP) * FF + col) = pack4(o); return o; } };
template <bool LAST> struct MGate { static constexpr bool SSQ = !LAST; float* HO; const bf16_t* BB; const bf16_t* PL; bf16_t* OB; const float* ssq_in; float* ssq_out; float sc;
    __device__ __forceinline__ f32x4 operator()(int row, int col, const f32x4 v) const { const float r = row_r(ssq_in, row); const size_t off = (size_t)row * DM + col;
        const u32x2 bw = *(const u32x2*)(BB + off), pw = *(const u32x2*)(PL + off);
        const f32x4 b = {bflo(bw.x), bfhi(bw.x), bflo(bw.y), bfhi(bw.y)}, p = {bflo(pw.x), bfhi(pw.x), bflo(pw.y), bfhi(pw.y)}; f32x4 o;
#pragma unroll
        for (int e = 0; e < 4; ++e) o[e] = b[e] + fsigmoid(v[e] * r) * p[e] * sc;
        if (LAST) *(f32x4*)(HO + off) = o; else *(u32x2*)(OB + off) = pack4(o); return o; } };
}

constexpr int NWAVES = 8, NTHREADS = 512;
constexpr int RING_BYTES = 131072, LDS_BYTES = 147456;
struct Args { const float* in[26]; float* out; unsigned char* ws; int ph_lo, ph_hi; };

struct TJob { const float* src; int ldw, kk, nblk; bf16_t* dst; const float* gain; float scale; int item; };
__device__ __forceinline__ void p0_tload(const TJob& J, float (&r)[32], int lane) {
    const int kb = J.item / J.nblk, nb = J.item % J.nblk, k0 = 64 * kb, n0 = 32 * nb;
#pragma unroll
    for (int i = 0; i < 32; ++i) r[i] = J.src[(size_t)(k0 + 2 * i + (lane >> 5)) * J.ldw + n0 + (lane & 31)];
}
__device__ __forceinline__ void p0_tfinish(const TJob& J, const float (&r)[32], LAS float* scr, int lane) {
    const int kb = J.item / J.nblk, nb = J.item % J.nblk, k0 = 64 * kb, n0 = 32 * nb, c = lane & 7;
    f32x4 g0 = {1.f, 1.f, 1.f, 1.f}, g1 = g0;
    if (J.gain) { g0 = *(const f32x4*)(J.gain + k0 + 8 * c); g1 = *(const f32x4*)(J.gain + k0 + 8 * c + 4); }
    g0 *= J.scale; g1 *= J.scale;
#pragma unroll
    for (int i = 0; i < 32; ++i) scr[(2 * i + (lane >> 5)) * 33 + (lane & 31)] = r[i];
    asm volatile("s_waitcnt lgkmcnt(0)" ::: "memory");
#pragma unroll
    for (int j = 0; j < 4; ++j) { const int n = (lane >> 3) + 8 * j; const LAS float* sp = scr + (8 * c) * 33 + n;
        u32x4 o; o.x = pk2(sp[0 * 33] * g0.x, sp[1 * 33] * g0.y); o.y = pk2(sp[2 * 33] * g0.z, sp[3 * 33] * g0.w); o.z = pk2(sp[4 * 33] * g1.x, sp[5 * 33] * g1.y); o.w = pk2(sp[6 * 33] * g1.z, sp[7 * 33] * g1.w);
        *(u32x4*)(J.dst + (size_t)(n0 + n) * J.kk + k0 + 8 * c) = o; }
    asm volatile("s_waitcnt lgkmcnt(0)" ::: "memory");
}

constexpr int T128 = 144, T256 = 272, TP = 80;
#define LDS_BAR() do { asm volatile("s_waitcnt lgkmcnt(0)" ::: "memory"); __builtin_amdgcn_s_barrier(); asm volatile("" ::: "memory"); } while (0)
struct GlaRegs { u32x4 lg[2], v[4], k[2], q[2]; };
template <bool WITH_Q, bool DO_LKQ = true, bool DO_V = true>
__device__ __forceinline__ void gla_fetch(GlaRegs& R, int item, const bf16_t* Q1, const bf16_t* K1, const bf16_t* V1, const bf16_t* LGp, int tid) {
    const int bh = item >> 7, c = item & 127, b = bh >> 2, h = bh & 3; const size_t row0 = (size_t)b * SEQ + c * 64;
    if (DO_LKQ) {
#pragma unroll
        for (int i = 0; i < 2; ++i) { const int x = tid + NTHREADS * i, j = x >> 4, d8 = (x & 15) * 8; const size_t off = (row0 + j) * NQK + h * 128 + d8;
            R.lg[i] = *(const u32x4*)(LGp + off); R.k[i] = *(const u32x4*)(K1 + off); if (WITH_Q) R.q[i] = *(const u32x4*)(Q1 + off); } }
    if (DO_V) {
#pragma unroll
        for (int i = 0; i < 4; ++i) { const int x = tid + NTHREADS * i, j = x >> 5, e8 = (x & 31) * 8; R.v[i] = *(const u32x4*)(V1 + (row0 + j) * NV + h * 256 + e8); } }
}
__device__ __forceinline__ void gla_stage_lg_v(const GlaRegs& R, LAS float* bc, LAS bf16_t* vt, int tid) {
#pragma unroll
    for (int i = 0; i < 2; ++i) { const int x = tid + NTHREADS * i, j = x >> 4, d8 = (x & 15) * 8; const u32x4 w = R.lg[i];
        *(LAS f32x4*)(bc + j * 128 + d8) = (f32x4){bflo(w.x), bfhi(w.x), bflo(w.y), bfhi(w.y)}; *(LAS f32x4*)(bc + j * 128 + d8 + 4) = (f32x4){bflo(w.z), bfhi(w.z), bflo(w.w), bfhi(w.w)}; }
#pragma unroll
    for (int i = 0; i < 4; ++i) { const int x = tid + NTHREADS * i, j = x >> 5, e8 = (x & 31) * 8; *(LAS u32x4*)(vt + j * T256 + e8) = R.v[i]; }
    LDS_BAR();
    if (tid < 128) { float s = 0.f;
#pragma unroll 8
        for (int j = 0; j < 64; ++j) { s += bc[j * 128 + tid]; bc[j * 128 + tid] = s; } }
    LDS_BAR();
}
constexpr int NSUP = 32, NSUP_ALL = NBH * NSUP;
template <bool OUT>
__device__ __forceinline__ void gla_super_phase(LAS unsigned char* lds, int G, int bx, const bf16_t* Q1, const bf16_t* K1, const bf16_t* V1, const bf16_t* G1, const bf16_t* LGp, bf16_t* US, float* DVS,
                                                const float* ogain, bf16_t* OG, float* SOUT, int tid, int lane, int wave) {
    LAS float* bc = (LAS float*)lds;
    LAS bf16_t* Pm = (LAS bf16_t*)lds;
    LAS bf16_t* qt = (LAS bf16_t*)(lds + 32768);
    LAS bf16_t* kt = qt + 64 * T128;
    LAS bf16_t* kd = kt + 64 * T128;
    LAS bf16_t* vt = kd + 64 * T128;
    LAS float* red = (LAS float*)(lds + 32768 + 3 * 64 * T128 * 2 + 64 * T256 * 2);
    LAS float* em = red + 512;
    LAS float* dvl = em + 128;
    const int l15 = lane & 15, g = lane >> 4, q = l15 >> 2, p = l15 & 3;
    f32x4 gn[2] = {(f32x4){0.f, 0.f, 0.f, 0.f}, (f32x4){0.f, 0.f, 0.f, 0.f}};
    if (OUT) {
#pragma unroll
        for (int t = 0; t < 2; ++t) gn[t] = *(const f32x4*)(ogain + 16 * (2 * wave + t) + 4 * g); }
    GlaRegs R;
    if (bx < NSUP_ALL) gla_fetch<OUT>(R, (bx >> 5) * NCHUNK + (bx & 31) * 4, Q1, K1, V1, LGp, tid);
    for (int item = bx; item < NSUP_ALL; item += G) {
        const int bh = item >> 5, sc = item & 31, b = bh >> 2, h = bh & 3;
        f32x4 S[8][2];
        if (OUT) {
#pragma unroll
            for (int dt = 0; dt < 8; ++dt)
#pragma unroll
                for (int t = 0; t < 2; ++t) { const u32x2 w = *(const u32x2*)(US + ((size_t)item * 256 + 16 * (2 * wave + t) + l15) * 128 + 16 * dt + 4 * g); S[dt][t] = (f32x4){bflo(w.x), bfhi(w.x), bflo(w.y), bfhi(w.y)}; }
        } else {
#pragma unroll
            for (int dt = 0; dt < 8; ++dt) { S[dt][0] = (f32x4){0.f, 0.f, 0.f, 0.f}; S[dt][1] = (f32x4){0.f, 0.f, 0.f, 0.f}; } }
        float lsum = 0.f;
        for (int cc = 0; cc < 4; ++cc) {
            const int c = sc * 4 + cc; const size_t row0 = (size_t)b * SEQ + c * 64;
            gla_stage_lg_v(R, bc, vt, tid);
#pragma unroll
            for (int i = 0; i < 2; ++i) { const int x = tid + NTHREADS * i, j = x >> 4, d8 = (x & 15) * 8; const u32x4 wk = R.k[i];
                float kv[8] = {bflo(wk.x), bfhi(wk.x), bflo(wk.y), bfhi(wk.y), bflo(wk.z), bfhi(wk.z), bflo(wk.w), bfhi(wk.w)};
                float cur[8], dd[8];
#pragma unroll
                for (int t = 0; t < 8; ++t) { cur[t] = bc[j * 128 + d8 + t]; dd[t] = kv[t] * fexp(bc[63 * 128 + d8 + t] - cur[t]); }
                u32x4 o; o.x = pk2(dd[0], dd[1]); o.y = pk2(dd[2], dd[3]); o.z = pk2(dd[4], dd[5]); o.w = pk2(dd[6], dd[7]); *(LAS u32x4*)(kd + j * T128 + d8) = o;
                if (OUT) { const u32x4 wq = R.q[i];
                    float qv[8] = {bflo(wq.x), bfhi(wq.x), bflo(wq.y), bfhi(wq.y), bflo(wq.z), bfhi(wq.z), bflo(wq.w), bfhi(wq.w)};
                    float a[8], bb[8];
#pragma unroll
                    for (int t = 0; t < 8; ++t) { const float mid = bc[31 * 128 + d8 + t]; a[t] = qv[t] * fexp(cur[t] - mid); bb[t] = kv[t] * fexp(mid - cur[t]); }
                    o.x = pk2(a[0], a[1]); o.y = pk2(a[2], a[3]); o.z = pk2(a[4], a[5]); o.w = pk2(a[6], a[7]); *(LAS u32x4*)(qt + j * T128 + d8) = o;
                    o.x = pk2(bb[0], bb[1]); o.y = pk2(bb[2], bb[3]); o.z = pk2(bb[4], bb[5]); o.w = pk2(bb[6], bb[7]); *(LAS u32x4*)(kt + j * T128 + d8) = o; } }
            if (tid < 128) { const float last = bc[63 * 128 + tid]; dvl[tid] = fexp(last); lsum += last; if (OUT) em[tid] = fexp(bc[31 * 128 + tid]); }
            const int nxt_ = (cc < 3) ? bh * NCHUNK + c + 1 : (item + G < NSUP_ALL ? ((item + G) >> 5) * NCHUNK + ((item + G) & 31) * 4 : -1);
            if (nxt_ >= 0) gla_fetch<OUT, true, false>(R, nxt_, Q1, K1, V1, LGp, tid);
            LDS_BAR();
            if (OUT) {
#pragma unroll
                for (int t = 0; t < 2; ++t) { const int id = 2 * wave + t, ti = id >> 2, tj = id & 3;
                    f32x4 a = {0.f, 0.f, 0.f, 0.f};
                    if (tj <= ti) {
#pragma unroll
                        for (int ks = 0; ks < 4; ++ks) { const bf16x8 Af = *(const LAS bf16x8*)(qt + (16 * ti + l15) * T128 + 32 * ks + 8 * g), Bf = *(const LAS bf16x8*)(kt + (16 * tj + l15) * T128 + 32 * ks + 8 * g);
                            a = __builtin_amdgcn_mfma_f32_16x16x32_bf16(Af, Bf, a, 0, 0, 0); } }
#pragma unroll
                    for (int r = 0; r < 4; ++r) { const int i = 16 * ti + 4 * g + r, j = 16 * tj + l15; const float v = (j <= i) ? a[r] : 0.f; Pm[i * TP + j] = (bf16_t)(pk2(v, 0.f) & 0xffffu); }
                }
                LDS_BAR();
                f32x4 o[4][2];
#pragma unroll
                for (int ti = 0; ti < 4; ++ti) { o[ti][0] = (f32x4){0.f, 0.f, 0.f, 0.f}; o[ti][1] = (f32x4){0.f, 0.f, 0.f, 0.f}; }
#pragma unroll
                for (int ks = 0; ks < 2; ++ks) {
                    bf16x8 Bf[2];
#pragma unroll
                    for (int t = 0; t < 2; ++t) { const LAS bf16_t* a0 = vt + (32 * ks + 8 * g + q) * T256 + 16 * (2 * wave + t) + 4 * p; Bf[t] = cat8(trd(a0), trd(a0 + 4 * T256)); }
#pragma unroll
                    for (int ti = 2 * ks; ti < 4; ++ti) { const bf16x8 Af = *(const LAS bf16x8*)(Pm + (16 * ti + l15) * TP + 32 * ks + 8 * g);
#pragma unroll
                        for (int t = 0; t < 2; ++t) o[ti][t] = __builtin_amdgcn_mfma_f32_16x16x32_bf16(Bf[t], Af, o[ti][t], 0, 0, 0); }
                }
#pragma unroll
                for (int ks = 0; ks < 4; ++ks) {
                    const f32x4 e0 = *(LAS f32x4*)(em + 32 * ks + 4 * g), e1 = *(LAS f32x4*)(em + 32 * ks + 16 + 4 * g);
                    bf16x8 Bf[2];
#pragma unroll
                    for (int t = 0; t < 2; ++t) { const f32x4 s0 = S[2 * ks][t] * e0, s1 = S[2 * ks + 1][t] * e1; u32x4 w; w.x = pk2(s0[0], s0[1]); w.y = pk2(s0[2], s0[3]); w.z = pk2(s1[0], s1[1]); w.w = pk2(s1[2], s1[3]); Bf[t] = __builtin_bit_cast(bf16x8, w); }
#pragma unroll
                    for (int ti = 0; ti < 4; ++ti) { const LAS bf16_t* ap = qt + (16 * ti + l15) * T128 + 32 * ks + 4 * g;
                        const u32x2 a0 = *(const LAS u32x2*)ap, a1 = *(const LAS u32x2*)(ap + 16); u32x4 aw; aw.x = a0.x; aw.y = a0.y; aw.z = a1.x; aw.w = a1.y; const bf16x8 Af = __builtin_bit_cast(bf16x8, aw);
#pragma unroll
                        for (int t = 0; t < 2; ++t) o[ti][t] = __builtin_amdgcn_mfma_f32_16x16x32_bf16(Bf[t], Af, o[ti][t], 0, 0, 0); }
                }
#pragma unroll
                for (int ti = 0; ti < 4; ++ti) { float s = 0.f;
#pragma unroll
                    for (int t = 0; t < 2; ++t) s += (o[ti][t][0] * o[ti][t][0] + o[ti][t][1] * o[ti][t][1]) + (o[ti][t][2] * o[ti][t][2] + o[ti][t][3] * o[ti][t][3]);
                    s += __shfl_xor(s, 16); s += __shfl_xor(s, 32);
                    if (g == 0) red[(16 * ti + l15) * 8 + wave] = s; }
                LDS_BAR();
#pragma unroll
                for (int ti = 0; ti < 4; ++ti) { const int i = 16 * ti + l15; const f32x4 r0 = *(LAS f32x4*)(red + i * 8), r1 = *(LAS f32x4*)(red + i * 8 + 4);
                    const float rms = frsq(((r0.x + r0.y) + (r0.z + r0.w) + (r1.x + r1.y) + (r1.z + r1.w)) * (1.f / 256.f) + EPS);
#pragma unroll
                    for (int t = 0; t < 2; ++t) { const size_t off = (row0 + i) * NV + h * 256 + 16 * (2 * wave + t) + 4 * g; const u32x2 gw_ = *(const u32x2*)(G1 + off);
                        const f32x4 gv = {bflo(gw_.x), bfhi(gw_.x), bflo(gw_.y), bfhi(gw_.y)}; f32x4 ov;
#pragma unroll
                        for (int r = 0; r < 4; ++r) ov[r] = o[ti][t][r] * rms * gn[t][r] * gv[r] * fsigmoid(gv[r]);
                        u32x2 w; w.x = pk2(ov[0], ov[1]); w.y = pk2(ov[2], ov[3]); *(u32x2*)(OG + off) = w; } }
            }
            if (nxt_ >= 0) gla_fetch<OUT, false, true>(R, nxt_, Q1, K1, V1, LGp, tid);
#pragma unroll
            for (int dt = 0; dt < 8; ++dt) { const f32x4 dvv = *(LAS f32x4*)(dvl + 16 * dt + 4 * g); S[dt][0] *= dvv; S[dt][1] *= dvv; }
#pragma unroll
            for (int ks = 0; ks < 2; ++ks) {
                bf16x8 Bf[2];
#pragma unroll
                for (int t = 0; t < 2; ++t) { const LAS bf16_t* a0 = vt + (32 * ks + 8 * g + q) * T256 + 16 * (2 * wave + t) + 4 * p; Bf[t] = cat8(trd(a0), trd(a0 + 4 * T256)); }
#pragma unroll
                for (int dt = 0; dt < 8; ++dt) { const LAS bf16_t* a0 = kd + (32 * ks + 8 * g + q) * T128 + 16 * dt + 4 * p; const bf16x8 Af = cat8(trd(a0), trd(a0 + 4 * T128));
#pragma unroll
                    for (int t = 0; t < 2; ++t) S[dt][t] = __builtin_amdgcn_mfma_f32_16x16x32_bf16(Af, Bf[t], S[dt][t], 0, 0, 0); }
            }
            LDS_BAR();
        }
        if (OUT && sc == NSUP - 1) {
            float* so = SOUT + (size_t)bh * 128 * 256 + (size_t)(4 * g) * 256 + 32 * wave + l15;
#pragma unroll
            for (int dt = 0; dt < 8; ++dt) {
#pragma unroll
                for (int t = 0; t < 2; ++t)
#pragma unroll
                    for (int r = 0; r < 4; ++r) so[r * 256 + 16 * t] = S[dt][t][r];
                so += 16 * 256; asm volatile("" : "+v"(so));
            }
        }
        if (!OUT) {
#pragma unroll
            for (int dt = 0; dt < 8; ++dt)
#pragma unroll
                for (int t = 0; t < 2; ++t) { u32x2 w; w.x = pk2(S[dt][t][0], S[dt][t][1]); w.y = pk2(S[dt][t][2], S[dt][t][3]);
                    *(u32x2*)(US + ((size_t)item * 256 + 16 * (2 * wave + t) + l15) * 128 + 16 * dt + 4 * g) = w; }
            if (tid < 128) DVS[(size_t)item * 128 + tid] = fexp(lsum);
        }
    }
}
template <int NSTEP>
__device__ __forceinline__ void gla_scan(bf16_t* UT, const float* DV, float* state_out, int gtid, int gthreads) {
    for (int idx = gtid; idx < NBH * 256 * 64; idx += gthreads) {
        const int bh = idx >> 14, rem = idx & 16383, e = rem >> 6, dp = rem & 63;
        unsigned* base = (unsigned*)UT + (size_t)bh * NSTEP * 16384 + e * 64 + dp;
        const float* dv = DV + (size_t)bh * NSTEP * 128 + 2 * dp;
        float s0 = 0.f, s1 = 0.f;
        for (int c0 = 0; c0 < NSTEP; c0 += 32) {
            unsigned uu[32]; f32x2 dd[32];
#pragma unroll
            for (int k = 0; k < 32; ++k) { uu[k] = base[(size_t)(c0 + k) * 16384]; dd[k] = *(const f32x2*)(dv + (size_t)(c0 + k) * 128); }
#pragma unroll
            for (int k = 0; k < 32; ++k) { base[(size_t)(c0 + k) * 16384] = pk2(s0, s1); s0 = dd[k].x * s0 + bflo(uu[k]); s1 = dd[k].y * s1 + bfhi(uu[k]); }
        }
        (void)state_out;
    }
}
__device__ __forceinline__ void gla_sample_pair(LAS unsigned char* lds, int base_item, const bf16_t* Q1, const bf16_t* K1, const bf16_t* V1, const bf16_t* G1, const bf16_t* LGp,
                                                const float* S0in, float* Sout, const float* ogain, bf16_t* OG, int tid) {
    const int hb = tid >> 8, t = tid & 255, item = base_item + hb, sb = item >> 2, h = item & 3; const size_t r0 = (size_t)MP + sb * 8;
    LAS float* qaT = (LAS float*)(lds + hb * 16384);
    LAS float* qsT = qaT + 1024, *kdT = qsT + 1024, *dvs = kdT + 1024, *att = dvs + 128, *red = att + 64;
    if (t < 128) { const int d = t; float bcv[8], s = 0.f;
#pragma unroll
        for (int i = 0; i < 8; ++i) { s += bf2f(LGp[(r0 + i) * NQK + h * 128 + d]); bcv[i] = s; }
#pragma unroll
        for (int i = 0; i < 8; ++i) { const float qv = bf2f(Q1[(r0 + i) * NQK + h * 128 + d]), kv = bf2f(K1[(r0 + i) * NQK + h * 128 + d]);
            qaT[d * 8 + i] = qv * fexp(bcv[i] - bcv[7]); qsT[d * 8 + i] = qv * fexp(bcv[i]); kdT[d * 8 + i] = kv * fexp(bcv[7] - bcv[i]); }
        dvs[d] = fexp(bcv[7]); }
    __syncthreads();
    if (t < 64) { const int i = t >> 3, j = t & 7; float s = 0.f;
        for (int d = 0; d < 128; ++d) s += qaT[d * 8 + i] * kdT[d * 8 + j];
        att[t] = (j <= i) ? s : 0.f; }
    __syncthreads();
    const int e = t; float v[8], o[8];
#pragma unroll
    for (int j = 0; j < 8; ++j) { v[j] = bf2f(V1[(r0 + j) * NV + h * 256 + e]); o[j] = 0.f; }
    const float* S0 = S0in + ((size_t)item * 128) * 256 + e; float* SO = Sout + ((size_t)item * 128) * 256 + e;
    for (int d0 = 0; d0 < 128; d0 += 32) { float sv[32];
#pragma unroll
        for (int k = 0; k < 32; ++k) sv[k] = __builtin_nontemporal_load(S0 + (size_t)(d0 + k) * 256);
#pragma unroll
        for (int k = 0; k < 32; ++k) { const int d = d0 + k; const f32x4 qa = *(LAS f32x4*)(qsT + d * 8), qb = *(LAS f32x4*)(qsT + d * 8 + 4), ka = *(LAS f32x4*)(kdT + d * 8), kb = *(LAS f32x4*)(kdT + d * 8 + 4);
            o[0] += qa.x * sv[k]; o[1] += qa.y * sv[k]; o[2] += qa.z * sv[k]; o[3] += qa.w * sv[k]; o[4] += qb.x * sv[k]; o[5] += qb.y * sv[k]; o[6] += qb.z * sv[k]; o[7] += qb.w * sv[k];
            __builtin_nontemporal_store(dvs[d] * sv[k] + ((ka.x * v[0] + ka.y * v[1]) + (ka.z * v[2] + ka.w * v[3])) + ((kb.x * v[4] + kb.y * v[5]) + (kb.z * v[6] + kb.w * v[7])), SO + (size_t)d * 256); }
    }
#pragma unroll
    for (int i = 0; i < 8; ++i)
#pragma unroll
        for (int j = 0; j <= i; ++j) o[i] += att[i * 8 + j] * v[j];
    const int wv = t >> 6;
#pragma unroll
    for (int i = 0; i < 8; ++i) { const float s = wave_sum(o[i] * o[i]); if ((t & 63) == 0) red[i * 4 + wv] = s; }
    __syncthreads();
    const float gn = ogain[e];
#pragma unroll
    for (int i = 0; i < 8; ++i) { const f32x4 rr = *(LAS f32x4*)(red + i * 4); const float rms = frsq(((rr.x + rr.y) + (rr.z + rr.w)) * (1.f / 256.f) + EPS);
        const size_t off = (r0 + i) * NV + h * 256 + e; const float gv = bf2f(G1[off]);
        OG[off] = (bf16_t)(pk2(o[i] * rms * gn * gv * fsigmoid(gv), 0.f) & 0xffffu); }
    __syncthreads();
}

constexpr int VT_LD = 72;
struct AttnP { const bf16_t* KV; const bf16_t* Qb; bf16_t* AO; const float* pk; const float* pv; float* ock; float* ocv; const float* sinks; const float* relb; };
constexpr int ATT_BUF = 32768 + 256 * VT_LD * 2 + 2048;
struct AttnRegs { u32x4 a[12]; };
#define ATT_DECODE(item) const bool smp = (item) >= 512; int b, kh, qblk, sb = 0; \
    if (!smp) { b = (item) >> 8; kh = ((item) >> 6) & 3; qblk = (item) & 63; } else { const int it_ = (item) - 512; sb = it_ >> 2; kh = it_ & 3; b = 0; qblk = 1; } \
    const long s0 = (long)b * SEQ + (long)qblk * 128; (void)s0; (void)sb
__device__ __forceinline__ void attn_load(int item, const AttnP& P, AttnRegs& R, int tid) {
    ATT_DECODE(item);
    if (!smp) {
#pragma unroll
        for (int j = 0; j < 4; ++j) { const int i = tid + NTHREADS * j, row = i >> 3, ch = i & 7; u32x4 wk = {0u, 0u, 0u, 0u}, wv = {0u, 0u, 0u, 0u};
            if (qblk > 0 || row >= 128) { const bf16_t* src = P.KV + (size_t)(s0 - 128 + row) * 512 + kh * 64 + ch * 8; wk = *(const u32x4*)src; wv = *(const u32x4*)(src + 256); }
            R.a[j] = wk; R.a[4 + j] = wv; }
    } else {
#pragma unroll
        for (int j = 0; j < 3; ++j) { const int i = tid + NTHREADS * j, row = i >> 3, ch = i & 7;
            u32x4 z = {0u, 0u, 0u, 0u}; R.a[4 * j] = z; R.a[4 * j + 1] = z; R.a[4 * j + 2] = z; R.a[4 * j + 3] = z;
            if (row < 128) { const size_t so = ((size_t)(sb * 128 + row) * 4 + kh) * 64 + ch * 8;
                R.a[4 * j] = *(const u32x4*)(P.pk + so); R.a[4 * j + 1] = *(const u32x4*)(P.pk + so + 4); R.a[4 * j + 2] = *(const u32x4*)(P.pv + so); R.a[4 * j + 3] = *(const u32x4*)(P.pv + so + 4); }
            else if (row < 136) { const bf16_t* src = P.KV + (size_t)(MP + sb * 8 + row - 128) * 512 + kh * 64 + ch * 8; R.a[4 * j] = *(const u32x4*)src; R.a[4 * j + 1] = *(const u32x4*)(src + 256); } }
    }
}
__device__ __forceinline__ void attn_stage(LAS unsigned char* lds, int item, const AttnP& P, const AttnRegs& R, int tid) {
    LAS unsigned char* Kt = lds; LAS bf16_t* Vt = (LAS bf16_t*)(lds + 32768); LAS float* bias2 = (LAS float*)(lds + 32768 + 256 * VT_LD * 2);
    ATT_DECODE(item);
    if (!smp) {
#pragma unroll
        for (int j = 0; j < 4; ++j) { const int i = tid + NTHREADS * j, row = i >> 3, ch = i & 7;
            *(LAS u32x4*)(Kt + row * 128 + ((ch ^ (row & 7)) << 4)) = R.a[j]; *(LAS u32x4*)(Vt + row * VT_LD + ch * 8) = R.a[4 + j]; }
    } else {
#pragma unroll
        for (int j = 0; j < 3; ++j) { const int i = tid + NTHREADS * j, row = i >> 3, ch = i & 7;
            if (i < 144 * 8) { u32x4 wk = R.a[4 * j], wv = R.a[4 * j + 1];
                if (row < 128) { const f32x4 k0 = __builtin_bit_cast(f32x4, R.a[4 * j]), k1 = __builtin_bit_cast(f32x4, R.a[4 * j + 1]), v0 = __builtin_bit_cast(f32x4, R.a[4 * j + 2]), v1 = __builtin_bit_cast(f32x4, R.a[4 * j + 3]);
                    wk = pg8::pack8(k0, k1); wv = pg8::pack8(v0, v1);
                    if (row >= 8) { const size_t oo = ((size_t)(sb * 128 + row - 8) * 4 + kh) * 64 + ch * 8;
                        *(f32x4*)(P.ock + oo) = k0; *(f32x4*)(P.ock + oo + 4) = k1; *(f32x4*)(P.ocv + oo) = v0; *(f32x4*)(P.ocv + oo + 4) = v1; } }
                *(LAS u32x4*)(Kt + row * 128 + ((ch ^ (row & 7)) << 4)) = wk; *(LAS u32x4*)(Vt + row * VT_LD + ch * 8) = wv; } }
    }
    { const int hl = tid >> 7, dist = tid & 127; int bk = dist;
      if (dist >= 16) { bk = 16 + (int)(__logf((float)dist * (1.f / 16.f)) * (16.f / 2.0794415416798357f)); bk = bk > 31 ? 31 : bk; }
      bias2[tid] = P.relb[bk * 16 + kh * 4 + hl] * LOG2E; }
}
__device__ __forceinline__ void attn_compute(LAS unsigned char* lds, int item, const AttnP& P, int lane, int wave) {
    LAS unsigned char* Kt = lds; LAS bf16_t* Vt = (LAS bf16_t*)(lds + 32768); LAS float* bias2 = (LAS float*)(lds + 32768 + 256 * VT_LD * 2);
    ATT_DECODE(item);
    const int l15 = lane & 15, g = lane >> 4, q = l15 >> 2, p = l15 & 3;
    const int ntq = smp ? (wave < 2 ? 1 : 0) : 4;
    for (int tq = 0; tq < ntq; ++tq) {
        const int qtile = smp ? 0 : (wave & 1) * 4 + tq;
        int hl_q, ioff; size_t qrow;
        if (!smp) { hl_q = wave >> 1; ioff = l15; qrow = (size_t)(s0 + 16 * qtile + l15); }
        else { hl_q = 2 * wave + (l15 >> 3); ioff = l15 & 7; qrow = (size_t)MP + sb * 8 + (l15 & 7); }
        const bf16_t* qp = P.Qb + qrow * DM + (kh * 4 + hl_q) * 64 + 8 * g;
        const bf16x8 Qf0 = *(const bf16x8*)qp, Qf1 = *(const bf16x8*)(qp + 32);
        f32x4 st[9];
#pragma unroll
        for (int j = 0; j < 9; ++j) { const int row = 16 * (qtile + j) + l15; const LAS unsigned char* kr = Kt + row * 128;
            const bf16x8 K0 = *(const LAS bf16x8*)(kr + ((g ^ (row & 7)) << 4)), K1f = *(const LAS bf16x8*)(kr + (((4 + g) ^ (row & 7)) << 4));
            f32x4 a = {0.f, 0.f, 0.f, 0.f};
            a = __builtin_amdgcn_mfma_f32_16x16x32_bf16(K0, Qf0, a, 0, 0, 0); a = __builtin_amdgcn_mfma_f32_16x16x32_bf16(K1f, Qf1, a, 0, 0, 0);
            st[j] = a; }
        const float sink2 = P.sinks[kh * 4 + hl_q] * LOG2E;
        float mx = sink2;
#pragma unroll
        for (int j = 0; j < 9; ++j)
#pragma unroll
            for (int r = 0; r < 4; ++r) { const int dist = 128 + ioff - 16 * j - 4 * g - r; const bool ok = (dist >= 0) && (dist < 128) && (smp || qblk > 0 || (16 * (qtile + j) + 4 * g + r) >= 128);
                const float v = ok ? st[j][r] + bias2[hl_q * 128 + (dist & 127)] : -INFINITY; st[j][r] = v; mx = fmaxf(mx, v); }
        mx = fmaxf(mx, __shfl_xor(mx, 16)); mx = fmaxf(mx, __shfl_xor(mx, 32));
        float sum = 0.f;
#pragma unroll
        for (int j = 0; j < 9; ++j)
#pragma unroll
            for (int r = 0; r < 4; ++r) { const float e = __builtin_amdgcn_exp2f(st[j][r] - mx); st[j][r] = e; sum += e; }
        sum += __shfl_xor(sum, 16); sum += __shfl_xor(sum, 32);
        const float inv = frcp(sum + __builtin_amdgcn_exp2f(sink2 - mx));
        f32x4 o[4];
#pragma unroll
        for (int dt = 0; dt < 4; ++dt) o[dt] = (f32x4){0.f, 0.f, 0.f, 0.f};
#pragma unroll
        for (int kk = 0; kk < 5; ++kk) {
            u32x4 pw; pw.x = pk2(st[2 * kk][0], st[2 * kk][1]); pw.y = pk2(st[2 * kk][2], st[2 * kk][3]);
            if (kk < 4) { pw.z = pk2(st[2 * kk + 1][0], st[2 * kk + 1][1]); pw.w = pk2(st[2 * kk + 1][2], st[2 * kk + 1][3]); } else { pw.z = 0u; pw.w = 0u; }
            const bf16x8 Pf = __builtin_bit_cast(bf16x8, pw);
            const LAS bf16_t* v0p = Vt + (16 * (qtile + 2 * kk) + 4 * g + q) * VT_LD + 4 * p;
#pragma unroll
            for (int dt = 0; dt < 4; ++dt) { const s16x4 lo = trd(v0p + 16 * dt); const s16x4 hi = (kk < 4) ? trd(v0p + 16 * VT_LD + 16 * dt) : (s16x4){0, 0, 0, 0};
                o[dt] = __builtin_amdgcn_mfma_f32_16x16x32_bf16(cat8(lo, hi), Pf, o[dt], 0, 0, 0); }
        }
        { bf16_t* op = P.AO + qrow * DM + (kh * 4 + hl_q) * 64 + 4 * g;
#pragma unroll
          for (int dt = 0; dt < 4; ++dt) { u32x2 w; w.x = pk2(o[dt][0] * inv, o[dt][1] * inv); w.y = pk2(o[dt][2] * inv, o[dt][3] * inv); *(u32x2*)(op + 16 * dt) = w; } }
    }
}


#define XB_TMO      128
#define XB_XCNT(j)  (256  + 64 * (j))
#define XB_XSUB(j)  (1280 + 64 * (j))
#define XB_XGEN(j)  (2304 + 64 * (j))
#define XB_TOP      3328
#define XB_TOPGEN   3392
#define XCD_BAR_WORDS 3456
#define XB_SPIN_CAP (1u << 20)
__device__ __forceinline__ unsigned xb_ld(unsigned* p)              { return __hip_atomic_load(p, __ATOMIC_RELAXED, __HIP_MEMORY_SCOPE_AGENT); }
__device__ __forceinline__ unsigned xb_add(unsigned* p, unsigned v) { return __hip_atomic_fetch_add(p, v, __ATOMIC_RELAXED, __HIP_MEMORY_SCOPE_AGENT); }
__device__ __forceinline__ unsigned xb_xcc_id() { return (unsigned)__builtin_amdgcn_s_getreg((3 << 11) | 20) & 0xFu; }
#define XB_SPIN(cond, bar) do { unsigned _sp = 0; while (cond) { __builtin_amdgcn_s_sleep(1); \
    if ((++_sp & 255u) == 0u) { if (xb_ld(&(bar)[XB_TMO])) break; if (_sp > XB_SPIN_CAP) { atomicAdd(&(bar)[XB_TMO], 1u); break; } } } } while (0)
struct XcdBarrier { unsigned* bar; unsigned x; volatile LAS unsigned* st; };
__device__ __forceinline__ XcdBarrier xcd_barrier_post(unsigned* bar, volatile LAS unsigned* st) {
    XcdBarrier b; b.bar = bar; b.x = xb_xcc_id(); b.st = st;
    if (threadIdx.x == 0) (void)xb_add(&bar[XB_XCNT(b.x)], 1u);
    return b;
}
__device__ __forceinline__ void xcd_barrier_complete(unsigned* bar, unsigned x, unsigned& nloc, unsigned& nx) {
    const unsigned G = gridDim.x * gridDim.y * gridDim.z;
    unsigned sum, cnt, mine, sp = 0u;
    for (;;) {
        sum = 0u; cnt = 0u; mine = 0u;
#pragma unroll
        for (unsigned j = 0; j < 16; ++j) { const unsigned c = xb_ld(&bar[XB_XCNT(j)]); sum += c; cnt += (c > 0u) ? 1u : 0u; mine = (j == x) ? c : mine; }
        if (sum == G) break;
        __builtin_amdgcn_s_sleep(1);
        if ((++sp & 255u) == 0u) { if (xb_ld(&bar[XB_TMO])) break; if (sp > XB_SPIN_CAP) { atomicAdd(&bar[XB_TMO], 1u); break; } }
    }
    nloc = mine > 0u ? mine : 1u; nx = cnt > 0u ? cnt : 1u;
}
__device__ __forceinline__ void xcd_barrier(const XcdBarrier& b) {
    asm volatile("s_waitcnt vmcnt(0)" ::: "memory");
    __syncthreads();
    if (threadIdx.x == 0) {
        unsigned* bar = b.bar;
        __builtin_amdgcn_s_waitcnt(0);
        unsigned nloc = b.st[0], nx = b.st[1];
        if (nloc == 0u) { xcd_barrier_complete(bar, b.x, nloc, nx); b.st[0] = nloc; b.st[1] = nx; }
        const unsigned old = xb_add(&bar[XB_XSUB(b.x)], 1u);
        const unsigned gen = old / nloc;
        if (old + 1u == (gen + 1u) * nloc) {
            __builtin_amdgcn_fence(__ATOMIC_RELEASE, "agent");
            asm volatile("s_waitcnt vmcnt(0)" ::: "memory");
            const unsigned og = xb_add(&bar[XB_TOP], 1u);
            const unsigned tg = og / nx;
            if (og + 1u == (tg + 1u) * nx) xb_add(&bar[XB_TOPGEN], 1u);
            else XB_SPIN(xb_ld(&bar[XB_TOPGEN]) == tg, bar);
            __builtin_amdgcn_fence(__ATOMIC_ACQUIRE, "agent");
            xb_add(&bar[XB_XGEN(b.x)], 1u);
            asm volatile("s_waitcnt vmcnt(0)" ::: "memory");
        } else {
            XB_SPIN(xb_ld(&bar[XB_XGEN(b.x)]) == gen, bar);
            __builtin_amdgcn_fence(__ATOMIC_ACQUIRE, "agent");
            asm volatile("s_waitcnt vmcnt(0)" ::: "memory");
        }
    }
    __syncthreads();
}

__global__ void __launch_bounds__(NTHREADS, 2) yoco_fwd(Args args) {
    extern __shared__ __attribute__((aligned(16))) unsigned char lds_raw[];
    LAS unsigned char* lds = (LAS unsigned char*)lds_raw;
    const int tid = threadIdx.x, lane = tid & 63, wave = __builtin_amdgcn_readfirstlane(tid >> 6), G = gridDim.x, bx = blockIdx.x;
    const int gw = bx * NWAVES + wave, NGW = G * NWAVES;
    typedef const __attribute__((address_space(4))) Args* KArgsP;
    const KArgsP kp0 = (KArgsP)__builtin_amdgcn_kernarg_segment_ptr();
#define KARG(field) ({ KArgsP q_ = kp0; asm volatile("" : "+s"(q_)); q_->field; })
#define ws KARG(ws)
#define out KARG(out)
#define x_prompt KARG(in[0])
#define x_sample KARG(in[1])
#define state_gla KARG(in[2])
#define cache_k KARG(in[3])
#define cache_v KARG(in[4])
#define p_prompt KARG(in[5])
#define p_sample KARG(in[6])
#define norm_mix KARG(in[7])
#define norm_mlp KARG(in[8])
#define norm_ple KARG(in[9])
#define norm_kv KARG(in[10])
#define norm_final KARG(in[11])
#define w_in_a KARG(in[12])
#define w_a2 KARG(in[13])
#define b_a2 KARG(in[14])
#define gla_o_gain KARG(in[15])
#define w_out_a KARG(in[16])
#define w_kv KARG(in[17])
#define w_q_b KARG(in[18])
#define w_o_b KARG(in[19])
#define sinks KARG(in[20])
#define rel_bias KARG(in[21])
#define w_up KARG(in[22])
#define w_down KARG(in[23])
#define w_ple KARG(in[24])
#define w_ple_gate KARG(in[25])
#define W_IN ((bf16_t*)(ws + WS_W_IN))
#define W_OUT ((bf16_t*)(ws + WS_W_OUT))
#define W_KVQ ((bf16_t*)(ws + WS_W_KVQ))
#define W_O ((bf16_t*)(ws + WS_W_O))
#define XB ((bf16_t*)(ws + WS_XB))
#define PB ((bf16_t*)(ws + WS_PB))
#define Q1 ((bf16_t*)(ws + WS_Q1))
#define K1 ((bf16_t*)(ws + WS_K1))
#define V1 ((bf16_t*)(ws + WS_V1))
#define G1 ((bf16_t*)(ws + WS_G1))
#define HIDA ((bf16_t*)(ws + WS_R1))
#define H3B ((bf16_t*)(ws + WS_R1))
#define R3 ((bf16_t*)(ws + WS_R3))
#define HIDS (R3 + (size_t)(64 - HID_SPLIT) * 256 * FF)
#define KVR ((bf16_t*)(ws + WS_KVR))
#define PLQ ((bf16_t*)(ws + WS_PLQ))
#define SSQ0 ((float*)(ws + WS_SSQ))
#define SSQ1 ((float*)(ws + WS_SSQ) + (size_t)M * 16)
#define DV ((float*)(ws + WS_DV))
#define H (out + O_Y)
#define UT ((bf16_t*)(out + O_Y))
    cg::grid_group grid = cg::this_grid();
    volatile LAS unsigned* bst = (volatile LAS unsigned*)(lds + LDS_BYTES - 64);
    if (tid < 2) bst[tid] = 0u;
    __syncthreads();
    XcdBarrier xbar; xbar.bar = nullptr; xbar.x = 0; xbar.st = bst;
#if !MK_SPLIT
    xbar = xcd_barrier_post((unsigned*)(ws + WS_CTL), bst);
#endif
    const int lo = KARG(ph_lo), hi = KARG(ph_hi);
#define IN(k) (lo <= (k) && (k) < hi)
#define SEAM(k) do { if (IN(k) && IN((k) + 1)) { if (MK_SPLIT) grid.sync(); else xcd_barrier(xbar); } } while (0)
    if (lo < 0) grid.sync();

    if (IN(0)) {
        LAS float* scr = (LAS float*)(lds + wave * 16384);
#define TJ_LIST(X) \
        X(w_in_a, IN_A_COLS, DM, 512, W_IN, norm_mix, 0.08838834764831845f)                                     \
        X(w_in_a + 512, IN_A_COLS, DM, 2560, W_IN + (size_t)512 * DM, norm_mix, 1.f)                            \
        X(w_out_a, DM, DM, DM, W_OUT, (const float*)nullptr, 1.f) \
        X(w_up, FF, DM, FF, (bf16_t*)(ws + WS_W_UP0), norm_mlp, 1.f) \
        X(w_up + (size_t)DM * FF, FF, DM, FF, (bf16_t*)(ws + WS_W_UP1), norm_mlp + DM, 1.f) \
        X(w_down, DM, FF, DM, (bf16_t*)(ws + WS_W_DN0), (const float*)nullptr, 1.f) \
        X(w_down + (size_t)DM * FF, DM, FF, DM, (bf16_t*)(ws + WS_W_DN1), (const float*)nullptr, 1.f) \
        X(w_ple_gate, DM, DM, DM, (bf16_t*)(ws + WS_W_G0), norm_ple, 1.f) \
        X(w_ple_gate + (size_t)DM * DM, DM, DM, DM, (bf16_t*)(ws + WS_W_G1), norm_ple + DM, 1.f) \
        X(w_ple, DM, PLE, DM, (bf16_t*)(ws + WS_W_P0), (const float*)nullptr, 1.f) \
        X(w_ple + (size_t)PLE * DM, DM, PLE, DM, (bf16_t*)(ws + WS_W_P1), (const float*)nullptr, 1.f) \
        X(w_kv, 512, DM, 512, W_KVQ, norm_kv, 1.f) \
        X(w_q_b, DM, DM, DM, W_KVQ + (size_t)512 * DM, norm_mix + DM, 0.125f * LOG2E)                          \
        X(w_o_b, DM, DM, DM, W_O, (const float*)nullptr, 1.f)
#define TJ_COUNT(W, LDW, KK, NCOLS, DST, GAIN, SCALE) + ((KK) / 64) * ((NCOLS) / 32)
        constexpr int TJ_TOTAL = 0 TJ_LIST(TJ_COUNT);
#define TJ_DECODE(WP, LDW, KK, NCOLS, DSTP, GAINP, SCALEV) if (!done_ && r_ < ((KK) / 64) * ((NCOLS) / 32)) { jt_.src = (WP); jt_.ldw = (LDW); jt_.kk = (KK); jt_.nblk = (NCOLS) / 32; jt_.dst = (DSTP); jt_.gain = (GAINP); jt_.scale = (SCALEV); jt_.item = r_; done_ = true; } else if (!done_) r_ -= ((KK) / 64) * ((NCOLS) / 32);
#define TJ_GET(JOUT, it) do { int r_ = (it); bool done_ = false; TJob jt_; jt_.src = nullptr; jt_.ldw = 0; jt_.kk = 0; jt_.nblk = 1; jt_.dst = nullptr; jt_.gain = nullptr; jt_.scale = 1.f; jt_.item = 0; TJ_LIST(TJ_DECODE) JOUT = jt_; } while (0)
        { float ra_[32], rb_[32]; TJob Ja, Jb; int it = gw;
          if (it < TJ_TOTAL) { TJ_GET(Ja, it); p0_tload(Ja, ra_, lane); }
          while (it < TJ_TOTAL) {
              const int it1 = it + NGW; if (it1 < TJ_TOTAL) { TJ_GET(Jb, it1); p0_tload(Jb, rb_, lane); }
              p0_tfinish(Ja, ra_, scr, lane);
              if (it1 >= TJ_TOTAL) break;
              const int it2 = it1 + NGW; if (it2 < TJ_TOTAL) { TJ_GET(Ja, it2); p0_tload(Ja, ra_, lane); }
              p0_tfinish(Jb, rb_, scr, lane);
              it = it2; } }
#undef TJ_LIST
#undef TJ_COUNT
#undef TJ_DECODE
#undef TJ_GET
        for (int idx = bx * NTHREADS + tid; idx < 512 * 128; idx += G * NTHREADS) { const int n = idx >> 7, k8 = (idx & 127) * 8; float wa[16];
#pragma unroll
            for (int r = 0; r < 16; ++r) wa[r] = w_a2[r * 512 + n];
            float o8[8];
#pragma unroll
            for (int kk = 0; kk < 8; ++kk) { const float* wr_ = w_in_a + (size_t)(k8 + kk) * IN_A_COLS + 3072; float s = 0.f;
#pragma unroll
                for (int r = 0; r < 16; ++r) s += wr_[r] * wa[r];
                o8[kk] = s * norm_mix[k8 + kk]; }
            u32x4 o; o.x = pk2(o8[0], o8[1]); o.y = pk2(o8[2], o8[3]); o.z = pk2(o8[4], o8[5]); o.w = pk2(o8[6], o8[7]);
            *(u32x4*)(W_IN + (size_t)(3072 + n) * DM + k8) = o; }
        for (int grp = bx; grp < M / 64; grp += G)
#pragma unroll 1
          for (int half = 0; half < 2; ++half) { const int m0 = 64 * grp + 8 * wave + 4 * half; f32x4 v[4][4]; float s[4];
#pragma unroll
            for (int q = 0; q < 4; ++q) { const int m = m0 + q; const float* xr = m < MP ? x_prompt + (size_t)m * DM : x_sample + (size_t)(m - MP) * DM;
#pragma unroll
                for (int j = 0; j < 4; ++j) v[q][j] = *((const f32x4*)xr + lane + 64 * j); }
#pragma unroll
            for (int q = 0; q < 4; ++q) { const int m = m0 + q; float ss = 0.f;
#pragma unroll
                for (int j = 0; j < 4; ++j) { ss += (v[q][j].x * v[q][j].x + v[q][j].y * v[q][j].y) + (v[q][j].z * v[q][j].z + v[q][j].w * v[q][j].w);
                    u32x2 w; w.x = pk2(v[q][j].x, v[q][j].y); w.y = pk2(v[q][j].z, v[q][j].w); *((u32x2*)(XB + (size_t)m * DM) + lane + 64 * j) = w; }
                s[q] = wave_sum(ss);
                if (lane < 4) *(f32x4*)(SSQ0 + ssq_idx(lane, m, 0)) = (f32x4){lane == 0 ? s[q] : 0.f, 0.f, 0.f, 0.f}; } }
        for (int m0 = gw * 8; m0 < M; m0 += NGW * 8) { f32x4 v[8];
#pragma unroll
            for (int q = 0; q < 8; ++q) { const int m = m0 + q; v[q] = *((const f32x4*)(m < MP ? p_prompt + (size_t)m * PLE : p_sample + (size_t)(m - MP) * PLE) + lane); }
#pragma unroll
            for (int q = 0; q < 8; ++q) { u32x2 w; w.x = pk2(v[q].x, v[q].y); w.y = pk2(v[q].z, v[q].w); *((u32x2*)(PB + (size_t)(m0 + q) * PLE) + lane) = w; } }
    }
    SEAM(0);
    if (IN(1)) { pg8::Gemm g{XB, XB, NPAN, W_IN, M, N_IN, DM}; pg8::StaticOrder S; S.init(M, N_IN, G, bx);
        pg8::EpiIn E{Q1, K1, V1, G1, KVR, SSQ0, b_a2}; pg8::gemm_phase(lds, g, S, E); }
    SEAM(1);
    if (IN(2)) {
        for (int base = bx * 2; base < SB * 4; base += G * 2) gla_sample_pair(lds, base, Q1, K1, V1, G1, KVR, state_gla, out + O_SS, gla_o_gain, R3, tid);
        gla_super_phase<false>(lds, G, bx, nullptr, K1, V1, nullptr, KVR, UT, DV, nullptr, nullptr, nullptr, tid, lane, wave);
    }
    SEAM(2);
    if (IN(3)) gla_scan<NSUP>(UT, DV, out + O_SP, bx * NTHREADS + tid, G * NTHREADS);
    SEAM(3);
    if (IN(4)) { gla_super_phase<true>(lds, G, bx, Q1, K1, V1, G1, KVR, UT, nullptr, gla_o_gain, R3, out + O_SP, tid, lane, wave); }
    SEAM(4);
    if (IN(5)) {
        { pg8::Gemm g{R3, R3, NPAN, W_OUT, MP, DM, DM}; pg8::StaticOrder S; S.init(MP, DM, G, bx); pg8::EpiRes<false> E{nullptr, nullptr, XB, XB, SSQ1, 1.f}; pg8::gemm_phase(lds, g, S, E); }
        { pg8::Gemm g{PB, PB, NPAN, (const bf16_t*)(ws + WS_W_P0), MP, DM, PLE}; pg8::StaticOrder S; S.init(MP, DM, G, bx); pg8::EpiPl E{PLQ}; pg8::gemm_phase(lds, g, S, E); }
        { mg::MRes<false> E{nullptr, XB, XB, SSQ1, 1.f}; mg::mini_gemm(lds, R3 + (size_t)MP * DM, W_OUT, DM, DM, G, bx, E); }
        { mg::MPl E{PLQ, nullptr}; mg::mini_gemm(lds, PB + (size_t)MP * PLE, (const bf16_t*)(ws + WS_W_P0), DM, PLE, G, bx, E); }
    }
    SEAM(5);
    if (IN(6)) { { pg8::Gemm g{XB, XB, NPAN, (const bf16_t*)(ws + WS_W_UP0), MP, FF, DM}; pg8::StaticOrder S; S.init(MP, FF, G, bx); pg8::EpiUp E{HIDA, R3, SSQ1}; pg8::gemm_phase(lds, g, S, E); }
        { mg::MUp E{HIDS, SSQ1, nullptr}; mg::mini_gemm(lds, XB + (size_t)MP * DM, (const bf16_t*)(ws + WS_W_UP0), FF, DM, G, bx, E); } }
    SEAM(6);
    if (IN(7)) { { pg8::Gemm g{HIDA, R3, HID_SPLIT, (const bf16_t*)(ws + WS_W_DN0), MP, DM, FF}; pg8::StaticOrder S; S.init(MP, DM, G, bx); pg8::EpiRes<false> E{nullptr, nullptr, XB, XB, SSQ0, 1.f}; pg8::gemm_phase(lds, g, S, E); }
        { mg::MRes<false> E{nullptr, XB, XB, SSQ0, 1.f}; mg::mini_gemm(lds, HIDS, (const bf16_t*)(ws + WS_W_DN0), DM, FF, G, bx, E); } }
    SEAM(7);
    if (IN(8)) { { pg8::Gemm g{XB, XB, NPAN, (const bf16_t*)(ws + WS_W_G0), MP, DM, DM}; pg8::StaticOrder S; S.init(MP, DM, G, bx); pg8::EpiGate<false> E{nullptr, XB, PLQ, H3B, SSQ0, SSQ1, 1.f}; pg8::gemm_phase(lds, g, S, E); }
        { mg::MGate<false> E{nullptr, XB, PLQ, H3B, SSQ0, SSQ1, 1.f}; mg::mini_gemm(lds, XB + (size_t)MP * DM, (const bf16_t*)(ws + WS_W_G0), DM, DM, G, bx, E); } }
    SEAM(8);
    if (IN(9)) { pg8::Gemm g{H3B, H3B, NPAN, W_KVQ, M, NKVQ, DM}; pg8::StaticOrder S; S.init(M, NKVQ, G, bx);
        pg8::EpiKvq E{KVR, PLQ, SSQ1, out + O_CKP, out + O_CVP, out + O_CKS, out + O_CVS}; pg8::gemm_phase(lds, g, S, E); }
    SEAM(9);
    if (IN(10)) {
        const AttnP AP{KVR, PLQ, R3, cache_k, cache_v, out + O_CKS, out + O_CVS, sinks, rel_bias};
        { AttnRegs AR; int buf = 0;
          if (bx < 1024) { attn_load(bx, AP, AR, tid); attn_stage(lds, bx, AP, AR, tid); }
          LDS_BAR();
          for (int it = bx; it < 1024; it += G) { const int nx = it + G;
              if (nx < 1024) attn_load(nx, AP, AR, tid);
              attn_compute(lds + buf * ATT_BUF, it, AP, lane, wave);
              if (nx < 1024) attn_stage(lds + (buf ^ 1) * ATT_BUF, nx, AP, AR, tid);
              LDS_BAR(); buf ^= 1; } }
        for (int m0 = gw * 8; m0 < M; m0 += NGW * 8) { f32x4 v[8];
#pragma unroll
            for (int q = 0; q < 8; ++q) { const int m = m0 + q; v[q] = *((const f32x4*)(m < MP ? p_prompt + (size_t)(MP + m) * PLE : p_sample + (size_t)(MS + m - MP) * PLE) + lane); }
#pragma unroll
            for (int q = 0; q < 8; ++q) { u32x2 w; w.x = pk2(v[q].x, v[q].y); w.y = pk2(v[q].z, v[q].w); *((u32x2*)(PB + (size_t)(m0 + q) * PLE) + lane) = w; } }
    }
    SEAM(10);
    if (IN(11)) {
        { pg8::Gemm g{R3, R3, NPAN, W_O, MP, DM, DM}; pg8::StaticOrder S; S.init(MP, DM, G, bx); pg8::EpiRes<false> E{nullptr, nullptr, H3B, XB, SSQ0, 1.f}; pg8::gemm_phase(lds, g, S, E); }
        { pg8::Gemm g{PB, PB, NPAN, (const bf16_t*)(ws + WS_W_P1), MP, DM, PLE}; pg8::StaticOrder S; S.init(MP, DM, G, bx); pg8::EpiPl E{PLQ}; pg8::gemm_phase(lds, g, S, E); }
        { mg::MRes<false> E{nullptr, H3B, XB, SSQ0, 1.f}; mg::mini_gemm(lds, R3 + (size_t)MP * DM, W_O, DM, DM, G, bx, E); }
        { mg::MPl E{PLQ, nullptr}; mg::mini_gemm(lds, PB + (size_t)MP * PLE, (const bf16_t*)(ws + WS_W_P1), DM, PLE, G, bx, E); }
    }
    SEAM(11);
    if (IN(12)) { { pg8::Gemm g{XB, XB, NPAN, (const bf16_t*)(ws + WS_W_UP1), MP, FF, DM}; pg8::StaticOrder S; S.init(MP, FF, G, bx); pg8::EpiUp E{HIDA, R3, SSQ0}; pg8::gemm_phase(lds, g, S, E); }
        { mg::MUp E{HIDS, SSQ0, nullptr}; mg::mini_gemm(lds, XB + (size_t)MP * DM, (const bf16_t*)(ws + WS_W_UP1), FF, DM, G, bx, E); } }
    SEAM(12);
    if (IN(13)) { { pg8::Gemm g{HIDA, R3, HID_SPLIT, (const bf16_t*)(ws + WS_W_DN1), MP, DM, FF}; pg8::StaticOrder S; S.init(MP, DM, G, bx); pg8::EpiRes<false> E{nullptr, nullptr, XB, XB, SSQ1, 1.f}; pg8::gemm_phase(lds, g, S, E); }
        { mg::MRes<false> E{nullptr, XB, XB, SSQ1, 1.f}; mg::mini_gemm(lds, HIDS, (const bf16_t*)(ws + WS_W_DN1), DM, FF, G, bx, E); } }
    SEAM(13);
    if (IN(14)) { { pg8::Gemm g{XB, XB, NPAN, (const bf16_t*)(ws + WS_W_G1), MP, DM, DM}; pg8::StaticOrder S; S.init(MP, DM, G, bx); pg8::EpiGate<false> E{nullptr, XB, PLQ, H3B, SSQ1, SSQ0, 1.f}; pg8::gemm_phase(lds, g, S, E); }
        { mg::MGate<false> E{nullptr, XB, PLQ, H3B, SSQ1, SSQ0, 1.f}; mg::mini_gemm(lds, XB + (size_t)MP * DM, (const bf16_t*)(ws + WS_W_G1), DM, DM, G, bx, E); } }
    SEAM(14);
    if (IN(15)) {
        f32x4 gn[4];
#pragma unroll
        for (int j = 0; j < 4; ++j) gn[j] = *((const f32x4*)norm_final + lane + 64 * j);
        for (int m0 = gw * 4; m0 < M; m0 += NGW * 4) { u32x2 w[4][4]; float r[4];
#pragma unroll
            for (int q = 0; q < 4; ++q) { r[q] = row_r(SSQ0, m0 + q);
#pragma unroll
                for (int j = 0; j < 4; ++j) w[q][j] = *((const u32x2*)(H3B + (size_t)(m0 + q) * DM) + lane + 64 * j); }
#pragma unroll
            for (int q = 0; q < 4; ++q)
#pragma unroll
                for (int j = 0; j < 4; ++j) { const f32x4 v = {bflo(w[q][j].x), bfhi(w[q][j].x), bflo(w[q][j].y), bfhi(w[q][j].y)};
                    *((f32x4*)(H + (size_t)(m0 + q) * DM) + lane + 64 * j) = v * r[q] * gn[j]; } }
    }
#undef IN
#undef SEAM
}
#undef ws
#undef out
#undef x_prompt
#undef x_sample
#undef state_gla
#undef cache_k
#undef cache_v
#undef p_prompt
#undef p_sample
#undef norm_mix
#undef norm_mlp
#undef norm_ple
#undef norm_kv
#undef norm_final
#undef w_in_a
#undef w_a2
#undef b_a2
#undef gla_o_gain
#undef w_out_a
#undef w_kv
#undef w_q_b
#undef w_o_b
#undef sinks
#undef rel_bias
#undef w_up
#undef w_down
#undef w_ple
#undef w_ple_gate
#undef W_IN
#undef W_OUT
#undef W_KVQ
#undef W_O
#undef XB
#undef PB
#undef Q1
#undef K1
#undef V1
#undef G1
#undef HIDA
#undef H3B
#undef R3
#undef HIDS
#undef KVR
#undef PLQ
#undef SSQ0
#undef SSQ1
#undef DV
#undef H
#undef UT
#undef KARG

extern "C" void kernel_launch(void* const* d_in, const int* in_sizes, int n_in, void* d_out, int out_size, void* d_ws, size_t ws_size, hipStream_t stream) {
    static int grid = 0;
    if (grid == 0) {
        if (n_in != 26 || (size_t)out_size != O_END || ws_size < WS_END) { fprintf(stderr, "kernel_launch: unexpected shapes (n_in %d out %d ws %zu need %zu)\n", n_in, out_size, ws_size, (size_t)WS_END); grid = -1; return; }
        int dev = 0, cus = 0, per_cu = 0;
        hipGetDevice(&dev); hipDeviceGetAttribute(&cus, hipDeviceAttributeMultiprocessorCount, dev);
        hipFuncSetAttribute((const void*)yoco_fwd, hipFuncAttributeMaxDynamicSharedMemorySize, LDS_BYTES);
        hipOccupancyMaxActiveBlocksPerMultiprocessor(&per_cu, (const void*)yoco_fwd, NTHREADS, LDS_BYTES);
        if (per_cu < 1) { fprintf(stderr, "kernel_launch: occupancy query says %d blocks per CU\n", per_cu); per_cu = 1; }
        (void)hipGetLastError();
        grid = cus * 1;
    }
    if (grid < 0) return;
    if (hipMemsetAsync((char*)d_ws + WS_CTL, 0, 65536, stream) != hipSuccess) { fprintf(stderr, "kernel_launch: memset failed\n"); return; }
    Args a{};
    for (int i = 0; i < 26; ++i) a.in[i] = (const float*)d_in[i];
    a.out = (float*)d_out; a.ws = (unsigned char*)d_ws;
#if MK_SPLIT
    for (int ph = 0; ph < 16; ++ph) { a.ph_lo = ph; a.ph_hi = ph + 1; hipLaunchKernelGGL(yoco_fwd, dim3(grid), dim3(NTHREADS), LDS_BYTES, stream, a); }
#else
    a.ph_lo = 0; a.ph_hi = 16;
    void* kargs[] = {&a};
    hipError_t e = hipLaunchCooperativeKernel((const void*)yoco_fwd, dim3(grid), dim3(NTHREADS), kargs, LDS_BYTES, stream);
    if (e != hipSuccess) fprintf(stderr, "cooperative launch failed: %s (grid %d)\n", hipGetErrorString(e), grid);
#endif
}
```

```cpp
#include <hip/hip_runtime.h>
#include <hip/hip_cooperative_groups.h>
#include <cstdio>
#include <cstdint>
namespace cg = cooperative_groups;

#define LAS __attribute__((address_space(3)))
#define GAS __attribute__((address_space(1)))
typedef unsigned short bf16_t;
typedef short bf16x8 __attribute__((ext_vector_type(8)));
typedef short s16x4 __attribute__((ext_vector_type(4)));
typedef float f32x4 __attribute__((ext_vector_type(4)));
typedef float f32x2 __attribute__((ext_vector_type(2)));
typedef unsigned u32x4 __attribute__((ext_vector_type(4)));
typedef unsigned u32x2 __attribute__((ext_vector_type(2)));

#ifndef MK_SPLIT
#define MK_SPLIT 0
#endif

constexpr int DM = 1024, SEQ = 8192, NBATCH = 2, MP = NBATCH * SEQ, SB = 128, SS = 8, MS = SB * SS, M = MP + MS, NPAN = M / 256;
constexpr int NQK = 512, NV = 1024, N_IN = 3584, FF = 4096, PLE = 256, NKVQ = 1536, IN_A_COLS = 3088;
constexpr int NCHUNK = 128, NBH = 8, NCH_ALL = NBH * NCHUNK;
constexpr float EPS = 1e-6f, LOG2E = 1.4426950408889634f;
constexpr int HID_SPLIT = 51;

constexpr size_t O_Y = 0, O_SP = (size_t)M * DM, O_SS = O_SP + 262144, O_CKP = O_SS + 16777216, O_CVP = O_CKP + 65536, O_CKS = O_CVP + 65536, O_CVS = O_CKS + 4194304, O_END = O_CVS + 4194304;

constexpr size_t al256(size_t x) { return (x + 255) & ~(size_t)255; }
constexpr size_t WS_CTL = 0, CTL_BYTES = 1u << 20;
constexpr size_t WS_W_IN = CTL_BYTES;
constexpr size_t WS_W_OUT = WS_W_IN + (size_t)N_IN * DM * 2;
constexpr size_t WS_W_UP0 = WS_W_OUT + (size_t)DM * DM * 2;
constexpr size_t WS_W_DN0 = WS_W_UP0 + (size_t)FF * DM * 2;
constexpr size_t WS_W_UP1 = WS_W_DN0 + (size_t)FF * DM * 2;
constexpr size_t WS_W_DN1 = WS_W_UP1 + (size_t)FF * DM * 2;
constexpr size_t WS_W_G0 = WS_W_DN1 + (size_t)FF * DM * 2;
constexpr size_t WS_W_G1 = WS_W_G0 + (size_t)DM * DM * 2;
constexpr size_t WS_W_P0 = WS_W_G1 + (size_t)DM * DM * 2;
constexpr size_t WS_W_P1 = WS_W_P0 + (size_t)DM * PLE * 2;
constexpr size_t WS_W_KVQ = WS_W_P1 + (size_t)DM * PLE * 2;
constexpr size_t WS_W_O = WS_W_KVQ + (size_t)NKVQ * DM * 2;
constexpr size_t WS_XB = WS_W_O + (size_t)DM * DM * 2;
constexpr size_t WS_PB = WS_XB + (size_t)M * DM * 2;
constexpr size_t WS_R1 = WS_PB + (size_t)M * PLE * 2;
constexpr size_t R1_BYTES = (size_t)HID_SPLIT * 256 * FF * 2;
constexpr size_t WS_Q1 = WS_R1, WS_K1 = WS_Q1 + (size_t)M * NQK * 2, WS_V1 = WS_K1 + (size_t)M * NQK * 2, WS_G1 = WS_V1 + (size_t)M * NV * 2;
static_assert(WS_G1 + (size_t)M * NV * 2 == WS_R1 + R1_BYTES, "R1 map");
constexpr size_t WS_R3 = WS_R1 + R1_BYTES;
static_assert((size_t)(NPAN - HID_SPLIT) * 256 * FF * 2 == (size_t)M * DM * 2, "R3 map");
constexpr size_t WS_KVR = WS_R3 + (size_t)M * DM * 2;
constexpr size_t WS_PLQ = WS_KVR + (size_t)M * NQK * 2;
constexpr size_t WS_SSQ = WS_PLQ + (size_t)M * DM * 2;
constexpr size_t WS_DV = WS_SSQ + (size_t)2 * M * 16 * 4;
constexpr size_t WS_END = WS_DV + (size_t)NCH_ALL * 128 * 4;

__device__ __forceinline__ float bf2f(unsigned short b) { return __uint_as_float((unsigned)b << 16); }
__device__ __forceinline__ float bflo(unsigned w) { return __uint_as_float(w << 16); }
__device__ __forceinline__ float bfhi(unsigned w) { return __uint_as_float(w & 0xffff0000u); }
typedef __bf16 bf16x2_t __attribute__((ext_vector_type(2)));
__device__ __forceinline__ unsigned pk2(float lo, float hi) { const f32x2 v = {lo, hi}; const bf16x2_t b = __builtin_convertvector(v, bf16x2_t); return __builtin_bit_cast(unsigned, b); }
__device__ __forceinline__ float fexp(float x) { return __builtin_amdgcn_exp2f(x * LOG2E); }
__device__ __forceinline__ float frcp(float x) { return __builtin_amdgcn_rcpf(x); }
__device__ __forceinline__ float frsq(float x) { return __builtin_amdgcn_rsqf(x); }
__device__ __forceinline__ float fsigmoid(float x) { return frcp(1.f + fexp(-x)); }
__device__ __forceinline__ float logsig(float x) { return fminf(x, 0.f) - __logf(1.f + fexp(-fabsf(x))); }
__device__ __forceinline__ s16x4 trd(const LAS bf16_t* p) { return __builtin_bit_cast(s16x4, __builtin_amdgcn_ds_read_tr16_b64_v4i16((LAS s16x4*)p)); }
__device__ __forceinline__ bf16x8 cat8(s16x4 lo, s16x4 hi) { return (bf16x8){lo[0], lo[1], lo[2], lo[3], hi[0], hi[1], hi[2], hi[3]}; }
__device__ __forceinline__ void st_wt(float* p, float v) { __hip_atomic_store(p, v, __ATOMIC_RELAXED, __HIP_MEMORY_SCOPE_AGENT); }
__device__ __forceinline__ void st16_wt(void* p, u32x4 v) { asm volatile("global_store_dwordx4 %0, %1, off sc1\n\ts_nop 1" :: "v"(p), "v"(v) : "memory"); }
__device__ __forceinline__ float wave_sum(float v) {
#pragma unroll
    for (int o = 1; o < 64; o <<= 1) v += __shfl_xor(v, o);
    return v;
}
__device__ __forceinline__ size_t ssq_idx(int pn, int row, int wc) { return ((size_t)pn * M + row) * 4 + wc; }
__device__ __forceinline__ float row_r(const float* ssq, int row) {
    const f32x4 a = *(const f32x4*)(ssq + ssq_idx(0, row, 0)), b = *(const f32x4*)(ssq + ssq_idx(1, row, 0)), c = *(const f32x4*)(ssq + ssq_idx(2, row, 0)), d = *(const f32x4*)(ssq + ssq_idx(3, row, 0));
    const f32x4 s = (a + b) + (c + d);
    return frsq(((s.x + s.y) + (s.z + s.w)) * (1.f / 1024.f) + EPS);
}

namespace pg8 {
constexpr int BM = 256, BK = 64, HALF = 128, HTB = HALF * BK * 2, STAGE_BYTES = 8 * HTB, NXCD = 8, WGM = 8;
__host__ __device__ __forceinline__ int lds_byte(int r, int c) { const int st = (r >> 4) * 2 + (c >> 5), rr = r & 15, cc = c & 31, ob = rr * 64 + cc * 2; return st * 1024 + (ob ^ (((ob >> 9) & 1) << 5)); }
__host__ __device__ __forceinline__ void stage_rc(int b, int& R, int& C) { const int st = b / 1024, sb = b % 1024, swz = sb ^ (((sb >> 9) & 1) << 5); R = (st >> 1) * 16 + swz / 64; C = (st & 1) * 32 + (swz % 64) / 2; }
__host__ __device__ __forceinline__ int perm32(int rho) { const int n = rho >> 4, i = rho & 15; return 8 * (i >> 2) + 4 * n + (i & 3); }
struct Unit { int pm, pn; };
struct Gemm { const bf16_t* A; const bf16_t* A2; int split; const bf16_t* Bt; int M, N, K; };
struct StaticOrder {
    int nM, nN, nwg, G, c;
    __device__ void init(int M_, int N, int G_, int c_) { nM = M_ / BM; nN = N / BM; nwg = nM * nN; G = G_; c = c_; }
    __device__ bool next(int i, Unit& u) const {
        const long L = (long)i * G + c; if (L >= nwg) return false;
        int wgid = (int)L; { const int q = nwg / NXCD, r = nwg % NXCD, xcd = wgid % NXCD, off = wgid / NXCD; wgid = (xcd < r ? xcd * (q + 1) : r * (q + 1) + (xcd - r) * q) + off; }
        const int nig = WGM * nN, gid = wgid / nig, fm = gid * WGM, gsz = (nM - fm) < WGM ? (nM - fm) : WGM;
        u.pm = fm + ((wgid % nig) % gsz); u.pn = (wgid % nig) / gsz; return true;
    }
};

template <class Epi>
__device__ __forceinline__ void gemm_phase(LAS unsigned char* lds, const Gemm g, const StaticOrder& S, const Epi& E) {
    const int tid = threadIdx.x, wid = __builtin_amdgcn_readfirstlane(tid >> 6), lane = tid & 63, wr = wid >> 2, wc = wid & 3, fr = lane & 15, fq = lane >> 4;
    const int K = g.K, nt = K / BK;
    unsigned voffA[2], voffB[2];
#pragma unroll
    for (int i = 0; i < 2; ++i) { int R, C; stage_rc(tid * 16 + i * 8192, R, C); const int Rb = (R & ~31) + perm32(R & 31);
        voffA[i] = (unsigned)(R * K + C) * 2u; voffB[i] = (unsigned)(Rb * K + C) * 2u; }
    const size_t kstep = (size_t)(BK * 2);
    const size_t hstep = (size_t)HALF * K * 2;
    const size_t tstep = 2 * hstep;
    const unsigned ldsw = (unsigned)wid * 1024u;
    const int aoff = lds_byte(wr * 64 + fr, fq * 8), boff = lds_byte(wc * 32 + fr, fq * 8);
#define PG8_APTR(pm) ((pm) < g.split ? (const char*)g.A + (size_t)(pm) * tstep : (const char*)g.A2 + (size_t)((pm) - g.split) * tstep)
#define PG8_SA(b, h) (((b) * 2 + (h)) * HTB)
#define PG8_SB(b, h) ((4 + (b) * 2 + (h)) * HTB)
#define PG8_STAGE(bufoff, gbase, voff) do { _Pragma("unroll") for (int _i = 0; _i < 2; ++_i) \
        __builtin_amdgcn_global_load_lds((const unsigned*)((const char*)(gbase) + (voff)[_i]), (LAS unsigned*)(lds + (bufoff) + ldsw + _i * 8192), 16, 0, 0); } while (0)
#define PG8_LDA(dst, b, h) do { _Pragma("unroll") for (int m = 0; m < 4; ++m) _Pragma("unroll") for (int k = 0; k < 2; ++k) dst[m][k] = *(const LAS bf16x8*)(lds + PG8_SA(b, h) + aoff + m * 2048 + k * 1024); } while (0)
#define PG8_LDB(dst, b, h) do { _Pragma("unroll") for (int n = 0; n < 2; ++n) _Pragma("unroll") for (int k = 0; k < 2; ++k) dst[n][k] = *(const LAS bf16x8*)(lds + PG8_SB(b, h) + boff + n * 2048 + k * 1024); } while (0)
#define PG8_MMA(ai, bj, At, Bt) do { __builtin_amdgcn_s_setprio(1); _Pragma("unroll") for (int m = 0; m < 4; ++m) _Pragma("unroll") for (int n = 0; n < 2; ++n) _Pragma("unroll") for (int k = 0; k < 2; ++k) \
        acc[ai][bj][m][n] = __builtin_amdgcn_mfma_f32_16x16x32_bf16(Bt[n][k], At[m][k], acc[ai][bj][m][n], 0, 0, 0); __builtin_amdgcn_s_setprio(0); } while (0)
#define PG8_WAIT_V(n) asm volatile("s_waitcnt vmcnt(" #n ")" ::: "memory")
#define PG8_WAIT_L(n) asm volatile("s_waitcnt lgkmcnt(" #n ")" ::: "memory")
#define PG8_BAR __builtin_amdgcn_s_barrier()
#define PG8_SCHED __builtin_amdgcn_sched_barrier(0)
    Unit cur, nxt; int ui = 0;
    if (!S.next(0, cur)) return;
    LAS float* rtab_all = (LAS float*)(lds + STAGE_BYTES);
    if (E.rsrc() != nullptr) { Unit uu; for (int i = 0; i < 8 && S.next(i, uu); ++i) if (tid < 256) rtab_all[i * 256 + tid] = row_r(E.rsrc(), uu.pm * BM + tid); }
    f32x4 acc[2][2][4][2];
#pragma unroll
    for (int a = 0; a < 2; ++a)
#pragma unroll
        for (int b = 0; b < 2; ++b)
#pragma unroll
            for (int m = 0; m < 4; ++m)
#pragma unroll
                for (int n = 0; n < 2; ++n) acc[a][b][m][n] = (f32x4){0.f, 0.f, 0.f, 0.f};
    bf16x8 At[4][2], B0[2][2], B1[2][2];
    const char* cA = PG8_APTR(cur.pm); const char* cB = (const char*)g.Bt + (size_t)cur.pn * tstep;
    PG8_STAGE(PG8_SB(0, 0), cB, voffB); PG8_STAGE(PG8_SB(0, 1), cB + hstep, voffB); PG8_STAGE(PG8_SA(0, 0), cA, voffA); PG8_STAGE(PG8_SA(0, 1), cA + hstep, voffA);
    PG8_WAIT_L(0);
    if (wr == 1) PG8_BAR;
    PG8_WAIT_V(2); PG8_BAR;
    PG8_STAGE(PG8_SB(1, 0), cB + kstep, voffB); PG8_STAGE(PG8_SA(1, 0), cA + kstep, voffA); PG8_STAGE(PG8_SB(1, 1), cB + hstep + kstep, voffB);
    PG8_WAIT_V(6); PG8_BAR;
    for (;;) {
        const bool has_next = S.next(ui + 1, nxt);
        const char* nA = has_next ? PG8_APTR(nxt.pm) : cA; const char* nB = has_next ? (const char*)g.Bt + (size_t)nxt.pn * tstep : cB;
#pragma clang loop unroll(disable)
        for (int t = 0; t < nt; t += 2) {
            const bool last = (t == nt - 2);
            const char* a1 = cA + (size_t)(t + 1) * kstep;
            const char* a2 = last ? nA : cA + (size_t)(t + 2) * kstep; const char* b2 = last ? nB : cB + (size_t)(t + 2) * kstep;
            const char* a3 = a2 + kstep; const char* b3 = b2 + kstep;
            PG8_LDB(B0, 0, 0); PG8_LDB(B1, 0, 1); PG8_SCHED; PG8_LDA(At, 0, 0); PG8_STAGE(PG8_SA(1, 1), a1 + hstep, voffA);
            PG8_WAIT_V(8); PG8_WAIT_L(0); PG8_BAR; PG8_MMA(0, 0, At, B0); PG8_MMA(0, 1, At, B1); PG8_BAR; PG8_SCHED;
            PG8_LDA(At, 0, 1); PG8_STAGE(PG8_SB(0, 0), b2, voffB); PG8_STAGE(PG8_SB(0, 1), b2 + hstep, voffB); PG8_STAGE(PG8_SA(0, 0), a2, voffA);
            PG8_WAIT_V(8); PG8_WAIT_L(0); PG8_BAR; PG8_MMA(1, 0, At, B0); PG8_MMA(1, 1, At, B1); PG8_BAR; PG8_SCHED;
            PG8_LDB(B0, 1, 0); PG8_LDB(B1, 1, 1); PG8_SCHED; PG8_LDA(At, 1, 0); PG8_STAGE(PG8_SA(0, 1), a2 + hstep, voffA);
            PG8_WAIT_V(8); PG8_WAIT_L(0); PG8_BAR; PG8_MMA(0, 0, At, B0); PG8_MMA(0, 1, At, B1); PG8_BAR; PG8_SCHED;
            PG8_LDA(At, 1, 1); PG8_STAGE(PG8_SB(1, 0), b3, voffB); PG8_STAGE(PG8_SB(1, 1), b3 + hstep, voffB); PG8_STAGE(PG8_SA(1, 0), a3, voffA);
            PG8_WAIT_V(8); PG8_WAIT_L(0); PG8_BAR; PG8_MMA(1, 0, At, B0); PG8_MMA(1, 1, At, B1); PG8_BAR; PG8_SCHED;
        }
        if (wr == 0) PG8_BAR;
        { int efr = fr, efq = fq, etid = tid; asm volatile("" : "+v"(efr), "+v"(efq), "+v"(etid));
          E(acc, cur, wr, wc, efr, efq, rtab_all + (ui & 7) * 256, etid); }
        if (!has_next) break;
#pragma unroll
        for (int a = 0; a < 2; ++a)
#pragma unroll
            for (int b = 0; b < 2; ++b)
#pragma unroll
                for (int m = 0; m < 4; ++m)
#pragma unroll
                    for (int n = 0; n < 2; ++n) acc[a][b][m][n] = (f32x4){0.f, 0.f, 0.f, 0.f};
        cur = nxt; cA = nA; cB = nB; ++ui;
        if (wr == 1) PG8_BAR;
    }
    PG8_WAIT_V(0);
    PG8_BAR;
#undef PG8_APTR
#undef PG8_SA
#undef PG8_SB
#undef PG8_STAGE
#undef PG8_LDA
#undef PG8_LDB
#undef PG8_MMA
#undef PG8_WAIT_V
#undef PG8_WAIT_L
#undef PG8_BAR
#undef PG8_SCHED
}

#define EPI_ROWLOOP _Pragma("unroll") for (int ai = 0; ai < 2; ++ai) _Pragma("unroll") for (int m = 0; m < 4; ++m)
__device__ __forceinline__ u32x4 pack8(const f32x4 v0, const f32x4 v1) { u32x4 w; w.x = pk2(v0[0], v0[1]); w.y = pk2(v0[2], v0[3]); w.z = pk2(v1[0], v1[1]); w.w = pk2(v1[2], v1[3]); return w; }

struct EpiIn {
    bf16_t *Q, *Kk, *V, *G, *LG; const float* ssq; const float* b_a2;
    __device__ __forceinline__ const float* rsrc() const { return ssq; }
    __device__ __forceinline__ void operator()(const f32x4 (&acc)[2][2][4][2], const Unit& u, int wr, int wc, int fr, int fq, LAS float* rtab, int tid) const {
        const int pn = u.pn; bf16_t* base; int ld, c0;
        if (pn < 2) { base = Q; ld = NQK; c0 = pn * 256; } else if (pn < 4) { base = Kk; ld = NQK; c0 = (pn - 2) * 256; }
        else if (pn < 8) { base = V; ld = NV; c0 = (pn - 4) * 256; } else if (pn < 12) { base = G; ld = NV; c0 = (pn - 8) * 256; }
        else { base = LG; ld = NQK; c0 = (pn - 12) * 256; }
        const bool is_lg = pn >= 12;
        const int col = c0 + wc * 32 + 8 * fq;
        f32x4 bb[2][2];
#pragma unroll
        for (int bj = 0; bj < 2; ++bj)
#pragma unroll
            for (int n = 0; n < 2; ++n) bb[bj][n] = is_lg ? *(const f32x4*)(b_a2 + col + bj * HALF + 4 * n) : (f32x4){0.f, 0.f, 0.f, 0.f};
        EPI_ROWLOOP { const int lr = ai * HALF + wr * 64 + m * 16 + fr, row = u.pm * BM + lr; const float r = rtab[lr];
#pragma unroll
            for (int bj = 0; bj < 2; ++bj) { f32x4 v0 = acc[ai][bj][m][0] * r, v1 = acc[ai][bj][m][1] * r;
                if (is_lg) { v0 += bb[bj][0]; v1 += bb[bj][1];
#pragma unroll
                    for (int e = 0; e < 4; ++e) { v0[e] = logsig(v0[e]) * (1.f / 16.f); v1[e] = logsig(v1[e]) * (1.f / 16.f); } }
                *(u32x4*)(base + (size_t)row * ld + col + bj * HALF) = pack8(v0, v1); } }
    }
};
template <bool FROM_X> struct EpiRes {
    const float* X0; const float* X1; const bf16_t* BB; bf16_t* XO; float* ssq_out; float sc;
    __device__ __forceinline__ const float* rsrc() const { return nullptr; }
    __device__ __forceinline__ void operator()(const f32x4 (&acc)[2][2][4][2], const Unit& u, int wr, int wc, int fr, int fq, LAS float* rtab, int tid) const {
        const int col = u.pn * BM + wc * 32 + 8 * fq;
#pragma unroll
        for (int ai = 0; ai < 2; ++ai) {
            f32x4 b0[4][2], b1[4][2]; u32x4 bw[4][2];
#pragma unroll
            for (int m = 0; m < 4; ++m) { const int row = u.pm * BM + ai * HALF + wr * 64 + m * 16 + fr;
#pragma unroll
                for (int bj = 0; bj < 2; ++bj) {
                    if (FROM_X) { const float* src = (u.pm < MP / 256 ? X0 + (size_t)row * DM : X1 + (size_t)(row - MP) * DM) + col + bj * HALF; b0[m][bj] = *(const f32x4*)src; b1[m][bj] = *(const f32x4*)(src + 4); }
                    else bw[m][bj] = *(const u32x4*)(BB + (size_t)row * DM + col + bj * HALF); } }
            if (!FROM_X) asm volatile("" ::: "memory");
#pragma unroll
            for (int m = 0; m < 4; ++m) { const int row = u.pm * BM + ai * HALF + wr * 64 + m * 16 + fr; float s = 0.f;
#pragma unroll
                for (int bj = 0; bj < 2; ++bj) {
                    if (!FROM_X) { const u32x4 w = bw[m][bj]; b0[m][bj] = (f32x4){bflo(w.x), bfhi(w.x), bflo(w.y), bfhi(w.y)}; b1[m][bj] = (f32x4){bflo(w.z), bfhi(w.z), bflo(w.w), bfhi(w.w)}; }
                    const f32x4 v0 = acc[ai][bj][m][0] * sc + b0[m][bj], v1 = acc[ai][bj][m][1] * sc + b1[m][bj];
                    *(u32x4*)(XO + (size_t)row * DM + col + bj * HALF) = pack8(v0, v1);
                    s += (v0[0] * v0[0] + v0[1] * v0[1]) + (v0[2] * v0[2] + v0[3] * v0[3]) + (v1[0] * v1[0] + v1[1] * v1[1]) + (v1[2] * v1[2] + v1[3] * v1[3]); }
                s += __shfl_xor(s, 16); s += __shfl_xor(s, 32);
                if (fq == 0) ssq_out[ssq_idx(u.pn, row, wc)] = s; }
        }
    }
};
struct EpiUp {
    bf16_t* HA; bf16_t* HB; const float* ssq;
    __device__ __forceinline__ const float* rsrc() const { return ssq; }
    __device__ __forceinline__ void operator()(const f32x4 (&acc)[2][2][4][2], const Unit& u, int wr, int wc, int fr, int fq, LAS float* rtab, int tid) const {
        bf16_t* base = u.pm < HID_SPLIT ? HA + (size_t)u.pm * 256 * FF : HB + (size_t)(u.pm - HID_SPLIT) * 256 * FF;
        const int col = u.pn * BM + wc * 32 + 8 * fq;
        EPI_ROWLOOP { const int lr = ai * HALF + wr * 64 + m * 16 + fr; const float r = rtab[lr];
#pragma unroll
            for (int bj = 0; bj < 2; ++bj) { f32x4 v0 = acc[ai][bj][m][0] * r, v1 = acc[ai][bj][m][1] * r;
#pragma unroll
                for (int e = 0; e < 4; ++e) { const float a = fmaxf(v0[e], 0.f), b = fmaxf(v1[e], 0.f); v0[e] = a * a; v1[e] = b * b; }
                st16_wt(base + (size_t)lr * FF + col + bj * HALF, pack8(v0, v1)); } }
    }
};
struct EpiPl {
    bf16_t* PL;
    __device__ __forceinline__ const float* rsrc() const { return nullptr; }
    __device__ __forceinline__ void operator()(const f32x4 (&acc)[2][2][4][2], const Unit& u, int wr, int wc, int fr, int fq, LAS float* rtab, int tid) const {
        const int col = u.pn * BM + wc * 32 + 8 * fq;
        EPI_ROWLOOP { const int row = u.pm * BM + ai * HALF + wr * 64 + m * 16 + fr;
#pragma unroll
            for (int bj = 0; bj < 2; ++bj) *(u32x4*)(PL + (size_t)row * DM + col + bj * HALF) = pack8(acc[ai][bj][m][0], acc[ai][bj][m][1]); }
    }
};
template <bool LAST> struct EpiGate {
    float* HO; const bf16_t* BB; const bf16_t* PL; bf16_t* OB; const float* ssq_in; float* ssq_out; float sc;
    __device__ __forceinline__ const float* rsrc() const { return ssq_in; }
    __device__ __forceinline__ void operator()(const f32x4 (&acc)[2][2][4][2], const Unit& u, int wr, int wc, int fr, int fq, LAS float* rtab, int tid) const {
        const int col = u.pn * BM + wc * 32 + 8 * fq;
#pragma unroll
        for (int ai = 0; ai < 2; ++ai) {
            u32x4 bw[4][2], pw[4][2];
#pragma unroll
            for (int m = 0; m < 4; ++m) { const size_t off0 = (size_t)(u.pm * BM + ai * HALF + wr * 64 + m * 16 + fr) * DM + col;
#pragma unroll
                for (int bj = 0; bj < 2; ++bj) { bw[m][bj] = *(const u32x4*)(BB + off0 + bj * HALF); pw[m][bj] = *(const u32x4*)(PL + off0 + bj * HALF); } }
#pragma unroll
            for (int m = 0; m < 4; ++m) { const int lr = ai * HALF + wr * 64 + m * 16 + fr, row = u.pm * BM + lr; const float r = rtab[lr];
                float s = 0.f;
#pragma unroll
                for (int bj = 0; bj < 2; ++bj) { const size_t off = (size_t)row * DM + col + bj * HALF; const u32x4 b_ = bw[m][bj], p_ = pw[m][bj];
                    const f32x4 b0 = {bflo(b_.x), bfhi(b_.x), bflo(b_.y), bfhi(b_.y)}, b1 = {bflo(b_.z), bfhi(b_.z), bflo(b_.w), bfhi(b_.w)};
                    const f32x4 p0 = {bflo(p_.x), bfhi(p_.x), bflo(p_.y), bfhi(p_.y)}, p1 = {bflo(p_.z), bfhi(p_.z), bflo(p_.w), bfhi(p_.w)};
                    f32x4 v0 = acc[ai][bj][m][0] * r, v1 = acc[ai][bj][m][1] * r;
#pragma unroll
                    for (int e = 0; e < 4; ++e) { v0[e] = b0[e] + fsigmoid(v0[e]) * p0[e] * sc; v1[e] = b1[e] + fsigmoid(v1[e]) * p1[e] * sc; }
                    if (LAST) { *(f32x4*)(HO + off) = v0; *(f32x4*)(HO + off + 4) = v1; }
                    else { *(u32x4*)(OB + off) = pack8(v0, v1);
                        s += (v0[0] * v0[0] + v0[1] * v0[1]) + (v0[2] * v0[2] + v0[3] * v0[3]) + (v1[0] * v1[0] + v1[1] * v1[1]) + (v1[2] * v1[2] + v1[3] * v1[3]); } }
                if (!LAST) { s += __shfl_xor(s, 16); s += __shfl_xor(s, 32); if (fq == 0) ssq_out[ssq_idx(u.pn, row, wc)] = s; } }
        }
    }
};
struct EpiKvq {
    bf16_t* KV; bf16_t* Qb; const float* ssq; float *CKP, *CVP, *CKS, *CVS;
    __device__ __forceinline__ const float* rsrc() const { return ssq; }
    __device__ __forceinline__ void operator()(const f32x4 (&acc)[2][2][4][2], const Unit& u, int wr, int wc, int fr, int fq, LAS float* rtab, int tid) const {
        const int pn = u.pn, c = wc * 32 + 8 * fq;
        EPI_ROWLOOP { const int lr = ai * HALF + wr * 64 + m * 16 + fr, row = u.pm * BM + lr; const float r = rtab[lr];
            float* cdst = nullptr;
            if (pn < 2) {
                if (row < MP) { const int b = row >> 13, t = row & (SEQ - 1); if (t >= SEQ - 128) cdst = (pn == 0 ? CKP : CVP) + ((size_t)(b * 128 + t - (SEQ - 128)) * 256 + c); }
                else { const int rs = row - MP, sb = rs >> 3, i = rs & 7; cdst = (pn == 0 ? CKS : CVS) + ((size_t)(sb * 128 + 120 + i) * 256 + c); }
            }
            bf16_t* dst = pn < 2 ? KV + (size_t)row * 512 + pn * 256 + c : Qb + (size_t)row * DM + (pn - 2) * 256 + c;
#pragma unroll
            for (int bj = 0; bj < 2; ++bj) { const f32x4 v0 = acc[ai][bj][m][0] * r, v1 = acc[ai][bj][m][1] * r;
                *(u32x4*)(dst + bj * HALF) = pack8(v0, v1);
                if (cdst) { *(f32x4*)(cdst + bj * HALF) = v0; *(f32x4*)(cdst + bj * HALF + 4) = v1; } } }
    }
};
}


namespace mg {
constexpr int KT = 256, LDT = KT + 8, TILE_B = 64 * LDT * 2;
template <class Epi>
__device__ __forceinline__ void mini_gemm(LAS unsigned char* lds, const bf16_t* A  , const bf16_t* Bt  , int N, int K, int G, int bx, const Epi& E) {
    const int tid = threadIdx.x, lane = tid & 63, wave = __builtin_amdgcn_readfirstlane(tid >> 6), l15 = lane & 15, g = lane >> 4;
    const int rt = wave & 3, chh = wave >> 2, nk = K / KT, units = 16 * (N / 64);
    LAS float* red = (LAS float*)(lds + 4 * TILE_B);
    for (int u = bx; u < units; u += G) {
        const int rm = u & 15, cn = u >> 4;
        const bf16_t* Ag = A + (size_t)(rm * 64) * K; const bf16_t* Bg = Bt + (size_t)(cn * 64) * K;
        u32x4 ra0[4], rb0[4], ra1[4], rb1[4];
#define MG_LOAD(ra, rb, kt) do { _Pragma("unroll") for (int i = 0; i < 4; ++i) { const int c = tid + 512 * i, row = c >> 5, ch = c & 31; \
            ra[i] = *(const u32x4*)(Ag + (size_t)row * K + (kt) * KT + ch * 8); rb[i] = *(const u32x4*)(Bg + (size_t)row * K + (kt) * KT + ch * 8); } } while (0)
#define MG_STORE(ra, rb, b) do { _Pragma("unroll") for (int i = 0; i < 4; ++i) { const int c = tid + 512 * i, row = c >> 5, ch = c & 31; \
            *(LAS u32x4*)(lds + (b) * 2 * TILE_B + (row * LDT + ch * 8) * 2) = ra[i]; *(LAS u32x4*)(lds + (b) * 2 * TILE_B + TILE_B + (row * LDT + ch * 8) * 2) = rb[i]; } } while (0)
#define MG_COMPUTE(b) do { const LAS bf16_t* Al = (const LAS bf16_t*)(lds + (b) * 2 * TILE_B); const LAS bf16_t* Bl = (const LAS bf16_t*)(lds + (b) * 2 * TILE_B + TILE_B); \
            _Pragma("unroll") for (int ks = 0; ks < KT / 32; ++ks) { const bf16x8 Af = *(const LAS bf16x8*)(Al + (16 * rt + l15) * LDT + 32 * ks + 8 * g); \
                _Pragma("unroll") for (int t = 0; t < 2; ++t) { const bf16x8 Bf = *(const LAS bf16x8*)(Bl + (16 * (2 * chh + t) + l15) * LDT + 32 * ks + 8 * g); \
                    acc[t] = __builtin_amdgcn_mfma_f32_16x16x32_bf16(Bf, Af, acc[t], 0, 0, 0); } } } while (0)
        f32x4 acc[2] = {(f32x4){0.f, 0.f, 0.f, 0.f}, (f32x4){0.f, 0.f, 0.f, 0.f}};
#define MG_BAR() do { asm volatile("s_waitcnt lgkmcnt(0)" ::: "memory"); __builtin_amdgcn_s_barrier(); asm volatile("" ::: "memory"); } while (0)
        MG_LOAD(ra0, rb0, 0); if (nk > 1) MG_LOAD(ra1, rb1, 1);
        MG_STORE(ra0, rb0, 0); MG_BAR();
        for (int kt = 0; kt < nk; kt += 2) {
            if (kt + 2 < nk) MG_LOAD(ra0, rb0, kt + 2);
            MG_COMPUTE(0);
            if (kt + 1 < nk) MG_STORE(ra1, rb1, 1);
            MG_BAR();
            if (kt + 1 < nk) {
                if (kt + 3 < nk) MG_LOAD(ra1, rb1, kt + 3);
                MG_COMPUTE(1);
                if (kt + 2 < nk) MG_STORE(ra0, rb0, 0);
                MG_BAR();
            }
        }
#undef MG_BAR
        const int row = MP + rm * 64 + 16 * rt + l15; float s = 0.f;
#pragma unroll
        for (int t = 0; t < 2; ++t) { const f32x4 o = E(row, cn * 64 + 16 * (2 * chh + t) + 4 * g, acc[t]); s += (o[0] * o[0] + o[1] * o[1]) + (o[2] * o[2] + o[3] * o[3]); }
        if (Epi::SSQ) { s += __shfl_xor(s, 16); s += __shfl_xor(s, 32); if (g == 0) red[(16 * rt + l15) * 2 + chh] = s;
            __syncthreads();
            if (tid < 64) st_wt(E.ssq_out + ssq_idx(cn >> 2, MP + rm * 64 + tid, cn & 3), red[tid * 2] + red[tid * 2 + 1]);
            __syncthreads(); }
#undef MG_LOAD
#undef MG_STORE
#undef MG_COMPUTE
    }
}
__device__ __forceinline__ u32x2 pack4(const f32x4 v) { u32x2 w; w.x = pk2(v[0], v[1]); w.y = pk2(v[2], v[3]); return w; }
template <bool FROM_X> struct MRes {
    static constexpr bool SSQ = true; const float* X1; const bf16_t* BB; bf16_t* XO; float* ssq_out; float sc;
    __device__ __forceinline__ f32x4 operator()(int row, int col, const f32x4 v) const {
        f32x4 b; if (FROM_X) b = *(const f32x4*)(X1 + (size_t)(row - MP) * DM + col); else { const u32x2 w = *(const u32x2*)(BB + (size_t)row * DM + col); b = (f32x4){bflo(w.x), bfhi(w.x), bflo(w.y), bfhi(w.y)}; }
        const f32x4 o = b + v * sc; *(u32x2*)(XO + (size_t)row * DM + col) = pack4(o); return o; }
};
struct MPl { static constexpr bool SSQ = false; bf16_t* PL; float* ssq_out;
    __device__ __forceinline__ f32x4 operator()(int row, int col, const f32x4 v) const { *(u32x2*)(PL + (size_t)row * DM + col) = pack4(v); return v; } };
struct MUp { static constexpr bool SSQ = false; bf16_t* HS  ; const float* ssq; float* ssq_out;
    __device__ __forceinline__ f32x4 operator()(int row, int col, const f32x4 v) const { const float r = row_r(ssq, row); f32x4 o;
#pragma unroll
        for (int e = 0; e < 4; ++e) { const float a = fmaxf(v[e] * r, 0.f); o[e] = a * a; }
        *(u32x2*)(HS + (size_t)(row - MP) * FF + col) = pack4(o); return o; } };
template <bool LAST> struct MGate { static constexpr bool SSQ = !LAST; float* HO; const bf16_t* BB; const bf16_t* PL; bf16_t* OB; const float* ssq_in; float* ssq_out; float sc;
    __device__ __forceinline__ f32x4 operator()(int row, int col, const f32x4 v) const { const float r = row_r(ssq_in, row); const size_t off = (size_t)row * DM + col;
        const u32x2 bw = *(const u32x2*)(BB + off), pw = *(const u32x2*)(PL + off);
        const f32x4 b = {bflo(bw.x), bfhi(bw.x), bflo(bw.y), bfhi(bw.y)}, p = {bflo(pw.x), bfhi(pw.x), bflo(pw.y), bfhi(pw.y)}; f32x4 o;
#pragma unroll
        for (int e = 0; e < 4; ++e) o[e] = b[e] + fsigmoid(v[e] * r) * p[e] * sc;
        if (LAST) *(f32x4*)(HO + off) = o; else *(u32x2*)(OB + off) = pack4(o); return o; } };
}

constexpr int NWAVES = 8, NTHREADS = 512;
constexpr int RING_BYTES = 131072, LDS_BYTES = 147456;
struct Args { const float* in[26]; float* out; unsigned char* ws; int ph_lo, ph_hi; };

struct TJob { const float* src; int ldw, kk, nblk; bf16_t* dst; const float* gain; float scale; int item; };
__device__ __forceinline__ void p0_tload(const TJob& J, float (&r)[32], int lane) {
    const int kb = J.item / J.nblk, nb = J.item % J.nblk, k0 = 64 * kb, n0 = 32 * nb;
#pragma unroll
    for (int i = 0; i < 32; ++i) r[i] = J.src[(size_t)(k0 + 2 * i + (lane >> 5)) * J.ldw + n0 + (lane & 31)];
}
__device__ __forceinline__ void p0_tfinish(const TJob& J, const float (&r)[32], LAS float* scr, int lane) {
    const int kb = J.item / J.nblk, nb = J.item % J.nblk, k0 = 64 * kb, n0 = 32 * nb, c = lane & 7;
    f32x4 g0 = {1.f, 1.f, 1.f, 1.f}, g1 = g0;
    if (J.gain) { g0 = *(const f32x4*)(J.gain + k0 + 8 * c); g1 = *(const f32x4*)(J.gain + k0 + 8 * c + 4); }
    g0 *= J.scale; g1 *= J.scale;
#pragma unroll
    for (int i = 0; i < 32; ++i) scr[(2 * i + (lane >> 5)) * 33 + (lane & 31)] = r[i];
    asm volatile("s_waitcnt lgkmcnt(0)" ::: "memory");
#pragma unroll
    for (int j = 0; j < 4; ++j) { const int n = (lane >> 3) + 8 * j; const LAS float* sp = scr + (8 * c) * 33 + n;
        u32x4 o; o.x = pk2(sp[0 * 33] * g0.x, sp[1 * 33] * g0.y); o.y = pk2(sp[2 * 33] * g0.z, sp[3 * 33] * g0.w); o.z = pk2(sp[4 * 33] * g1.x, sp[5 * 33] * g1.y); o.w = pk2(sp[6 * 33] * g1.z, sp[7 * 33] * g1.w);
        *(u32x4*)(J.dst + (size_t)(n0 + n) * J.kk + k0 + 8 * c) = o; }
    asm volatile("s_waitcnt lgkmcnt(0)" ::: "memory");
}

constexpr int T128 = 144, T256 = 272, TP = 80;
#define LDS_BAR() do { asm volatile("s_waitcnt lgkmcnt(0)" ::: "memory"); __builtin_amdgcn_s_barrier(); asm volatile("" ::: "memory"); } while (0)
struct GlaRegs { u32x4 lg[2], v[4], k[2], q[2]; };
template <bool WITH_Q, bool DO_LKQ = true, bool DO_V = true>
__device__ __forceinline__ void gla_fetch(GlaRegs& R, int item, const bf16_t* Q1, const bf16_t* K1, const bf16_t* V1, const bf16_t* LGp, int tid) {
    const int bh = item >> 7, c = item & 127, b = bh >> 2, h = bh & 3; const size_t row0 = (size_t)b * SEQ + c * 64;
    if (DO_LKQ) {
#pragma unroll
        for (int i = 0; i < 2; ++i) { const int x = tid + NTHREADS * i, j = x >> 4, d8 = (x & 15) * 8; const size_t off = (row0 + j) * NQK + h * 128 + d8;
            R.lg[i] = *(const u32x4*)(LGp + off); R.k[i] = *(const u32x4*)(K1 + off); if (WITH_Q) R.q[i] = *(const u32x4*)(Q1 + off); } }
    if (DO_V) {
#pragma unroll
        for (int i = 0; i < 4; ++i) { const int x = tid + NTHREADS * i, j = x >> 5, e8 = (x & 31) * 8; R.v[i] = *(const u32x4*)(V1 + (row0 + j) * NV + h * 256 + e8); } }
}
__device__ __forceinline__ void gla_stage_lg_v(const GlaRegs& R, LAS float* bc, LAS bf16_t* vt, int tid) {
#pragma unroll
    for (int i = 0; i < 2; ++i) { const int x = tid + NTHREADS * i, j = x >> 4, d8 = (x & 15) * 8; const u32x4 w = R.lg[i];
        *(LAS f32x4*)(bc + j * 128 + d8) = (f32x4){bflo(w.x), bfhi(w.x), bflo(w.y), bfhi(w.y)}; *(LAS f32x4*)(bc + j * 128 + d8 + 4) = (f32x4){bflo(w.z), bfhi(w.z), bflo(w.w), bfhi(w.w)}; }
#pragma unroll
    for (int i = 0; i < 4; ++i) { const int x = tid + NTHREADS * i, j = x >> 5, e8 = (x & 31) * 8; *(LAS u32x4*)(vt + j * T256 + e8) = R.v[i]; }
    LDS_BAR();
    if (tid < 128) { float s = 0.f;
#pragma unroll 8
        for (int j = 0; j < 64; ++j) { s += bc[j * 128 + tid]; bc[j * 128 + tid] = s; } }
    LDS_BAR();
}
constexpr int NSUP = 32, NSUP_ALL = NBH * NSUP;
template <bool OUT>
__device__ __forceinline__ void gla_super_phase(LAS unsigned char* lds, int G, int bx, const bf16_t* Q1, const bf16_t* K1, const bf16_t* V1, const bf16_t* G1, const bf16_t* LGp, bf16_t* US, float* DVS,
                                                const float* ogain, bf16_t* OG, float* SOUT, int tid, int lane, int wave) {
    LAS float* bc = (LAS float*)lds;
    LAS bf16_t* Pm = (LAS bf16_t*)lds;
    LAS bf16_t* qt = (LAS bf16_t*)(lds + 32768);
    LAS bf16_t* kt = qt + 64 * T128;
    LAS bf16_t* kd = kt + 64 * T128;
    LAS bf16_t* vt = kd + 64 * T128;
    LAS float* red = (LAS float*)(lds + 32768 + 3 * 64 * T128 * 2 + 64 * T256 * 2);
    LAS float* em = red + 512;
    LAS float* dvl = em + 128;
    const int l15 = lane & 15, g = lane >> 4, q = l15 >> 2, p = l15 & 3;
    f32x4 gn[2] = {(f32x4){0.f, 0.f, 0.f, 0.f}, (f32x4){0.f, 0.f, 0.f, 0.f}};
    if (OUT) {
#pragma unroll
        for (int t = 0; t < 2; ++t) gn[t] = *(const f32x4*)(ogain + 16 * (2 * wave + t) + 4 * g); }
    GlaRegs R;
    if (bx < NSUP_ALL) gla_fetch<OUT>(R, (bx >> 5) * NCHUNK + (bx & 31) * 4, Q1, K1, V1, LGp, tid);
    for (int item = bx; item < NSUP_ALL; item += G) {
        const int bh = item >> 5, sc = item & 31, b = bh >> 2, h = bh & 3;
        f32x4 S[8][2];
        if (OUT) {
#pragma unroll
            for (int dt = 0; dt < 8; ++dt)
#pragma unroll
                for (int t = 0; t < 2; ++t) { const u32x2 w = *(const u32x2*)(US + ((size_t)item * 256 + 16 * (2 * wave + t) + l15) * 128 + 16 * dt + 4 * g); S[dt][t] = (f32x4){bflo(w.x), bfhi(w.x), bflo(w.y), bfhi(w.y)}; }
        } else {
#pragma unroll
            for (int dt = 0; dt < 8; ++dt) { S[dt][0] = (f32x4){0.f, 0.f, 0.f, 0.f}; S[dt][1] = (f32x4){0.f, 0.f, 0.f, 0.f}; } }
        float lsum = 0.f;
        for (int cc = 0; cc < 4; ++cc) {
            const int c = sc * 4 + cc; const size_t row0 = (size_t)b * SEQ + c * 64;
            gla_stage_lg_v(R, bc, vt, tid);
#pragma unroll
            for (int i = 0; i < 2; ++i) { const int x = tid + NTHREADS * i, j = x >> 4, d8 = (x & 15) * 8; const u32x4 wk = R.k[i];
                float kv[8] = {bflo(wk.x), bfhi(wk.x), bflo(wk.y), bfhi(wk.y), bflo(wk.z), bfhi(wk.z), bflo(wk.w), bfhi(wk.w)};
                float cur[8], dd[8];
#pragma unroll
                for (int t = 0; t < 8; ++t) { cur[t] = bc[j * 128 + d8 + t]; dd[t] = kv[t] * fexp(bc[63 * 128 + d8 + t] - cur[t]); }
                u32x4 o; o.x = pk2(dd[0], dd[1]); o.y = pk2(dd[2], dd[3]); o.z = pk2(dd[4], dd[5]); o.w = pk2(dd[6], dd[7]); *(LAS u32x4*)(kd + j * T128 + d8) = o;
                if (OUT) { const u32x4 wq = R.q[i];
                    float qv[8] = {bflo(wq.x), bfhi(wq.x), bflo(wq.y), bfhi(wq.y), bflo(wq.z), bfhi(wq.z), bflo(wq.w), bfhi(wq.w)};
                    float a[8], bb[8];
#pragma unroll
                    for (int t = 0; t < 8; ++t) { const float mid = bc[31 * 128 + d8 + t]; a[t] = qv[t] * fexp(cur[t] - mid); bb[t] = kv[t] * fexp(mid - cur[t]); }
                    o.x = pk2(a[0], a[1]); o.y = pk2(a[2], a[3]); o.z = pk2(a[4], a[5]); o.w = pk2(a[6], a[7]); *(LAS u32x4*)(qt + j * T128 + d8) = o;
                    o.x = pk2(bb[0], bb[1]); o.y = pk2(bb[2], bb[3]); o.z = pk2(bb[4], bb[5]); o.w = pk2(bb[6], bb[7]); *(LAS u32x4*)(kt + j * T128 + d8) = o; } }
            if (tid < 128) { const float last = bc[63 * 128 + tid]; dvl[tid] = fexp(last); lsum += last; if (OUT) em[tid] = fexp(bc[31 * 128 + tid]); }
            const int nxt_ = (cc < 3) ? bh * NCHUNK + c + 1 : (item + G < NSUP_ALL ? ((item + G) >> 5) * NCHUNK + ((item + G) & 31) * 4 : -1);
            if (nxt_ >= 0) gla_fetch<OUT, true, false>(R, nxt_, Q1, K1, V1, LGp, tid);
            LDS_BAR();
            if (OUT) {
#pragma unroll
                for (int t = 0; t < 2; ++t) { const int id = 2 * wave + t, ti = id >> 2, tj = id & 3;
                    f32x4 a = {0.f, 0.f, 0.f, 0.f};
                    if (tj <= ti) {
#pragma unroll
                        for (int ks = 0; ks < 4; ++ks) { const bf16x8 Af = *(const LAS bf16x8*)(qt + (16 * ti + l15) * T128 + 32 * ks + 8 * g), Bf = *(const LAS bf16x8*)(kt + (16 * tj + l15) * T128 + 32 * ks + 8 * g);
                            a = __builtin_amdgcn_mfma_f32_16x16x32_bf16(Af, Bf, a, 0, 0, 0); } }
#pragma unroll
                    for (int r = 0; r < 4; ++r) { const int i = 16 * ti + 4 * g + r, j = 16 * tj + l15; const float v = (j <= i) ? a[r] : 0.f; Pm[i * TP + j] = (bf16_t)(pk2(v, 0.f) & 0xffffu); }
                }
                LDS_BAR();
                f32x4 o[4][2];
#pragma unroll
                for (int ti = 0; ti < 4; ++ti) { o[ti][0] = (f32x4){0.f, 0.f, 0.f, 0.f}; o[ti][1] = (f32x4){0.f, 0.f, 0.f, 0.f}; }
#pragma unroll
                for (int ks = 0; ks < 2; ++ks) {
                    bf16x8 Bf[2];
#pragma unroll
                    for (int t = 0; t < 2; ++t) { const LAS bf16_t* a0 = vt + (32 * ks + 8 * g + q) * T256 + 16 * (2 * wave + t) + 4 * p; Bf[t] = cat8(trd(a0), trd(a0 + 4 * T256)); }
#pragma unroll
                    for (int ti = 2 * ks; ti < 4; ++ti) { const bf16x8 Af = *(const LAS bf16x8*)(Pm + (16 * ti + l15) * TP + 32 * ks + 8 * g);
#pragma unroll
                        for (int t = 0; t < 2; ++t) o[ti][t] = __builtin_amdgcn_mfma_f32_16x16x32_bf16(Bf[t], Af, o[ti][t], 0, 0, 0); }
                }
#pragma unroll
                for (int ks = 0; ks < 4; ++ks) {
                    const f32x4 e0 = *(LAS f32x4*)(em + 32 * ks + 4 * g), e1 = *(LAS f32x4*)(em + 32 * ks + 16 + 4 * g);
                    bf16x8 Bf[2];
#pragma unroll
                    for (int t = 0; t < 2; ++t) { const f32x4 s0 = S[2 * ks][t] * e0, s1 = S[2 * ks + 1][t] * e1; u32x4 w; w.x = pk2(s0[0], s0[1]); w.y = pk2(s0[2], s0[3]); w.z = pk2(s1[0], s1[1]); w.w = pk2(s1[2], s1[3]); Bf[t] = __builtin_bit_cast(bf16x8, w); }
#pragma unroll
                    for (int ti = 0; ti < 4; ++ti) { const LAS bf16_t* ap = qt + (16 * ti + l15) * T128 + 32 * ks + 4 * g;
                        const u32x2 a0 = *(const LAS u32x2*)ap, a1 = *(const LAS u32x2*)(ap + 16); u32x4 aw; aw.x = a0.x; aw.y = a0.y; aw.z = a1.x; aw.w = a1.y; const bf16x8 Af = __builtin_bit_cast(bf16x8, aw);
#pragma unroll
                        for (int t = 0; t < 2; ++t) o[ti][t] = __builtin_amdgcn_mfma_f32_16x16x32_bf16(Bf[t], Af, o[ti][t], 0, 0, 0); }
                }
#pragma unroll
                for (int ti = 0; ti < 4; ++ti) { float s = 0.f;
#pragma unroll
                    for (int t = 0; t < 2; ++t) s += (o[ti][t][0] * o[ti][t][0] + o[ti][t][1] * o[ti][t][1]) + (o[ti][t][2] * o[ti][t][2] + o[ti][t][3] * o[ti][t][3]);
                    s += __shfl_xor(s, 16); s += __shfl_xor(s, 32);
                    if (g == 0) red[(16 * ti + l15) * 8 + wave] = s; }
                LDS_BAR();
#pragma unroll
                for (int ti = 0; ti < 4; ++ti) { const int i = 16 * ti + l15; const f32x4 r0 = *(LAS f32x4*)(red + i * 8), r1 = *(LAS f32x4*)(red + i * 8 + 4);
                    const float rms = frsq(((r0.x + r0.y) + (r0.z + r0.w) + (r1.x + r1.y) + (r1.z + r1.w)) * (1.f / 256.f) + EPS);
#pragma unroll
                    for (int t = 0; t < 2; ++t) { const size_t off = (row0 + i) * NV + h * 256 + 16 * (2 * wave + t) + 4 * g; const u32x2 gw_ = *(const u32x2*)(G1 + off);
                        const f32x4 gv = {bflo(gw_.x), bfhi(gw_.x), bflo(gw_.y), bfhi(gw_.y)}; f32x4 ov;
#pragma unroll
                        for (int r = 0; r < 4; ++r) ov[r] = o[ti][t][r] * rms * gn[t][r] * gv[r] * fsigmoid(gv[r]);
                        u32x2 w; w.x = pk2(ov[0], ov[1]); w.y = pk2(ov[2], ov[3]); *(u32x2*)(OG + off) = w; } }
            }
            if (nxt_ >= 0) gla_fetch<OUT, false, true>(R, nxt_, Q1, K1, V1, LGp, tid);
#pragma unroll
            for (int dt = 0; dt < 8; ++dt) { const f32x4 dvv = *(LAS f32x4*)(dvl + 16 * dt + 4 * g); S[dt][0] *= dvv; S[dt][1] *= dvv; }
#pragma unroll
            for (int ks = 0; ks < 2; ++ks) {
                bf16x8 Bf[2];
#pragma unroll
                for (int t = 0; t < 2; ++t) { const LAS bf16_t* a0 = vt + (32 * ks + 8 * g + q) * T256 + 16 * (2 * wave + t) + 4 * p; Bf[t] = cat8(trd(a0), trd(a0 + 4 * T256)); }
#pragma unroll
                for (int dt = 0; dt < 8; ++dt) { const LAS bf16_t* a0 = kd + (32 * ks + 8 * g + q) * T128 + 16 * dt + 4 * p; const bf16x8 Af = cat8(trd(a0), trd(a0 + 4 * T128));
#pragma unroll
                    for (int t = 0; t < 2; ++t) S[dt][t] = __builtin_amdgcn_mfma_f32_16x16x32_bf16(Af, Bf[t], S[dt][t], 0, 0, 0); }
            }
            LDS_BAR();
        }
        if (OUT && sc == NSUP - 1) {
            float* so = SOUT + (size_t)bh * 128 * 256 + (size_t)(4 * g) * 256 + 32 * wave + l15;
#pragma unroll
            for (int dt = 0; dt < 8; ++dt) {
#pragma unroll
                for (int t = 0; t < 2; ++t)
#pragma unroll
                    for (int r = 0; r < 4; ++r) so[r * 256 + 16 * t] = S[dt][t][r];
                so += 16 * 256; asm volatile("" : "+v"(so));
            }
        }
        if (!OUT) {
#pragma unroll
            for (int dt = 0; dt < 8; ++dt)
#pragma unroll
                for (int t = 0; t < 2; ++t) { u32x2 w; w.x = pk2(S[dt][t][0], S[dt][t][1]); w.y = pk2(S[dt][t][2], S[dt][t][3]);
                    *(u32x2*)(US + ((size_t)item * 256 + 16 * (2 * wave + t) + l15) * 128 + 16 * dt + 4 * g) = w; }
            if (tid < 128) DVS[(size_t)item * 128 + tid] = fexp(lsum);
        }
    }
}
template <int NSTEP>
__device__ __forceinline__ void gla_scan(bf16_t* UT, const float* DV, float* state_out, int gtid, int gthreads) {
    for (int idx = gtid; idx < NBH * 256 * 64; idx += gthreads) {
        const int bh = idx >> 14, rem = idx & 16383, e = rem >> 6, dp = rem & 63;
        unsigned* base = (unsigned*)UT + (size_t)bh * NSTEP * 16384 + e * 64 + dp;
        const float* dv = DV + (size_t)bh * NSTEP * 128 + 2 * dp;
        float s0 = 0.f, s1 = 0.f;
        for (int c0 = 0; c0 < NSTEP; c0 += 32) {
            unsigned uu[32]; f32x2 dd[32];
#pragma unroll
            for (int k = 0; k < 32; ++k) { uu[k] = base[(size_t)(c0 + k) * 16384]; dd[k] = *(const f32x2*)(dv + (size_t)(c0 + k) * 128); }
#pragma unroll
            for (int k = 0; k < 32; ++k) { base[(size_t)(c0 + k) * 16384] = pk2(s0, s1); s0 = dd[k].x * s0 + bflo(uu[k]); s1 = dd[k].y * s1 + bfhi(uu[k]); }
        }
        (void)state_out;
    }
}
__device__ __forceinline__ void gla_sample_pair(LAS unsigned char* lds, int base_item, const bf16_t* Q1, const bf16_t* K1, const bf16_t* V1, const bf16_t* G1, const bf16_t* LGp,
                                                const float* S0in, float* Sout, const float* ogain, bf16_t* OG, int tid) {
    const int hb = tid >> 8, t = tid & 255, item = base_item + hb, sb = item >> 2, h = item & 3; const size_t r0 = (size_t)MP + sb * 8;
    LAS float* qaT = (LAS float*)(lds + hb * 16384);
    LAS float* qsT = qaT + 1024, *kdT = qsT + 1024, *dvs = kdT + 1024, *att = dvs + 128, *red = att + 64;
    if (t < 128) { const int d = t; float bcv[8], s = 0.f;
#pragma unroll
        for (int i = 0; i < 8; ++i) { s += bf2f(LGp[(r0 + i) * NQK + h * 128 + d]); bcv[i] = s; }
#pragma unroll
        for (int i = 0; i < 8; ++i) { const float qv = bf2f(Q1[(r0 + i) * NQK + h * 128 + d]), kv = bf2f(K1[(r0 + i) * NQK + h * 128 + d]);
            qaT[d * 8 + i] = qv * fexp(bcv[i] - bcv[7]); qsT[d * 8 + i] = qv * fexp(bcv[i]); kdT[d * 8 + i] = kv * fexp(bcv[7] - bcv[i]); }
        dvs[d] = fexp(bcv[7]); }
    __syncthreads();
    if (t < 64) { const int i = t >> 3, j = t & 7; float s = 0.f;
        for (int d = 0; d < 128; ++d) s += qaT[d * 8 + i] * kdT[d * 8 + j];
        att[t] = (j <= i) ? s : 0.f; }
    __syncthreads();
    const int e = t; float v[8], o[8];
#pragma unroll
    for (int j = 0; j < 8; ++j) { v[j] = bf2f(V1[(r0 + j) * NV + h * 256 + e]); o[j] = 0.f; }
    const float* S0 = S0in + ((size_t)item * 128) * 256 + e; float* SO = Sout + ((size_t)item * 128) * 256 + e;
    for (int d0 = 0; d0 < 128; d0 += 32) { float sv[32];
#pragma unroll
        for (int k = 0; k < 32; ++k) sv[k] = __builtin_nontemporal_load(S0 + (size_t)(d0 + k) * 256);
#pragma unroll
        for (int k = 0; k < 32; ++k) { const int d = d0 + k; const f32x4 qa = *(LAS f32x4*)(qsT + d * 8), qb = *(LAS f32x4*)(qsT + d * 8 + 4), ka = *(LAS f32x4*)(kdT + d * 8), kb = *(LAS f32x4*)(kdT + d * 8 + 4);
            o[0] += qa.x * sv[k]; o[1] += qa.y * sv[k]; o[2] += qa.z * sv[k]; o[3] += qa.w * sv[k]; o[4] += qb.x * sv[k]; o[5] += qb.y * sv[k]; o[6] += qb.z * sv[k]; o[7] += qb.w * sv[k];
            __builtin_nontemporal_store(dvs[d] * sv[k] + ((ka.x * v[0] + ka.y * v[1]) + (ka.z * v[2] + ka.w * v[3])) + ((kb.x * v[4] + kb.y * v[5]) + (kb.z * v[6] + kb.w * v[7])), SO + (size_t)d * 256); }
    }
#pragma unroll
    for (int i = 0; i < 8; ++i)
#pragma unroll
        for (int j = 0; j <= i; ++j) o[i] += att[i * 8 + j] * v[j];
    const int wv = t >> 6;
#pragma unroll
    for (int i = 0; i < 8; ++i) { const float s = wave_sum(o[i] * o[i]); if ((t & 63) == 0) red[i * 4 + wv] = s; }
    __syncthreads();
    const float gn = ogain[e];
#pragma unroll
    for (int i = 0; i < 8; ++i) { const f32x4 rr = *(LAS f32x4*)(red + i * 4); const float rms = frsq(((rr.x + rr.y) + (rr.z + rr.w)) * (1.f / 256.f) + EPS);
        const size_t off = (r0 + i) * NV + h * 256 + e; const float gv = bf2f(G1[off]);
        OG[off] = (bf16_t)(pk2(o[i] * rms * gn * gv * fsigmoid(gv), 0.f) & 0xffffu); }
    __syncthreads();
}

constexpr int VT_LD = 72;
struct AttnP { const bf16_t* KV; const bf16_t* Qb; bf16_t* AO; const float* pk; const float* pv; float* ock; float* ocv; const float* sinks; const float* relb; };
constexpr int ATT_BUF = 32768 + 256 * VT_LD * 2 + 2048;
struct AttnRegs { u32x4 a[12]; };
#define ATT_DECODE(item) const bool smp = (item) >= 512; int b, kh, qblk, sb = 0; \
    if (!smp) { b = (item) >> 8; kh = ((item) >> 6) & 3; qblk = (item) & 63; } else { const int it_ = (item) - 512; sb = it_ >> 2; kh = it_ & 3; b = 0; qblk = 1; } \
    const long s0 = (long)b * SEQ + (long)qblk * 128; (void)s0; (void)sb
__device__ __forceinline__ void attn_load(int item, const AttnP& P, AttnRegs& R, int tid) {
    ATT_DECODE(item);
    if (!smp) {
#pragma unroll
        for (int j = 0; j < 4; ++j) { const int i = tid + NTHREADS * j, row = i >> 3, ch = i & 7; u32x4 wk = {0u, 0u, 0u, 0u}, wv = {0u, 0u, 0u, 0u};
            if (qblk > 0 || row >= 128) { const bf16_t* src = P.KV + (size_t)(s0 - 128 + row) * 512 + kh * 64 + ch * 8; wk = *(const u32x4*)src; wv = *(const u32x4*)(src + 256); }
            R.a[j] = wk; R.a[4 + j] = wv; }
    } else {
#pragma unroll
        for (int j = 0; j < 3; ++j) { const int i = tid + NTHREADS * j, row = i >> 3, ch = i & 7;
            u32x4 z = {0u, 0u, 0u, 0u}; R.a[4 * j] = z; R.a[4 * j + 1] = z; R.a[4 * j + 2] = z; R.a[4 * j + 3] = z;
            if (row < 128) { const size_t so = ((size_t)(sb * 128 + row) * 4 + kh) * 64 + ch * 8;
                R.a[4 * j] = *(const u32x4*)(P.pk + so); R.a[4 * j + 1] = *(const u32x4*)(P.pk + so + 4); R.a[4 * j + 2] = *(const u32x4*)(P.pv + so); R.a[4 * j + 3] = *(const u32x4*)(P.pv + so + 4); }
            else if (row < 136) { const bf16_t* src = P.KV + (size_t)(MP + sb * 8 + row - 128) * 512 + kh * 64 + ch * 8; R.a[4 * j] = *(const u32x4*)src; R.a[4 * j + 1] = *(const u32x4*)(src + 256); } }
    }
}
__device__ __forceinline__ void attn_stage(LAS unsigned char* lds, int item, const AttnP& P, const AttnRegs& R, int tid) {
    LAS unsigned char* Kt = lds; LAS bf16_t* Vt = (LAS bf16_t*)(lds + 32768); LAS float* bias2 = (LAS float*)(lds + 32768 + 256 * VT_LD * 2);
    ATT_DECODE(item);
    if (!smp) {
#pragma unroll
        for (int j = 0; j < 4; ++j) { const int i = tid + NTHREADS * j, row = i >> 3, ch = i & 7;
            *(LAS u32x4*)(Kt + row * 128 + ((ch ^ (row & 7)) << 4)) = R.a[j]; *(LAS u32x4*)(Vt + row * VT_LD + ch * 8) = R.a[4 + j]; }
    } else {
#pragma unroll
        for (int j = 0; j < 3; ++j) { const int i = tid + NTHREADS * j, row = i >> 3, ch = i & 7;
            if (i < 144 * 8) { u32x4 wk = R.a[4 * j], wv = R.a[4 * j + 1];
                if (row < 128) { const f32x4 k0 = __builtin_bit_cast(f32x4, R.a[4 * j]), k1 = __builtin_bit_cast(f32x4, R.a[4 * j + 1]), v0 = __builtin_bit_cast(f32x4, R.a[4 * j + 2]), v1 = __builtin_bit_cast(f32x4, R.a[4 * j + 3]);
                    wk = pg8::pack8(k0, k1); wv = pg8::pack8(v0, v1);
                    if (row >= 8) { const size_t oo = ((size_t)(sb * 128 + row - 8) * 4 + kh) * 64 + ch * 8;
                        *(f32x4*)(P.ock + oo) = k0; *(f32x4*)(P.ock + oo + 4) = k1; *(f32x4*)(P.ocv + oo) = v0; *(f32x4*)(P.ocv + oo + 4) = v1; } }
                *(LAS u32x4*)(Kt + row * 128 + ((ch ^ (row & 7)) << 4)) = wk; *(LAS u32x4*)(Vt + row * VT_LD + ch * 8) = wv; } }
    }
    { const int hl = tid >> 7, dist = tid & 127; int bk = dist;
      if (dist >= 16) { bk = 16 + (int)(__logf((float)dist * (1.f / 16.f)) * (16.f / 2.0794415416798357f)); bk = bk > 31 ? 31 : bk; }
      bias2[tid] = P.relb[bk * 16 + kh * 4 + hl] * LOG2E; }
}
__device__ __forceinline__ void attn_compute(LAS unsigned char* lds, int item, const AttnP& P, int lane, int wave) {
    LAS unsigned char* Kt = lds; LAS bf16_t* Vt = (LAS bf16_t*)(lds + 32768); LAS float* bias2 = (LAS float*)(lds + 32768 + 256 * VT_LD * 2);
    ATT_DECODE(item);
    const int l15 = lane & 15, g = lane >> 4, q = l15 >> 2, p = l15 & 3;
    const int ntq = smp ? (wave < 2 ? 1 : 0) : 4;
    for (int tq = 0; tq < ntq; ++tq) {
        const int qtile = smp ? 0 : (wave & 1) * 4 + tq;
        int hl_q, ioff; size_t qrow;
        if (!smp) { hl_q = wave >> 1; ioff = l15; qrow = (size_t)(s0 + 16 * qtile + l15); }
        else { hl_q = 2 * wave + (l15 >> 3); ioff = l15 & 7; qrow = (size_t)MP + sb * 8 + (l15 & 7); }
        const bf16_t* qp = P.Qb + qrow * DM + (kh * 4 + hl_q) * 64 + 8 * g;
        const bf16x8 Qf0 = *(const bf16x8*)qp, Qf1 = *(const bf16x8*)(qp + 32);
        f32x4 st[9];
#pragma unroll
        for (int j = 0; j < 9; ++j) { const int row = 16 * (qtile + j) + l15; const LAS unsigned char* kr = Kt + row * 128;
            const bf16x8 K0 = *(const LAS bf16x8*)(kr + ((g ^ (row & 7)) << 4)), K1f = *(const LAS bf16x8*)(kr + (((4 + g) ^ (row & 7)) << 4));
            f32x4 a = {0.f, 0.f, 0.f, 0.f};
            a = __builtin_amdgcn_mfma_f32_16x16x32_bf16(K0, Qf0, a, 0, 0, 0); a = __builtin_amdgcn_mfma_f32_16x16x32_bf16(K1f, Qf1, a, 0, 0, 0);
            st[j] = a; }
        const float sink2 = P.sinks[kh * 4 + hl_q] * LOG2E;
        float mx = sink2;
#pragma unroll
        for (int j = 0; j < 9; ++j)
#pragma unroll
            for (int r = 0; r < 4; ++r) { const int dist = 128 + ioff - 16 * j - 4 * g - r; const bool ok = (dist >= 0) && (dist < 128) && (smp || qblk > 0 || (16 * (qtile + j) + 4 * g + r) >= 128);
                const float v = ok ? st[j][r] + bias2[hl_q * 128 + (dist & 127)] : -INFINITY; st[j][r] = v; mx = fmaxf(mx, v); }
        mx = fmaxf(mx, __shfl_xor(mx, 16)); mx = fmaxf(mx, __shfl_xor(mx, 32));
        float sum = 0.f;
#pragma unroll
        for (int j = 0; j < 9; ++j)
#pragma unroll
            for (int r = 0; r < 4; ++r) { const float e = __builtin_amdgcn_exp2f(st[j][r] - mx); st[j][r] = e; sum += e; }
        sum += __shfl_xor(sum, 16); sum += __shfl_xor(sum, 32);
        const float inv = frcp(sum + __builtin_amdgcn_exp2f(sink2 - mx));
        f32x4 o[4];
#pragma unroll
        for (int dt = 0; dt < 4; ++dt) o[dt] = (f32x4){0.f, 0.f, 0.f, 0.f};
#pragma unroll
        for (int kk = 0; kk < 5; ++kk) {
            u32x4 pw; pw.x = pk2(st[2 * kk][0], st[2 * kk][1]); pw.y = pk2(st[2 * kk][2], st[2 * kk][3]);
            if (kk < 4) { pw.z = pk2(st[2 * kk + 1][0], st[2 * kk + 1][1]); pw.w = pk2(st[2 * kk + 1][2], st[2 * kk + 1][3]); } else { pw.z = 0u; pw.w = 0u; }
            const bf16x8 Pf = __builtin_bit_cast(bf16x8, pw);
            const LAS bf16_t* v0p = Vt + (16 * (qtile + 2 * kk) + 4 * g + q) * VT_LD + 4 * p;
#pragma unroll
            for (int dt = 0; dt < 4; ++dt) { const s16x4 lo = trd(v0p + 16 * dt); const s16x4 hi = (kk < 4) ? trd(v0p + 16 * VT_LD + 16 * dt) : (s16x4){0, 0, 0, 0};
                o[dt] = __builtin_amdgcn_mfma_f32_16x16x32_bf16(cat8(lo, hi), Pf, o[dt], 0, 0, 0); }
        }
        { bf16_t* op = P.AO + qrow * DM + (kh * 4 + hl_q) * 64 + 4 * g;
#pragma unroll
          for (int dt = 0; dt < 4; ++dt) { u32x2 w; w.x = pk2(o[dt][0] * inv, o[dt][1] * inv); w.y = pk2(o[dt][2] * inv, o[dt][3] * inv); *(u32x2*)(op + 16 * dt) = w; } }
    }
}


#define XB_TMO      128
#define XB_XCNT(j)  (256  + 64 * (j))
#define XB_XSUB(j)  (1280 + 64 * (j))
#define XB_XGEN(j)  (2304 + 64 * (j))
#define XB_TOP      3328
#define XB_TOPGEN   3392
#define XCD_BAR_WORDS 3456
#define XB_SPIN_CAP (1u << 20)
__device__ __forceinline__ unsigned xb_ld(unsigned* p)              { return __hip_atomic_load(p, __ATOMIC_RELAXED, __HIP_MEMORY_SCOPE_AGENT); }
__device__ __forceinline__ unsigned xb_add(unsigned* p, unsigned v) { return __hip_atomic_fetch_add(p, v, __ATOMIC_RELAXED, __HIP_MEMORY_SCOPE_AGENT); }
__device__ __forceinline__ unsigned xb_xcc_id() { return (unsigned)__builtin_amdgcn_s_getreg((3 << 11) | 20) & 0xFu; }
#define XB_SPIN(cond, bar) do { unsigned _sp = 0; while (cond) { __builtin_amdgcn_s_sleep(1); \
    if ((++_sp & 255u) == 0u) { if (xb_ld(&(bar)[XB_TMO])) break; if (_sp > XB_SPIN_CAP) { atomicAdd(&(bar)[XB_TMO], 1u); break; } } } } while (0)
struct XcdBarrier { unsigned* bar; unsigned x; volatile LAS unsigned* st; };
__device__ __forceinline__ XcdBarrier xcd_barrier_post(unsigned* bar, volatile LAS unsigned* st) {
    XcdBarrier b; b.bar = bar; b.x = xb_xcc_id(); b.st = st;
    if (threadIdx.x == 0) (void)xb_add(&bar[XB_XCNT(b.x)], 1u);
    return b;
}
__device__ __forceinline__ void xcd_barrier_complete(unsigned* bar, unsigned x, unsigned& nloc, unsigned& nx) {
    const unsigned G = gridDim.x * gridDim.y * gridDim.z;
    unsigned sum, cnt, mine, sp = 0u;
    for (;;) {
        sum = 0u; cnt = 0u; mine = 0u;
#pragma unroll
        for (unsigned j = 0; j < 16; ++j) { const unsigned c = xb_ld(&bar[XB_XCNT(j)]); sum += c; cnt += (c > 0u) ? 1u : 0u; mine = (j == x) ? c : mine; }
        if (sum == G) break;
        __builtin_amdgcn_s_sleep(1);
        if ((++sp & 255u) == 0u) { if (xb_ld(&bar[XB_TMO])) break; if (sp > XB_SPIN_CAP) { atomicAdd(&bar[XB_TMO], 1u); break; } }
    }
    nloc = mine > 0u ? mine : 1u; nx = cnt > 0u ? cnt : 1u;
}
__device__ __forceinline__ void xcd_barrier(const XcdBarrier& b) {
    asm volatile("s_waitcnt vmcnt(0)" ::: "memory");
    __syncthreads();
    if (threadIdx.x == 0) {
        unsigned* bar = b.bar;
        __builtin_amdgcn_s_waitcnt(0);
        unsigned nloc = b.st[0], nx = b.st[1];
        if (nloc == 0u) { xcd_barrier_complete(bar, b.x, nloc, nx); b.st[0] = nloc; b.st[1] = nx; }
        const unsigned old = xb_add(&bar[XB_XSUB(b.x)], 1u);
        const unsigned gen = old / nloc;
        if (old + 1u == (gen + 1u) * nloc) {
            __builtin_amdgcn_fence(__ATOMIC_RELEASE, "agent");
            asm volatile("s_waitcnt vmcnt(0)" ::: "memory");
            const unsigned og = xb_add(&bar[XB_TOP], 1u);
            const unsigned tg = og / nx;
            if (og + 1u == (tg + 1u) * nx) xb_add(&bar[XB_TOPGEN], 1u);
            else XB_SPIN(xb_ld(&bar[XB_TOPGEN]) == tg, bar);
            __builtin_amdgcn_fence(__ATOMIC_ACQUIRE, "agent");
            xb_add(&bar[XB_XGEN(b.x)], 1u);
            asm volatile("s_waitcnt vmcnt(0)" ::: "memory");
        } else {
            XB_SPIN(xb_ld(&bar[XB_XGEN(b.x)]) == gen, bar);
            __builtin_amdgcn_fence(__ATOMIC_ACQUIRE, "agent");
            asm volatile("s_waitcnt vmcnt(0)" ::: "memory");
        }
    }
    __syncthreads();
}

__global__ void __launch_bounds__(NTHREADS, 2) yoco_fwd(Args args) {
    extern __shared__ __attribute__((aligned(16))) unsigned char lds_raw[];
    LAS unsigned char* lds = (LAS unsigned char*)lds_raw;
    const int tid = threadIdx.x, lane = tid & 63, wave = __builtin_amdgcn_readfirstlane(tid >> 6), G = gridDim.x, bx = blockIdx.x;
    const int gw = bx * NWAVES + wave, NGW = G * NWAVES;
    typedef const __attribute__((address_space(4))) Args* KArgsP;
    const KArgsP kp0 = (KArgsP)__builtin_amdgcn_kernarg_segment_ptr();
#define KARG(field) ({ KArgsP q_ = kp0; asm volatile("" : "+s"(q_)); q_->field; })
#define ws KARG(ws)
#define out KARG(out)
#define x_prompt KARG(in[0])
#define x_sample KARG(in[1])
#define state_gla KARG(in[2])
#define cache_k KARG(in[3])
#define cache_v KARG(in[4])
#define p_prompt KARG(in[5])
#define p_sample KARG(in[6])
#define norm_mix KARG(in[7])
#define norm_mlp KARG(in[8])
#define norm_ple KARG(in[9])
#define norm_kv KARG(in[10])
#define norm_final KARG(in[11])
#define w_in_a KARG(in[12])
#define w_a2 KARG(in[13])
#define b_a2 KARG(in[14])
#define gla_o_gain KARG(in[15])
#define w_out_a KARG(in[16])
#define w_kv KARG(in[17])
#define w_q_b KARG(in[18])
#define w_o_b KARG(in[19])
#define sinks KARG(in[20])
#define rel_bias KARG(in[21])
#define w_up KARG(in[22])
#define w_down KARG(in[23])
#define w_ple KARG(in[24])
#define w_ple_gate KARG(in[25])
#define W_IN ((bf16_t*)(ws + WS_W_IN))
#define W_OUT ((bf16_t*)(ws + WS_W_OUT))
#define W_KVQ ((bf16_t*)(ws + WS_W_KVQ))
#define W_O ((bf16_t*)(ws + WS_W_O))
#define XB ((bf16_t*)(ws + WS_XB))
#define PB ((bf16_t*)(ws + WS_PB))
#define Q1 ((bf16_t*)(ws + WS_Q1))
#define K1 ((bf16_t*)(ws + WS_K1))
#define V1 ((bf16_t*)(ws + WS_V1))
#define G1 ((bf16_t*)(ws + WS_G1))
#define HIDA ((bf16_t*)(ws + WS_R1))
#define H3B ((bf16_t*)(ws + WS_R1))
#define R3 ((bf16_t*)(ws + WS_R3))
#define HIDS (R3 + (size_t)(64 - HID_SPLIT) * 256 * FF)
#define KVR ((bf16_t*)(ws + WS_KVR))
#define PLQ ((bf16_t*)(ws + WS_PLQ))
#define SSQ0 ((float*)(ws + WS_SSQ))
#define SSQ1 ((float*)(ws + WS_SSQ) + (size_t)M * 16)
#define DV ((float*)(ws + WS_DV))
#define H (out + O_Y)
#define UT ((bf16_t*)(out + O_Y))
    cg::grid_group grid = cg::this_grid();
    volatile LAS unsigned* bst = (volatile LAS unsigned*)(lds + LDS_BYTES - 64);
    if (tid < 2) bst[tid] = 0u;
    __syncthreads();
    XcdBarrier xbar; xbar.bar = nullptr; xbar.x = 0; xbar.st = bst;
#if !MK_SPLIT
    xbar = xcd_barrier_post((unsigned*)(ws + WS_CTL), bst);
#endif
    const int lo = KARG(ph_lo), hi = KARG(ph_hi);
#define IN(k) (lo <= (k) && (k) < hi)
#define SEAM(k) do { if (IN(k) && IN((k) + 1)) { if (MK_SPLIT) grid.sync(); else xcd_barrier(xbar); } } while (0)
    if (lo < 0) grid.sync();

    if (IN(0)) {
        LAS float* scr = (LAS float*)(lds + wave * 16384);
#define TJ_LIST(X) \
        X(w_in_a, IN_A_COLS, DM, 512, W_IN, norm_mix, 0.08838834764831845f)                                     \
        X(w_in_a + 512, IN_A_COLS, DM, 2560, W_IN + (size_t)512 * DM, norm_mix, 1.f)                            \
        X(w_out_a, DM, DM, DM, W_OUT, (const float*)nullptr, 1.f) \
        X(w_up, FF, DM, FF, (bf16_t*)(ws + WS_W_UP0), norm_mlp, 1.f) \
        X(w_up + (size_t)DM * FF, FF, DM, FF, (bf16_t*)(ws + WS_W_UP1), norm_mlp + DM, 1.f) \
        X(w_down, DM, FF, DM, (bf16_t*)(ws + WS_W_DN0), (const float*)nullptr, 1.f) \
        X(w_down + (size_t)DM * FF, DM, FF, DM, (bf16_t*)(ws + WS_W_DN1), (const float*)nullptr, 1.f) \
        X(w_ple_gate, DM, DM, DM, (bf16_t*)(ws + WS_W_G0), norm_ple, 1.f) \
        X(w_ple_gate + (size_t)DM * DM, DM, DM, DM, (bf16_t*)(ws + WS_W_G1), norm_ple + DM, 1.f) \
        X(w_ple, DM, PLE, DM, (bf16_t*)(ws + WS_W_P0), (const float*)nullptr, 1.f) \
        X(w_ple + (size_t)PLE * DM, DM, PLE, DM, (bf16_t*)(ws + WS_W_P1), (const float*)nullptr, 1.f) \
        X(w_kv, 512, DM, 512, W_KVQ, norm_kv, 1.f) \
        X(w_q_b, DM, DM, DM, W_KVQ + (size_t)512 * DM, norm_mix + DM, 0.125f * LOG2E)                          \
        X(w_o_b, DM, DM, DM, W_O, (const float*)nullptr, 1.f)
#define TJ_COUNT(W, LDW, KK, NCOLS, DST, GAIN, SCALE) + ((KK) / 64) * ((NCOLS) / 32)
        constexpr int TJ_TOTAL = 0 TJ_LIST(TJ_COUNT);
#define TJ_DECODE(WP, LDW, KK, NCOLS, DSTP, GAINP, SCALEV) if (!done_ && r_ < ((KK) / 64) * ((NCOLS) / 32)) { jt_.src = (WP); jt_.ldw = (LDW); jt_.kk = (KK); jt_.nblk = (NCOLS) / 32; jt_.dst = (DSTP); jt_.gain = (GAINP); jt_.scale = (SCALEV); jt_.item = r_; done_ = true; } else if (!done_) r_ -= ((KK) / 64) * ((NCOLS) / 32);
#define TJ_GET(JOUT, it) do { int r_ = (it); bool done_ = false; TJob jt_; jt_.src = nullptr; jt_.ldw = 0; jt_.kk = 0; jt_.nblk = 1; jt_.dst = nullptr; jt_.gain = nullptr; jt_.scale = 1.f; jt_.item = 0; TJ_LIST(TJ_DECODE) JOUT = jt_; } while (0)
        { float ra_[32], rb_[32]; TJob Ja, Jb; int it = gw;
          if (it < TJ_TOTAL) { TJ_GET(Ja, it); p0_tload(Ja, ra_, lane); }
          while (it < TJ_TOTAL) {
              const int it1 = it + NGW; if (it1 < TJ_TOTAL) { TJ_GET(Jb, it1); p0_tload(Jb, rb_, lane); }
              p0_tfinish(Ja, ra_, scr, lane);
              if (it1 >= TJ_TOTAL) break;
              const int it2 = it1 + NGW; if (it2 < TJ_TOTAL) { TJ_GET(Ja, it2); p0_tload(Ja, ra_, lane); }
              p0_tfinish(Jb, rb_, scr, lane);
              it = it2; } }
#undef TJ_LIST
#undef TJ_COUNT
#undef TJ_DECODE
#undef TJ_GET
        for (int idx = bx * NTHREADS + tid; idx < 512 * 128; idx += G * NTHREADS) { const int n = idx >> 7, k8 = (idx & 127) * 8; float wa[16];
#pragma unroll
            for (int r = 0; r < 16; ++r) wa[r] = w_a2[r * 512 + n];
            float o8[8];
#pragma unroll
            for (int kk = 0; kk < 8; ++kk) { const float* wr_ = w_in_a + (size_t)(k8 + kk) * IN_A_COLS + 3072; float s = 0.f;
#pragma unroll
                for (int r = 0; r < 16; ++r) s += wr_[r] * wa[r];
                o8[kk] = s * norm_mix[k8 + kk]; }
            u32x4 o; o.x = pk2(o8[0], o8[1]); o.y = pk2(o8[2], o8[3]); o.z = pk2(o8[4], o8[5]); o.w = pk2(o8[6], o8[7]);
            *(u32x4*)(W_IN + (size_t)(3072 + n) * DM + k8) = o; }
        for (int grp = bx; grp < M / 64; grp += G)
#pragma unroll 1
          for (int half = 0; half < 2; ++half) { const int m0 = 64 * grp + 8 * wave + 4 * half; f32x4 v[4][4]; float s[4];
#pragma unroll
            for (int q = 0; q < 4; ++q) { const int m = m0 + q; const float* xr = m < MP ? x_prompt + (size_t)m * DM : x_sample + (size_t)(m - MP) * DM;
#pragma unroll
                for (int j = 0; j < 4; ++j) v[q][j] = *((const f32x4*)xr + lane + 64 * j); }
#pragma unroll
            for (int q = 0; q < 4; ++q) { const int m = m0 + q; float ss = 0.f;
#pragma unroll
                for (int j = 0; j < 4; ++j) { ss += (v[q][j].x * v[q][j].x + v[q][j].y * v[q][j].y) + (v[q][j].z * v[q][j].z + v[q][j].w * v[q][j].w);
                    u32x2 w; w.x = pk2(v[q][j].x, v[q][j].y); w.y = pk2(v[q][j].z, v[q][j].w); *((u32x2*)(XB + (size_t)m * DM) + lane + 64 * j) = w; }
                s[q] = wave_sum(ss);
                if (lane < 4) *(f32x4*)(SSQ0 + ssq_idx(lane, m, 0)) = (f32x4){lane == 0 ? s[q] : 0.f, 0.f, 0.f, 0.f}; } }
        for (int m0 = gw * 8; m0 < M; m0 += NGW * 8) { f32x4 v[8];
#pragma unroll
            for (int q = 0; q < 8; ++q) { const int m = m0 + q; v[q] = *((const f32x4*)(m < MP ? p_prompt + (size_t)m * PLE : p_sample + (size_t)(m - MP) * PLE) + lane); }
#pragma unroll
            for (int q = 0; q < 8; ++q) { u32x2 w; w.x = pk2(v[q].x, v[q].y); w.y = pk2(v[q].z, v[q].w); *((u32x2*)(PB + (size_t)(m0 + q) * PLE) + lane) = w; } }
    }
    SEAM(0);
    if (IN(1)) { pg8::Gemm g{XB, XB, NPAN, W_IN, M, N_IN, DM}; pg8::StaticOrder S; S.init(M, N_IN, G, bx);
        pg8::EpiIn E{Q1, K1, V1, G1, KVR, SSQ0, b_a2}; pg8::gemm_phase(lds, g, S, E); }
    SEAM(1);
    if (IN(2)) {
        for (int base = bx * 2; base < SB * 4; base += G * 2) gla_sample_pair(lds, base, Q1, K1, V1, G1, KVR, state_gla, out + O_SS, gla_o_gain, R3, tid);
        gla_super_phase<false>(lds, G, bx, nullptr, K1, V1, nullptr, KVR, UT, DV, nullptr, nullptr, nullptr, tid, lane, wave);
    }
    SEAM(2);
    if (IN(3)) gla_scan<NSUP>(UT, DV, out + O_SP, bx * NTHREADS + tid, G * NTHREADS);
    SEAM(3);
    if (IN(4)) { gla_super_phase<true>(lds, G, bx, Q1, K1, V1, G1, KVR, UT, nullptr, gla_o_gain, R3, out + O_SP, tid, lane, wave); }
    SEAM(4);
    if (IN(5)) {
        { pg8::Gemm g{R3, R3, NPAN, W_OUT, MP, DM, DM}; pg8::StaticOrder S; S.init(MP, DM, G, bx); pg8::EpiRes<false> E{nullptr, nullptr, XB, XB, SSQ1, 1.f}; pg8::gemm_phase(lds, g, S, E); }
        { pg8::Gemm g{PB, PB, NPAN, (const bf16_t*)(ws + WS_W_P0), MP, DM, PLE}; pg8::StaticOrder S; S.init(MP, DM, G, bx); pg8::EpiPl E{PLQ}; pg8::gemm_phase(lds, g, S, E); }
        { mg::MRes<false> E{nullptr, XB, XB, SSQ1, 1.f}; mg::mini_gemm(lds, R3 + (size_t)MP * DM, W_OUT, DM, DM, G, bx, E); }
        { mg::MPl E{PLQ, nullptr}; mg::mini_gemm(lds, PB + (size_t)MP * PLE, (const bf16_t*)(ws + WS_W_P0), DM, PLE, G, bx, E); }
    }
    SEAM(5);
    if (IN(6)) { { pg8::Gemm g{XB, XB, NPAN, (const bf16_t*)(ws + WS_W_UP0), MP, FF, DM}; pg8::StaticOrder S; S.init(MP, FF, G, bx); pg8::EpiUp E{HIDA, R3, SSQ1}; pg8::gemm_phase(lds, g, S, E); }
        { mg::MUp E{HIDS, SSQ1, nullptr}; mg::mini_gemm(lds, XB + (size_t)MP * DM, (const bf16_t*)(ws + WS_W_UP0), FF, DM, G, bx, E); } }
    SEAM(6);
    if (IN(7)) { { pg8::Gemm g{HIDA, R3, HID_SPLIT, (const bf16_t*)(ws + WS_W_DN0), MP, DM, FF}; pg8::StaticOrder S; S.init(MP, DM, G, bx); pg8::EpiRes<false> E{nullptr, nullptr, XB, XB, SSQ0, 1.f}; pg8::gemm_phase(lds, g, S, E); }
        { mg::MRes<false> E{nullptr, XB, XB, SSQ0, 1.f}; mg::mini_gemm(lds, HIDS, (const bf16_t*)(ws + WS_W_DN0), DM, FF, G, bx, E); } }
    SEAM(7);
    if (IN(8)) { { pg8::Gemm g{XB, XB, NPAN, (const bf16_t*)(ws + WS_W_G0), MP, DM, DM}; pg8::StaticOrder S; S.init(MP, DM, G, bx); pg8::EpiGate<false> E{nullptr, XB, PLQ, H3B, SSQ0, SSQ1, 1.f}; pg8::gemm_phase(lds, g, S, E); }
        { mg::MGate<false> E{nullptr, XB, PLQ, H3B, SSQ0, SSQ1, 1.f}; mg::mini_gemm(lds, XB + (size_t)MP * DM, (const bf16_t*)(ws + WS_W_G0), DM, DM, G, bx, E); } }
    SEAM(8);
    if (IN(9)) { pg8::Gemm g{H3B, H3B, NPAN, W_KVQ, M, NKVQ, DM}; pg8::StaticOrder S; S.init(M, NKVQ, G, bx);
        pg8::EpiKvq E{KVR, PLQ, SSQ1, out + O_CKP, out + O_CVP, out + O_CKS, out + O_CVS}; pg8::gemm_phase(lds, g, S, E); }
    SEAM(9);
    if (IN(10)) {
        const AttnP AP{KVR, PLQ, R3, cache_k, cache_v, out + O_CKS, out + O_CVS, sinks, rel_bias};
        { AttnRegs AR; int buf = 0;
          if (bx < 1024) { attn_load(bx, AP, AR, tid); attn_stage(lds, bx, AP, AR, tid); }
          LDS_BAR();
          for (int it = bx; it < 1024; it += G) { const int nx = it + G;
              if (nx < 1024) attn_load(nx, AP, AR, tid);
              attn_compute(lds + buf * ATT_BUF, it, AP, lane, wave);
              if (nx < 1024) attn_stage(lds + (buf ^ 1) * ATT_BUF, nx, AP, AR, tid);
              LDS_BAR(); buf ^= 1; } }
        for (int m0 = gw * 8; m0 < M; m0 += NGW * 8) { f32x4 v[8];
#pragma unroll
            for (int q = 0; q < 8; ++q) { const int m = m0 + q; v[q] = *((const f32x4*)(m < MP ? p_prompt + (size_t)(MP + m) * PLE : p_sample + (size_t)(MS + m - MP) * PLE) + lane); }
#pragma unroll
            for (int q = 0; q < 8; ++q) { u32x2 w; w.x = pk2(v[q].x, v[q].y); w.y = pk2(v[q].z, v[q].w); *((u32x2*)(PB + (size_t)(m0 + q) * PLE) + lane) = w; } }
    }
    SEAM(10);
    if (IN(11)) {
        { pg8::Gemm g{R3, R3, NPAN, W_O, MP, DM, DM}; pg8::StaticOrder S; S.init(MP, DM, G, bx); pg8::EpiRes<false> E{nullptr, nullptr, H3B, XB, SSQ0, 1.f}; pg8::gemm_phase(lds, g, S, E); }
        { pg8::Gemm g{PB, PB, NPAN, (const bf16_t*)(ws + WS_W_P1), MP, DM, PLE}; pg8::StaticOrder S; S.init(MP, DM, G, bx); pg8::EpiPl E{PLQ}; pg8::gemm_phase(lds, g, S, E); }
        { mg::MRes<false> E{nullptr, H3B, XB, SSQ0, 1.f}; mg::mini_gemm(lds, R3 + (size_t)MP * DM, W_O, DM, DM, G, bx, E); }
        { mg::MPl E{PLQ, nullptr}; mg::mini_gemm(lds, PB + (size_t)MP * PLE, (const bf16_t*)(ws + WS_W_P1), DM, PLE, G, bx, E); }
    }
    SEAM(11);
    if (IN(12)) { { pg8::Gemm g{XB, XB, NPAN, (const bf16_t*)(ws + WS_W_UP1), MP, FF, DM}; pg8::StaticOrder S; S.init(MP, FF, G, bx); pg8::EpiUp E{HIDA, R3, SSQ0}; pg8::gemm_phase(lds, g, S, E); }
        { mg::MUp E{HIDS, SSQ0, nullptr}; mg::mini_gemm(lds, XB + (size_t)MP * DM, (const bf16_t*)(ws + WS_W_UP1), FF, DM, G, bx, E); } }
    SEAM(12);
    if (IN(13)) { { pg8::Gemm g{HIDA, R3, HID_SPLIT, (const bf16_t*)(ws + WS_W_DN1), MP, DM, FF}; pg8::StaticOrder S; S.init(MP, DM, G, bx); pg8::EpiRes<false> E{nullptr, nullptr, XB, XB, SSQ1, 1.f}; pg8::gemm_phase(lds, g, S, E); }
        { mg::MRes<false> E{nullptr, XB, XB, SSQ1, 1.f}; mg::mini_gemm(lds, HIDS, (const bf16_t*)(ws + WS_W_DN1), DM, FF, G, bx, E); } }
    SEAM(13);
    if (IN(14)) { { pg8::Gemm g{XB, XB, NPAN, (const bf16_t*)(ws + WS_W_G1), MP, DM, DM}; pg8::StaticOrder S; S.init(MP, DM, G, bx); pg8::EpiGate<false> E{nullptr, XB, PLQ, H3B, SSQ1, SSQ0, 1.f}; pg8::gemm_phase(lds, g, S, E); }
        { mg::MGate<false> E{nullptr, XB, PLQ, H3B, SSQ1, SSQ0, 1.f}; mg::mini_gemm(lds, XB + (size_t)MP * DM, (const bf16_t*)(ws + WS_W_G1), DM, DM, G, bx, E); } }
    SEAM(14);
    if (IN(15)) {
        f32x4 gn[4];
#pragma unroll
        for (int j = 0; j < 4; ++j) gn[j] = *((const f32x4*)norm_final + lane + 64 * j);
        for (int m0 = gw * 4; m0 < M; m0 += NGW * 4) { u32x2 w[4][4]; float r[4];
#pragma unroll
            for (int q = 0; q < 4; ++q) { r[q] = row_r(SSQ0, m0 + q);
#pragma unroll
                for (int j = 0; j < 4; ++j) w[q][j] = *((const u32x2*)(H3B + (size_t)(m0 + q) * DM) + lane + 64 * j); }
#pragma unroll
            for (int q = 0; q < 4; ++q)
#pragma unroll
                for (int j = 0; j < 4; ++j) { const f32x4 v = {bflo(w[q][j].x), bfhi(w[q][j].x), bflo(w[q][j].y), bfhi(w[q][j].y)};
                    *((f32x4*)(H + (size_t)(m0 + q) * DM) + lane + 64 * j) = v * r[q] * gn[j]; } }
    }
#undef IN
#undef SEAM
}
#undef ws
#undef out
#undef x_prompt
#undef x_sample
#undef state_gla
#undef cache_k
#undef cache_v
#undef p_prompt
#undef p_sample
#undef norm_mix
#undef norm_mlp
#undef norm_ple
#undef norm_kv
#undef norm_final
#undef w_in_a
#undef w_a2
#undef b_a2
#undef gla_o_gain
#undef w_out_a
#undef w_kv
#undef w_q_b
#undef w_o_b
#undef sinks
#undef rel_bias
#undef w_up
#undef w_down
#undef w_ple
#undef w_ple_gate
#undef W_IN
#undef W_OUT
#undef W_KVQ
#undef W_O
#undef XB
#undef PB
#undef Q1
#undef K1
#undef V1
#undef G1
#undef HIDA
#undef H3B
#undef R3
#undef HIDS
#undef KVR
#undef PLQ
#undef SSQ0
#undef SSQ1
#undef DV
#undef H
#undef UT
#undef KARG

extern "C" void kernel_launch(void* const* d_in, const int* in_sizes, int n_in, void* d_out, int out_size, void* d_ws, size_t ws_size, hipStream_t stream) {
    static int grid = 0;
    if (grid == 0) {
        if (n_in != 26 || (size_t)out_size != O_END || ws_size < WS_END) { fprintf(stderr, "kernel_launch: unexpected shapes (n_in %d out %d ws %zu need %zu)\n", n_in, out_size, ws_size, (size_t)WS_END); grid = -1; return; }
        int dev = 0, cus = 0, per_cu = 0;
        hipGetDevice(&dev); hipDeviceGetAttribute(&cus, hipDeviceAttributeMultiprocessorCount, dev);
        hipFuncSetAttribute((const void*)yoco_fwd, hipFuncAttributeMaxDynamicSharedMemorySize, LDS_BYTES);
        hipOccupancyMaxActiveBlocksPerMultiprocessor(&per_cu, (const void*)yoco_fwd, NTHREADS, LDS_BYTES);
        if (per_cu < 1) { fprintf(stderr, "kernel_launch: occupancy query says %d blocks per CU\n", per_cu); per_cu = 1; }
        (void)hipGetLastError();
        grid = cus * 1;
    }
    if (grid < 0) return;
    if (hipMemsetAsync((char*)d_ws + WS_CTL, 0, 65536, stream) != hipSuccess) { fprintf(stderr, "kernel_launch: memset failed\n"); return; }
    Args a{};
    for (int i = 0; i < 26; ++i) a.in[i] = (const float*)d_in[i];
    a.out = (float*)d_out; a.ws = (unsigned char*)d_ws;
#if MK_SPLIT
    for (int ph = 0; ph < 16; ++ph) { a.ph_lo = ph; a.ph_hi = ph + 1; hipLaunchKernelGGL(yoco_fwd, dim3(grid), dim3(NTHREADS), LDS_BYTES, stream, a); }
#else
    a.ph_lo = 0; a.ph_hi = 16;
    void* kargs[] = {&a};
    hipError_t e = hipLaunchCooperativeKernel((const void*)yoco_fwd, dim3(grid), dim3(NTHREADS), kargs, LDS_BYTES, stream);
    if (e != hipSuccess) fprintf(stderr, "cooperative launch failed: %s (grid %d)\n", hipGetErrorString(e), grid);
#endif
}
```

```cpp
#include <hip/hip_runtime.h>
#include <hip/hip_cooperative_groups.h>
#include <cstdio>
#include <cstdint>
namespace cg = cooperative_groups;

#define LAS __attribute__((address_space(3)))
#define GAS __attribute__((address_space(1)))
typedef unsigned short bf16_t;
typedef short bf16x8 __attribute__((ext_vector_type(8)));
typedef short s16x4 __attribute__((ext_vector_type(4)));
typedef float f32x4 __attribute__((ext_vector_type(4)));
typedef float f32x2 __attribute__((ext_vector_type(2)));
typedef unsigned u32x4 __attribute__((ext_vector_type(4)));
typedef unsigned u32x2 __attribute__((ext_vector_type(2)));

#ifndef MK_SPLIT
#define MK_SPLIT 0
#endif

constexpr int DM = 1024, SEQ = 8192, NBATCH = 2, MP = NBATCH * SEQ, SB = 128, SS = 8, MS = SB * SS, M = MP + MS, NPAN = M / 256;
constexpr int NQK = 512, NV = 1024, N_IN = 3584, FF = 4096, PLE = 256, NKVQ = 1536, IN_A_COLS = 3088;
constexpr int NCHUNK = 128, NBH = 8, NCH_ALL = NBH * NCHUNK;
constexpr float EPS = 1e-6f, LOG2E = 1.4426950408889634f;
constexpr int HID_SPLIT = 51;

constexpr size_t O_Y = 0, O_SP = (size_t)M * DM, O_SS = O_SP + 262144, O_CKP = O_SS + 16777216, O_CVP = O_CKP + 65536, O_CKS = O_CVP + 65536, O_CVS = O_CKS + 4194304, O_END = O_CVS + 4194304;

constexpr size_t al256(size_t x) { return (x + 255) & ~(size_t)255; }
constexpr size_t WS_CTL = 0, CTL_BYTES = 1u << 20;
constexpr size_t WS_W_IN = CTL_BYTES;
constexpr size_t WS_W_OUT = WS_W_IN + (size_t)N_IN * DM * 2;
constexpr size_t WS_W_UP0 = WS_W_OUT + (size_t)DM * DM * 2;
constexpr size_t WS_W_DN0 = WS_W_UP0 + (size_t)FF * DM * 2;
constexpr size_t WS_W_UP1 = WS_W_DN0 + (size_t)FF * DM * 2;
constexpr size_t WS_W_DN1 = WS_W_UP1 + (size_t)FF * DM * 2;
constexpr size_t WS_W_G0 = WS_W_DN1 + (size_t)FF * DM * 2;
constexpr size_t WS_W_G1 = WS_W_G0 + (size_t)DM * DM * 2;
constexpr size_t WS_W_P0 = WS_W_G1 + (size_t)DM * DM * 2;
constexpr size_t WS_W_P1 = WS_W_P0 + (size_t)DM * PLE * 2;
constexpr size_t WS_W_KVQ = WS_W_P1 + (size_t)DM * PLE * 2;
constexpr size_t WS_W_O = WS_W_KVQ + (size_t)NKVQ * DM * 2;
constexpr size_t WS_XB = WS_W_O + (size_t)DM * DM * 2;
constexpr size_t WS_PB = WS_XB + (size_t)M * DM * 2;
constexpr size_t WS_R1 = WS_PB + (size_t)M * PLE * 2;
constexpr size_t R1_BYTES = (size_t)HID_SPLIT * 256 * FF * 2;
constexpr size_t WS_Q1 = WS_R1, WS_K1 = WS_Q1 + (size_t)M * NQK * 2, WS_V1 = WS_K1 + (size_t)M * NQK * 2, WS_G1 = WS_V1 + (size_t)M * NV * 2;
static_assert(WS_G1 + (size_t)M * NV * 2 == WS_R1 + R1_BYTES, "R1 map");
constexpr size_t WS_R3 = WS_R1 + R1_BYTES;
static_assert((size_t)(NPAN - HID_SPLIT) * 256 * FF * 2 == (size_t)M * DM * 2, "R3 map");
constexpr size_t WS_KVR = WS_R3 + (size_t)M * DM * 2;
constexpr size_t WS_PLQ = WS_KVR + (size_t)M * NQK * 2;
constexpr size_t WS_SSQ = WS_PLQ + (size_t)M * DM * 2;
constexpr size_t WS_DV = WS_SSQ + (size_t)2 * M * 16 * 4;
constexpr size_t WS_END = WS_DV + (size_t)NCH_ALL * 128 * 4;

__device__ __forceinline__ float bf2f(unsigned short b) { return __uint_as_float((unsigned)b << 16); }
__device__ __forceinline__ float bflo(unsigned w) { return __uint_as_float(w << 16); }
__device__ __forceinline__ float bfhi(unsigned w) { return __uint_as_float(w & 0xffff0000u); }
typedef __bf16 bf16x2_t __attribute__((ext_vector_type(2)));
__device__ __forceinline__ unsigned pk2(float lo, float hi) { const f32x2 v = {lo, hi}; const bf16x2_t b = __builtin_convertvector(v, bf16x2_t); return __builtin_bit_cast(unsigned, b); }
__device__ __forceinline__ float fexp(float x) { return __builtin_amdgcn_exp2f(x * LOG2E); }
__device__ __forceinline__ float frcp(float x) { return __builtin_amdgcn_rcpf(x); }
__device__ __forceinline__ float frsq(float x) { return __builtin_amdgcn_rsqf(x); }
__device__ __forceinline__ float fsigmoid(float x) { return frcp(1.f + fexp(-x)); }
__device__ __forceinline__ float logsig(float x) { return fminf(x, 0.f) - __logf(1.f + fexp(-fabsf(x))); }
__device__ __forceinline__ s16x4 trd(const LAS bf16_t* p) { return __builtin_bit_cast(s16x4, __builtin_amdgcn_ds_read_tr16_b64_v4i16((LAS s16x4*)p)); }
__device__ __forceinline__ bf16x8 cat8(s16x4 lo, s16x4 hi) { return (bf16x8){lo[0], lo[1], lo[2], lo[3], hi[0], hi[1], hi[2], hi[3]}; }
__device__ __forceinline__ void st_wt(float* p, float v) { __hip_atomic_store(p, v, __ATOMIC_RELAXED, __HIP_MEMORY_SCOPE_AGENT); }
__device__ __forceinline__ void st16_wt(void* p, u32x4 v) { asm volatile("global_store_dwordx4 %0, %1, off sc1\n\ts_nop 1" :: "v"(p), "v"(v) : "memory"); }
__device__ __forceinline__ float wave_sum(float v) {
#pragma unroll
    for (int o = 1; o < 64; o <<= 1) v += __shfl_xor(v, o);
    return v;
}
__device__ __forceinline__ size_t ssq_idx(int pn, int row, int wc) { return ((size_t)pn * M + row) * 4 + wc; }
__device__ __forceinline__ float row_r(const float* ssq, int row) {
    const f32x4 a = *(const f32x4*)(ssq + ssq_idx(0, row, 0)), b = *(const f32x4*)(ssq + ssq_idx(1, row, 0)), c = *(const f32x4*)(ssq + ssq_idx(2, row, 0)), d = *(const f32x4*)(ssq + ssq_idx(3, row, 0));
    const f32x4 s = (a + b) + (c + d);
    return frsq(((s.x + s.y) + (s.z + s.w)) * (1.f / 1024.f) + EPS);
}

namespace pg8 {
constexpr int BM = 256, BK = 64, HALF = 128, HTB = HALF * BK * 2, STAGE_BYTES = 8 * HTB, NXCD = 8, WGM = 8;
__host__ __device__ __forceinline__ int lds_byte(int r, int c) { const int st = (r >> 4) * 2 + (c >> 5), rr = r & 15, cc = c & 31, ob = rr * 64 + cc * 2; return st * 1024 + (ob ^ (((ob >> 9) & 1) << 5)); }
__host__ __device__ __forceinline__ void stage_rc(int b, int& R, int& C) { const int st = b / 1024, sb = b % 1024, swz = sb ^ (((sb >> 9) & 1) << 5); R = (st >> 1) * 16 + swz / 64; C = (st & 1) * 32 + (swz % 64) / 2; }
__host__ __device__ __forceinline__ int perm32(int rho) { const int n = rho >> 4, i = rho & 15; return 8 * (i >> 2) + 4 * n + (i & 3); }
struct Unit { int pm, pn; };
struct Gemm { const bf16_t* A; const bf16_t* A2; int split; const bf16_t* Bt; int M, N, K; };
struct StaticOrder {
    int nM, nN, nwg, G, c;
    __device__ void init(int M_, int N, int G_, int c_) { nM = M_ / BM; nN = N / BM; nwg = nM * nN; G = G_; c = c_; }
    __device__ bool next(int i, Unit& u) const {
        const long L = (long)i * G + c; if (L >= nwg) return false;
        int wgid = (int)L; { const int q = nwg / NXCD, r = nwg % NXCD, xcd = wgid % NXCD, off = wgid / NXCD; wgid = (xcd < r ? xcd * (q + 1) : r * (q + 1) + (xcd - r) * q) + off; }
        const int nig = WGM * nN, gid = wgid / nig, fm = gid * WGM, gsz = (nM - fm) < WGM ? (nM - fm) : WGM;
        u.pm = fm + ((wgid % nig) % gsz); u.pn = (wgid % nig) / gsz; return true;
    }
};

template <class Epi>
__device__ __forceinline__ void gemm_phase(LAS unsigned char* lds, const Gemm g, const StaticOrder& S, const Epi& E) {
    const int tid = threadIdx.x, wid = __builtin_amdgcn_readfirstlane(tid >> 6), lane = tid & 63, wr = wid >> 2, wc = wid & 3, fr = lane & 15, fq = lane >> 4;
    const int K = g.K, nt = K / BK;
    unsigned voffA[2], voffB[2];
#pragma unroll
    for (int i = 0; i < 2; ++i) { int R, C; stage_rc(tid * 16 + i * 8192, R, C); const int Rb = (R & ~31) + perm32(R & 31);
        voffA[i] = (unsigned)(R * K + C) * 2u; voffB[i] = (unsigned)(Rb * K + C) * 2u; }
    const size_t kstep = (size_t)(BK * 2);
    const size_t hstep = (size_t)HALF * K * 2;
    const size_t tstep = 2 * hstep;
    const unsigned ldsw = (unsigned)wid * 1024u;
    const int aoff = lds_byte(wr * 64 + fr, fq * 8), boff = lds_byte(wc * 32 + fr, fq * 8);
#define PG8_APTR(pm) ((pm) < g.split ? (const char*)g.A + (size_t)(pm) * tstep : (const char*)g.A2 + (size_t)((pm) - g.split) * tstep)
#define PG8_SA(b, h) (((b) * 2 + (h)) * HTB)
#define PG8_SB(b, h) ((4 + (b) * 2 + (h)) * HTB)
#define PG8_STAGE(bufoff, gbase, voff) do { _Pragma("unroll") for (int _i = 0; _i < 2; ++_i) \
        __builtin_amdgcn_global_load_lds((const unsigned*)((const char*)(gbase) + (voff)[_i]), (LAS unsigned*)(lds + (bufoff) + ldsw + _i * 8192), 16, 0, 0); } while (0)
#define PG8_LDA(dst, b, h) do { _Pragma("unroll") for (int m = 0; m < 4; ++m) _Pragma("unroll") for (int k = 0; k < 2; ++k) dst[m][k] = *(const LAS bf16x8*)(lds + PG8_SA(b, h) + aoff + m * 2048 + k * 1024); } while (0)
#define PG8_LDB(dst, b, h) do { _Pragma("unroll") for (int n = 0; n < 2; ++n) _Pragma("unroll") for (int k = 0; k < 2; ++k) dst[n][k] = *(const LAS bf16x8*)(lds + PG8_SB(b, h) + boff + n * 2048 + k * 1024); } while (0)
#define PG8_MMA(ai, bj, At, Bt) do { __builtin_amdgcn_s_setprio(1); _Pragma("unroll") for (int m = 0; m < 4; ++m) _Pragma("unroll") for (int n = 0; n < 2; ++n) _Pragma("unroll") for (int k = 0; k < 2; ++k) \
        acc[ai][bj][m][n] = __builtin_amdgcn_mfma_f32_16x16x32_bf16(Bt[n][k], At[m][k], acc[ai][bj][m][n], 0, 0, 0); __builtin_amdgcn_s_setprio(0); } while (0)
#define PG8_WAIT_V(n) asm volatile("s_waitcnt vmcnt(" #n ")" ::: "memory")
#define PG8_WAIT_L(n) asm volatile("s_waitcnt lgkmcnt(" #n ")" ::: "memory")
#define PG8_BAR __builtin_amdgcn_s_barrier()
#define PG8_SCHED __builtin_amdgcn_sched_barrier(0)
    Unit cur, nxt; int ui = 0;
    if (!S.next(0, cur)) return;
    LAS float* rtab_all = (LAS float*)(lds + STAGE_BYTES);
    if (E.rsrc() != nullptr) { Unit uu; for (int i = 0; i < 8 && S.next(i, uu); ++i) if (tid < 256) rtab_all[i * 256 + tid] = row_r(E.rsrc(), uu.pm * BM + tid); }
    f32x4 acc[2][2][4][2];
#pragma unroll
    for (int a = 0; a < 2; ++a)
#pragma unroll
        for (int b = 0; b < 2; ++b)
#pragma unroll
            for (int m = 0; m < 4; ++m)
#pragma unroll
                for (int n = 0; n < 2; ++n) acc[a][b][m][n] = (f32x4){0.f, 0.f, 0.f, 0.f};
    bf16x8 At[4][2], B0[2][2], B1[2][2];
    const char* cA = PG8_APTR(cur.pm); const char* cB = (const char*)g.Bt + (size_t)cur.pn * tstep;
    PG8_STAGE(PG8_SB(0, 0), cB, voffB); PG8_STAGE(PG8_SB(0, 1), cB + hstep, voffB); PG8_STAGE(PG8_SA(0, 0), cA, voffA); PG8_STAGE(PG8_SA(0, 1), cA + hstep, voffA);
    PG8_WAIT_L(0);
    if (wr == 1) PG8_BAR;
    PG8_WAIT_V(2); PG8_BAR;
    PG8_STAGE(PG8_SB(1, 0), cB + kstep, voffB); PG8_STAGE(PG8_SA(1, 0), cA + kstep, voffA); PG8_STAGE(PG8_SB(1, 1), cB + hstep + kstep, voffB);
    PG8_WAIT_V(6); PG8_BAR;
    for (;;) {
        const bool has_next = S.next(ui + 1, nxt);
        const char* nA = has_next ? PG8_APTR(nxt.pm) : cA; const char* nB = has_next ? (const char*)g.Bt + (size_t)nxt.pn * tstep : cB;
#pragma clang loop unroll(disable)
        for (int t = 0; t < nt; t += 2) {
            const bool last = (t == nt - 2);
            const char* a1 = cA + (size_t)(t + 1) * kstep;
            const char* a2 = last ? nA : cA + (size_t)(t + 2) * kstep; const char* b2 = last ? nB : cB + (size_t)(t + 2) * kstep;
            const char* a3 = a2 + kstep; const char* b3 = b2 + kstep;
            PG8_LDB(B0, 0, 0); PG8_LDB(B1, 0, 1); PG8_SCHED; PG8_LDA(At, 0, 0); PG8_STAGE(PG8_SA(1, 1), a1 + hstep, voffA);
            PG8_WAIT_V(8); PG8_WAIT_L(0); PG8_BAR; PG8_MMA(0, 0, At, B0); PG8_MMA(0, 1, At, B1); PG8_BAR; PG8_SCHED;
            PG8_LDA(At, 0, 1); PG8_STAGE(PG8_SB(0, 0), b2, voffB); PG8_STAGE(PG8_SB(0, 1), b2 + hstep, voffB); PG8_STAGE(PG8_SA(0, 0), a2, voffA);
            PG8_WAIT_V(8); PG8_WAIT_L(0); PG8_BAR; PG8_MMA(1, 0, At, B0); PG8_MMA(1, 1, At, B1); PG8_BAR; PG8_SCHED;
            PG8_LDB(B0, 1, 0); PG8_LDB(B1, 1, 1); PG8_SCHED; PG8_LDA(At, 1, 0); PG8_STAGE(PG8_SA(0, 1), a2 + hstep, voffA);
            PG8_WAIT_V(8); PG8_WAIT_L(0); PG8_BAR; PG8_MMA(0, 0, At, B0); PG8_MMA(0, 1, At, B1); PG8_BAR; PG8_SCHED;
            PG8_LDA(At, 1, 1); PG8_STAGE(PG8_SB(1, 0), b3, voffB); PG8_STAGE(PG8_SB(1, 1), b3 + hstep, voffB); PG8_STAGE(PG8_SA(1, 0), a3, voffA);
            PG8_WAIT_V(8); PG8_WAIT_L(0); PG8_BAR; PG8_MMA(1, 0, At, B0); PG8_MMA(1, 1, At, B1); PG8_BAR; PG8_SCHED;
        }
        if (wr == 0) PG8_BAR;
        { int efr = fr, efq = fq, etid = tid; asm volatile("" : "+v"(efr), "+v"(efq), "+v"(etid));
          E(acc, cur, wr, wc, efr, efq, rtab_all + (ui & 7) * 256, etid); }
        if (!has_next) break;
#pragma unroll
        for (int a = 0; a < 2; ++a)
#pragma unroll
            for (int b = 0; b < 2; ++b)
#pragma unroll
                for (int m = 0; m < 4; ++m)
#pragma unroll
                    for (int n = 0; n < 2; ++n) acc[a][b][m][n] = (f32x4){0.f, 0.f, 0.f, 0.f};
        cur = nxt; cA = nA; cB = nB; ++ui;
        if (wr == 1) PG8_BAR;
    }
    PG8_WAIT_V(0);
    PG8_BAR;
#undef PG8_APTR
#undef PG8_SA
#undef PG8_SB
#undef PG8_STAGE
#undef PG8_LDA
#undef PG8_LDB
#undef PG8_MMA
#undef PG8_WAIT_V
#undef PG8_WAIT_L
#undef PG8_BAR
#undef PG8_SCHED
}

#define EPI_ROWLOOP _Pragma("unroll") for (int ai = 0; ai < 2; ++ai) _Pragma("unroll") for (int m = 0; m < 4; ++m)
__device__ __forceinline__ u32x4 pack8(const f32x4 v0, const f32x4 v1) { u32x4 w; w.x = pk2(v0[0], v0[1]); w.y = pk2(v0[2], v0[3]); w.z = pk2(v1[0], v1[1]); w.w = pk2(v1[2], v1[3]); return w; }

struct EpiIn {
    bf16_t *Q, *Kk, *V, *G, *LG; const float* ssq; const float* b_a2;
    __device__ __forceinline__ const float* rsrc() const { return ssq; }
    __device__ __forceinline__ void operator()(const f32x4 (&acc)[2][2][4][2], const Unit& u, int wr, int wc, int fr, int fq, LAS float* rtab, int tid) const {
        const int pn = u.pn; bf16_t* base; int ld, c0;
        if (pn < 2) { base = Q; ld = NQK; c0 = pn * 256; } else if (pn < 4) { base = Kk; ld = NQK; c0 = (pn - 2) * 256; }
        else if (pn < 8) { base = V; ld = NV; c0 = (pn - 4) * 256; } else if (pn < 12) { base = G; ld = NV; c0 = (pn - 8) * 256; }
        else { base = LG; ld = NQK; c0 = (pn - 12) * 256; }
        const bool is_lg = pn >= 12;
        const int col = c0 + wc * 32 + 8 * fq;
        f32x4 bb[2][2];
#pragma unroll
        for (int bj = 0; bj < 2; ++bj)
#pragma unroll
            for (int n = 0; n < 2; ++n) bb[bj][n] = is_lg ? *(const f32x4*)(b_a2 + col + bj * HALF + 4 * n) : (f32x4){0.f, 0.f, 0.f, 0.f};
        EPI_ROWLOOP { const int lr = ai * HALF + wr * 64 + m * 16 + fr, row = u.pm * BM + lr; const float r = rtab[lr];
#pragma unroll
            for (int bj = 0; bj < 2; ++bj) { f32x4 v0 = acc[ai][bj][m][0] * r, v1 = acc[ai][bj][m][1] * r;
                if (is_lg) { v0 += bb[bj][0]; v1 += bb[bj][1];
#pragma unroll
                    for (int e = 0; e < 4; ++e) { v0[e] = logsig(v0[e]) * (1.f / 16.f); v1[e] = logsig(v1[e]) * (1.f / 16.f); } }
                *(u32x4*)(base + (size_t)row * ld + col + bj * HALF) = pack8(v0, v1); } }
    }
};
template <bool FROM_X> struct EpiRes {
    const float* X0; const float* X1; const bf16_t* BB; bf16_t* XO; float* ssq_out; float sc;
    __device__ __forceinline__ const float* rsrc() const { return nullptr; }
    __device__ __forceinline__ void operator()(const f32x4 (&acc)[2][2][4][2], const Unit& u, int wr, int wc, int fr, int fq, LAS float* rtab, int tid) const {
        const int col = u.pn * BM + wc * 32 + 8 * fq;
#pragma unroll
        for (int ai = 0; ai < 2; ++ai) {
            f32x4 b0[4][2], b1[4][2]; u32x4 bw[4][2];
#pragma unroll
            for (int m = 0; m < 4; ++m) { const int row = u.pm * BM + ai * HALF + wr * 64 + m * 16 + fr;
#pragma unroll
                for (int bj = 0; bj < 2; ++bj) {
                    if (FROM_X) { const float* src = (u.pm < MP / 256 ? X0 + (size_t)row * DM : X1 + (size_t)(row - MP) * DM) + col + bj * HALF; b0[m][bj] = *(const f32x4*)src; b1[m][bj] = *(const f32x4*)(src + 4); }
                    else bw[m][bj] = *(const u32x4*)(BB + (size_t)row * DM + col + bj * HALF); } }
            if (!FROM_X) asm volatile("" ::: "memory");
#pragma unroll
            for (int m = 0; m < 4; ++m) { const int row = u.pm * BM + ai * HALF + wr * 64 + m * 16 + fr; float s = 0.f;
#pragma unroll
                for (int bj = 0; bj < 2; ++bj) {
                    if (!FROM_X) { const u32x4 w = bw[m][bj]; b0[m][bj] = (f32x4){bflo(w.x), bfhi(w.x), bflo(w.y), bfhi(w.y)}; b1[m][bj] = (f32x4){bflo(w.z), bfhi(w.z), bflo(w.w), bfhi(w.w)}; }
                    const f32x4 v0 = acc[ai][bj][m][0] * sc + b0[m][bj], v1 = acc[ai][bj][m][1] * sc + b1[m][bj];
                    *(u32x4*)(XO + (size_t)row * DM + col + bj * HALF) = pack8(v0, v1);
                    s += (v0[0] * v0[0] + v0[1] * v0[1]) + (v0[2] * v0[2] + v0[3] * v0[3]) + (v1[0] * v1[0] + v1[1] * v1[1]) + (v1[2] * v1[2] + v1[3] * v1[3]); }
                s += __shfl_xor(s, 16); s += __shfl_xor(s, 32);
                if (fq == 0) ssq_out[ssq_idx(u.pn, row, wc)] = s; }
        }
    }
};
struct EpiUp {
    bf16_t* HA; bf16_t* HB; const float* ssq;
    __device__ __forceinline__ const float* rsrc() const { return ssq; }
    __device__ __forceinline__ void operator()(const f32x4 (&acc)[2][2][4][2], const Unit& u, int wr, int wc, int fr, int fq, LAS float* rtab, int tid) const {
        bf16_t* base = u.pm < HID_SPLIT ? HA + (size_t)u.pm * 256 * FF : HB + (size_t)(u.pm - HID_SPLIT) * 256 * FF;
        const int col = u.pn * BM + wc * 32 + 8 * fq;
        EPI_ROWLOOP { const int lr = ai * HALF + wr * 64 + m * 16 + fr; const float r = rtab[lr];
#pragma unroll
            for (int bj = 0; bj < 2; ++bj) { f32x4 v0 = acc[ai][bj][m][0] * r, v1 = acc[ai][bj][m][1] * r;
#pragma unroll
                for (int e = 0; e < 4; ++e) { const float a = fmaxf(v0[e], 0.f), b = fmaxf(v1[e], 0.f); v0[e] = a * a; v1[e] = b * b; }
                st16_wt(base + (size_t)lr * FF + col + bj * HALF, pack8(v0, v1)); } }
    }
};
struct EpiPl {
    bf16_t* PL;
    __device__ __forceinline__ const float* rsrc() const { return nullptr; }
    __device__ __forceinline__ void operator()(const f32x4 (&acc)[2][2][4][2], const Unit& u, int wr, int wc, int fr, int fq, LAS float* rtab, int tid) const {
        const int col = u.pn * BM + wc * 32 + 8 * fq;
        EPI_ROWLOOP { const int row = u.pm * BM + ai * HALF + wr * 64 + m * 16 + fr;
#pragma unroll
            for (int bj = 0; bj < 2; ++bj) *(u32x4*)(PL + (size_t)row * DM + col + bj * HALF) = pack8(acc[ai][bj][m][0], acc[ai][bj][m][1]); }
    }
};
template <bool LAST> struct EpiGate {
    float* HO; const bf16_t* BB; const bf16_t* PL; bf16_t* OB; const float* ssq_in; float* ssq_out; float sc;
    __device__ __forceinline__ const float* rsrc() const { return ssq_in; }
    __device__ __forceinline__ void operator()(const f32x4 (&acc)[2][2][4][2], const Unit& u, int wr, int wc, int fr, int fq, LAS float* rtab, int tid) const {
        const int col = u.pn * BM + wc * 32 + 8 * fq;
#pragma unroll
        for (int ai = 0; ai < 2; ++ai) {
            u32x4 bw[4][2], pw[4][2];
#pragma unroll
            for (int m = 0; m < 4; ++m) { const size_t off0 = (size_t)(u.pm * BM + ai * HALF + wr * 64 + m * 16 + fr) * DM + col;
#pragma unroll
                for (int bj = 0; bj < 2; ++bj) { bw[m][bj] = *(const u32x4*)(BB + off0 + bj * HALF); pw[m][bj] = *(const u32x4*)(PL + off0 + bj * HALF); } }
#pragma unroll
            for (int m = 0; m < 4; ++m) { const int lr = ai * HALF + wr * 64 + m * 16 + fr, row = u.pm * BM + lr; const float r = rtab[lr];
                float s = 0.f;
#pragma unroll
                for (int bj = 0; bj < 2; ++bj) { const size_t off = (size_t)row * DM + col + bj * HALF; const u32x4 b_ = bw[m][bj], p_ = pw[m][bj];
                    const f32x4 b0 = {bflo(b_.x), bfhi(b_.x), bflo(b_.y), bfhi(b_.y)}, b1 = {bflo(b_.z), bfhi(b_.z), bflo(b_.w), bfhi(b_.w)};
                    const f32x4 p0 = {bflo(p_.x), bfhi(p_.x), bflo(p_.y), bfhi(p_.y)}, p1 = {bflo(p_.z), bfhi(p_.z), bflo(p_.w), bfhi(p_.w)};
                    f32x4 v0 = acc[ai][bj][m][0] * r, v1 = acc[ai][bj][m][1] * r;
#pragma unroll
                    for (int e = 0; e < 4; ++e) { v0[e] = b0[e] + fsigmoid(v0[e]) * p0[e] * sc; v1[e] = b1[e] + fsigmoid(v1[e]) * p1[e] * sc; }
                    if (LAST) { *(f32x4*)(HO + off) = v0; *(f32x4*)(HO + off + 4) = v1; }
                    else { *(u32x4*)(OB + off) = pack8(v0, v1);
                        s += (v0[0] * v0[0] + v0[1] * v0[1]) + (v0[2] * v0[2] + v0[3] * v0[3]) + (v1[0] * v1[0] + v1[1] * v1[1]) + (v1[2] * v1[2] + v1[3] * v1[3]); } }
                if (!LAST) { s += __shfl_xor(s, 16); s += __shfl_xor(s, 32); if (fq == 0) ssq_out[ssq_idx(u.pn, row, wc)] = s; } }
        }
    }
};
struct EpiKvq {
    bf16_t* KV; bf16_t* Qb; const float* ssq; float *CKP, *CVP, *CKS, *CVS;
    __device__ __forceinline__ const float* rsrc() const { return ssq; }
    __device__ __forceinline__ void operator()(const f32x4 (&acc)[2][2][4][2], const Unit& u, int wr, int wc, int fr, int fq, LAS float* rtab, int tid) const {
        const int pn = u.pn, c = wc * 32 + 8 * fq;
        EPI_ROWLOOP { const int lr = ai * HALF + wr * 64 + m * 16 + fr, row = u.pm * BM + lr; const float r = rtab[lr];
            float* cdst = nullptr;
            if (pn < 2) {
                if (row < MP) { const int b = row >> 13, t = row & (SEQ - 1); if (t >= SEQ - 128) cdst = (pn == 0 ? CKP : CVP) + ((size_t)(b * 128 + t - (SEQ - 128)) * 256 + c); }
                else { const int rs = row - MP, sb = rs >> 3, i = rs & 7; cdst = (pn == 0 ? CKS : CVS) + ((size_t)(sb * 128 + 120 + i) * 256 + c); }
            }
            bf16_t* dst = pn < 2 ? KV + (size_t)row * 512 + pn * 256 + c : Qb + (size_t)row * DM + (pn - 2) * 256 + c;
#pragma unroll
            for (int bj = 0; bj < 2; ++bj) { const f32x4 v0 = acc[ai][bj][m][0] * r, v1 = acc[ai][bj][m][1] * r;
                *(u32x4*)(dst + bj * HALF) = pack8(v0, v1);
                if (cdst) { *(f32x4*)(cdst + bj * HALF) = v0; *(f32x4*)(cdst + bj * HALF + 4) = v1; } } }
    }
};
}


namespace mg {
constexpr int KT = 256, LDT = KT + 8, TILE_B = 64 * LDT * 2;
template <class Epi>
__device__ __forceinline__ void mini_gemm(LAS unsigned char* lds, const bf16_t* A  , const bf16_t* Bt  , int N, int K, int G, int bx, const Epi& E) {
    const int tid = threadIdx.x, lane = tid & 63, wave = __builtin_amdgcn_readfirstlane(tid >> 6), l15 = lane & 15, g = lane >> 4;
    const int rt = wave & 3, chh = wave >> 2, nk = K / KT, units = 16 * (N / 64);
    LAS float* red = (LAS float*)(lds + 4 * TILE_B);
    for (int u = bx; u < units; u += G) {
        const int rm = u & 15, cn = u >> 4;
        const bf16_t* Ag = A + (size_t)(rm * 64) * K; const bf16_t* Bg = Bt + (size_t)(cn * 64) * K;
        u32x4 ra0[4], rb0[4], ra1[4], rb1[4];
#define MG_LOAD(ra, rb, kt) do { _Pragma("unroll") for (int i = 0; i < 4; ++i) { const int c = tid + 512 * i, row = c >> 5, ch = c & 31; \
            ra[i] = *(const u32x4*)(Ag + (size_t)row * K + (kt) * KT + ch * 8); rb[i] = *(const u32x4*)(Bg + (size_t)row * K + (kt) * KT + ch * 8); } } while (0)
#define MG_STORE(ra, rb, b) do { _Pragma("unroll") for (int i = 0; i < 4; ++i) { const int c = tid + 512 * i, row = c >> 5, ch = c & 31; \
            *(LAS u32x4*)(lds + (b) * 2 * TILE_B + (row * LDT + ch * 8) * 2) = ra[i]; *(LAS u32x4*)(lds + (b) * 2 * TILE_B + TILE_B + (row * LDT + ch * 8) * 2) = rb[i]; } } while (0)
#define MG_COMPUTE(b) do { const LAS bf16_t* Al = (const LAS bf16_t*)(lds + (b) * 2 * TILE_B); const LAS bf16_t* Bl = (const LAS bf16_t*)(lds + (b) * 2 * TILE_B + TILE_B); \
            _Pragma("unroll") for (int ks = 0; ks < KT / 32; ++ks) { const bf16x8 Af = *(const LAS bf16x8*)(Al + (16 * rt + l15) * LDT + 32 * ks + 8 * g); \
                _Pragma("unroll") for (int t = 0; t < 2; ++t) { const bf16x8 Bf = *(const LAS bf16x8*)(Bl + (16 * (2 * chh + t) + l15) * LDT + 32 * ks + 8 * g); \
                    acc[t] = __builtin_amdgcn_mfma_f32_16x16x32_bf16(Bf, Af, acc[t], 0, 0, 0); } } } while (0)
        f32x4 acc[2] = {(f32x4){0.f, 0.f, 0.f, 0.f}, (f32x4){0.f, 0.f, 0.f, 0.f}};
#define MG_BAR() do { asm volatile("s_waitcnt lgkmcnt(0)" ::: "memory"); __builtin_amdgcn_s_barrier(); asm volatile("" ::: "memory"); } while (0)
        MG_LOAD(ra0, rb0, 0); if (nk > 1) MG_LOAD(ra1, rb1, 1);
        MG_STORE(ra0, rb0, 0); MG_BAR();
        for (int kt = 0; kt < nk; kt += 2) {
            if (kt + 2 < nk) MG_LOAD(ra0, rb0, kt + 2);
            MG_COMPUTE(0);
            if (kt + 1 < nk) MG_STORE(ra1, rb1, 1);
            MG_BAR();
            if (kt + 1 < nk) {
                if (kt + 3 < nk) MG_LOAD(ra1, rb1, kt + 3);
                MG_COMPUTE(1);
                if (kt + 2 < nk) MG_STORE(ra0, rb0, 0);
                MG_BAR();
            }
        }
#undef MG_BAR
        const int row = MP + rm * 64 + 16 * rt + l15; float s = 0.f;
#pragma unroll
        for (int t = 0; t < 2; ++t) { const f32x4 o = E(row, cn * 64 + 16 * (2 * chh + t) + 4 * g, acc[t]); s += (o[0] * o[0] + o[1] * o[1]) + (o[2] * o[2] + o[3] * o[3]); }
        if (Epi::SSQ) { s += __shfl_xor(s, 16); s += __shfl_xor(s, 32); if (g == 0) red[(16 * rt + l15) * 2 + chh] = s;
            __syncthreads();
            if (tid < 64) st_wt(E.ssq_out + ssq_idx(cn >> 2, MP + rm * 64 + tid, cn & 3), red[tid * 2] + red[tid * 2 + 1]);
            __syncthreads(); }
#undef MG_LOAD
#undef MG_STORE
#undef MG_COMPUTE
    }
}
__device__ __forceinline__ u32x2 pack4(const f32x4 v) { u32x2 w; w.x = pk2(v[0], v[1]); w.y = pk2(v[2], v[3]); return w; }
template <bool FROM_X> struct MRes {
    static constexpr bool SSQ = true; const float* X1; const bf16_t* BB; bf16_t* XO; float* ssq_out; float sc;
    __device__ __forceinline__ f32x4 operator()(int row, int col, const f32x4 v) const {
        f32x4 b; if (FROM_X) b = *(const f32x4*)(X1 + (size_t)(row - MP) * DM + col); else { const u32x2 w = *(const u32x2*)(BB + (size_t)row * DM + col); b = (f32x4){bflo(w.x), bfhi(w.x), bflo(w.y), bfhi(w.y)}; }
        const f32x4 o = b + v * sc; *(u32x2*)(XO + (size_t)row * DM + col) = pack4(o); return o; }
};
struct MPl { static constexpr bool SSQ = false; bf16_t* PL; float* ssq_out;
    __device__ __forceinline__ f32x4 operator()(int row, int col, const f32x4 v) const { *(u32x2*)(PL + (size_t)row * DM + col) = pack4(v); return v; } };
struct MUp { static constexpr bool SSQ = false; bf16_t* HS  ; const float* ssq; float* ssq_out;
    __device__ __forceinline__ f32x4 operator()(int row, int col, const f32x4 v) const { const float r = row_r(ssq, row); f32x4 o;
#pragma unroll
        for (int e = 0; e < 4; ++e) { const float a = fmaxf(v[e] * r, 0.f); o[e] = a * a; }
        *(u32x2*)(HS + (size_t)(row - MP) * FF + col) = pack4(o); return o; } };
template <bool LAST> struct MGate { static constexpr bool SSQ = !LAST; float* HO; const bf16_t* BB; const bf16_t* PL; bf16_t* OB; const float* ssq_in; float* ssq_out; float sc;
    __device__ __forceinline__ f32x4 operator()(int row, int col, const f32x4 v) const { const float r = row_r(ssq_in, row); const size_t off = (size_t)row * DM + col;
        const u32x2 bw = *(const u32x2*)(BB + off), pw = *(const u32x2*)(PL + off);
        const f32x4 b = {bflo(bw.x), bfhi(bw.x), bflo(bw.y), bfhi(bw.y)}, p = {bflo(pw.x), bfhi(pw.x), bflo(pw.y), bfhi(pw.y)}; f32x4 o;
#pragma unroll
        for (int e = 0; e < 4; ++e) o[e] = b[e] + fsigmoid(v[e] * r) * p[e] * sc;
        if (LAST) *(f32x4*)(HO + off) = o; else *(u32x2*)(OB + off) = pack4(o); return o; } };
}

constexpr int NWAVES = 8, NTHREADS = 512;
constexpr int RING_BYTES = 131072, LDS_BYTES = 147456;
struct Args { const float* in[26]; float* out; unsigned char* ws; int ph_lo, ph_hi; };

struct TJob { const float* src; int ldw, kk, nblk; bf16_t* dst; const float* gain; float scale; int item; };
__device__ __forceinline__ void p0_tload(const TJob& J, float (&r)[32], int lane) {
    const int kb = J.item / J.nblk, nb = J.item % J.nblk, k0 = 64 * kb, n0 = 32 * nb;
#pragma unroll
    for (int i = 0; i < 32; ++i) r[i] = __builtin_nontemporal_load(J.src + (size_t)(k0 + 2 * i + (lane >> 5)) * J.ldw + n0 + (lane & 31));
}
__device__ __forceinline__ void p0_tfinish(const TJob& J, const float (&r)[32], LAS float* scr, int lane) {
    const int kb = J.item / J.nblk, nb = J.item % J.nblk, k0 = 64 * kb, n0 = 32 * nb, c = lane & 7;
    f32x4 g0 = {1.f, 1.f, 1.f, 1.f}, g1 = g0;
    if (J.gain) { g0 = *(const f32x4*)(J.gain + k0 + 8 * c); g1 = *(const f32x4*)(J.gain + k0 + 8 * c + 4); }
    g0 *= J.scale; g1 *= J.scale;
#pragma unroll
    for (int i = 0; i < 32; ++i) scr[(2 * i + (lane >> 5)) * 33 + (lane & 31)] = r[i];
    asm volatile("s_waitcnt lgkmcnt(0)" ::: "memory");
#pragma unroll
    for (int j = 0; j < 4; ++j) { const int n = (lane >> 3) + 8 * j; const LAS float* sp = scr + (8 * c) * 33 + n;
        u32x4 o; o.x = pk2(sp[0 * 33] * g0.x, sp[1 * 33] * g0.y); o.y = pk2(sp[2 * 33] * g0.z, sp[3 * 33] * g0.w); o.z = pk2(sp[4 * 33] * g1.x, sp[5 * 33] * g1.y); o.w = pk2(sp[6 * 33] * g1.z, sp[7 * 33] * g1.w);
        *(u32x4*)(J.dst + (size_t)(n0 + n) * J.kk + k0 + 8 * c) = o; }
    asm volatile("s_waitcnt lgkmcnt(0)" ::: "memory");
}

constexpr int T128 = 144, T256 = 272, TP = 80;
#define LDS_BAR() do { asm volatile("s_waitcnt lgkmcnt(0)" ::: "memory"); __builtin_amdgcn_s_barrier(); asm volatile("" ::: "memory"); } while (0)
struct GlaRegs { u32x4 lg[2], v[4], k[2], q[2]; };
template <bool WITH_Q, bool DO_LKQ = true, bool DO_V = true>
__device__ __forceinline__ void gla_fetch(GlaRegs& R, int item, const bf16_t* Q1, const bf16_t* K1, const bf16_t* V1, const bf16_t* LGp, int tid) {
    const int bh = item >> 7, c = item & 127, b = bh >> 2, h = bh & 3; const size_t row0 = (size_t)b * SEQ + c * 64;
    if (DO_LKQ) {
#pragma unroll
        for (int i = 0; i < 2; ++i) { const int x = tid + NTHREADS * i, j = x >> 4, d8 = (x & 15) * 8; const size_t off = (row0 + j) * NQK + h * 128 + d8;
            R.lg[i] = *(const u32x4*)(LGp + off); R.k[i] = *(const u32x4*)(K1 + off); if (WITH_Q) R.q[i] = *(const u32x4*)(Q1 + off); } }
    if (DO_V) {
#pragma unroll
        for (int i = 0; i < 4; ++i) { const int x = tid + NTHREADS * i, j = x >> 5, e8 = (x & 31) * 8; R.v[i] = *(const u32x4*)(V1 + (row0 + j) * NV + h * 256 + e8); } }
}
__device__ __forceinline__ void gla_stage_lg_v(const GlaRegs& R, LAS float* bc, LAS bf16_t* vt, int tid) {
#pragma unroll
    for (int i = 0; i < 2; ++i) { const int x = tid + NTHREADS * i, j = x >> 4, d8 = (x & 15) * 8; const u32x4 w = R.lg[i];
        *(LAS f32x4*)(bc + j * 128 + d8) = (f32x4){bflo(w.x), bfhi(w.x), bflo(w.y), bfhi(w.y)}; *(LAS f32x4*)(bc + j * 128 + d8 + 4) = (f32x4){bflo(w.z), bfhi(w.z), bflo(w.w), bfhi(w.w)}; }
#pragma unroll
    for (int i = 0; i < 4; ++i) { const int x = tid + NTHREADS * i, j = x >> 5, e8 = (x & 31) * 8; *(LAS u32x4*)(vt + j * T256 + e8) = R.v[i]; }
    LDS_BAR();
    if (tid < 128) { float s = 0.f;
#pragma unroll 8
        for (int j = 0; j < 64; ++j) { s += bc[j * 128 + tid]; bc[j * 128 + tid] = s; } }
    LDS_BAR();
}
constexpr int NSUP = 32, NSUP_ALL = NBH * NSUP;
template <bool OUT>
__device__ __forceinline__ void gla_super_phase(LAS unsigned char* lds, int G, int bx, const bf16_t* Q1, const bf16_t* K1, const bf16_t* V1, const bf16_t* G1, const bf16_t* LGp, bf16_t* US, float* DVS,
                                                const float* ogain, bf16_t* OG, float* SOUT, int tid, int lane, int wave) {
    LAS float* bc = (LAS float*)lds;
    LAS bf16_t* Pm = (LAS bf16_t*)lds;
    LAS bf16_t* qt = (LAS bf16_t*)(lds + 32768);
    LAS bf16_t* kt = qt + 64 * T128;
    LAS bf16_t* kd = kt + 64 * T128;
    LAS bf16_t* vt = kd + 64 * T128;
    LAS float* red = (LAS float*)(lds + 32768 + 3 * 64 * T128 * 2 + 64 * T256 * 2);
    LAS float* em = red + 512;
    LAS float* dvl = em + 128;
    const int l15 = lane & 15, g = lane >> 4, q = l15 >> 2, p = l15 & 3;
    f32x4 gn[2] = {(f32x4){0.f, 0.f, 0.f, 0.f}, (f32x4){0.f, 0.f, 0.f, 0.f}};
    if (OUT) {
#pragma unroll
        for (int t = 0; t < 2; ++t) gn[t] = *(const f32x4*)(ogain + 16 * (2 * wave + t) + 4 * g); }
    GlaRegs R;
    if (bx < NSUP_ALL) gla_fetch<OUT>(R, (bx >> 5) * NCHUNK + (bx & 31) * 4, Q1, K1, V1, LGp, tid);
    for (int item = bx; item < NSUP_ALL; item += G) {
        const int bh = item >> 5, sc = item & 31, b = bh >> 2, h = bh & 3;
        f32x4 S[8][2];
        if (OUT) {
#pragma unroll
            for (int dt = 0; dt < 8; ++dt)
#pragma unroll
                for (int t = 0; t < 2; ++t) { const u32x2 w = *(const u32x2*)(US + ((size_t)item * 256 + 16 * (2 * wave + t) + l15) * 128 + 16 * dt + 4 * g); S[dt][t] = (f32x4){bflo(w.x), bfhi(w.x), bflo(w.y), bfhi(w.y)}; }
        } else {
#pragma unroll
            for (int dt = 0; dt < 8; ++dt) { S[dt][0] = (f32x4){0.f, 0.f, 0.f, 0.f}; S[dt][1] = (f32x4){0.f, 0.f, 0.f, 0.f}; } }
        float lsum = 0.f;
        for (int cc = 0; cc < 4; ++cc) {
            const int c = sc * 4 + cc; const size_t row0 = (size_t)b * SEQ + c * 64;
            gla_stage_lg_v(R, bc, vt, tid);
#pragma unroll
            for (int i = 0; i < 2; ++i) { const int x = tid + NTHREADS * i, j = x >> 4, d8 = (x & 15) * 8; const u32x4 wk = R.k[i];
                float kv[8] = {bflo(wk.x), bfhi(wk.x), bflo(wk.y), bfhi(wk.y), bflo(wk.z), bfhi(wk.z), bflo(wk.w), bfhi(wk.w)};
                float cur[8], dd[8];
#pragma unroll
                for (int t = 0; t < 8; ++t) { cur[t] = bc[j * 128 + d8 + t]; dd[t] = kv[t] * fexp(bc[63 * 128 + d8 + t] - cur[t]); }
                u32x4 o; o.x = pk2(dd[0], dd[1]); o.y = pk2(dd[2], dd[3]); o.z = pk2(dd[4], dd[5]); o.w = pk2(dd[6], dd[7]); *(LAS u32x4*)(kd + j * T128 + d8) = o;
                if (OUT) { const u32x4 wq = R.q[i];
                    float qv[8] = {bflo(wq.x), bfhi(wq.x), bflo(wq.y), bfhi(wq.y), bflo(wq.z), bfhi(wq.z), bflo(wq.w), bfhi(wq.w)};
                    float a[8], bb[8];
#pragma unroll
                    for (int t = 0; t < 8; ++t) { const float mid = bc[31 * 128 + d8 + t]; a[t] = qv[t] * fexp(cur[t] - mid); bb[t] = kv[t] * fexp(mid - cur[t]); }
                    o.x = pk2(a[0], a[1]); o.y = pk2(a[2], a[3]); o.z = pk2(a[4], a[5]); o.w = pk2(a[6], a[7]); *(LAS u32x4*)(qt + j * T128 + d8) = o;
                    o.x = pk2(bb[0], bb[1]); o.y = pk2(bb[2], bb[3]); o.z = pk2(bb[4], bb[5]); o.w = pk2(bb[6], bb[7]); *(LAS u32x4*)(kt + j * T128 + d8) = o; } }
            if (tid < 128) { const float last = bc[63 * 128 + tid]; dvl[tid] = fexp(last); lsum += last; if (OUT) em[tid] = fexp(bc[31 * 128 + tid]); }
            const int nxt_ = (cc < 3) ? bh * NCHUNK + c + 1 : (item + G < NSUP_ALL ? ((item + G) >> 5) * NCHUNK + ((item + G) & 31) * 4 : -1);
            if (nxt_ >= 0) gla_fetch<OUT, true, false>(R, nxt_, Q1, K1, V1, LGp, tid);
            LDS_BAR();
            if (OUT) {
#pragma unroll
                for (int t = 0; t < 2; ++t) { const int id = 2 * wave + t, ti = id >> 2, tj = id & 3;
                    f32x4 a = {0.f, 0.f, 0.f, 0.f};
                    if (tj <= ti) {
#pragma unroll
                        for (int ks = 0; ks < 4; ++ks) { const bf16x8 Af = *(const LAS bf16x8*)(qt + (16 * ti + l15) * T128 + 32 * ks + 8 * g), Bf = *(const LAS bf16x8*)(kt + (16 * tj + l15) * T128 + 32 * ks + 8 * g);
                            a = __builtin_amdgcn_mfma_f32_16x16x32_bf16(Af, Bf, a, 0, 0, 0); } }
#pragma unroll
                    for (int r = 0; r < 4; ++r) { const int i = 16 * ti + 4 * g + r, j = 16 * tj + l15; const float v = (j <= i) ? a[r] : 0.f; Pm[i * TP + j] = (bf16_t)(pk2(v, 0.f) & 0xffffu); }
                }
                LDS_BAR();
                f32x4 o[4][2];
#pragma unroll
                for (int ti = 0; ti < 4; ++ti) { o[ti][0] = (f32x4){0.f, 0.f, 0.f, 0.f}; o[ti][1] = (f32x4){0.f, 0.f, 0.f, 0.f}; }
#pragma unroll
                for (int ks = 0; ks < 2; ++ks) {
                    bf16x8 Bf[2];
#pragma unroll
                    for (int t = 0; t < 2; ++t) { const LAS bf16_t* a0 = vt + (32 * ks + 8 * g + q) * T256 + 16 * (2 * wave + t) + 4 * p; Bf[t] = cat8(trd(a0), trd(a0 + 4 * T256)); }
#pragma unroll
                    for (int ti = 2 * ks; ti < 4; ++ti) { const bf16x8 Af = *(const LAS bf16x8*)(Pm + (16 * ti + l15) * TP + 32 * ks + 8 * g);
#pragma unroll
                        for (int t = 0; t < 2; ++t) o[ti][t] = __builtin_amdgcn_mfma_f32_16x16x32_bf16(Bf[t], Af, o[ti][t], 0, 0, 0); }
                }
#pragma unroll
                for (int ks = 0; ks < 4; ++ks) {
                    const f32x4 e0 = *(LAS f32x4*)(em + 32 * ks + 4 * g), e1 = *(LAS f32x4*)(em + 32 * ks + 16 + 4 * g);
                    bf16x8 Bf[2];
#pragma unroll
                    for (int t = 0; t < 2; ++t) { const f32x4 s0 = S[2 * ks][t] * e0, s1 = S[2 * ks + 1][t] * e1; u32x4 w; w.x = pk2(s0[0], s0[1]); w.y = pk2(s0[2], s0[3]); w.z = pk2(s1[0], s1[1]); w.w = pk2(s1[2], s1[3]); Bf[t] = __builtin_bit_cast(bf16x8, w); }
#pragma unroll
                    for (int ti = 0; ti < 4; ++ti) { const LAS bf16_t* ap = qt + (16 * ti + l15) * T128 + 32 * ks + 4 * g;
                        const u32x2 a0 = *(const LAS u32x2*)ap, a1 = *(const LAS u32x2*)(ap + 16); u32x4 aw; aw.x = a0.x; aw.y = a0.y; aw.z = a1.x; aw.w = a1.y; const bf16x8 Af = __builtin_bit_cast(bf16x8, aw);
#pragma unroll
                        for (int t = 0; t < 2; ++t) o[ti][t] = __builtin_amdgcn_mfma_f32_16x16x32_bf16(Bf[t], Af, o[ti][t], 0, 0, 0); }
                }
#pragma unroll
                for (int ti = 0; ti < 4; ++ti) { float s = 0.f;
#pragma unroll
                    for (int t = 0; t < 2; ++t) s += (o[ti][t][0] * o[ti][t][0] + o[ti][t][1] * o[ti][t][1]) + (o[ti][t][2] * o[ti][t][2] + o[ti][t][3] * o[ti][t][3]);
                    s += __shfl_xor(s, 16); s += __shfl_xor(s, 32);
                    if (g == 0) red[(16 * ti + l15) * 8 + wave] = s; }
                LDS_BAR();
#pragma unroll
                for (int ti = 0; ti < 4; ++ti) { const int i = 16 * ti + l15; const f32x4 r0 = *(LAS f32x4*)(red + i * 8), r1 = *(LAS f32x4*)(red + i * 8 + 4);
                    const float rms = frsq(((r0.x + r0.y) + (r0.z + r0.w) + (r1.x + r1.y) + (r1.z + r1.w)) * (1.f / 256.f) + EPS);
#pragma unroll
                    for (int t = 0; t < 2; ++t) { const size_t off = (row0 + i) * NV + h * 256 + 16 * (2 * wave + t) + 4 * g; const u32x2 gw_ = *(const u32x2*)(G1 + off);
                        const f32x4 gv = {bflo(gw_.x), bfhi(gw_.x), bflo(gw_.y), bfhi(gw_.y)}; f32x4 ov;
#pragma unroll
                        for (int r = 0; r < 4; ++r) ov[r] = o[ti][t][r] * rms * gn[t][r] * gv[r] * fsigmoid(gv[r]);
                        u32x2 w; w.x = pk2(ov[0], ov[1]); w.y = pk2(ov[2], ov[3]); *(u32x2*)(OG + off) = w; } }
            }
            if (nxt_ >= 0) gla_fetch<OUT, false, true>(R, nxt_, Q1, K1, V1, LGp, tid);
#pragma unroll
            for (int dt = 0; dt < 8; ++dt) { const f32x4 dvv = *(LAS f32x4*)(dvl + 16 * dt + 4 * g); S[dt][0] *= dvv; S[dt][1] *= dvv; }
#pragma unroll
            for (int ks = 0; ks < 2; ++ks) {
                bf16x8 Bf[2];
#pragma unroll
                for (int t = 0; t < 2; ++t) { const LAS bf16_t* a0 = vt + (32 * ks + 8 * g + q) * T256 + 16 * (2 * wave + t) + 4 * p; Bf[t] = cat8(trd(a0), trd(a0 + 4 * T256)); }
#pragma unroll
                for (int dt = 0; dt < 8; ++dt) { const LAS bf16_t* a0 = kd + (32 * ks + 8 * g + q) * T128 + 16 * dt + 4 * p; const bf16x8 Af = cat8(trd(a0), trd(a0 + 4 * T128));
#pragma unroll
                    for (int t = 0; t < 2; ++t) S[dt][t] = __builtin_amdgcn_mfma_f32_16x16x32_bf16(Af, Bf[t], S[dt][t], 0, 0, 0); }
            }
            LDS_BAR();
        }
        if (OUT && sc == NSUP - 1) {
            float* so = SOUT + (size_t)bh * 128 * 256 + (size_t)(4 * g) * 256 + 32 * wave + l15;
#pragma unroll
            for (int dt = 0; dt < 8; ++dt) {
#pragma unroll
                for (int t = 0; t < 2; ++t)
#pragma unroll
                    for (int r = 0; r < 4; ++r) so[r * 256 + 16 * t] = S[dt][t][r];
                so += 16 * 256; asm volatile("" : "+v"(so));
            }
        }
        if (!OUT) {
#pragma unroll
            for (int dt = 0; dt < 8; ++dt)
#pragma unroll
                for (int t = 0; t < 2; ++t) { u32x2 w; w.x = pk2(S[dt][t][0], S[dt][t][1]); w.y = pk2(S[dt][t][2], S[dt][t][3]);
                    *(u32x2*)(US + ((size_t)item * 256 + 16 * (2 * wave + t) + l15) * 128 + 16 * dt + 4 * g) = w; }
            if (tid < 128) DVS[(size_t)item * 128 + tid] = fexp(lsum);
        }
    }
}
template <int NSTEP>
__device__ __forceinline__ void gla_scan(bf16_t* UT, const float* DV, float* state_out, int gtid, int gthreads) {
    for (int idx = gtid; idx < NBH * 256 * 64; idx += gthreads) {
        const int bh = idx >> 14, rem = idx & 16383, e = rem >> 6, dp = rem & 63;
        unsigned* base = (unsigned*)UT + (size_t)bh * NSTEP * 16384 + e * 64 + dp;
        const float* dv = DV + (size_t)bh * NSTEP * 128 + 2 * dp;
        float s0 = 0.f, s1 = 0.f;
        for (int c0 = 0; c0 < NSTEP; c0 += 32) {
            unsigned uu[32]; f32x2 dd[32];
#pragma unroll
            for (int k = 0; k < 32; ++k) { uu[k] = base[(size_t)(c0 + k) * 16384]; dd[k] = *(const f32x2*)(dv + (size_t)(c0 + k) * 128); }
#pragma unroll
            for (int k = 0; k < 32; ++k) { base[(size_t)(c0 + k) * 16384] = pk2(s0, s1); s0 = dd[k].x * s0 + bflo(uu[k]); s1 = dd[k].y * s1 + bfhi(uu[k]); }
        }
        (void)state_out;
    }
}
__device__ __forceinline__ void gla_sample_pair(LAS unsigned char* lds, int base_item, const bf16_t* Q1, const bf16_t* K1, const bf16_t* V1, const bf16_t* G1, const bf16_t* LGp,
                                                const float* S0in, float* Sout, const float* ogain, bf16_t* OG, int tid) {
    const int hb = tid >> 8, t = tid & 255, item = base_item + hb, sb = item >> 2, h = item & 3; const size_t r0 = (size_t)MP + sb * 8;
    LAS float* qaT = (LAS float*)(lds + hb * 16384);
    LAS float* qsT = qaT + 1024, *kdT = qsT + 1024, *dvs = kdT + 1024, *att = dvs + 128, *red = att + 64;
    if (t < 128) { const int d = t; float bcv[8], s = 0.f;
#pragma unroll
        for (int i = 0; i < 8; ++i) { s += bf2f(LGp[(r0 + i) * NQK + h * 128 + d]); bcv[i] = s; }
#pragma unroll
        for (int i = 0; i < 8; ++i) { const float qv = bf2f(Q1[(r0 + i) * NQK + h * 128 + d]), kv = bf2f(K1[(r0 + i) * NQK + h * 128 + d]);
            qaT[d * 8 + i] = qv * fexp(bcv[i] - bcv[7]); qsT[d * 8 + i] = qv * fexp(bcv[i]); kdT[d * 8 + i] = kv * fexp(bcv[7] - bcv[i]); }
        dvs[d] = fexp(bcv[7]); }
    __syncthreads();
    if (t < 64) { const int i = t >> 3, j = t & 7; float s = 0.f;
        for (int d = 0; d < 128; ++d) s += qaT[d * 8 + i] * kdT[d * 8 + j];
        att[t] = (j <= i) ? s : 0.f; }
    __syncthreads();
    const int e = t; float v[8], o[8];
#pragma unroll
    for (int j = 0; j < 8; ++j) { v[j] = bf2f(V1[(r0 + j) * NV + h * 256 + e]); o[j] = 0.f; }
    const float* S0 = S0in + ((size_t)item * 128) * 256 + e; float* SO = Sout + ((size_t)item * 128) * 256 + e;
    for (int d0 = 0; d0 < 128; d0 += 32) { float sv[32];
#pragma unroll
        for (int k = 0; k < 32; ++k) sv[k] = __builtin_nontemporal_load(S0 + (size_t)(d0 + k) * 256);
#pragma unroll
        for (int k = 0; k < 32; ++k) { const int d = d0 + k; const f32x4 qa = *(LAS f32x4*)(qsT + d * 8), qb = *(LAS f32x4*)(qsT + d * 8 + 4), ka = *(LAS f32x4*)(kdT + d * 8), kb = *(LAS f32x4*)(kdT + d * 8 + 4);
            o[0] += qa.x * sv[k]; o[1] += qa.y * sv[k]; o[2] += qa.z * sv[k]; o[3] += qa.w * sv[k]; o[4] += qb.x * sv[k]; o[5] += qb.y * sv[k]; o[6] += qb.z * sv[k]; o[7] += qb.w * sv[k];
            __builtin_nontemporal_store(dvs[d] * sv[k] + ((ka.x * v[0] + ka.y * v[1]) + (ka.z * v[2] + ka.w * v[3])) + ((kb.x * v[4] + kb.y * v[5]) + (kb.z * v[6] + kb.w * v[7])), SO + (size_t)d * 256); }
    }
#pragma unroll
    for (int i = 0; i < 8; ++i)
#pragma unroll
        for (int j = 0; j <= i; ++j) o[i] += att[i * 8 + j] * v[j];
    const int wv = t >> 6;
#pragma unroll
    for (int i = 0; i < 8; ++i) { const float s = wave_sum(o[i] * o[i]); if ((t & 63) == 0) red[i * 4 + wv] = s; }
    __syncthreads();
    const float gn = ogain[e];
#pragma unroll
    for (int i = 0; i < 8; ++i) { const f32x4 rr = *(LAS f32x4*)(red + i * 4); const float rms = frsq(((rr.x + rr.y) + (rr.z + rr.w)) * (1.f / 256.f) + EPS);
        const size_t off = (r0 + i) * NV + h * 256 + e; const float gv = bf2f(G1[off]);
        OG[off] = (bf16_t)(pk2(o[i] * rms * gn * gv * fsigmoid(gv), 0.f) & 0xffffu); }
    __syncthreads();
}

constexpr int VT_LD = 72;
struct AttnP { const bf16_t* KV; const bf16_t* Qb; bf16_t* AO; const float* pk; const float* pv; float* ock; float* ocv; const float* sinks; const float* relb; };
constexpr int ATT_BUF = 32768 + 256 * VT_LD * 2 + 2048;
struct AttnRegs { u32x4 a[12]; };
#define ATT_DECODE(item) const bool smp = (item) >= 512; int b, kh, qblk, sb = 0; \
    if (!smp) { b = (item) >> 8; kh = ((item) >> 6) & 3; qblk = (item) & 63; } else { const int it_ = (item) - 512; sb = it_ >> 2; kh = it_ & 3; b = 0; qblk = 1; } \
    const long s0 = (long)b * SEQ + (long)qblk * 128; (void)s0; (void)sb
__device__ __forceinline__ void attn_load(int item, const AttnP& P, AttnRegs& R, int tid) {
    ATT_DECODE(item);
    if (!smp) {
#pragma unroll
        for (int j = 0; j < 4; ++j) { const int i = tid + NTHREADS * j, row = i >> 3, ch = i & 7; u32x4 wk = {0u, 0u, 0u, 0u}, wv = {0u, 0u, 0u, 0u};
            if (qblk > 0 || row >= 128) { const bf16_t* src = P.KV + (size_t)(s0 - 128 + row) * 512 + kh * 64 + ch * 8; wk = *(const u32x4*)src; wv = *(const u32x4*)(src + 256); }
            R.a[j] = wk; R.a[4 + j] = wv; }
    } else {
#pragma unroll
        for (int j = 0; j < 3; ++j) { const int i = tid + NTHREADS * j, row = i >> 3, ch = i & 7;
            u32x4 z = {0u, 0u, 0u, 0u}; R.a[4 * j] = z; R.a[4 * j + 1] = z; R.a[4 * j + 2] = z; R.a[4 * j + 3] = z;
            if (row < 128) { const size_t so = ((size_t)(sb * 128 + row) * 4 + kh) * 64 + ch * 8;
                R.a[4 * j] = *(const u32x4*)(P.pk + so); R.a[4 * j + 1] = *(const u32x4*)(P.pk + so + 4); R.a[4 * j + 2] = *(const u32x4*)(P.pv + so); R.a[4 * j + 3] = *(const u32x4*)(P.pv + so + 4); }
            else if (row < 136) { const bf16_t* src = P.KV + (size_t)(MP + sb * 8 + row - 128) * 512 + kh * 64 + ch * 8; R.a[4 * j] = *(const u32x4*)src; R.a[4 * j + 1] = *(const u32x4*)(src + 256); } }
    }
}
__device__ __forceinline__ void attn_stage(LAS unsigned char* lds, int item, const AttnP& P, const AttnRegs& R, int tid) {
    LAS unsigned char* Kt = lds; LAS bf16_t* Vt = (LAS bf16_t*)(lds + 32768); LAS float* bias2 = (LAS float*)(lds + 32768 + 256 * VT_LD * 2);
    ATT_DECODE(item);
    if (!smp) {
#pragma unroll
        for (int j = 0; j < 4; ++j) { const int i = tid + NTHREADS * j, row = i >> 3, ch = i & 7;
            *(LAS u32x4*)(Kt + row * 128 + ((ch ^ (row & 7)) << 4)) = R.a[j]; *(LAS u32x4*)(Vt + row * VT_LD + ch * 8) = R.a[4 + j]; }
    } else {
#pragma unroll
        for (int j = 0; j < 3; ++j) { const int i = tid + NTHREADS * j, row = i >> 3, ch = i & 7;
            if (i < 144 * 8) { u32x4 wk = R.a[4 * j], wv = R.a[4 * j + 1];
                if (row < 128) { const f32x4 k0 = __builtin_bit_cast(f32x4, R.a[4 * j]), k1 = __builtin_bit_cast(f32x4, R.a[4 * j + 1]), v0 = __builtin_bit_cast(f32x4, R.a[4 * j + 2]), v1 = __builtin_bit_cast(f32x4, R.a[4 * j + 3]);
                    wk = pg8::pack8(k0, k1); wv = pg8::pack8(v0, v1);
                    if (row >= 8) { const size_t oo = ((size_t)(sb * 128 + row - 8) * 4 + kh) * 64 + ch * 8;
                        *(f32x4*)(P.ock + oo) = k0; *(f32x4*)(P.ock + oo + 4) = k1; *(f32x4*)(P.ocv + oo) = v0; *(f32x4*)(P.ocv + oo + 4) = v1; } }
                *(LAS u32x4*)(Kt + row * 128 + ((ch ^ (row & 7)) << 4)) = wk; *(LAS u32x4*)(Vt + row * VT_LD + ch * 8) = wv; } }
    }
    { const int hl = tid >> 7, dist = tid & 127; int bk = dist;
      if (dist >= 16) { bk = 16 + (int)(__logf((float)dist * (1.f / 16.f)) * (16.f / 2.0794415416798357f)); bk = bk > 31 ? 31 : bk; }
      bias2[tid] = P.relb[bk * 16 + kh * 4 + hl] * LOG2E; }
}
__device__ __forceinline__ void attn_compute(LAS unsigned char* lds, int item, const AttnP& P, int lane, int wave) {
    LAS unsigned char* Kt = lds; LAS bf16_t* Vt = (LAS bf16_t*)(lds + 32768); LAS float* bias2 = (LAS float*)(lds + 32768 + 256 * VT_LD * 2);
    ATT_DECODE(item);
    const int l15 = lane & 15, g = lane >> 4, q = l15 >> 2, p = l15 & 3;
    const int ntq = smp ? (wave < 2 ? 1 : 0) : 4;
    for (int tq = 0; tq < ntq; ++tq) {
        const int qtile = smp ? 0 : (wave & 1) * 4 + tq;
        int hl_q, ioff; size_t qrow;
        if (!smp) { hl_q = wave >> 1; ioff = l15; qrow = (size_t)(s0 + 16 * qtile + l15); }
        else { hl_q = 2 * wave + (l15 >> 3); ioff = l15 & 7; qrow = (size_t)MP + sb * 8 + (l15 & 7); }
        const bf16_t* qp = P.Qb + qrow * DM + (kh * 4 + hl_q) * 64 + 8 * g;
        const bf16x8 Qf0 = *(const bf16x8*)qp, Qf1 = *(const bf16x8*)(qp + 32);
        f32x4 st[9];
#pragma unroll
        for (int j = 0; j < 9; ++j) { const int row = 16 * (qtile + j) + l15; const LAS unsigned char* kr = Kt + row * 128;
            const bf16x8 K0 = *(const LAS bf16x8*)(kr + ((g ^ (row & 7)) << 4)), K1f = *(const LAS bf16x8*)(kr + (((4 + g) ^ (row & 7)) << 4));
            f32x4 a = {0.f, 0.f, 0.f, 0.f};
            a = __builtin_amdgcn_mfma_f32_16x16x32_bf16(K0, Qf0, a, 0, 0, 0); a = __builtin_amdgcn_mfma_f32_16x16x32_bf16(K1f, Qf1, a, 0, 0, 0);
            st[j] = a; }
        const float sink2 = P.sinks[kh * 4 + hl_q] * LOG2E;
        float mx = sink2;
#pragma unroll
        for (int j = 0; j < 9; ++j)
#pragma unroll
            for (int r = 0; r < 4; ++r) { const int dist = 128 + ioff - 16 * j - 4 * g - r; const bool ok = (dist >= 0) && (dist < 128) && (smp || qblk > 0 || (16 * (qtile + j) + 4 * g + r) >= 128);
                const float v = ok ? st[j][r] + bias2[hl_q * 128 + (dist & 127)] : -INFINITY; st[j][r] = v; mx = fmaxf(mx, v); }
        mx = fmaxf(mx, __shfl_xor(mx, 16)); mx = fmaxf(mx, __shfl_xor(mx, 32));
        float sum = 0.f;
#pragma unroll
        for (int j = 0; j < 9; ++j)
#pragma unroll
            for (int r = 0; r < 4; ++r) { const float e = __builtin_amdgcn_exp2f(st[j][r] - mx); st[j][r] = e; sum += e; }
        sum += __shfl_xor(sum, 16); sum += __shfl_xor(sum, 32);
        const float inv = frcp(sum + __builtin_amdgcn_exp2f(sink2 - mx));
        f32x4 o[4];
#pragma unroll
        for (int dt = 0; dt < 4; ++dt) o[dt] = (f32x4){0.f, 0.f, 0.f, 0.f};
#pragma unroll
        for (int kk = 0; kk < 5; ++kk) {
            u32x4 pw; pw.x = pk2(st[2 * kk][0], st[2 * kk][1]); pw.y = pk2(st[2 * kk][2], st[2 * kk][3]);
            if (kk < 4) { pw.z = pk2(st[2 * kk + 1][0], st[2 * kk + 1][1]); pw.w = pk2(st[2 * kk + 1][2], st[2 * kk + 1][3]); } else { pw.z = 0u; pw.w = 0u; }
            const bf16x8 Pf = __builtin_bit_cast(bf16x8, pw);
            const LAS bf16_t* v0p = Vt + (16 * (qtile + 2 * kk) + 4 * g + q) * VT_LD + 4 * p;
#pragma unroll
            for (int dt = 0; dt < 4; ++dt) { const s16x4 lo = trd(v0p + 16 * dt); const s16x4 hi = (kk < 4) ? trd(v0p + 16 * VT_LD + 16 * dt) : (s16x4){0, 0, 0, 0};
                o[dt] = __builtin_amdgcn_mfma_f32_16x16x32_bf16(cat8(lo, hi), Pf, o[dt], 0, 0, 0); }
        }
        { bf16_t* op = P.AO + qrow * DM + (kh * 4 + hl_q) * 64 + 4 * g;
#pragma unroll
          for (int dt = 0; dt < 4; ++dt) { u32x2 w; w.x = pk2(o[dt][0] * inv, o[dt][1] * inv); w.y = pk2(o[dt][2] * inv, o[dt][3] * inv); *(u32x2*)(op + 16 * dt) = w; } }
    }
}


#define XB_TMO      128
#define XB_XCNT(j)  (256  + 64 * (j))
#define XB_XSUB(j)  (1280 + 64 * (j))
#define XB_XGEN(j)  (2304 + 64 * (j))
#define XB_TOP      3328
#define XB_TOPGEN   3392
#define XCD_BAR_WORDS 3456
#define XB_SPIN_CAP (1u << 20)
__device__ __forceinline__ unsigned xb_ld(unsigned* p)              { return __hip_atomic_load(p, __ATOMIC_RELAXED, __HIP_MEMORY_SCOPE_AGENT); }
__device__ __forceinline__ unsigned xb_add(unsigned* p, unsigned v) { return __hip_atomic_fetch_add(p, v, __ATOMIC_RELAXED, __HIP_MEMORY_SCOPE_AGENT); }
__device__ __forceinline__ unsigned xb_xcc_id() { return (unsigned)__builtin_amdgcn_s_getreg((3 << 11) | 20) & 0xFu; }
#define XB_SPIN(cond, bar) do { unsigned _sp = 0; while (cond) { __builtin_amdgcn_s_sleep(1); \
    if ((++_sp & 255u) == 0u) { if (xb_ld(&(bar)[XB_TMO])) break; if (_sp > XB_SPIN_CAP) { atomicAdd(&(bar)[XB_TMO], 1u); break; } } } } while (0)
struct XcdBarrier { unsigned* bar; unsigned x; volatile LAS unsigned* st; };
__device__ __forceinline__ XcdBarrier xcd_barrier_post(unsigned* bar, volatile LAS unsigned* st) {
    XcdBarrier b; b.bar = bar; b.x = xb_xcc_id(); b.st = st;
    if (threadIdx.x == 0) (void)xb_add(&bar[XB_XCNT(b.x)], 1u);
    return b;
}
__device__ __forceinline__ void xcd_barrier_complete(unsigned* bar, unsigned x, unsigned& nloc, unsigned& nx) {
    const unsigned G = gridDim.x * gridDim.y * gridDim.z;
    unsigned sum, cnt, mine, sp = 0u;
    for (;;) {
        sum = 0u; cnt = 0u; mine = 0u;
#pragma unroll
        for (unsigned j = 0; j < 16; ++j) { const unsigned c = xb_ld(&bar[XB_XCNT(j)]); sum += c; cnt += (c > 0u) ? 1u : 0u; mine = (j == x) ? c : mine; }
        if (sum == G) break;
        __builtin_amdgcn_s_sleep(1);
        if ((++sp & 255u) == 0u) { if (xb_ld(&bar[XB_TMO])) break; if (sp > XB_SPIN_CAP) { atomicAdd(&bar[XB_TMO], 1u); break; } }
    }
    nloc = mine > 0u ? mine : 1u; nx = cnt > 0u ? cnt : 1u;
}
__device__ __forceinline__ void xcd_barrier(const XcdBarrier& b) {
    asm volatile("s_waitcnt vmcnt(0)" ::: "memory");
    __syncthreads();
    if (threadIdx.x == 0) {
        unsigned* bar = b.bar;
        __builtin_amdgcn_s_waitcnt(0);
        unsigned nloc = b.st[0], nx = b.st[1];
        if (nloc == 0u) { xcd_barrier_complete(bar, b.x, nloc, nx); b.st[0] = nloc; b.st[1] = nx; }
        const unsigned old = xb_add(&bar[XB_XSUB(b.x)], 1u);
        const unsigned gen = old / nloc;
        if (old + 1u == (gen + 1u) * nloc) {
            __builtin_amdgcn_fence(__ATOMIC_RELEASE, "agent");
            asm volatile("s_waitcnt vmcnt(0)" ::: "memory");
            const unsigned og = xb_add(&bar[XB_TOP], 1u);
            const unsigned tg = og / nx;
            if (og + 1u == (tg + 1u) * nx) xb_add(&bar[XB_TOPGEN], 1u);
            else XB_SPIN(xb_ld(&bar[XB_TOPGEN]) == tg, bar);
            __builtin_amdgcn_fence(__ATOMIC_ACQUIRE, "agent");
            xb_add(&bar[XB_XGEN(b.x)], 1u);
            asm volatile("s_waitcnt vmcnt(0)" ::: "memory");
        } else {
            XB_SPIN(xb_ld(&bar[XB_XGEN(b.x)]) == gen, bar);
            __builtin_amdgcn_fence(__ATOMIC_ACQUIRE, "agent");
            asm volatile("s_waitcnt vmcnt(0)" ::: "memory");
        }
    }
    __syncthreads();
}

__global__ void __launch_bounds__(NTHREADS, 2) yoco_fwd(Args args) {
    extern __shared__ __attribute__((aligned(16))) unsigned char lds_raw[];
    LAS unsigned char* lds = (LAS unsigned char*)lds_raw;
    const int tid = threadIdx.x, lane = tid & 63, wave = __builtin_amdgcn_readfirstlane(tid >> 6), G = gridDim.x, bx = blockIdx.x;
    const int gw = bx * NWAVES + wave, NGW = G * NWAVES;
    typedef const __attribute__((address_space(4))) Args* KArgsP;
    const KArgsP kp0 = (KArgsP)__builtin_amdgcn_kernarg_segment_ptr();
#define KARG(field) ({ KArgsP q_ = kp0; asm volatile("" : "+s"(q_)); q_->field; })
#define ws KARG(ws)
#define out KARG(out)
#define x_prompt KARG(in[0])
#define x_sample KARG(in[1])
#define state_gla KARG(in[2])
#define cache_k KARG(in[3])
#define cache_v KARG(in[4])
#define p_prompt KARG(in[5])
#define p_sample KARG(in[6])
#define norm_mix KARG(in[7])
#define norm_mlp KARG(in[8])
#define norm_ple KARG(in[9])
#define norm_kv KARG(in[10])
#define norm_final KARG(in[11])
#define w_in_a KARG(in[12])
#define w_a2 KARG(in[13])
#define b_a2 KARG(in[14])
#define gla_o_gain KARG(in[15])
#define w_out_a KARG(in[16])
#define w_kv KARG(in[17])
#define w_q_b KARG(in[18])
#define w_o_b KARG(in[19])
#define sinks KARG(in[20])
#define rel_bias KARG(in[21])
#define w_up KARG(in[22])
#define w_down KARG(in[23])
#define w_ple KARG(in[24])
#define w_ple_gate KARG(in[25])
#define W_IN ((bf16_t*)(ws + WS_W_IN))
#define W_OUT ((bf16_t*)(ws + WS_W_OUT))
#define W_KVQ ((bf16_t*)(ws + WS_W_KVQ))
#define W_O ((bf16_t*)(ws + WS_W_O))
#define XB ((bf16_t*)(ws + WS_XB))
#define PB ((bf16_t*)(ws + WS_PB))
#define Q1 ((bf16_t*)(ws + WS_Q1))
#define K1 ((bf16_t*)(ws + WS_K1))
#define V1 ((bf16_t*)(ws + WS_V1))
#define G1 ((bf16_t*)(ws + WS_G1))
#define HIDA ((bf16_t*)(ws + WS_R1))
#define H3B ((bf16_t*)(ws + WS_R1))
#define R3 ((bf16_t*)(ws + WS_R3))
#define HIDS (R3 + (size_t)(64 - HID_SPLIT) * 256 * FF)
#define KVR ((bf16_t*)(ws + WS_KVR))
#define PLQ ((bf16_t*)(ws + WS_PLQ))
#define SSQ0 ((float*)(ws + WS_SSQ))
#define SSQ1 ((float*)(ws + WS_SSQ) + (size_t)M * 16)
#define DV ((float*)(ws + WS_DV))
#define H (out + O_Y)
#define UT ((bf16_t*)(out + O_Y))
    cg::grid_group grid = cg::this_grid();
    volatile LAS unsigned* bst = (volatile LAS unsigned*)(lds + LDS_BYTES - 64);
    if (tid < 2) bst[tid] = 0u;
    __syncthreads();
    XcdBarrier xbar; xbar.bar = nullptr; xbar.x = 0; xbar.st = bst;
#if !MK_SPLIT
    xbar = xcd_barrier_post((unsigned*)(ws + WS_CTL), bst);
#endif
    const int lo = KARG(ph_lo), hi = KARG(ph_hi);
#define IN(k) (lo <= (k) && (k) < hi)
#define SEAM(k) do { if (IN(k) && IN((k) + 1)) { if (MK_SPLIT) grid.sync(); else xcd_barrier(xbar); } } while (0)
    if (lo < 0) grid.sync();

    if (IN(0)) {
        LAS float* scr = (LAS float*)(lds + wave * 16384);
#define TJ_LIST(X) \
        X(w_in_a, IN_A_COLS, DM, 512, W_IN, norm_mix, 0.08838834764831845f)                                     \
        X(w_in_a + 512, IN_A_COLS, DM, 2560, W_IN + (size_t)512 * DM, norm_mix, 1.f)                            \
        X(w_out_a, DM, DM, DM, W_OUT, (const float*)nullptr, 1.f) \
        X(w_up, FF, DM, FF, (bf16_t*)(ws + WS_W_UP0), norm_mlp, 1.f) \
        X(w_up + (size_t)DM * FF, FF, DM, FF, (bf16_t*)(ws + WS_W_UP1), norm_mlp + DM, 1.f) \
        X(w_down, DM, FF, DM, (bf16_t*)(ws + WS_W_DN0), (const float*)nullptr, 1.f) \
        X(w_down + (size_t)DM * FF, DM, FF, DM, (bf16_t*)(ws + WS_W_DN1), (const float*)nullptr, 1.f) \
        X(w_ple_gate, DM, DM, DM, (bf16_t*)(ws + WS_W_G0), norm_ple, 1.f) \
        X(w_ple_gate + (size_t)DM * DM, DM, DM, DM, (bf16_t*)(ws + WS_W_G1), norm_ple + DM, 1.f) \
        X(w_ple, DM, PLE, DM, (bf16_t*)(ws + WS_W_P0), (const float*)nullptr, 1.f) \
        X(w_ple + (size_t)PLE * DM, DM, PLE, DM, (bf16_t*)(ws + WS_W_P1), (const float*)nullptr, 1.f) \
        X(w_kv, 512, DM, 512, W_KVQ, norm_kv, 1.f) \
        X(w_q_b, DM, DM, DM, W_KVQ + (size_t)512 * DM, norm_mix + DM, 0.125f * LOG2E)                          \
        X(w_o_b, DM, DM, DM, W_O, (const float*)nullptr, 1.f)
#define TJ_COUNT(W, LDW, KK, NCOLS, DST, GAIN, SCALE) + ((KK) / 64) * ((NCOLS) / 32)
        constexpr int TJ_TOTAL = 0 TJ_LIST(TJ_COUNT);
#define TJ_DECODE(WP, LDW, KK, NCOLS, DSTP, GAINP, SCALEV) if (!done_ && r_ < ((KK) / 64) * ((NCOLS) / 32)) { jt_.src = (WP); jt_.ldw = (LDW); jt_.kk = (KK); jt_.nblk = (NCOLS) / 32; jt_.dst = (DSTP); jt_.gain = (GAINP); jt_.scale = (SCALEV); jt_.item = r_; done_ = true; } else if (!done_) r_ -= ((KK) / 64) * ((NCOLS) / 32);
#define TJ_GET(JOUT, it) do { int r_ = (it); bool done_ = false; TJob jt_; jt_.src = nullptr; jt_.ldw = 0; jt_.kk = 0; jt_.nblk = 1; jt_.dst = nullptr; jt_.gain = nullptr; jt_.scale = 1.f; jt_.item = 0; TJ_LIST(TJ_DECODE) JOUT = jt_; } while (0)
        { float ra_[32], rb_[32]; TJob Ja, Jb; int it = gw;
          if (it < TJ_TOTAL) { TJ_GET(Ja, it); p0_tload(Ja, ra_, lane); }
          while (it < TJ_TOTAL) {
              const int it1 = it + NGW; if (it1 < TJ_TOTAL) { TJ_GET(Jb, it1); p0_tload(Jb, rb_, lane); }
              p0_tfinish(Ja, ra_, scr, lane);
              if (it1 >= TJ_TOTAL) break;
              const int it2 = it1 + NGW; if (it2 < TJ_TOTAL) { TJ_GET(Ja, it2); p0_tload(Ja, ra_, lane); }
              p0_tfinish(Jb, rb_, scr, lane);
              it = it2; } }
#undef TJ_LIST
#undef TJ_COUNT
#undef TJ_DECODE
#undef TJ_GET
        for (int idx = bx * NTHREADS + tid; idx < 512 * 128; idx += G * NTHREADS) { const int n = idx >> 7, k8 = (idx & 127) * 8; float wa[16];
#pragma unroll
            for (int r = 0; r < 16; ++r) wa[r] = w_a2[r * 512 + n];
            float o8[8];
#pragma unroll
            for (int kk = 0; kk < 8; ++kk) { const float* wr_ = w_in_a + (size_t)(k8 + kk) * IN_A_COLS + 3072; float s = 0.f;
#pragma unroll
                for (int r = 0; r < 16; ++r) s += wr_[r] * wa[r];
                o8[kk] = s * norm_mix[k8 + kk]; }
            u32x4 o; o.x = pk2(o8[0], o8[1]); o.y = pk2(o8[2], o8[3]); o.z = pk2(o8[4], o8[5]); o.w = pk2(o8[6], o8[7]);
            *(u32x4*)(W_IN + (size_t)(3072 + n) * DM + k8) = o; }
        for (int grp = bx; grp < M / 64; grp += G)
#pragma unroll 1
          for (int half = 0; half < 2; ++half) { const int m0 = 64 * grp + 8 * wave + 4 * half; f32x4 v[4][4]; float s[4];
#pragma unroll
            for (int q = 0; q < 4; ++q) { const int m = m0 + q; const float* xr = m < MP ? x_prompt + (size_t)m * DM : x_sample + (size_t)(m - MP) * DM;
#pragma unroll
                for (int j = 0; j < 4; ++j) v[q][j] = __builtin_nontemporal_load((const f32x4*)xr + lane + 64 * j); }
#pragma unroll
            for (int q = 0; q < 4; ++q) { const int m = m0 + q; float ss = 0.f;
#pragma unroll
                for (int j = 0; j < 4; ++j) { ss += (v[q][j].x * v[q][j].x + v[q][j].y * v[q][j].y) + (v[q][j].z * v[q][j].z + v[q][j].w * v[q][j].w);
                    u32x2 w; w.x = pk2(v[q][j].x, v[q][j].y); w.y = pk2(v[q][j].z, v[q][j].w); *((u32x2*)(XB + (size_t)m * DM) + lane + 64 * j) = w; }
                s[q] = wave_sum(ss);
                if (lane < 4) *(f32x4*)(SSQ0 + ssq_idx(lane, m, 0)) = (f32x4){lane == 0 ? s[q] : 0.f, 0.f, 0.f, 0.f}; } }
        for (int m0 = gw * 8; m0 < M; m0 += NGW * 8) { f32x4 v[8];
#pragma unroll
            for (int q = 0; q < 8; ++q) { const int m = m0 + q; v[q] = *((const f32x4*)(m < MP ? p_prompt + (size_t)m * PLE : p_sample + (size_t)(m - MP) * PLE) + lane); }
#pragma unroll
            for (int q = 0; q < 8; ++q) { u32x2 w; w.x = pk2(v[q].x, v[q].y); w.y = pk2(v[q].z, v[q].w); *((u32x2*)(PB + (size_t)(m0 + q) * PLE) + lane) = w; } }
    }
    SEAM(0);
    if (IN(1)) { pg8::Gemm g{XB, XB, NPAN, W_IN, M, N_IN, DM}; pg8::StaticOrder S; S.init(M, N_IN, G, bx);
        pg8::EpiIn E{Q1, K1, V1, G1, KVR, SSQ0, b_a2}; pg8::gemm_phase(lds, g, S, E); }
    SEAM(1);
    if (IN(2)) {
        for (int base = bx * 2; base < SB * 4; base += G * 2) gla_sample_pair(lds, base, Q1, K1, V1, G1, KVR, state_gla, out + O_SS, gla_o_gain, R3, tid);
        gla_super_phase<false>(lds, G, bx, nullptr, K1, V1, nullptr, KVR, UT, DV, nullptr, nullptr, nullptr, tid, lane, wave);
    }
    SEAM(2);
    if (IN(3)) gla_scan<NSUP>(UT, DV, out + O_SP, bx * NTHREADS + tid, G * NTHREADS);
    SEAM(3);
    if (IN(4)) { gla_super_phase<true>(lds, G, bx, Q1, K1, V1, G1, KVR, UT, nullptr, gla_o_gain, R3, out + O_SP, tid, lane, wave); }
    SEAM(4);
    if (IN(5)) {
        { pg8::Gemm g{R3, R3, NPAN, W_OUT, MP, DM, DM}; pg8::StaticOrder S; S.init(MP, DM, G, bx); pg8::EpiRes<false> E{nullptr, nullptr, XB, XB, SSQ1, 1.f}; pg8::gemm_phase(lds, g, S, E); }
        { pg8::Gemm g{PB, PB, NPAN, (const bf16_t*)(ws + WS_W_P0), MP, DM, PLE}; pg8::StaticOrder S; S.init(MP, DM, G, bx); pg8::EpiPl E{PLQ}; pg8::gemm_phase(lds, g, S, E); }
        { mg::MRes<false> E{nullptr, XB, XB, SSQ1, 1.f}; mg::mini_gemm(lds, R3 + (size_t)MP * DM, W_OUT, DM, DM, G, bx, E); }
        { mg::MPl E{PLQ, nullptr}; mg::mini_gemm(lds, PB + (size_t)MP * PLE, (const bf16_t*)(ws + WS_W_P0), DM, PLE, G, bx, E); }
    }
    SEAM(5);
    if (IN(6)) { { pg8::Gemm g{XB, XB, NPAN, (const bf16_t*)(ws + WS_W_UP0), MP, FF, DM}; pg8::StaticOrder S; S.init(MP, FF, G, bx); pg8::EpiUp E{HIDA, R3, SSQ1}; pg8::gemm_phase(lds, g, S, E); }
        { mg::MUp E{HIDS, SSQ1, nullptr}; mg::mini_gemm(lds, XB + (size_t)MP * DM, (const bf16_t*)(ws + WS_W_UP0), FF, DM, G, bx, E); } }
    SEAM(6);
    if (IN(7)) { { pg8::Gemm g{HIDA, R3, HID_SPLIT, (const bf16_t*)(ws + WS_W_DN0), MP, DM, FF}; pg8::StaticOrder S; S.init(MP, DM, G, bx); pg8::EpiRes<false> E{nullptr, nullptr, XB, XB, SSQ0, 1.f}; pg8::gemm_phase(lds, g, S, E); }
        { mg::MRes<false> E{nullptr, XB, XB, SSQ0, 1.f}; mg::mini_gemm(lds, HIDS, (const bf16_t*)(ws + WS_W_DN0), DM, FF, G, bx, E); } }
    SEAM(7);
    if (IN(8)) { { pg8::Gemm g{XB, XB, NPAN, (const bf16_t*)(ws + WS_W_G0), MP, DM, DM}; pg8::StaticOrder S; S.init(MP, DM, G, bx); pg8::EpiGate<false> E{nullptr, XB, PLQ, H3B, SSQ0, SSQ1, 1.f}; pg8::gemm_phase(lds, g, S, E); }
        { mg::MGate<false> E{nullptr, XB, PLQ, H3B, SSQ0, SSQ1, 1.f}; mg::mini_gemm(lds, XB + (size_t)MP * DM, (const bf16_t*)(ws + WS_W_G0), DM, DM, G, bx, E); } }
    SEAM(8);
    if (IN(9)) { pg8::Gemm g{H3B, H3B, NPAN, W_KVQ, M, NKVQ, DM}; pg8::StaticOrder S; S.init(M, NKVQ, G, bx);
        pg8::EpiKvq E{KVR, PLQ, SSQ1, out + O_CKP, out + O_CVP, out + O_CKS, out + O_CVS}; pg8::gemm_phase(lds, g, S, E); }
    SEAM(9);
    if (IN(10)) {
        const AttnP AP{KVR, PLQ, R3, cache_k, cache_v, out + O_CKS, out + O_CVS, sinks, rel_bias};
        { AttnRegs AR; int buf = 0;
          if (bx < 1024) { attn_load(bx, AP, AR, tid); attn_stage(lds, bx, AP, AR, tid); }
          LDS_BAR();
          for (int it = bx; it < 1024; it += G) { const int nx = it + G;
              if (nx < 1024) attn_load(nx, AP, AR, tid);
              attn_compute(lds + buf * ATT_BUF, it, AP, lane, wave);
              if (nx < 1024) attn_stage(lds + (buf ^ 1) * ATT_BUF, nx, AP, AR, tid);
              LDS_BAR(); buf ^= 1; } }
        for (int m0 = gw * 8; m0 < M; m0 += NGW * 8) { f32x4 v[8];
#pragma unroll
            for (int q = 0; q < 8; ++q) { const int m = m0 + q; v[q] = *((const f32x4*)(m < MP ? p_prompt + (size_t)(MP + m) * PLE : p_sample + (size_t)(MS + m - MP) * PLE) + lane); }
#pragma unroll
            for (int q = 0; q < 8; ++q) { u32x2 w; w.x = pk2(v[q].x, v[q].y); w.y = pk2(v[q].z, v[q].w); *((u32x2*)(PB + (size_t)(m0 + q) * PLE) + lane) = w; } }
    }
    SEAM(10);
    if (IN(11)) {
        { pg8::Gemm g{R3, R3, NPAN, W_O, MP, DM, DM}; pg8::StaticOrder S; S.init(MP, DM, G, bx); pg8::EpiRes<false> E{nullptr, nullptr, H3B, XB, SSQ0, 1.f}; pg8::gemm_phase(lds, g, S, E); }
        { pg8::Gemm g{PB, PB, NPAN, (const bf16_t*)(ws + WS_W_P1), MP, DM, PLE}; pg8::StaticOrder S; S.init(MP, DM, G, bx); pg8::EpiPl E{PLQ}; pg8::gemm_phase(lds, g, S, E); }
        { mg::MRes<false> E{nullptr, H3B, XB, SSQ0, 1.f}; mg::mini_gemm(lds, R3 + (size_t)MP * DM, W_O, DM, DM, G, bx, E); }
        { mg::MPl E{PLQ, nullptr}; mg::mini_gemm(lds, PB + (size_t)MP * PLE, (const bf16_t*)(ws + WS_W_P1), DM, PLE, G, bx, E); }
    }
    SEAM(11);
    if (IN(12)) { { pg8::Gemm g{XB, XB, NPAN, (const bf16_t*)(ws + WS_W_UP1), MP, FF, DM}; pg8::StaticOrder S; S.init(MP, FF, G, bx); pg8::EpiUp E{HIDA, R3, SSQ0}; pg8::gemm_phase(lds, g, S, E); }
        { mg::MUp E{HIDS, SSQ0, nullptr}; mg::mini_gemm(lds, XB + (size_t)MP * DM, (const bf16_t*)(ws + WS_W_UP1), FF, DM, G, bx, E); } }
    SEAM(12);
    if (IN(13)) { { pg8::Gemm g{HIDA, R3, HID_SPLIT, (const bf16_t*)(ws + WS_W_DN1), MP, DM, FF}; pg8::StaticOrder S; S.init(MP, DM, G, bx); pg8::EpiRes<false> E{nullptr, nullptr, XB, XB, SSQ1, 1.f}; pg8::gemm_phase(lds, g, S, E); }
        { mg::MRes<false> E{nullptr, XB, XB, SSQ1, 1.f}; mg::mini_gemm(lds, HIDS, (const bf16_t*)(ws + WS_W_DN1), DM, FF, G, bx, E); } }
    SEAM(13);
    if (IN(14)) { { pg8::Gemm g{XB, XB, NPAN, (const bf16_t*)(ws + WS_W_G1), MP, DM, DM}; pg8::StaticOrder S; S.init(MP, DM, G, bx); pg8::EpiGate<false> E{nullptr, XB, PLQ, H3B, SSQ1, SSQ0, 1.f}; pg8::gemm_phase(lds, g, S, E); }
        { mg::MGate<false> E{nullptr, XB, PLQ, H3B, SSQ1, SSQ0, 1.f}; mg::mini_gemm(lds, XB + (size_t)MP * DM, (const bf16_t*)(ws + WS_W_G1), DM, DM, G, bx, E); } }
    SEAM(14);
    if (IN(15)) {
        f32x4 gn[4];
#pragma unroll
        for (int j = 0; j < 4; ++j) gn[j] = *((const f32x4*)norm_final + lane + 64 * j);
        for (int m0 = gw * 4; m0 < M; m0 += NGW * 4) { u32x2 w[4][4]; float r[4];
#pragma unroll
            for (int q = 0; q < 4; ++q) { r[q] = row_r(SSQ0, m0 + q);
#pragma unroll
                for (int j = 0; j < 4; ++j) w[q][j] = *((const u32x2*)(H3B + (size_t)(m0 + q) * DM) + lane + 64 * j); }
#pragma unroll
            for (int q = 0; q < 4; ++q)
#pragma unroll
                for (int j = 0; j < 4; ++j) { const f32x4 v = {bflo(w[q][j].x), bfhi(w[q][j].x), bflo(w[q][j].y), bfhi(w[q][j].y)};
                    *((f32x4*)(H + (size_t)(m0 + q) * DM) + lane + 64 * j) = v * r[q] * gn[j]; } }
    }
#undef IN
#undef SEAM
}
#undef ws
#undef out
#undef x_prompt
#undef x_sample
#undef state_gla
#undef cache_k
#undef cache_v
#undef p_prompt
#undef p_sample
#undef norm_mix
#undef norm_mlp
#undef norm_ple
#undef norm_kv
#undef norm_final
#undef w_in_a
#undef w_a2
#undef b_a2
#undef gla_o_gain
#undef w_out_a
#undef w_kv
#undef w_q_b
#undef w_o_b
#undef sinks
#undef rel_bias
#undef w_up
#undef w_down
#undef w_ple
#undef w_ple_gate
#undef W_IN
#undef W_OUT
#undef W_KVQ
#undef W_O
#undef XB
#undef PB
#undef Q1
#undef K1
#undef V1
#undef G1
#undef HIDA
#undef H3B
#undef R3
#undef HIDS
#undef KVR
#undef PLQ
#undef SSQ0
#undef SSQ1
#undef DV
#undef H
#undef UT
#undef KARG

extern "C" void kernel_launch(void* const* d_in, const int* in_sizes, int n_in, void* d_out, int out_size, void* d_ws, size_t ws_size, hipStream_t stream) {
    static int grid = 0;
    if (grid == 0) {
        if (n_in != 26 || (size_t)out_size != O_END || ws_size < WS_END) { fprintf(stderr, "kernel_launch: unexpected shapes (n_in %d out %d ws %zu need %zu)\n", n_in, out_size, ws_size, (size_t)WS_END); grid = -1; return; }
        int dev = 0, cus = 0, per_cu = 0;
        hipGetDevice(&dev); hipDeviceGetAttribute(&cus, hipDeviceAttributeMultiprocessorCount, dev);
        hipFuncSetAttribute((const void*)yoco_fwd, hipFuncAttributeMaxDynamicSharedMemorySize, LDS_BYTES);
        hipOccupancyMaxActiveBlocksPerMultiprocessor(&per_cu, (const void*)yoco_fwd, NTHREADS, LDS_BYTES);
        if (per_cu < 1) { fprintf(stderr, "kernel_launch: occupancy query says %d blocks per CU\n", per_cu); per_cu = 1; }
        (void)hipGetLastError();
        grid = cus * 1;
    }
    if (grid < 0) return;
    if (hipMemsetAsync((char*)d_ws + WS_CTL, 0, 65536, stream) != hipSuccess) { fprintf(stderr, "kernel_launch: memset failed\n"); return; }
    Args a{};
    for (int i = 0; i < 26; ++i) a.in[i] = (const float*)d_in[i];
    a.out = (float*)d_out; a.ws = (unsigned char*)d_ws;
#if MK_SPLIT
    for (int ph = 0; ph < 16; ++ph) { a.ph_lo = ph; a.ph_hi = ph + 1; hipLaunchKernelGGL(yoco_fwd, dim3(grid), dim3(NTHREADS), LDS_BYTES, stream, a); }
#else
    a.ph_lo = 0; a.ph_hi = 16;
    void* kargs[] = {&a};
    hipError_t e = hipLaunchCooperativeKernel((const void*)yoco_fwd, dim3(grid), dim3(NTHREADS), kargs, LDS_BYTES, stream);
    if (e != hipSuccess) fprintf(stderr, "cooperative launch failed: %s (grid %d)\n", hipGetErrorString(e), grid);
#endif
}
```

```cpp
#include <hip/hip_runtime.h>
#include <hip/hip_cooperative_groups.h>
#include <cstdio>
#include <cstdint>
namespace cg = cooperative_groups;

#define LAS __attribute__((address_space(3)))
#define GAS __attribute__((address_space(1)))
typedef unsigned short bf16_t;
typedef short bf16x8 __attribute__((ext_vector_type(8)));
typedef short s16x4 __attribute__((ext_vector_type(4)));
typedef float f32x4 __attribute__((ext_vector_type(4)));
typedef float f32x2 __attribute__((ext_vector_type(2)));
typedef unsigned u32x4 __attribute__((ext_vector_type(4)));
typedef unsigned u32x2 __attribute__((ext_vector_type(2)));

#ifndef MK_SPLIT
#define MK_SPLIT 0
#endif

constexpr int DM = 1024, SEQ = 8192, NBATCH = 2, MP = NBATCH * SEQ, SB = 128, SS = 8, MS = SB * SS, M = MP + MS, NPAN = M / 256;
constexpr int NQK = 512, NV = 1024, N_IN = 3584, FF = 4096, PLE = 256, NKVQ = 1536, IN_A_COLS = 3088;
constexpr int NCHUNK = 128, NBH = 8, NCH_ALL = NBH * NCHUNK;
constexpr float EPS = 1e-6f, LOG2E = 1.4426950408889634f;
constexpr int HID_SPLIT = 51;

constexpr size_t O_Y = 0, O_SP = (size_t)M * DM, O_SS = O_SP + 262144, O_CKP = O_SS + 16777216, O_CVP = O_CKP + 65536, O_CKS = O_CVP + 65536, O_CVS = O_CKS + 4194304, O_END = O_CVS + 4194304;

constexpr size_t al256(size_t x) { return (x + 255) & ~(size_t)255; }
constexpr size_t WS_CTL = 0, CTL_BYTES = 1u << 20;
constexpr size_t WS_W_IN = CTL_BYTES;
constexpr size_t WS_W_OUT = WS_W_IN + (size_t)N_IN * DM * 2;
constexpr size_t WS_W_UP0 = WS_W_OUT + (size_t)DM * DM * 2;
constexpr size_t WS_W_DN0 = WS_W_UP0 + (size_t)FF * DM * 2;
constexpr size_t WS_W_UP1 = WS_W_DN0 + (size_t)FF * DM * 2;
constexpr size_t WS_W_DN1 = WS_W_UP1 + (size_t)FF * DM * 2;
constexpr size_t WS_W_G0 = WS_W_DN1 + (size_t)FF * DM * 2;
constexpr size_t WS_W_G1 = WS_W_G0 + (size_t)DM * DM * 2;
constexpr size_t WS_W_P0 = WS_W_G1 + (size_t)DM * DM * 2;
constexpr size_t WS_W_P1 = WS_W_P0 + (size_t)DM * PLE * 2;
constexpr size_t WS_W_KVQ = WS_W_P1 + (size_t)DM * PLE * 2;
constexpr size_t WS_W_O = WS_W_KVQ + (size_t)NKVQ * DM * 2;
constexpr size_t WS_XB = WS_W_O + (size_t)DM * DM * 2;
constexpr size_t WS_PB = WS_XB + (size_t)M * DM * 2;
constexpr size_t WS_R1 = WS_PB + (size_t)M * PLE * 2;
constexpr size_t R1_BYTES = (size_t)HID_SPLIT * 256 * FF * 2;
constexpr size_t WS_Q1 = WS_R1, WS_K1 = WS_Q1 + (size_t)M * NQK * 2, WS_V1 = WS_K1 + (size_t)M * NQK * 2, WS_G1 = WS_V1 + (size_t)M * NV * 2;
static_assert(WS_G1 + (size_t)M * NV * 2 == WS_R1 + R1_BYTES, "R1 map");
constexpr size_t WS_R3 = WS_R1 + R1_BYTES;
static_assert((size_t)(NPAN - HID_SPLIT) * 256 * FF * 2 == (size_t)M * DM * 2, "R3 map");
constexpr size_t WS_KVR = WS_R3 + (size_t)M * DM * 2;
constexpr size_t WS_PLQ = WS_KVR + (size_t)M * NQK * 2;
constexpr size_t WS_SSQ = WS_PLQ + (size_t)M * DM * 2;
constexpr size_t WS_DV = WS_SSQ + (size_t)2 * M * 16 * 4;
constexpr size_t WS_END = WS_DV + (size_t)NCH_ALL * 128 * 4;

__device__ __forceinline__ float bf2f(unsigned short b) { return __uint_as_float((unsigned)b << 16); }
__device__ __forceinline__ float bflo(unsigned w) { return __uint_as_float(w << 16); }
__device__ __forceinline__ float bfhi(unsigned w) { return __uint_as_float(w & 0xffff0000u); }
typedef __bf16 bf16x2_t __attribute__((ext_vector_type(2)));
__device__ __forceinline__ unsigned pk2(float lo, float hi) { const f32x2 v = {lo, hi}; const bf16x2_t b = __builtin_convertvector(v, bf16x2_t); return __builtin_bit_cast(unsigned, b); }
__device__ __forceinline__ float fexp(float x) { return __builtin_amdgcn_exp2f(x * LOG2E); }
__device__ __forceinline__ float frcp(float x) { return __builtin_amdgcn_rcpf(x); }
__device__ __forceinline__ float frsq(float x) { return __builtin_amdgcn_rsqf(x); }
__device__ __forceinline__ float fsigmoid(float x) { return frcp(1.f + fexp(-x)); }
__device__ __forceinline__ float logsig(float x) { return fminf(x, 0.f) - __logf(1.f + fexp(-fabsf(x))); }
__device__ __forceinline__ s16x4 trd(const LAS bf16_t* p) { return __builtin_bit_cast(s16x4, __builtin_amdgcn_ds_read_tr16_b64_v4i16((LAS s16x4*)p)); }
__device__ __forceinline__ bf16x8 cat8(s16x4 lo, s16x4 hi) { return (bf16x8){lo[0], lo[1], lo[2], lo[3], hi[0], hi[1], hi[2], hi[3]}; }
__device__ __forceinline__ void st_wt(float* p, float v) { __hip_atomic_store(p, v, __ATOMIC_RELAXED, __HIP_MEMORY_SCOPE_AGENT); }
__device__ __forceinline__ void st16_wt(void* p, u32x4 v) { asm volatile("global_store_dwordx4 %0, %1, off sc1\n\ts_nop 1" :: "v"(p), "v"(v) : "memory"); }
__device__ __forceinline__ float wave_sum(float v) {
#pragma unroll
    for (int o = 1; o < 64; o <<= 1) v += __shfl_xor(v, o);
    return v;
}
__device__ __forceinline__ size_t ssq_idx(int pn, int row, int wc) { return ((size_t)pn * M + row) * 4 + wc; }
__device__ __forceinline__ float row_r(const float* ssq, int row) {
    const f32x4 a = *(const f32x4*)(ssq + ssq_idx(0, row, 0)), b = *(const f32x4*)(ssq + ssq_idx(1, row, 0)), c = *(const f32x4*)(ssq + ssq_idx(2, row, 0)), d = *(const f32x4*)(ssq + ssq_idx(3, row, 0));
    const f32x4 s = (a + b) + (c + d);
    return frsq(((s.x + s.y) + (s.z + s.w)) * (1.f / 1024.f) + EPS);
}

namespace pg8 {
constexpr int BM = 256, BK = 64, HALF = 128, HTB = HALF * BK * 2, STAGE_BYTES = 8 * HTB, NXCD = 8, WGM = 8;
__host__ __device__ __forceinline__ int lds_byte(int r, int c) { const int st = (r >> 4) * 2 + (c >> 5), rr = r & 15, cc = c & 31, ob = rr * 64 + cc * 2; return st * 1024 + (ob ^ (((ob >> 9) & 1) << 5)); }
__host__ __device__ __forceinline__ void stage_rc(int b, int& R, int& C) { const int st = b / 1024, sb = b % 1024, swz = sb ^ (((sb >> 9) & 1) << 5); R = (st >> 1) * 16 + swz / 64; C = (st & 1) * 32 + (swz % 64) / 2; }
__host__ __device__ __forceinline__ int perm32(int rho) { const int n = rho >> 4, i = rho & 15; return 8 * (i >> 2) + 4 * n + (i & 3); }
struct Unit { int pm, pn; };
struct Gemm { const bf16_t* A; const bf16_t* A2; int split; const bf16_t* Bt; int M, N, K; };
struct StaticOrder {
    int nM, nN, nwg, G, c;
    __device__ void init(int M_, int N, int G_, int c_) { nM = M_ / BM; nN = N / BM; nwg = nM * nN; G = G_; c = c_; }
    __device__ bool next(int i, Unit& u) const {
        const long L = (long)i * G + c; if (L >= nwg) return false;
        int wgid = (int)L; { const int q = nwg / NXCD, r = nwg % NXCD, xcd = wgid % NXCD, off = wgid / NXCD; wgid = (xcd < r ? xcd * (q + 1) : r * (q + 1) + (xcd - r) * q) + off; }
        const int nig = WGM * nN, gid = wgid / nig, fm = gid * WGM, gsz = (nM - fm) < WGM ? (nM - fm) : WGM;
        u.pm = fm + ((wgid % nig) % gsz); u.pn = (wgid % nig) / gsz; return true;
    }
};

template <class Epi>
__device__ __forceinline__ void gemm_phase(LAS unsigned char* lds, const Gemm g, const StaticOrder& S, const Epi& E) {
    const int tid = threadIdx.x, wid = __builtin_amdgcn_readfirstlane(tid >> 6), lane = tid & 63, wr = wid >> 2, wc = wid & 3, fr = lane & 15, fq = lane >> 4;
    const int K = g.K, nt = K / BK;
    unsigned voffA[2], voffB[2];
#pragma unroll
    for (int i = 0; i < 2; ++i) { int R, C; stage_rc(tid * 16 + i * 8192, R, C); const int Rb = (R & ~31) + perm32(R & 31);
        voffA[i] = (unsigned)(R * K + C) * 2u; voffB[i] = (unsigned)(Rb * K + C) * 2u; }
    const size_t kstep = (size_t)(BK * 2);
    const size_t hstep = (size_t)HALF * K * 2;
    const size_t tstep = 2 * hstep;
    const unsigned ldsw = (unsigned)wid * 1024u;
    const int aoff = lds_byte(wr * 64 + fr, fq * 8), boff = lds_byte(wc * 32 + fr, fq * 8);
#define PG8_APTR(pm) ((pm) < g.split ? (const char*)g.A + (size_t)(pm) * tstep : (const char*)g.A2 + (size_t)((pm) - g.split) * tstep)
#define PG8_SA(b, h) (((b) * 2 + (h)) * HTB)
#define PG8_SB(b, h) ((4 + (b) * 2 + (h)) * HTB)
#define PG8_STAGE(bufoff, gbase, voff) do { _Pragma("unroll") for (int _i = 0; _i < 2; ++_i) \
        __builtin_amdgcn_global_load_lds((const unsigned*)((const char*)(gbase) + (voff)[_i]), (LAS unsigned*)(lds + (bufoff) + ldsw + _i * 8192), 16, 0, 0); } while (0)
#define PG8_LDA(dst, b, h) do { _Pragma("unroll") for (int m = 0; m < 4; ++m) _Pragma("unroll") for (int k = 0; k < 2; ++k) dst[m][k] = *(const LAS bf16x8*)(lds + PG8_SA(b, h) + aoff + m * 2048 + k * 1024); } while (0)
#define PG8_LDB(dst, b, h) do { _Pragma("unroll") for (int n = 0; n < 2; ++n) _Pragma("unroll") for (int k = 0; k < 2; ++k) dst[n][k] = *(const LAS bf16x8*)(lds + PG8_SB(b, h) + boff + n * 2048 + k * 1024); } while (0)
#define PG8_MMA(ai, bj, At, Bt) do { __builtin_amdgcn_s_setprio(1); _Pragma("unroll") for (int m = 0; m < 4; ++m) _Pragma("unroll") for (int n = 0; n < 2; ++n) _Pragma("unroll") for (int k = 0; k < 2; ++k) \
        acc[ai][bj][m][n] = __builtin_amdgcn_mfma_f32_16x16x32_bf16(Bt[n][k], At[m][k], acc[ai][bj][m][n], 0, 0, 0); __builtin_amdgcn_s_setprio(0); } while (0)
#define PG8_WAIT_V(n) asm volatile("s_waitcnt vmcnt(" #n ")" ::: "memory")
#define PG8_WAIT_L(n) asm volatile("s_waitcnt lgkmcnt(" #n ")" ::: "memory")
#define PG8_BAR __builtin_amdgcn_s_barrier()
#define PG8_SCHED __builtin_amdgcn_sched_barrier(0)
    Unit cur, nxt; int ui = 0;
    if (!S.next(0, cur)) return;
    LAS float* rtab_all = (LAS float*)(lds + STAGE_BYTES);
    if (E.rsrc() != nullptr) { Unit uu; for (int i = 0; i < 8 && S.next(i, uu); ++i) if (tid < 256) rtab_all[i * 256 + tid] = row_r(E.rsrc(), uu.pm * BM + tid); }
    f32x4 acc[2][2][4][2];
#pragma unroll
    for (int a = 0; a < 2; ++a)
#pragma unroll
        for (int b = 0; b < 2; ++b)
#pragma unroll
            for (int m = 0; m < 4; ++m)
#pragma unroll
                for (int n = 0; n < 2; ++n) acc[a][b][m][n] = (f32x4){0.f, 0.f, 0.f, 0.f};
    bf16x8 At[4][2], B0[2][2], B1[2][2];
    const char* cA = PG8_APTR(cur.pm); const char* cB = (const char*)g.Bt + (size_t)cur.pn * tstep;
    PG8_STAGE(PG8_SB(0, 0), cB, voffB); PG8_STAGE(PG8_SB(0, 1), cB + hstep, voffB); PG8_STAGE(PG8_SA(0, 0), cA, voffA); PG8_STAGE(PG8_SA(0, 1), cA + hstep, voffA);
    PG8_WAIT_L(0);
    if (wr == 1) PG8_BAR;
    PG8_WAIT_V(2); PG8_BAR;
    PG8_STAGE(PG8_SB(1, 0), cB + kstep, voffB); PG8_STAGE(PG8_SA(1, 0), cA + kstep, voffA); PG8_STAGE(PG8_SB(1, 1), cB + hstep + kstep, voffB);
    PG8_WAIT_V(6); PG8_BAR;
    for (;;) {
        const bool has_next = S.next(ui + 1, nxt);
        const char* nA = has_next ? PG8_APTR(nxt.pm) : cA; const char* nB = has_next ? (const char*)g.Bt + (size_t)nxt.pn * tstep : cB;
#pragma clang loop unroll(disable)
        for (int t = 0; t < nt; t += 2) {
            const bool last = (t == nt - 2);
            const char* a1 = cA + (size_t)(t + 1) * kstep;
            const char* a2 = last ? nA : cA + (size_t)(t + 2) * kstep; const char* b2 = last ? nB : cB + (size_t)(t + 2) * kstep;
            const char* a3 = a2 + kstep; const char* b3 = b2 + kstep;
            PG8_LDB(B0, 0, 0); PG8_LDB(B1, 0, 1); PG8_SCHED; PG8_LDA(At, 0, 0); PG8_STAGE(PG8_SA(1, 1), a1 + hstep, voffA);
            PG8_WAIT_V(8); PG8_WAIT_L(0); PG8_BAR; PG8_MMA(0, 0, At, B0); PG8_MMA(0, 1, At, B1); PG8_BAR; PG8_SCHED;
            PG8_LDA(At, 0, 1); PG8_STAGE(PG8_SB(0, 0), b2, voffB); PG8_STAGE(PG8_SB(0, 1), b2 + hstep, voffB); PG8_STAGE(PG8_SA(0, 0), a2, voffA);
            PG8_WAIT_V(8); PG8_WAIT_L(0); PG8_BAR; PG8_MMA(1, 0, At, B0); PG8_MMA(1, 1, At, B1); PG8_BAR; PG8_SCHED;
            PG8_LDB(B0, 1, 0); PG8_LDB(B1, 1, 1); PG8_SCHED; PG8_LDA(At, 1, 0); PG8_STAGE(PG8_SA(0, 1), a2 + hstep, voffA);
            PG8_WAIT_V(8); PG8_WAIT_L(0); PG8_BAR; PG8_MMA(0, 0, At, B0); PG8_MMA(0, 1, At, B1); PG8_BAR; PG8_SCHED;
            PG8_LDA(At, 1, 1); PG8_STAGE(PG8_SB(1, 0), b3, voffB); PG8_STAGE(PG8_SB(1, 1), b3 + hstep, voffB); PG8_STAGE(PG8_SA(1, 0), a3, voffA);
            PG8_WAIT_V(8); PG8_WAIT_L(0); PG8_BAR; PG8_MMA(1, 0, At, B0); PG8_MMA(1, 1, At, B1); PG8_BAR; PG8_SCHED;
        }
        if (wr == 0) PG8_BAR;
        { int efr = fr, efq = fq, etid = tid; asm volatile("" : "+v"(efr), "+v"(efq), "+v"(etid));
          E(acc, cur, wr, wc, efr, efq, rtab_all + (ui & 7) * 256, etid); }
        if (!has_next) break;
#pragma unroll
        for (int a = 0; a < 2; ++a)
#pragma unroll
            for (int b = 0; b < 2; ++b)
#pragma unroll
                for (int m = 0; m < 4; ++m)
#pragma unroll
                    for (int n = 0; n < 2; ++n) acc[a][b][m][n] = (f32x4){0.f, 0.f, 0.f, 0.f};
        cur = nxt; cA = nA; cB = nB; ++ui;
        if (wr == 1) PG8_BAR;
    }
    PG8_WAIT_V(0);
    PG8_BAR;
#undef PG8_APTR
#undef PG8_SA
#undef PG8_SB
#undef PG8_STAGE
#undef PG8_LDA
#undef PG8_LDB
#undef PG8_MMA
#undef PG8_WAIT_V
#undef PG8_WAIT_L
#undef PG8_BAR
#undef PG8_SCHED
}

#define EPI_ROWLOOP _Pragma("unroll") for (int ai = 0; ai < 2; ++ai) _Pragma("unroll") for (int m = 0; m < 4; ++m)
__device__ __forceinline__ u32x4 pack8(const f32x4 v0, const f32x4 v1) { u32x4 w; w.x = pk2(v0[0], v0[1]); w.y = pk2(v0[2], v0[3]); w.z = pk2(v1[0], v1[1]); w.w = pk2(v1[2], v1[3]); return w; }

struct EpiIn {
    bf16_t *Q, *Kk, *V, *G, *LG; const float* ssq; const float* b_a2;
    __device__ __forceinline__ const float* rsrc() const { return ssq; }
    __device__ __forceinline__ void operator()(const f32x4 (&acc)[2][2][4][2], const Unit& u, int wr, int wc, int fr, int fq, LAS float* rtab, int tid) const {
        const int pn = u.pn; bf16_t* base; int ld, c0;
        if (pn < 2) { base = Q; ld = NQK; c0 = pn * 256; } else if (pn < 4) { base = Kk; ld = NQK; c0 = (pn - 2) * 256; }
        else if (pn < 8) { base = V; ld = NV; c0 = (pn - 4) * 256; } else if (pn < 12) { base = G; ld = NV; c0 = (pn - 8) * 256; }
        else { base = LG; ld = NQK; c0 = (pn - 12) * 256; }
        const bool is_lg = pn >= 12;
        const int col = c0 + wc * 32 + 8 * fq;
        f32x4 bb[2][2];
#pragma unroll
        for (int bj = 0; bj < 2; ++bj)
#pragma unroll
            for (int n = 0; n < 2; ++n) bb[bj][n] = is_lg ? *(const f32x4*)(b_a2 + col + bj * HALF + 4 * n) : (f32x4){0.f, 0.f, 0.f, 0.f};
        EPI_ROWLOOP { const int lr = ai * HALF + wr * 64 + m * 16 + fr, row = u.pm * BM + lr; const float r = rtab[lr];
#pragma unroll
            for (int bj = 0; bj < 2; ++bj) { f32x4 v0 = acc[ai][bj][m][0] * r, v1 = acc[ai][bj][m][1] * r;
                if (is_lg) { v0 += bb[bj][0]; v1 += bb[bj][1];
#pragma unroll
                    for (int e = 0; e < 4; ++e) { v0[e] = logsig(v0[e]) * (1.f / 16.f); v1[e] = logsig(v1[e]) * (1.f / 16.f); } }
                *(u32x4*)(base + (size_t)row * ld + col + bj * HALF) = pack8(v0, v1); } }
    }
};
template <bool FROM_X> struct EpiRes {
    const float* X0; const float* X1; const bf16_t* BB; bf16_t* XO; float* ssq_out; float sc;
    __device__ __forceinline__ const float* rsrc() const { return nullptr; }
    __device__ __forceinline__ void operator()(const f32x4 (&acc)[2][2][4][2], const Unit& u, int wr, int wc, int fr, int fq, LAS float* rtab, int tid) const {
        const int col = u.pn * BM + wc * 32 + 8 * fq;
#pragma unroll
        for (int ai = 0; ai < 2; ++ai) {
            f32x4 b0[4][2], b1[4][2]; u32x4 bw[4][2];
#pragma unroll
            for (int m = 0; m < 4; ++m) { const int row = u.pm * BM + ai * HALF + wr * 64 + m * 16 + fr;
#pragma unroll
                for (int bj = 0; bj < 2; ++bj) {
                    if (FROM_X) { const float* src = (u.pm < MP / 256 ? X0 + (size_t)row * DM : X1 + (size_t)(row - MP) * DM) + col + bj * HALF; b0[m][bj] = *(const f32x4*)src; b1[m][bj] = *(const f32x4*)(src + 4); }
                    else bw[m][bj] = *(const u32x4*)(BB + (size_t)row * DM + col + bj * HALF); } }
            if (!FROM_X) asm volatile("" ::: "memory");
#pragma unroll
            for (int m = 0; m < 4; ++m) { const int row = u.pm * BM + ai * HALF + wr * 64 + m * 16 + fr; float s = 0.f;
#pragma unroll
                for (int bj = 0; bj < 2; ++bj) {
                    if (!FROM_X) { const u32x4 w = bw[m][bj]; b0[m][bj] = (f32x4){bflo(w.x), bfhi(w.x), bflo(w.y), bfhi(w.y)}; b1[m][bj] = (f32x4){bflo(w.z), bfhi(w.z), bflo(w.w), bfhi(w.w)}; }
                    const f32x4 v0 = acc[ai][bj][m][0] * sc + b0[m][bj], v1 = acc[ai][bj][m][1] * sc + b1[m][bj];
                    *(u32x4*)(XO + (size_t)row * DM + col + bj * HALF) = pack8(v0, v1);
                    s += (v0[0] * v0[0] + v0[1] * v0[1]) + (v0[2] * v0[2] + v0[3] * v0[3]) + (v1[0] * v1[0] + v1[1] * v1[1]) + (v1[2] * v1[2] + v1[3] * v1[3]); }
                s += __shfl_xor(s, 16); s += __shfl_xor(s, 32);
                if (fq == 0) ssq_out[ssq_idx(u.pn, row, wc)] = s; }
        }
    }
};
struct EpiUp {
    bf16_t* HA; bf16_t* HB; const float* ssq;
    __device__ __forceinline__ const float* rsrc() const { return ssq; }
    __device__ __forceinline__ void operator()(const f32x4 (&acc)[2][2][4][2], const Unit& u, int wr, int wc, int fr, int fq, LAS float* rtab, int tid) const {
        bf16_t* base = u.pm < HID_SPLIT ? HA + (size_t)u.pm * 256 * FF : HB + (size_t)(u.pm - HID_SPLIT) * 256 * FF;
        const int col = u.pn * BM + wc * 32 + 8 * fq;
        EPI_ROWLOOP { const int lr = ai * HALF + wr * 64 + m * 16 + fr; const float r = rtab[lr];
#pragma unroll
            for (int bj = 0; bj < 2; ++bj) { f32x4 v0 = acc[ai][bj][m][0] * r, v1 = acc[ai][bj][m][1] * r;
#pragma unroll
                for (int e = 0; e < 4; ++e) { const float a = fmaxf(v0[e], 0.f), b = fmaxf(v1[e], 0.f); v0[e] = a * a; v1[e] = b * b; }
                st16_wt(base + (size_t)lr * FF + col + bj * HALF, pack8(v0, v1)); } }
    }
};
struct EpiPl {
    bf16_t* PL;
    __device__ __forceinline__ const float* rsrc() const { return nullptr; }
    __device__ __forceinline__ void operator()(const f32x4 (&acc)[2][2][4][2], const Unit& u, int wr, int wc, int fr, int fq, LAS float* rtab, int tid) const {
        const int col = u.pn * BM + wc * 32 + 8 * fq;
        EPI_ROWLOOP { const int row = u.pm * BM + ai * HALF + wr * 64 + m * 16 + fr;
#pragma unroll
            for (int bj = 0; bj < 2; ++bj) *(u32x4*)(PL + (size_t)row * DM + col + bj * HALF) = pack8(acc[ai][bj][m][0], acc[ai][bj][m][1]); }
    }
};
template <bool LAST> struct EpiGate {
    float* HO; const bf16_t* BB; const bf16_t* PL; bf16_t* OB; const float* ssq_in; float* ssq_out; float sc;
    __device__ __forceinline__ const float* rsrc() const { return ssq_in; }
    __device__ __forceinline__ void operator()(const f32x4 (&acc)[2][2][4][2], const Unit& u, int wr, int wc, int fr, int fq, LAS float* rtab, int tid) const {
        const int col = u.pn * BM + wc * 32 + 8 * fq;
#pragma unroll
        for (int ai = 0; ai < 2; ++ai) {
            u32x4 bw[4][2], pw[4][2];
#pragma unroll
            for (int m = 0; m < 4; ++m) { const size_t off0 = (size_t)(u.pm * BM + ai * HALF + wr * 64 + m * 16 + fr) * DM + col;
#pragma unroll
                for (int bj = 0; bj < 2; ++bj) { bw[m][bj] = *(const u32x4*)(BB + off0 + bj * HALF); pw[m][bj] = *(const u32x4*)(PL + off0 + bj * HALF); } }
#pragma unroll
            for (int m = 0; m < 4; ++m) { const int lr = ai * HALF + wr * 64 + m * 16 + fr, row = u.pm * BM + lr; const float r = rtab[lr];
                float s = 0.f;
#pragma unroll
                for (int bj = 0; bj < 2; ++bj) { const size_t off = (size_t)row * DM + col + bj * HALF; const u32x4 b_ = bw[m][bj], p_ = pw[m][bj];
                    const f32x4 b0 = {bflo(b_.x), bfhi(b_.x), bflo(b_.y), bfhi(b_.y)}, b1 = {bflo(b_.z), bfhi(b_.z), bflo(b_.w), bfhi(b_.w)};
                    const f32x4 p0 = {bflo(p_.x), bfhi(p_.x), bflo(p_.y), bfhi(p_.y)}, p1 = {bflo(p_.z), bfhi(p_.z), bflo(p_.w), bfhi(p_.w)};
                    f32x4 v0 = acc[ai][bj][m][0] * r, v1 = acc[ai][bj][m][1] * r;
#pragma unroll
                    for (int e = 0; e < 4; ++e) { v0[e] = b0[e] + fsigmoid(v0[e]) * p0[e] * sc; v1[e] = b1[e] + fsigmoid(v1[e]) * p1[e] * sc; }
                    if (LAST) { *(f32x4*)(HO + off) = v0; *(f32x4*)(HO + off + 4) = v1; }
                    else { *(u32x4*)(OB + off) = pack8(v0, v1);
                        s += (v0[0] * v0[0] + v0[1] * v0[1]) + (v0[2] * v0[2] + v0[3] * v0[3]) + (v1[0] * v1[0] + v1[1] * v1[1]) + (v1[2] * v1[2] + v1[3] * v1[3]); } }
                if (!LAST) { s += __shfl_xor(s, 16); s += __shfl_xor(s, 32); if (fq == 0) ssq_out[ssq_idx(u.pn, row, wc)] = s; } }
        }
    }
};
struct EpiKvq {
    bf16_t* KV; bf16_t* Qb; const float* ssq; float *CKP, *CVP, *CKS, *CVS;
    __device__ __forceinline__ const float* rsrc() const { return ssq; }
    __device__ __forceinline__ void operator()(const f32x4 (&acc)[2][2][4][2], const Unit& u, int wr, int wc, int fr, int fq, LAS float* rtab, int tid) const {
        const int pn = u.pn, c = wc * 32 + 8 * fq;
        EPI_ROWLOOP { const int lr = ai * HALF + wr * 64 + m * 16 + fr, row = u.pm * BM + lr; const float r = rtab[lr];
            float* cdst = nullptr;
            if (pn < 2) {
                if (row < MP) { const int b = row >> 13, t = row & (SEQ - 1); if (t >= SEQ - 128) cdst = (pn == 0 ? CKP : CVP) + ((size_t)(b * 128 + t - (SEQ - 128)) * 256 + c); }
                else { const int rs = row - MP, sb = rs >> 3, i = rs & 7; cdst = (pn == 0 ? CKS : CVS) + ((size_t)(sb * 128 + 120 + i) * 256 + c); }
            }
            bf16_t* dst = pn < 2 ? KV + (size_t)row * 512 + pn * 256 + c : Qb + (size_t)row * DM + (pn - 2) * 256 + c;
#pragma unroll
            for (int bj = 0; bj < 2; ++bj) { const f32x4 v0 = acc[ai][bj][m][0] * r, v1 = acc[ai][bj][m][1] * r;
                *(u32x4*)(dst + bj * HALF) = pack8(v0, v1);
                if (cdst) { *(f32x4*)(cdst + bj * HALF) = v0; *(f32x4*)(cdst + bj * HALF + 4) = v1; } } }
    }
};
}


namespace mg {
constexpr int KT = 256, LDT = KT + 8, TILE_B = 64 * LDT * 2;
template <class Epi>
__device__ __forceinline__ void mini_gemm(LAS unsigned char* lds, const bf16_t* A  , const bf16_t* Bt  , int N, int K, int G, int bx, const Epi& E) {
    const int tid = threadIdx.x, lane = tid & 63, wave = __builtin_amdgcn_readfirstlane(tid >> 6), l15 = lane & 15, g = lane >> 4;
    const int rt = wave & 3, chh = wave >> 2, nk = K / KT, units = 16 * (N / 64);
    LAS float* red = (LAS float*)(lds + 4 * TILE_B);
    for (int u = bx; u < units; u += G) {
        const int rm = u & 15, cn = u >> 4;
        const bf16_t* Ag = A + (size_t)(rm * 64) * K; const bf16_t* Bg = Bt + (size_t)(cn * 64) * K;
        u32x4 ra0[4], rb0[4], ra1[4], rb1[4];
#define MG_LOAD(ra, rb, kt) do { _Pragma("unroll") for (int i = 0; i < 4; ++i) { const int c = tid + 512 * i, row = c >> 5, ch = c & 31; \
            ra[i] = *(const u32x4*)(Ag + (size_t)row * K + (kt) * KT + ch * 8); rb[i] = *(const u32x4*)(Bg + (size_t)row * K + (kt) * KT + ch * 8); } } while (0)
#define MG_STORE(ra, rb, b) do { _Pragma("unroll") for (int i = 0; i < 4; ++i) { const int c = tid + 512 * i, row = c >> 5, ch = c & 31; \
            *(LAS u32x4*)(lds + (b) * 2 * TILE_B + (row * LDT + ch * 8) * 2) = ra[i]; *(LAS u32x4*)(lds + (b) * 2 * TILE_B + TILE_B + (row * LDT + ch * 8) * 2) = rb[i]; } } while (0)
#define MG_COMPUTE(b) do { const LAS bf16_t* Al = (const LAS bf16_t*)(lds + (b) * 2 * TILE_B); const LAS bf16_t* Bl = (const LAS bf16_t*)(lds + (b) * 2 * TILE_B + TILE_B); \
            _Pragma("unroll") for (int ks = 0; ks < KT / 32; ++ks) { const bf16x8 Af = *(const LAS bf16x8*)(Al + (16 * rt + l15) * LDT + 32 * ks + 8 * g); \
                _Pragma("unroll") for (int t = 0; t < 2; ++t) { const bf16x8 Bf = *(const LAS bf16x8*)(Bl + (16 * (2 * chh + t) + l15) * LDT + 32 * ks + 8 * g); \
                    acc[t] = __builtin_amdgcn_mfma_f32_16x16x32_bf16(Bf, Af, acc[t], 0, 0, 0); } } } while (0)
        f32x4 acc[2] = {(f32x4){0.f, 0.f, 0.f, 0.f}, (f32x4){0.f, 0.f, 0.f, 0.f}};
#define MG_BAR() do { asm volatile("s_waitcnt lgkmcnt(0)" ::: "memory"); __builtin_amdgcn_s_barrier(); asm volatile("" ::: "memory"); } while (0)
        MG_LOAD(ra0, rb0, 0); if (nk > 1) MG_LOAD(ra1, rb1, 1);
        MG_STORE(ra0, rb0, 0); MG_BAR();
        for (int kt = 0; kt < nk; kt += 2) {
            if (kt + 2 < nk) MG_LOAD(ra0, rb0, kt + 2);
            MG_COMPUTE(0);
            if (kt + 1 < nk) MG_STORE(ra1, rb1, 1);
            MG_BAR();
            if (kt + 1 < nk) {
                if (kt + 3 < nk) MG_LOAD(ra1, rb1, kt + 3);
                MG_COMPUTE(1);
                if (kt + 2 < nk) MG_STORE(ra0, rb0, 0);
                MG_BAR();
            }
        }
#undef MG_BAR
        const int row = MP + rm * 64 + 16 * rt + l15; float s = 0.f;
#pragma unroll
        for (int t = 0; t < 2; ++t) { const f32x4 o = E(row, cn * 64 + 16 * (2 * chh + t) + 4 * g, acc[t]); s += (o[0] * o[0] + o[1] * o[1]) + (o[2] * o[2] + o[3] * o[3]); }
        if (Epi::SSQ) { s += __shfl_xor(s, 16); s += __shfl_xor(s, 32); if (g == 0) red[(16 * rt + l15) * 2 + chh] = s;
            __syncthreads();
            if (tid < 64) st_wt(E.ssq_out + ssq_idx(cn >> 2, MP + rm * 64 + tid, cn & 3), red[tid * 2] + red[tid * 2 + 1]);
            __syncthreads(); }
#undef MG_LOAD
#undef MG_STORE
#undef MG_COMPUTE
    }
}
__device__ __forceinline__ u32x2 pack4(const f32x4 v) { u32x2 w; w.x = pk2(v[0], v[1]); w.y = pk2(v[2], v[3]); return w; }
template <bool FROM_X> struct MRes {
    static constexpr bool SSQ = true; const float* X1; const bf16_t* BB; bf16_t* XO; float* ssq_out; float sc;
    __device__ __forceinline__ f32x4 operator()(int row, int col, const f32x4 v) const {
        f32x4 b; if (FROM_X) b = *(const f32x4*)(X1 + (size_t)(row - MP) * DM + col); else { const u32x2 w = *(const u32x2*)(BB + (size_t)row * DM + col); b = (f32x4){bflo(w.x), bfhi(w.x), bflo(w.y), bfhi(w.y)}; }
        const f32x4 o = b + v * sc; *(u32x2*)(XO + (size_t)row * DM + col) = pack4(o); return o; }
};
struct MPl { static constexpr bool SSQ = false; bf16_t* PL; float* ssq_out;
    __device__ __forceinline__ f32x4 operator()(int row, int col, const f32x4 v) const { *(u32x2*)(PL + (size_t)row * DM + col) = pack4(v); return v; } };
struct MUp { static constexpr bool SSQ = false; bf16_t* HS  ; const float* ssq; float* ssq_out;
    __device__ __forceinline__ f32x4 operator()(int row, int col, const f32x4 v) const { const float r = row_r(ssq, row); f32x4 o;
#pragma unroll
        for (int e = 0; e < 4; ++e) { const float a = fmaxf(v[e] * r, 0.f); o[e] = a * a; }
        *(u32x2*)(HS + (size_t)(row - MP) * FF + col) = pack4(o); return o; } };
template <bool LAST> struct MGate { static constexpr bool SSQ = !LAST; float* HO; const bf16_t* BB; const bf16_t* PL; bf16_t* OB; const float* ssq_in; float* ssq_out; float sc;
    __device__ __forceinline__ f32x4 operator()(int row, int col, const f32x4 v) const { const float r = row_r(ssq_in, row); const size_t off = (size_t)row * DM + col;
        const u32x2 bw = *(const u32x2*)(BB + off), pw = *(const u32x2*)(PL + off);
        const f32x4 b = {bflo(bw.x), bfhi(bw.x), bflo(bw.y), bfhi(bw.y)}, p = {bflo(pw.x), bfhi(pw.x), bflo(pw.y), bfhi(pw.y)}; f32x4 o;
#pragma unroll
        for (int e = 0; e < 4; ++e) o[e] = b[e] + fsigmoid(v[e] * r) * p[e] * sc;
        if (LAST) *(f32x4*)(HO + off) = o; else *(u32x2*)(OB + off) = pack4(o); return o; } };
}

constexpr int NWAVES = 8, NTHREADS = 512;
constexpr int RING_BYTES = 131072, LDS_BYTES = 147456;
struct Args { const float* in[26]; float* out; unsigned char* ws; int ph_lo, ph_hi; };

struct TJob { const float* src; int ldw, kk, nblk; bf16_t* dst; const float* gain; float scale; int item; };
__device__ __forceinline__ void p0_tload(const TJob& J, float (&r)[32], int lane) {
    const int kb = J.item / J.nblk, nb = J.item % J.nblk, k0 = 64 * kb, n0 = 32 * nb;
#pragma unroll
    for (int i = 0; i < 32; ++i) r[i] = __builtin_nontemporal_load(J.src + (size_t)(k0 + 2 * i + (lane >> 5)) * J.ldw + n0 + (lane & 31));
}
__device__ __forceinline__ void p0_tfinish(const TJob& J, const float (&r)[32], LAS float* scr, int lane) {
    const int kb = J.item / J.nblk, nb = J.item % J.nblk, k0 = 64 * kb, n0 = 32 * nb, c = lane & 7;
    f32x4 g0 = {1.f, 1.f, 1.f, 1.f}, g1 = g0;
    if (J.gain) { g0 = *(const f32x4*)(J.gain + k0 + 8 * c); g1 = *(const f32x4*)(J.gain + k0 + 8 * c + 4); }
    g0 *= J.scale; g1 *= J.scale;
#pragma unroll
    for (int i = 0; i < 32; ++i) scr[(2 * i + (lane >> 5)) * 33 + (lane & 31)] = r[i];
    asm volatile("s_waitcnt lgkmcnt(0)" ::: "memory");
#pragma unroll
    for (int j = 0; j < 4; ++j) { const int n = (lane >> 3) + 8 * j; const LAS float* sp = scr + (8 * c) * 33 + n;
        u32x4 o; o.x = pk2(sp[0 * 33] * g0.x, sp[1 * 33] * g0.y); o.y = pk2(sp[2 * 33] * g0.z, sp[3 * 33] * g0.w); o.z = pk2(sp[4 * 33] * g1.x, sp[5 * 33] * g1.y); o.w = pk2(sp[6 * 33] * g1.z, sp[7 * 33] * g1.w);
        *(u32x4*)(J.dst + (size_t)(n0 + n) * J.kk + k0 + 8 * c) = o; }
    asm volatile("s_waitcnt lgkmcnt(0)" ::: "memory");
}

constexpr int T128 = 144, T256 = 272, TP = 80;
#define LDS_BAR() do { asm volatile("s_waitcnt lgkmcnt(0)" ::: "memory"); __builtin_amdgcn_s_barrier(); asm volatile("" ::: "memory"); } while (0)
struct GlaRegs { u32x4 lg[2], v[4], k[2], q[2]; };
template <bool WITH_Q, bool DO_LKQ = true, bool DO_V = true>
__device__ __forceinline__ void gla_fetch(GlaRegs& R, int item, const bf16_t* Q1, const bf16_t* K1, const bf16_t* V1, const bf16_t* LGp, int tid) {
    const int bh = item >> 7, c = item & 127, b = bh >> 2, h = bh & 3; const size_t row0 = (size_t)b * SEQ + c * 64;
    if (DO_LKQ) {
#pragma unroll
        for (int i = 0; i < 2; ++i) { const int x = tid + NTHREADS * i, j = x >> 4, d8 = (x & 15) * 8; const size_t off = (row0 + j) * NQK + h * 128 + d8;
            R.lg[i] = *(const u32x4*)(LGp + off); R.k[i] = *(const u32x4*)(K1 + off); if (WITH_Q) R.q[i] = *(const u32x4*)(Q1 + off); } }
    if (DO_V) {
#pragma unroll
        for (int i = 0; i < 4; ++i) { const int x = tid + NTHREADS * i, j = x >> 5, e8 = (x & 31) * 8; R.v[i] = *(const u32x4*)(V1 + (row0 + j) * NV + h * 256 + e8); } }
}
__device__ __forceinline__ void gla_stage_lg_v(const GlaRegs& R, LAS float* bc, LAS bf16_t* vt, int tid) {
#pragma unroll
    for (int i = 0; i < 2; ++i) { const int x = tid + NTHREADS * i, j = x >> 4, d8 = (x & 15) * 8; const u32x4 w = R.lg[i];
        *(LAS f32x4*)(bc + j * 128 + d8) = (f32x4){bflo(w.x), bfhi(w.x), bflo(w.y), bfhi(w.y)}; *(LAS f32x4*)(bc + j * 128 + d8 + 4) = (f32x4){bflo(w.z), bfhi(w.z), bflo(w.w), bfhi(w.w)}; }
#pragma unroll
    for (int i = 0; i < 4; ++i) { const int x = tid + NTHREADS * i, j = x >> 5, e8 = (x & 31) * 8; *(LAS u32x4*)(vt + j * T256 + e8) = R.v[i]; }
    LDS_BAR();
    if (tid < 128) { float s = 0.f;
#pragma unroll 8
        for (int j = 0; j < 64; ++j) { s += bc[j * 128 + tid]; bc[j * 128 + tid] = s; } }
    LDS_BAR();
}
constexpr int NSUP = 32, NSUP_ALL = NBH * NSUP;
template <bool OUT>
__device__ __forceinline__ void gla_super_phase(LAS unsigned char* lds, int G, int bx, const bf16_t* Q1, const bf16_t* K1, const bf16_t* V1, const bf16_t* G1, const bf16_t* LGp, bf16_t* US, float* DVS,
                                                const float* ogain, bf16_t* OG, float* SOUT, int tid, int lane, int wave) {
    LAS float* bc = (LAS float*)lds;
    LAS bf16_t* Pm = (LAS bf16_t*)lds;
    LAS bf16_t* qt = (LAS bf16_t*)(lds + 32768);
    LAS bf16_t* kt = qt + 64 * T128;
    LAS bf16_t* kd = kt + 64 * T128;
    LAS bf16_t* vt = kd + 64 * T128;
    LAS float* red = (LAS float*)(lds + 32768 + 3 * 64 * T128 * 2 + 64 * T256 * 2);
    LAS float* em = red + 512;
    LAS float* dvl = em + 128;
    const int l15 = lane & 15, g = lane >> 4, q = l15 >> 2, p = l15 & 3;
    f32x4 gn[2] = {(f32x4){0.f, 0.f, 0.f, 0.f}, (f32x4){0.f, 0.f, 0.f, 0.f}};
    if (OUT) {
#pragma unroll
        for (int t = 0; t < 2; ++t) gn[t] = *(const f32x4*)(ogain + 16 * (2 * wave + t) + 4 * g); }
    GlaRegs R;
    if (bx < NSUP_ALL) gla_fetch<OUT>(R, (bx >> 5) * NCHUNK + (bx & 31) * 4, Q1, K1, V1, LGp, tid);
    for (int item = bx; item < NSUP_ALL; item += G) {
        const int bh = item >> 5, sc = item & 31, b = bh >> 2, h = bh & 3;
        f32x4 S[8][2];
        if (OUT) {
#pragma unroll
            for (int dt = 0; dt < 8; ++dt)
#pragma unroll
                for (int t = 0; t < 2; ++t) { const u32x2 w = *(const u32x2*)(US + ((size_t)item * 256 + 16 * (2 * wave + t) + l15) * 128 + 16 * dt + 4 * g); S[dt][t] = (f32x4){bflo(w.x), bfhi(w.x), bflo(w.y), bfhi(w.y)}; }
        } else {
#pragma unroll
            for (int dt = 0; dt < 8; ++dt) { S[dt][0] = (f32x4){0.f, 0.f, 0.f, 0.f}; S[dt][1] = (f32x4){0.f, 0.f, 0.f, 0.f}; } }
        float lsum = 0.f;
        for (int cc = 0; cc < 4; ++cc) {
            const int c = sc * 4 + cc; const size_t row0 = (size_t)b * SEQ + c * 64;
            gla_stage_lg_v(R, bc, vt, tid);
#pragma unroll
            for (int i = 0; i < 2; ++i) { const int x = tid + NTHREADS * i, j = x >> 4, d8 = (x & 15) * 8; const u32x4 wk = R.k[i];
                float kv[8] = {bflo(wk.x), bfhi(wk.x), bflo(wk.y), bfhi(wk.y), bflo(wk.z), bfhi(wk.z), bflo(wk.w), bfhi(wk.w)};
                float cur[8], dd[8];
#pragma unroll
                for (int t = 0; t < 8; ++t) { cur[t] = bc[j * 128 + d8 + t]; dd[t] = kv[t] * fexp(bc[63 * 128 + d8 + t] - cur[t]); }
                u32x4 o; o.x = pk2(dd[0], dd[1]); o.y = pk2(dd[2], dd[3]); o.z = pk2(dd[4], dd[5]); o.w = pk2(dd[6], dd[7]); *(LAS u32x4*)(kd + j * T128 + d8) = o;
                if (OUT) { const u32x4 wq = R.q[i];
                    float qv[8] = {bflo(wq.x), bfhi(wq.x), bflo(wq.y), bfhi(wq.y), bflo(wq.z), bfhi(wq.z), bflo(wq.w), bfhi(wq.w)};
                    float a[8], bb[8];
#pragma unroll
                    for (int t = 0; t < 8; ++t) { const float mid = bc[31 * 128 + d8 + t]; a[t] = qv[t] * fexp(cur[t] - mid); bb[t] = kv[t] * fexp(mid - cur[t]); }
                    o.x = pk2(a[0], a[1]); o.y = pk2(a[2], a[3]); o.z = pk2(a[4], a[5]); o.w = pk2(a[6], a[7]); *(LAS u32x4*)(qt + j * T128 + d8) = o;
                    o.x = pk2(bb[0], bb[1]); o.y = pk2(bb[2], bb[3]); o.z = pk2(bb[4], bb[5]); o.w = pk2(bb[6], bb[7]); *(LAS u32x4*)(kt + j * T128 + d8) = o; } }
            if (tid < 128) { const float last = bc[63 * 128 + tid]; dvl[tid] = fexp(last); lsum += last; if (OUT) em[tid] = fexp(bc[31 * 128 + tid]); }
            const int nxt_ = (cc < 3) ? bh * NCHUNK + c + 1 : (item + G < NSUP_ALL ? ((item + G) >> 5) * NCHUNK + ((item + G) & 31) * 4 : -1);
            if (nxt_ >= 0) gla_fetch<OUT, true, false>(R, nxt_, Q1, K1, V1, LGp, tid);
            LDS_BAR();
            if (OUT) {
#pragma unroll
                for (int t = 0; t < 2; ++t) { const int id = 2 * wave + t, ti = id >> 2, tj = id & 3;
                    f32x4 a = {0.f, 0.f, 0.f, 0.f};
                    if (tj <= ti) {
#pragma unroll
                        for (int ks = 0; ks < 4; ++ks) { const bf16x8 Af = *(const LAS bf16x8*)(qt + (16 * ti + l15) * T128 + 32 * ks + 8 * g), Bf = *(const LAS bf16x8*)(kt + (16 * tj + l15) * T128 + 32 * ks + 8 * g);
                            a = __builtin_amdgcn_mfma_f32_16x16x32_bf16(Af, Bf, a, 0, 0, 0); } }
#pragma unroll
                    for (int r = 0; r < 4; ++r) { const int i = 16 * ti + 4 * g + r, j = 16 * tj + l15; const float v = (j <= i) ? a[r] : 0.f; Pm[i * TP + j] = (bf16_t)(pk2(v, 0.f) & 0xffffu); }
                }
                LDS_BAR();
                f32x4 o[4][2];
#pragma unroll
                for (int ti = 0; ti < 4; ++ti) { o[ti][0] = (f32x4){0.f, 0.f, 0.f, 0.f}; o[ti][1] = (f32x4){0.f, 0.f, 0.f, 0.f}; }
#pragma unroll
                for (int ks = 0; ks < 2; ++ks) {
                    bf16x8 Bf[2];
#pragma unroll
                    for (int t = 0; t < 2; ++t) { const LAS bf16_t* a0 = vt + (32 * ks + 8 * g + q) * T256 + 16 * (2 * wave + t) + 4 * p; Bf[t] = cat8(trd(a0), trd(a0 + 4 * T256)); }
#pragma unroll
                    for (int ti = 2 * ks; ti < 4; ++ti) { const bf16x8 Af = *(const LAS bf16x8*)(Pm + (16 * ti + l15) * TP + 32 * ks + 8 * g);
#pragma unroll
                        for (int t = 0; t < 2; ++t) o[ti][t] = __builtin_amdgcn_mfma_f32_16x16x32_bf16(Bf[t], Af, o[ti][t], 0, 0, 0); }
                }
#pragma unroll
                for (int ks = 0; ks < 4; ++ks) {
                    const f32x4 e0 = *(LAS f32x4*)(em + 32 * ks + 4 * g), e1 = *(LAS f32x4*)(em + 32 * ks + 16 + 4 * g);
                    bf16x8 Bf[2];
#pragma unroll
                    for (int t = 0; t < 2; ++t) { const f32x4 s0 = S[2 * ks][t] * e0, s1 = S[2 * ks + 1][t] * e1; u32x4 w; w.x = pk2(s0[0], s0[1]); w.y = pk2(s0[2], s0[3]); w.z = pk2(s1[0], s1[1]); w.w = pk2(s1[2], s1[3]); Bf[t] = __builtin_bit_cast(bf16x8, w); }
#pragma unroll
                    for (int ti = 0; ti < 4; ++ti) { const LAS bf16_t* ap = qt + (16 * ti + l15) * T128 + 32 * ks + 4 * g;
                        const u32x2 a0 = *(const LAS u32x2*)ap, a1 = *(const LAS u32x2*)(ap + 16); u32x4 aw; aw.x = a0.x; aw.y = a0.y; aw.z = a1.x; aw.w = a1.y; const bf16x8 Af = __builtin_bit_cast(bf16x8, aw);
#pragma unroll
                        for (int t = 0; t < 2; ++t) o[ti][t] = __builtin_amdgcn_mfma_f32_16x16x32_bf16(Bf[t], Af, o[ti][t], 0, 0, 0); }
                }
#pragma unroll
                for (int ti = 0; ti < 4; ++ti) { float s = 0.f;
#pragma unroll
                    for (int t = 0; t < 2; ++t) s += (o[ti][t][0] * o[ti][t][0] + o[ti][t][1] * o[ti][t][1]) + (o[ti][t][2] * o[ti][t][2] + o[ti][t][3] * o[ti][t][3]);
                    s += __shfl_xor(s, 16); s += __shfl_xor(s, 32);
                    if (g == 0) red[(16 * ti + l15) * 8 + wave] = s; }
                LDS_BAR();
#pragma unroll
                for (int ti = 0; ti < 4; ++ti) { const int i = 16 * ti + l15; const f32x4 r0 = *(LAS f32x4*)(red + i * 8), r1 = *(LAS f32x4*)(red + i * 8 + 4);
                    const float rms = frsq(((r0.x + r0.y) + (r0.z + r0.w) + (r1.x + r1.y) + (r1.z + r1.w)) * (1.f / 256.f) + EPS);
#pragma unroll
                    for (int t = 0; t < 2; ++t) { const size_t off = (row0 + i) * NV + h * 256 + 16 * (2 * wave + t) + 4 * g; const u32x2 gw_ = *(const u32x2*)(G1 + off);
                        const f32x4 gv = {bflo(gw_.x), bfhi(gw_.x), bflo(gw_.y), bfhi(gw_.y)}; f32x4 ov;
#pragma unroll
                        for (int r = 0; r < 4; ++r) ov[r] = o[ti][t][r] * rms * gn[t][r] * gv[r] * fsigmoid(gv[r]);
                        u32x2 w; w.x = pk2(ov[0], ov[1]); w.y = pk2(ov[2], ov[3]); *(u32x2*)(OG + off) = w; } }
            }
            if (nxt_ >= 0) gla_fetch<OUT, false, true>(R, nxt_, Q1, K1, V1, LGp, tid);
#pragma unroll
            for (int dt = 0; dt < 8; ++dt) { const f32x4 dvv = *(LAS f32x4*)(dvl + 16 * dt + 4 * g); S[dt][0] *= dvv; S[dt][1] *= dvv; }
#pragma unroll
            for (int ks = 0; ks < 2; ++ks) {
                bf16x8 Bf[2];
#pragma unroll
                for (int t = 0; t < 2; ++t) { const LAS bf16_t* a0 = vt + (32 * ks + 8 * g + q) * T256 + 16 * (2 * wave + t) + 4 * p; Bf[t] = cat8(trd(a0), trd(a0 + 4 * T256)); }
#pragma unroll
                for (int dt = 0; dt < 8; ++dt) { const LAS bf16_t* a0 = kd + (32 * ks + 8 * g + q) * T128 + 16 * dt + 4 * p; const bf16x8 Af = cat8(trd(a0), trd(a0 + 4 * T128));
#pragma unroll
                    for (int t = 0; t < 2; ++t) S[dt][t] = __builtin_amdgcn_mfma_f32_16x16x32_bf16(Af, Bf[t], S[dt][t], 0, 0, 0); }
            }
            LDS_BAR();
        }
        if (OUT && sc == NSUP - 1) {
            float* so = SOUT + (size_t)bh * 128 * 256 + (size_t)(4 * g) * 256 + 32 * wave + l15;
#pragma unroll
            for (int dt = 0; dt < 8; ++dt) {
#pragma unroll
                for (int t = 0; t < 2; ++t)
#pragma unroll
                    for (int r = 0; r < 4; ++r) so[r * 256 + 16 * t] = S[dt][t][r];
                so += 16 * 256; asm volatile("" : "+v"(so));
            }
        }
        if (!OUT) {
#pragma unroll
            for (int dt = 0; dt < 8; ++dt)
#pragma unroll
                for (int t = 0; t < 2; ++t) { u32x2 w; w.x = pk2(S[dt][t][0], S[dt][t][1]); w.y = pk2(S[dt][t][2], S[dt][t][3]);
                    *(u32x2*)(US + ((size_t)item * 256 + 16 * (2 * wave + t) + l15) * 128 + 16 * dt + 4 * g) = w; }
            if (tid < 128) DVS[(size_t)item * 128 + tid] = fexp(lsum);
        }
    }
}
template <int NSTEP>
__device__ __forceinline__ void gla_scan(bf16_t* UT, const float* DV, float* state_out, int gtid, int gthreads) {
    for (int idx = gtid; idx < NBH * 256 * 64; idx += gthreads) {
        const int bh = idx >> 14, rem = idx & 16383, e = rem >> 6, dp = rem & 63;
        unsigned* base = (unsigned*)UT + (size_t)bh * NSTEP * 16384 + e * 64 + dp;
        const float* dv = DV + (size_t)bh * NSTEP * 128 + 2 * dp;
        float s0 = 0.f, s1 = 0.f;
        for (int c0 = 0; c0 < NSTEP; c0 += 32) {
            unsigned uu[32]; f32x2 dd[32];
#pragma unroll
            for (int k = 0; k < 32; ++k) { uu[k] = base[(size_t)(c0 + k) * 16384]; dd[k] = *(const f32x2*)(dv + (size_t)(c0 + k) * 128); }
#pragma unroll
            for (int k = 0; k < 32; ++k) { base[(size_t)(c0 + k) * 16384] = pk2(s0, s1); s0 = dd[k].x * s0 + bflo(uu[k]); s1 = dd[k].y * s1 + bfhi(uu[k]); }
        }
        (void)state_out;
    }
}
__device__ __forceinline__ void gla_sample_pair(LAS unsigned char* lds, int base_item, const bf16_t* Q1, const bf16_t* K1, const bf16_t* V1, const bf16_t* G1, const bf16_t* LGp,
                                                const float* S0in, float* Sout, const float* ogain, bf16_t* OG, int tid) {
    const int hb = tid >> 8, t = tid & 255, item = base_item + hb, sb = item >> 2, h = item & 3; const size_t r0 = (size_t)MP + sb * 8;
    LAS float* qaT = (LAS float*)(lds + hb * 16384);
    LAS float* qsT = qaT + 1024, *kdT = qsT + 1024, *dvs = kdT + 1024, *att = dvs + 128, *red = att + 64;
    if (t < 128) { const int d = t; float bcv[8], s = 0.f;
#pragma unroll
        for (int i = 0; i < 8; ++i) { s += bf2f(LGp[(r0 + i) * NQK + h * 128 + d]); bcv[i] = s; }
#pragma unroll
        for (int i = 0; i < 8; ++i) { const float qv = bf2f(Q1[(r0 + i) * NQK + h * 128 + d]), kv = bf2f(K1[(r0 + i) * NQK + h * 128 + d]);
            qaT[d * 8 + i] = qv * fexp(bcv[i] - bcv[7]); qsT[d * 8 + i] = qv * fexp(bcv[i]); kdT[d * 8 + i] = kv * fexp(bcv[7] - bcv[i]); }
        dvs[d] = fexp(bcv[7]); }
    __syncthreads();
    if (t < 64) { const int i = t >> 3, j = t & 7; float s = 0.f;
        for (int d = 0; d < 128; ++d) s += qaT[d * 8 + i] * kdT[d * 8 + j];
        att[t] = (j <= i) ? s : 0.f; }
    __syncthreads();
    const int e = t; float v[8], o[8];
#pragma unroll
    for (int j = 0; j < 8; ++j) { v[j] = bf2f(V1[(r0 + j) * NV + h * 256 + e]); o[j] = 0.f; }
    const float* S0 = S0in + ((size_t)item * 128) * 256 + e; float* SO = Sout + ((size_t)item * 128) * 256 + e;
    for (int d0 = 0; d0 < 128; d0 += 32) { float sv[32];
#pragma unroll
        for (int k = 0; k < 32; ++k) sv[k] = __builtin_nontemporal_load(S0 + (size_t)(d0 + k) * 256);
#pragma unroll
        for (int k = 0; k < 32; ++k) { const int d = d0 + k; const f32x4 qa = *(LAS f32x4*)(qsT + d * 8), qb = *(LAS f32x4*)(qsT + d * 8 + 4), ka = *(LAS f32x4*)(kdT + d * 8), kb = *(LAS f32x4*)(kdT + d * 8 + 4);
            o[0] += qa.x * sv[k]; o[1] += qa.y * sv[k]; o[2] += qa.z * sv[k]; o[3] += qa.w * sv[k]; o[4] += qb.x * sv[k]; o[5] += qb.y * sv[k]; o[6] += qb.z * sv[k]; o[7] += qb.w * sv[k];
            __builtin_nontemporal_store(dvs[d] * sv[k] + ((ka.x * v[0] + ka.y * v[1]) + (ka.z * v[2] + ka.w * v[3])) + ((kb.x * v[4] + kb.y * v[5]) + (kb.z * v[6] + kb.w * v[7])), SO + (size_t)d * 256); }
    }
#pragma unroll
    for (int i = 0; i < 8; ++i)
#pragma unroll
        for (int j = 0; j <= i; ++j) o[i] += att[i * 8 + j] * v[j];
    const int wv = t >> 6;
#pragma unroll
    for (int i = 0; i < 8; ++i) { const float s = wave_sum(o[i] * o[i]); if ((t & 63) == 0) red[i * 4 + wv] = s; }
    __syncthreads();
    const float gn = ogain[e];
#pragma unroll
    for (int i = 0; i < 8; ++i) { const f32x4 rr = *(LAS f32x4*)(red + i * 4); const float rms = frsq(((rr.x + rr.y) + (rr.z + rr.w)) * (1.f / 256.f) + EPS);
        const size_t off = (r0 + i) * NV + h * 256 + e; const float gv = bf2f(G1[off]);
        OG[off] = (bf16_t)(pk2(o[i] * rms * gn * gv * fsigmoid(gv), 0.f) & 0xffffu); }
    __syncthreads();
}

constexpr int VT_LD = 72;
struct AttnP { const bf16_t* KV; const bf16_t* Qb; bf16_t* AO; const float* pk; const float* pv; float* ock; float* ocv; const float* sinks; const float* relb; };
constexpr int ATT_BUF = 32768 + 256 * VT_LD * 2 + 2048;
struct AttnRegs { u32x4 a[12]; };
#define ATT_DECODE(item) const bool smp = (item) >= 512; int b, kh, qblk, sb = 0; \
    if (!smp) { b = (item) >> 8; kh = ((item) >> 6) & 3; qblk = (item) & 63; } else { const int it_ = (item) - 512; sb = it_ >> 2; kh = it_ & 3; b = 0; qblk = 1; } \
    const long s0 = (long)b * SEQ + (long)qblk * 128; (void)s0; (void)sb
__device__ __forceinline__ void attn_load(int item, const AttnP& P, AttnRegs& R, int tid) {
    ATT_DECODE(item);
    if (!smp) {
#pragma unroll
        for (int j = 0; j < 4; ++j) { const int i = tid + NTHREADS * j, row = i >> 3, ch = i & 7; u32x4 wk = {0u, 0u, 0u, 0u}, wv = {0u, 0u, 0u, 0u};
            if (qblk > 0 || row >= 128) { const bf16_t* src = P.KV + (size_t)(s0 - 128 + row) * 512 + kh * 64 + ch * 8; wk = *(const u32x4*)src; wv = *(const u32x4*)(src + 256); }
            R.a[j] = wk; R.a[4 + j] = wv; }
    } else {
#pragma unroll
        for (int j = 0; j < 3; ++j) { const int i = tid + NTHREADS * j, row = i >> 3, ch = i & 7;
            u32x4 z = {0u, 0u, 0u, 0u}; R.a[4 * j] = z; R.a[4 * j + 1] = z; R.a[4 * j + 2] = z; R.a[4 * j + 3] = z;
            if (row < 128) { const size_t so = ((size_t)(sb * 128 + row) * 4 + kh) * 64 + ch * 8;
                R.a[4 * j] = *(const u32x4*)(P.pk + so); R.a[4 * j + 1] = *(const u32x4*)(P.pk + so + 4); R.a[4 * j + 2] = *(const u32x4*)(P.pv + so); R.a[4 * j + 3] = *(const u32x4*)(P.pv + so + 4); }
            else if (row < 136) { const bf16_t* src = P.KV + (size_t)(MP + sb * 8 + row - 128) * 512 + kh * 64 + ch * 8; R.a[4 * j] = *(const u32x4*)src; R.a[4 * j + 1] = *(const u32x4*)(src + 256); } }
    }
}
__device__ __forceinline__ void attn_stage(LAS unsigned char* lds, int item, const AttnP& P, const AttnRegs& R, int tid) {
    LAS unsigned char* Kt = lds; LAS bf16_t* Vt = (LAS bf16_t*)(lds + 32768); LAS float* bias2 = (LAS float*)(lds + 32768 + 256 * VT_LD * 2);
    ATT_DECODE(item);
    if (!smp) {
#pragma unroll
        for (int j = 0; j < 4; ++j) { const int i = tid + NTHREADS * j, row = i >> 3, ch = i & 7;
            *(LAS u32x4*)(Kt + row * 128 + ((ch ^ (row & 7)) << 4)) = R.a[j]; *(LAS u32x4*)(Vt + row * VT_LD + ch * 8) = R.a[4 + j]; }
    } else {
#pragma unroll
        for (int j = 0; j < 3; ++j) { const int i = tid + NTHREADS * j, row = i >> 3, ch = i & 7;
            if (i < 144 * 8) { u32x4 wk = R.a[4 * j], wv = R.a[4 * j + 1];
                if (row < 128) { const f32x4 k0 = __builtin_bit_cast(f32x4, R.a[4 * j]), k1 = __builtin_bit_cast(f32x4, R.a[4 * j + 1]), v0 = __builtin_bit_cast(f32x4, R.a[4 * j + 2]), v1 = __builtin_bit_cast(f32x4, R.a[4 * j + 3]);
                    wk = pg8::pack8(k0, k1); wv = pg8::pack8(v0, v1);
                    if (row >= 8) { const size_t oo = ((size_t)(sb * 128 + row - 8) * 4 + kh) * 64 + ch * 8;
                        __builtin_nontemporal_store(k0, (f32x4*)(P.ock + oo)); __builtin_nontemporal_store(k1, (f32x4*)(P.ock + oo + 4)); __builtin_nontemporal_store(v0, (f32x4*)(P.ocv + oo)); __builtin_nontemporal_store(v1, (f32x4*)(P.ocv + oo + 4)); } }
                *(LAS u32x4*)(Kt + row * 128 + ((ch ^ (row & 7)) << 4)) = wk; *(LAS u32x4*)(Vt + row * VT_LD + ch * 8) = wv; } }
    }
    { const int hl = tid >> 7, dist = tid & 127; int bk = dist;
      if (dist >= 16) { bk = 16 + (int)(__logf((float)dist * (1.f / 16.f)) * (16.f / 2.0794415416798357f)); bk = bk > 31 ? 31 : bk; }
      bias2[tid] = P.relb[bk * 16 + kh * 4 + hl] * LOG2E; }
}
__device__ __forceinline__ void attn_compute(LAS unsigned char* lds, int item, const AttnP& P, int lane, int wave) {
    LAS unsigned char* Kt = lds; LAS bf16_t* Vt = (LAS bf16_t*)(lds + 32768); LAS float* bias2 = (LAS float*)(lds + 32768 + 256 * VT_LD * 2);
    ATT_DECODE(item);
    const int l15 = lane & 15, g = lane >> 4, q = l15 >> 2, p = l15 & 3;
    const int ntq = smp ? (wave < 2 ? 1 : 0) : 4;
    for (int tq = 0; tq < ntq; ++tq) {
        const int qtile = smp ? 0 : (wave & 1) * 4 + tq;
        int hl_q, ioff; size_t qrow;
        if (!smp) { hl_q = wave >> 1; ioff = l15; qrow = (size_t)(s0 + 16 * qtile + l15); }
        else { hl_q = 2 * wave + (l15 >> 3); ioff = l15 & 7; qrow = (size_t)MP + sb * 8 + (l15 & 7); }
        const bf16_t* qp = P.Qb + qrow * DM + (kh * 4 + hl_q) * 64 + 8 * g;
        const bf16x8 Qf0 = *(const bf16x8*)qp, Qf1 = *(const bf16x8*)(qp + 32);
        f32x4 st[9];
#pragma unroll
        for (int j = 0; j < 9; ++j) { const int row = 16 * (qtile + j) + l15; const LAS unsigned char* kr = Kt + row * 128;
            const bf16x8 K0 = *(const LAS bf16x8*)(kr + ((g ^ (row & 7)) << 4)), K1f = *(const LAS bf16x8*)(kr + (((4 + g) ^ (row & 7)) << 4));
            f32x4 a = {0.f, 0.f, 0.f, 0.f};
            a = __builtin_amdgcn_mfma_f32_16x16x32_bf16(K0, Qf0, a, 0, 0, 0); a = __builtin_amdgcn_mfma_f32_16x16x32_bf16(K1f, Qf1, a, 0, 0, 0);
            st[j] = a; }
        const float sink2 = P.sinks[kh * 4 + hl_q] * LOG2E;
        float mx = sink2;
#pragma unroll
        for (int j = 0; j < 9; ++j)
#pragma unroll
            for (int r = 0; r < 4; ++r) { const int dist = 128 + ioff - 16 * j - 4 * g - r; const bool ok = (dist >= 0) && (dist < 128) && (smp || qblk > 0 || (16 * (qtile + j) + 4 * g + r) >= 128);
                const float v = ok ? st[j][r] + bias2[hl_q * 128 + (dist & 127)] : -INFINITY; st[j][r] = v; mx = fmaxf(mx, v); }
        mx = fmaxf(mx, __shfl_xor(mx, 16)); mx = fmaxf(mx, __shfl_xor(mx, 32));
        float sum = 0.f;
#pragma unroll
        for (int j = 0; j < 9; ++j)
#pragma unroll
            for (int r = 0; r < 4; ++r) { const float e = __builtin_amdgcn_exp2f(st[j][r] - mx); st[j][r] = e; sum += e; }
        sum += __shfl_xor(sum, 16); sum += __shfl_xor(sum, 32);
        const float inv = frcp(sum + __builtin_amdgcn_exp2f(sink2 - mx));
        f32x4 o[4];
#pragma unroll
        for (int dt = 0; dt < 4; ++dt) o[dt] = (f32x4){0.f, 0.f, 0.f, 0.f};
#pragma unroll
        for (int kk = 0; kk < 5; ++kk) {
            u32x4 pw; pw.x = pk2(st[2 * kk][0], st[2 * kk][1]); pw.y = pk2(st[2 * kk][2], st[2 * kk][3]);
            if (kk < 4) { pw.z = pk2(st[2 * kk + 1][0], st[2 * kk + 1][1]); pw.w = pk2(st[2 * kk + 1][2], st[2 * kk + 1][3]); } else { pw.z = 0u; pw.w = 0u; }
            const bf16x8 Pf = __builtin_bit_cast(bf16x8, pw);
            const LAS bf16_t* v0p = Vt + (16 * (qtile + 2 * kk) + 4 * g + q) * VT_LD + 4 * p;
#pragma unroll
            for (int dt = 0; dt < 4; ++dt) { const s16x4 lo = trd(v0p + 16 * dt); const s16x4 hi = (kk < 4) ? trd(v0p + 16 * VT_LD + 16 * dt) : (s16x4){0, 0, 0, 0};
                o[dt] = __builtin_amdgcn_mfma_f32_16x16x32_bf16(cat8(lo, hi), Pf, o[dt], 0, 0, 0); }
        }
        { bf16_t* op = P.AO + qrow * DM + (kh * 4 + hl_q) * 64 + 4 * g;
#pragma unroll
          for (int dt = 0; dt < 4; ++dt) { u32x2 w; w.x = pk2(o[dt][0] * inv, o[dt][1] * inv); w.y = pk2(o[dt][2] * inv, o[dt][3] * inv); *(u32x2*)(op + 16 * dt) = w; } }
    }
}


#define XB_TMO      128
#define XB_XCNT(j)  (256  + 64 * (j))
#define XB_XSUB(j)  (1280 + 64 * (j))
#define XB_XGEN(j)  (2304 + 64 * (j))
#define XB_TOP      3328
#define XB_TOPGEN   3392
#define XCD_BAR_WORDS 3456
#define XB_SPIN_CAP (1u << 20)
__device__ __forceinline__ unsigned xb_ld(unsigned* p)              { return __hip_atomic_load(p, __ATOMIC_RELAXED, __HIP_MEMORY_SCOPE_AGENT); }
__device__ __forceinline__ unsigned xb_add(unsigned* p, unsigned v) { return __hip_atomic_fetch_add(p, v, __ATOMIC_RELAXED, __HIP_MEMORY_SCOPE_AGENT); }
__device__ __forceinline__ unsigned xb_xcc_id() { return (unsigned)__builtin_amdgcn_s_getreg((3 << 11) | 20) & 0xFu; }
#define XB_SPIN(cond, bar) do { unsigned _sp = 0; while (cond) { __builtin_amdgcn_s_sleep(1); \
    if ((++_sp & 255u) == 0u) { if (xb_ld(&(bar)[XB_TMO])) break; if (_sp > XB_SPIN_CAP) { atomicAdd(&(bar)[XB_TMO], 1u); break; } } } } while (0)
struct XcdBarrier { unsigned* bar; unsigned x; volatile LAS unsigned* st; };
__device__ __forceinline__ XcdBarrier xcd_barrier_post(unsigned* bar, volatile LAS unsigned* st) {
    XcdBarrier b; b.bar = bar; b.x = xb_xcc_id(); b.st = st;
    if (threadIdx.x == 0) (void)xb_add(&bar[XB_XCNT(b.x)], 1u);
    return b;
}
__device__ __forceinline__ void xcd_barrier_complete(unsigned* bar, unsigned x, unsigned& nloc, unsigned& nx) {
    const unsigned G = gridDim.x * gridDim.y * gridDim.z;
    unsigned sum, cnt, mine, sp = 0u;
    for (;;) {
        sum = 0u; cnt = 0u; mine = 0u;
#pragma unroll
        for (unsigned j = 0; j < 16; ++j) { const unsigned c = xb_ld(&bar[XB_XCNT(j)]); sum += c; cnt += (c > 0u) ? 1u : 0u; mine = (j == x) ? c : mine; }
        if (sum == G) break;
        __builtin_amdgcn_s_sleep(1);
        if ((++sp & 255u) == 0u) { if (xb_ld(&bar[XB_TMO])) break; if (sp > XB_SPIN_CAP) { atomicAdd(&bar[XB_TMO], 1u); break; } }
    }
    nloc = mine > 0u ? mine : 1u; nx = cnt > 0u ? cnt : 1u;
}
__device__ __forceinline__ void xcd_barrier(const XcdBarrier& b) {
    asm volatile("s_waitcnt vmcnt(0)" ::: "memory");
    __syncthreads();
    if (threadIdx.x == 0) {
        unsigned* bar = b.bar;
        __builtin_amdgcn_s_waitcnt(0);
        unsigned nloc = b.st[0], nx = b.st[1];
        if (nloc == 0u) { xcd_barrier_complete(bar, b.x, nloc, nx); b.st[0] = nloc; b.st[1] = nx; }
        const unsigned old = xb_add(&bar[XB_XSUB(b.x)], 1u);
        const unsigned gen = old / nloc;
        if (old + 1u == (gen + 1u) * nloc) {
            __builtin_amdgcn_fence(__ATOMIC_RELEASE, "agent");
            asm volatile("s_waitcnt vmcnt(0)" ::: "memory");
            const unsigned og = xb_add(&bar[XB_TOP], 1u);
            const unsigned tg = og / nx;
            if (og + 1u == (tg + 1u) * nx) xb_add(&bar[XB_TOPGEN], 1u);
            else XB_SPIN(xb_ld(&bar[XB_TOPGEN]) == tg, bar);
            __builtin_amdgcn_fence(__ATOMIC_ACQUIRE, "agent");
            xb_add(&bar[XB_XGEN(b.x)], 1u);
            asm volatile("s_waitcnt vmcnt(0)" ::: "memory");
        } else {
            XB_SPIN(xb_ld(&bar[XB_XGEN(b.x)]) == gen, bar);
            __builtin_amdgcn_fence(__ATOMIC_ACQUIRE, "agent");
            asm volatile("s_waitcnt vmcnt(0)" ::: "memory");
        }
    }
    __syncthreads();
}

__global__ void __launch_bounds__(NTHREADS, 2) yoco_fwd(Args args) {
    extern __shared__ __attribute__((aligned(16))) unsigned char lds_raw[];
    LAS unsigned char* lds = (LAS unsigned char*)lds_raw;
    const int tid = threadIdx.x, lane = tid & 63, wave = __builtin_amdgcn_readfirstlane(tid >> 6), G = gridDim.x, bx = blockIdx.x;
    const int gw = bx * NWAVES + wave, NGW = G * NWAVES;
    typedef const __attribute__((address_space(4))) Args* KArgsP;
    const KArgsP kp0 = (KArgsP)__builtin_amdgcn_kernarg_segment_ptr();
#define KARG(field) ({ KArgsP q_ = kp0; asm volatile("" : "+s"(q_)); q_->field; })
#define ws KARG(ws)
#define out KARG(out)
#define x_prompt KARG(in[0])
#define x_sample KARG(in[1])
#define state_gla KARG(in[2])
#define cache_k KARG(in[3])
#define cache_v KARG(in[4])
#define p_prompt KARG(in[5])
#define p_sample KARG(in[6])
#define norm_mix KARG(in[7])
#define norm_mlp KARG(in[8])
#define norm_ple KARG(in[9])
#define norm_kv KARG(in[10])
#define norm_final KARG(in[11])
#define w_in_a KARG(in[12])
#define w_a2 KARG(in[13])
#define b_a2 KARG(in[14])
#define gla_o_gain KARG(in[15])
#define w_out_a KARG(in[16])
#define w_kv KARG(in[17])
#define w_q_b KARG(in[18])
#define w_o_b KARG(in[19])
#define sinks KARG(in[20])
#define rel_bias KARG(in[21])
#define w_up KARG(in[22])
#define w_down KARG(in[23])
#define w_ple KARG(in[24])
#define w_ple_gate KARG(in[25])
#define W_IN ((bf16_t*)(ws + WS_W_IN))
#define W_OUT ((bf16_t*)(ws + WS_W_OUT))
#define W_KVQ ((bf16_t*)(ws + WS_W_KVQ))
#define W_O ((bf16_t*)(ws + WS_W_O))
#define XB ((bf16_t*)(ws + WS_XB))
#define PB ((bf16_t*)(ws + WS_PB))
#define Q1 ((bf16_t*)(ws + WS_Q1))
#define K1 ((bf16_t*)(ws + WS_K1))
#define V1 ((bf16_t*)(ws + WS_V1))
#define G1 ((bf16_t*)(ws + WS_G1))
#define HIDA ((bf16_t*)(ws + WS_R1))
#define H3B ((bf16_t*)(ws + WS_R1))
#define R3 ((bf16_t*)(ws + WS_R3))
#define HIDS (R3 + (size_t)(64 - HID_SPLIT) * 256 * FF)
#define KVR ((bf16_t*)(ws + WS_KVR))
#define PLQ ((bf16_t*)(ws + WS_PLQ))
#define SSQ0 ((float*)(ws + WS_SSQ))
#define SSQ1 ((float*)(ws + WS_SSQ) + (size_t)M * 16)
#define DV ((float*)(ws + WS_DV))
#define H (out + O_Y)
#define UT ((bf16_t*)(out + O_Y))
    cg::grid_group grid = cg::this_grid();
    volatile LAS unsigned* bst = (volatile LAS unsigned*)(lds + LDS_BYTES - 64);
    if (tid < 2) bst[tid] = 0u;
    __syncthreads();
    XcdBarrier xbar; xbar.bar = nullptr; xbar.x = 0; xbar.st = bst;
#if !MK_SPLIT
    xbar = xcd_barrier_post((unsigned*)(ws + WS_CTL), bst);
#endif
    const int lo = KARG(ph_lo), hi = KARG(ph_hi);
#define IN(k) (lo <= (k) && (k) < hi)
#define SEAM(k) do { if (IN(k) && IN((k) + 1)) { if (MK_SPLIT) grid.sync(); else xcd_barrier(xbar); } } while (0)
    if (lo < 0) grid.sync();

    if (IN(0)) {
        LAS float* scr = (LAS float*)(lds + wave * 16384);
#define TJ_LIST(X) \
        X(w_in_a, IN_A_COLS, DM, 512, W_IN, norm_mix, 0.08838834764831845f)                                     \
        X(w_in_a + 512, IN_A_COLS, DM, 2560, W_IN + (size_t)512 * DM, norm_mix, 1.f)                            \
        X(w_out_a, DM, DM, DM, W_OUT, (const float*)nullptr, 1.f) \
        X(w_up, FF, DM, FF, (bf16_t*)(ws + WS_W_UP0), norm_mlp, 1.f) \
        X(w_up + (size_t)DM * FF, FF, DM, FF, (bf16_t*)(ws + WS_W_UP1), norm_mlp + DM, 1.f) \
        X(w_down, DM, FF, DM, (bf16_t*)(ws + WS_W_DN0), (const float*)nullptr, 1.f) \
        X(w_down + (size_t)DM * FF, DM, FF, DM, (bf16_t*)(ws + WS_W_DN1), (const float*)nullptr, 1.f) \
        X(w_ple_gate, DM, DM, DM, (bf16_t*)(ws + WS_W_G0), norm_ple, 1.f) \
        X(w_ple_gate + (size_t)DM * DM, DM, DM, DM, (bf16_t*)(ws + WS_W_G1), norm_ple + DM, 1.f) \
        X(w_ple, DM, PLE, DM, (bf16_t*)(ws + WS_W_P0), (const float*)nullptr, 1.f) \
        X(w_ple + (size_t)PLE * DM, DM, PLE, DM, (bf16_t*)(ws + WS_W_P1), (const float*)nullptr, 1.f) \
        X(w_kv, 512, DM, 512, W_KVQ, norm_kv, 1.f) \
        X(w_q_b, DM, DM, DM, W_KVQ + (size_t)512 * DM, norm_mix + DM, 0.125f * LOG2E)                          \
        X(w_o_b, DM, DM, DM, W_O, (const float*)nullptr, 1.f)
#define TJ_COUNT(W, LDW, KK, NCOLS, DST, GAIN, SCALE) + ((KK) / 64) * ((NCOLS) / 32)
        constexpr int TJ_TOTAL = 0 TJ_LIST(TJ_COUNT);
#define TJ_DECODE(WP, LDW, KK, NCOLS, DSTP, GAINP, SCALEV) if (!done_ && r_ < ((KK) / 64) * ((NCOLS) / 32)) { jt_.src = (WP); jt_.ldw = (LDW); jt_.kk = (KK); jt_.nblk = (NCOLS) / 32; jt_.dst = (DSTP); jt_.gain = (GAINP); jt_.scale = (SCALEV); jt_.item = r_; done_ = true; } else if (!done_) r_ -= ((KK) / 64) * ((NCOLS) / 32);
#define TJ_GET(JOUT, it) do { int r_ = (it); bool done_ = false; TJob jt_; jt_.src = nullptr; jt_.ldw = 0; jt_.kk = 0; jt_.nblk = 1; jt_.dst = nullptr; jt_.gain = nullptr; jt_.scale = 1.f; jt_.item = 0; TJ_LIST(TJ_DECODE) JOUT = jt_; } while (0)
        { float ra_[32], rb_[32]; TJob Ja, Jb; int it = gw;
          if (it < TJ_TOTAL) { TJ_GET(Ja, it); p0_tload(Ja, ra_, lane); }
          while (it < TJ_TOTAL) {
              const int it1 = it + NGW; if (it1 < TJ_TOTAL) { TJ_GET(Jb, it1); p0_tload(Jb, rb_, lane); }
              p0_tfinish(Ja, ra_, scr, lane);
              if (it1 >= TJ_TOTAL) break;
              const int it2 = it1 + NGW; if (it2 < TJ_TOTAL) { TJ_GET(Ja, it2); p0_tload(Ja, ra_, lane); }
              p0_tfinish(Jb, rb_, scr, lane);
              it = it2; } }
#undef TJ_LIST
#undef TJ_COUNT
#undef TJ_DECODE
#undef TJ_GET
        for (int idx = bx * NTHREADS + tid; idx < 512 * 128; idx += G * NTHREADS) { const int n = idx >> 7, k8 = (idx & 127) * 8; float wa[16];
#pragma unroll
            for (int r = 0; r < 16; ++r) wa[r] = w_a2[r * 512 + n];
            float o8[8];
#pragma unroll
            for (int kk = 0; kk < 8; ++kk) { const float* wr_ = w_in_a + (size_t)(k8 + kk) * IN_A_COLS + 3072; float s = 0.f;
#pragma unroll
                for (int r = 0; r < 16; ++r) s += wr_[r] * wa[r];
                o8[kk] = s * norm_mix[k8 + kk]; }
            u32x4 o; o.x = pk2(o8[0], o8[1]); o.y = pk2(o8[2], o8[3]); o.z = pk2(o8[4], o8[5]); o.w = pk2(o8[6], o8[7]);
            *(u32x4*)(W_IN + (size_t)(3072 + n) * DM + k8) = o; }
        for (int grp = bx; grp < M / 64; grp += G)
#pragma unroll 1
          for (int half = 0; half < 2; ++half) { const int m0 = 64 * grp + 8 * wave + 4 * half; f32x4 v[4][4]; float s[4];
#pragma unroll
            for (int q = 0; q < 4; ++q) { const int m = m0 + q; const float* xr = m < MP ? x_prompt + (size_t)m * DM : x_sample + (size_t)(m - MP) * DM;
#pragma unroll
                for (int j = 0; j < 4; ++j) v[q][j] = __builtin_nontemporal_load((const f32x4*)xr + lane + 64 * j); }
#pragma unroll
            for (int q = 0; q < 4; ++q) { const int m = m0 + q; float ss = 0.f;
#pragma unroll
                for (int j = 0; j < 4; ++j) { ss += (v[q][j].x * v[q][j].x + v[q][j].y * v[q][j].y) + (v[q][j].z * v[q][j].z + v[q][j].w * v[q][j].w);
                    u32x2 w; w.x = pk2(v[q][j].x, v[q][j].y); w.y = pk2(v[q][j].z, v[q][j].w); *((u32x2*)(XB + (size_t)m * DM) + lane + 64 * j) = w; }
                s[q] = wave_sum(ss);
                if (lane < 4) *(f32x4*)(SSQ0 + ssq_idx(lane, m, 0)) = (f32x4){lane == 0 ? s[q] : 0.f, 0.f, 0.f, 0.f}; } }
        for (int m0 = gw * 8; m0 < M; m0 += NGW * 8) { f32x4 v[8];
#pragma unroll
            for (int q = 0; q < 8; ++q) { const int m = m0 + q; v[q] = *((const f32x4*)(m < MP ? p_prompt + (size_t)m * PLE : p_sample + (size_t)(m - MP) * PLE) + lane); }
#pragma unroll
            for (int q = 0; q < 8; ++q) { u32x2 w; w.x = pk2(v[q].x, v[q].y); w.y = pk2(v[q].z, v[q].w); *((u32x2*)(PB + (size_t)(m0 + q) * PLE) + lane) = w; } }
    }
    SEAM(0);
    if (IN(1)) { pg8::Gemm g{XB, XB, NPAN, W_IN, M, N_IN, DM}; pg8::StaticOrder S; S.init(M, N_IN, G, bx);
        pg8::EpiIn E{Q1, K1, V1, G1, KVR, SSQ0, b_a2}; pg8::gemm_phase(lds, g, S, E); }
    SEAM(1);
    if (IN(2)) {
        for (int base = bx * 2; base < SB * 4; base += G * 2) gla_sample_pair(lds, base, Q1, K1, V1, G1, KVR, state_gla, out + O_SS, gla_o_gain, R3, tid);
        gla_super_phase<false>(lds, G, bx, nullptr, K1, V1, nullptr, KVR, UT, DV, nullptr, nullptr, nullptr, tid, lane, wave);
    }
    SEAM(2);
    if (IN(3)) gla_scan<NSUP>(UT, DV, out + O_SP, bx * NTHREADS + tid, G * NTHREADS);
    SEAM(3);
    if (IN(4)) { gla_super_phase<true>(lds, G, bx, Q1, K1, V1, G1, KVR, UT, nullptr, gla_o_gain, R3, out + O_SP, tid, lane, wave); }
    SEAM(4);
    if (IN(5)) {
        { pg8::Gemm g{R3, R3, NPAN, W_OUT, MP, DM, DM}; pg8::StaticOrder S; S.init(MP, DM, G, bx); pg8::EpiRes<false> E{nullptr, nullptr, XB, XB, SSQ1, 1.f}; pg8::gemm_phase(lds, g, S, E); }
        { pg8::Gemm g{PB, PB, NPAN, (const bf16_t*)(ws + WS_W_P0), MP, DM, PLE}; pg8::StaticOrder S; S.init(MP, DM, G, bx); pg8::EpiPl E{PLQ}; pg8::gemm_phase(lds, g, S, E); }
        { mg::MRes<false> E{nullptr, XB, XB, SSQ1, 1.f}; mg::mini_gemm(lds, R3 + (size_t)MP * DM, W_OUT, DM, DM, G, bx, E); }
        { mg::MPl E{PLQ, nullptr}; mg::mini_gemm(lds, PB + (size_t)MP * PLE, (const bf16_t*)(ws + WS_W_P0), DM, PLE, G, bx, E); }
    }
    SEAM(5);
    if (IN(6)) { { pg8::Gemm g{XB, XB, NPAN, (const bf16_t*)(ws + WS_W_UP0), MP, FF, DM}; pg8::StaticOrder S; S.init(MP, FF, G, bx); pg8::EpiUp E{HIDA, R3, SSQ1}; pg8::gemm_phase(lds, g, S, E); }
        { mg::MUp E{HIDS, SSQ1, nullptr}; mg::mini_gemm(lds, XB + (size_t)MP * DM, (const bf16_t*)(ws + WS_W_UP0), FF, DM, G, bx, E); } }
    SEAM(6);
    if (IN(7)) { { pg8::Gemm g{HIDA, R3, HID_SPLIT, (const bf16_t*)(ws + WS_W_DN0), MP, DM, FF}; pg8::StaticOrder S; S.init(MP, DM, G, bx); pg8::EpiRes<false> E{nullptr, nullptr, XB, XB, SSQ0, 1.f}; pg8::gemm_phase(lds, g, S, E); }
        { mg::MRes<false> E{nullptr, XB, XB, SSQ0, 1.f}; mg::mini_gemm(lds, HIDS, (const bf16_t*)(ws + WS_W_DN0), DM, FF, G, bx, E); } }
    SEAM(7);
    if (IN(8)) { { pg8::Gemm g{XB, XB, NPAN, (const bf16_t*)(ws + WS_W_G0), MP, DM, DM}; pg8::StaticOrder S; S.init(MP, DM, G, bx); pg8::EpiGate<false> E{nullptr, XB, PLQ, H3B, SSQ0, SSQ1, 1.f}; pg8::gemm_phase(lds, g, S, E); }
        { mg::MGate<false> E{nullptr, XB, PLQ, H3B, SSQ0, SSQ1, 1.f}; mg::mini_gemm(lds, XB + (size_t)MP * DM, (const bf16_t*)(ws + WS_W_G0), DM, DM, G, bx, E); } }
    SEAM(8);
    if (IN(9)) { pg8::Gemm g{H3B, H3B, NPAN, W_KVQ, M, NKVQ, DM}; pg8::StaticOrder S; S.init(M, NKVQ, G, bx);
        pg8::EpiKvq E{KVR, PLQ, SSQ1, out + O_CKP, out + O_CVP, out + O_CKS, out + O_CVS}; pg8::gemm_phase(lds, g, S, E); }
    SEAM(9);
    if (IN(10)) {
        const AttnP AP{KVR, PLQ, R3, cache_k, cache_v, out + O_CKS, out + O_CVS, sinks, rel_bias};
        { AttnRegs AR; int buf = 0;
          if (bx < 1024) { attn_load(bx, AP, AR, tid); attn_stage(lds, bx, AP, AR, tid); }
          LDS_BAR();
          for (int it = bx; it < 1024; it += G) { const int nx = it + G;
              if (nx < 1024) attn_load(nx, AP, AR, tid);
              attn_compute(lds + buf * ATT_BUF, it, AP, lane, wave);
              if (nx < 1024) attn_stage(lds + (buf ^ 1) * ATT_BUF, nx, AP, AR, tid);
              LDS_BAR(); buf ^= 1; } }
        for (int m0 = gw * 8; m0 < M; m0 += NGW * 8) { f32x4 v[8];
#pragma unroll
            for (int q = 0; q < 8; ++q) { const int m = m0 + q; v[q] = *((const f32x4*)(m < MP ? p_prompt + (size_t)(MP + m) * PLE : p_sample + (size_t)(MS + m - MP) * PLE) + lane); }
#pragma unroll
            for (int q = 0; q < 8; ++q) { u32x2 w; w.x = pk2(v[q].x, v[q].y); w.y = pk2(v[q].z, v[q].w); *((u32x2*)(PB + (size_t)(m0 + q) * PLE) + lane) = w; } }
    }
    SEAM(10);
    if (IN(11)) {
        { pg8::Gemm g{R3, R3, NPAN, W_O, MP, DM, DM}; pg8::StaticOrder S; S.init(MP, DM, G, bx); pg8::EpiRes<false> E{nullptr, nullptr, H3B, XB, SSQ0, 1.f}; pg8::gemm_phase(lds, g, S, E); }
        { pg8::Gemm g{PB, PB, NPAN, (const bf16_t*)(ws + WS_W_P1), MP, DM, PLE}; pg8::StaticOrder S; S.init(MP, DM, G, bx); pg8::EpiPl E{PLQ}; pg8::gemm_phase(lds, g, S, E); }
        { mg::MRes<false> E{nullptr, H3B, XB, SSQ0, 1.f}; mg::mini_gemm(lds, R3 + (size_t)MP * DM, W_O, DM, DM, G, bx, E); }
        { mg::MPl E{PLQ, nullptr}; mg::mini_gemm(lds, PB + (size_t)MP * PLE, (const bf16_t*)(ws + WS_W_P1), DM, PLE, G, bx, E); }
    }
    SEAM(11);
    if (IN(12)) { { pg8::Gemm g{XB, XB, NPAN, (const bf16_t*)(ws + WS_W_UP1), MP, FF, DM}; pg8::StaticOrder S; S.init(MP, FF, G, bx); pg8::EpiUp E{HIDA, R3, SSQ0}; pg8::gemm_phase(lds, g, S, E); }
        { mg::MUp E{HIDS, SSQ0, nullptr}; mg::mini_gemm(lds, XB + (size_t)MP * DM, (const bf16_t*)(ws + WS_W_UP1), FF, DM, G, bx, E); } }
    SEAM(12);
    if (IN(13)) { { pg8::Gemm g{HIDA, R3, HID_SPLIT, (const bf16_t*)(ws + WS_W_DN1), MP, DM, FF}; pg8::StaticOrder S; S.init(MP, DM, G, bx); pg8::EpiRes<false> E{nullptr, nullptr, XB, XB, SSQ1, 1.f}; pg8::gemm_phase(lds, g, S, E); }
        { mg::MRes<false> E{nullptr, XB, XB, SSQ1, 1.f}; mg::mini_gemm(lds, HIDS, (const bf16_t*)(ws + WS_W_DN1), DM, FF, G, bx, E); } }
    SEAM(13);
    if (IN(14)) { { pg8::Gemm g{XB, XB, NPAN, (const bf16_t*)(ws + WS_W_G1), MP, DM, DM}; pg8::StaticOrder S; S.init(MP, DM, G, bx); pg8::EpiGate<false> E{nullptr, XB, PLQ, H3B, SSQ1, SSQ0, 1.f}; pg8::gemm_phase(lds, g, S, E); }
        { mg::MGate<false> E{nullptr, XB, PLQ, H3B, SSQ1, SSQ0, 1.f}; mg::mini_gemm(lds, XB + (size_t)MP * DM, (const bf16_t*)(ws + WS_W_G1), DM, DM, G, bx, E); } }
    SEAM(14);
    if (IN(15)) {
        f32x4 gn[4];
#pragma unroll
        for (int j = 0; j < 4; ++j) gn[j] = *((const f32x4*)norm_final + lane + 64 * j);
        for (int m0 = gw * 4; m0 < M; m0 += NGW * 4) { u32x2 w[4][4]; float r[4];
#pragma unroll
            for (int q = 0; q < 4; ++q) { r[q] = row_r(SSQ0, m0 + q);
#pragma unroll
                for (int j = 0; j < 4; ++j) w[q][j] = *((const u32x2*)(H3B + (size_t)(m0 + q) * DM) + lane + 64 * j); }
#pragma unroll
            for (int q = 0; q < 4; ++q)
#pragma unroll
                for (int j = 0; j < 4; ++j) { const f32x4 v = {bflo(w[q][j].x), bfhi(w[q][j].x), bflo(w[q][j].y), bfhi(w[q][j].y)};
                    __builtin_nontemporal_store(v * r[q] * gn[j], (f32x4*)(H + (size_t)(m0 + q) * DM) + lane + 64 * j); } }
    }
#undef IN
#undef SEAM
}
#undef ws
#undef out
#undef x_prompt
#undef x_sample
#undef state_gla
#undef cache_k
#undef cache_v
#undef p_prompt
#undef p_sample
#undef norm_mix
#undef norm_mlp
#undef norm_ple
#undef norm_kv
#undef norm_final
#undef w_in_a
#undef w_a2
#undef b_a2
#undef gla_o_gain
#undef w_out_a
#undef w_kv
#undef w_q_b
#undef w_o_b
#undef sinks
#undef rel_bias
#undef w_up
#undef w_down
#undef w_ple
#undef w_ple_gate
#undef W_IN
#undef W_OUT
#undef W_KVQ
#undef W_O
#undef XB
#undef PB
#undef Q1
#undef K1
#undef V1
#undef G1
#undef HIDA
#undef H3B
#undef R3
#undef HIDS
#undef KVR
#undef PLQ
#undef SSQ0
#undef SSQ1
#undef DV
#undef H
#undef UT
#undef KARG

extern "C" void kernel_launch(void* const* d_in, const int* in_sizes, int n_in, void* d_out, int out_size, void* d_ws, size_t ws_size, hipStream_t stream) {
    static int grid = 0;
    if (grid == 0) {
        if (n_in != 26 || (size_t)out_size != O_END || ws_size < WS_END) { fprintf(stderr, "kernel_launch: unexpected shapes (n_in %d out %d ws %zu need %zu)\n", n_in, out_size, ws_size, (size_t)WS_END); grid = -1; return; }
        int dev = 0, cus = 0, per_cu = 0;
        hipGetDevice(&dev); hipDeviceGetAttribute(&cus, hipDeviceAttributeMultiprocessorCount, dev);
        hipFuncSetAttribute((const void*)yoco_fwd, hipFuncAttributeMaxDynamicSharedMemorySize, LDS_BYTES);
        hipOccupancyMaxActiveBlocksPerMultiprocessor(&per_cu, (const void*)yoco_fwd, NTHREADS, LDS_BYTES);
        if (per_cu < 1) { fprintf(stderr, "kernel_launch: occupancy query says %d blocks per CU\n", per_cu); per_cu = 1; }
        (void)hipGetLastError();
        grid = cus * 1;
    }
    if (grid < 0) return;
    if (hipMemsetAsync((char*)d_ws + WS_CTL, 0, 65536, stream) != hipSuccess) { fprintf(stderr, "kernel_launch: memset failed\n"); return; }
    Args a{};
    for (int i = 0; i < 26; ++i) a.in[i] = (const float*)d_in[i];
    a.out = (float*)d_out; a.ws = (unsigned char*)d_ws;
#if MK_SPLIT
    for (int ph = 0; ph < 16; ++ph) { a.ph_lo = ph; a.ph_hi = ph + 1; hipLaunchKernelGGL(yoco_fwd, dim3(grid), dim3(NTHREADS), LDS_BYTES, stream, a); }
#else
    a.ph_lo = 0; a.ph_hi = 16;
    void* kargs[] = {&a};
    hipError_t e = hipLaunchCooperativeKernel((const void*)yoco_fwd, dim3(grid), dim3(NTHREADS), kargs, LDS_BYTES, stream);
    if (e != hipSuccess) fprintf(stderr, "cooperative launch failed: %s (grid %d)\n", hipGetErrorString(e), grid);
#endif
}
```

```cpp
#include <hip/hip_runtime.h>
#include <hip/hip_cooperative_groups.h>
#include <cstdio>
#include <cstdint>
namespace cg = cooperative_groups;

#define LAS __attribute__((address_space(3)))
#define GAS __attribute__((address_space(1)))
typedef unsigned short bf16_t;
typedef short bf16x8 __attribute__((ext_vector_type(8)));
typedef short s16x4 __attribute__((ext_vector_type(4)));
typedef float f32x4 __attribute__((ext_vector_type(4)));
typedef float f32x2 __attribute__((ext_vector_type(2)));
typedef unsigned u32x4 __attribute__((ext_vector_type(4)));
typedef unsigned u32x2 __attribute__((ext_vector_type(2)));

#ifndef MK_SPLIT
#define MK_SPLIT 0
#endif

constexpr int DM = 1024, SEQ = 8192, NBATCH = 2, MP = NBATCH * SEQ, SB = 128, SS = 8, MS = SB * SS, M = MP + MS, NPAN = M / 256;
constexpr int NQK = 512, NV = 1024, N_IN = 3584, FF = 4096, PLE = 256, NKVQ = 1536, IN_A_COLS = 3088;
constexpr int NCHUNK = 128, NBH = 8, NCH_ALL = NBH * NCHUNK;
constexpr float EPS = 1e-6f, LOG2E = 1.4426950408889634f;
constexpr int HID_SPLIT = 51;

constexpr size_t O_Y = 0, O_SP = (size_t)M * DM, O_SS = O_SP + 262144, O_CKP = O_SS + 16777216, O_CVP = O_CKP + 65536, O_CKS = O_CVP + 65536, O_CVS = O_CKS + 4194304, O_END = O_CVS + 4194304;

constexpr size_t al256(size_t x) { return (x + 255) & ~(size_t)255; }
constexpr size_t WS_CTL = 0, CTL_BYTES = 1u << 20;
constexpr size_t WS_W_IN = CTL_BYTES;
constexpr size_t WS_W_OUT = WS_W_IN + (size_t)N_IN * DM * 2;
constexpr size_t WS_W_UP0 = WS_W_OUT + (size_t)DM * DM * 2;
constexpr size_t WS_W_DN0 = WS_W_UP0 + (size_t)FF * DM * 2;
constexpr size_t WS_W_UP1 = WS_W_DN0 + (size_t)FF * DM * 2;
constexpr size_t WS_W_DN1 = WS_W_UP1 + (size_t)FF * DM * 2;
constexpr size_t WS_W_G0 = WS_W_DN1 + (size_t)FF * DM * 2;
constexpr size_t WS_W_G1 = WS_W_G0 + (size_t)DM * DM * 2;
constexpr size_t WS_W_P0 = WS_W_G1 + (size_t)DM * DM * 2;
constexpr size_t WS_W_P1 = WS_W_P0 + (size_t)DM * PLE * 2;
constexpr size_t WS_W_KVQ = WS_W_P1 + (size_t)DM * PLE * 2;
constexpr size_t WS_W_O = WS_W_KVQ + (size_t)NKVQ * DM * 2;
constexpr size_t WS_XB = WS_W_O + (size_t)DM * DM * 2;
constexpr size_t WS_PB = WS_XB + (size_t)M * DM * 2;
constexpr size_t WS_R1 = WS_PB + (size_t)M * PLE * 2;
constexpr size_t R1_BYTES = (size_t)HID_SPLIT * 256 * FF * 2;
constexpr size_t WS_Q1 = WS_R1, WS_K1 = WS_Q1 + (size_t)M * NQK * 2, WS_V1 = WS_K1 + (size_t)M * NQK * 2, WS_G1 = WS_V1 + (size_t)M * NV * 2;
static_assert(WS_G1 + (size_t)M * NV * 2 == WS_R1 + R1_BYTES, "R1 map");
constexpr size_t WS_R3 = WS_R1 + R1_BYTES;
static_assert((size_t)(NPAN - HID_SPLIT) * 256 * FF * 2 == (size_t)M * DM * 2, "R3 map");
constexpr size_t WS_KVR = WS_R3 + (size_t)M * DM * 2;
constexpr size_t WS_PLQ = WS_KVR + (size_t)M * NQK * 2;
constexpr size_t WS_SSQ = WS_PLQ + (size_t)M * DM * 2;
constexpr size_t WS_DV = WS_SSQ + (size_t)2 * M * 16 * 4;
constexpr size_t WS_END = WS_DV + (size_t)NCH_ALL * 128 * 4;

__device__ __forceinline__ float bf2f(unsigned short b) { return __uint_as_float((unsigned)b << 16); }
__device__ __forceinline__ float bflo(unsigned w) { return __uint_as_float(w << 16); }
__device__ __forceinline__ float bfhi(unsigned w) { return __uint_as_float(w & 0xffff0000u); }
typedef __bf16 bf16x2_t __attribute__((ext_vector_type(2)));
__device__ __forceinline__ unsigned pk2(float lo, float hi) { const f32x2 v = {lo, hi}; const bf16x2_t b = __builtin_convertvector(v, bf16x2_t); return __builtin_bit_cast(unsigned, b); }
__device__ __forceinline__ float fexp(float x) { return __builtin_amdgcn_exp2f(x * LOG2E); }
__device__ __forceinline__ float frcp(float x) { return __builtin_amdgcn_rcpf(x); }
__device__ __forceinline__ float frsq(float x) { return __builtin_amdgcn_rsqf(x); }
__device__ __forceinline__ float fsigmoid(float x) { return frcp(1.f + fexp(-x)); }
__device__ __forceinline__ float logsig(float x) { return fminf(x, 0.f) - __logf(1.f + fexp(-fabsf(x))); }
__device__ __forceinline__ s16x4 trd(const LAS bf16_t* p) { return __builtin_bit_cast(s16x4, __builtin_amdgcn_ds_read_tr16_b64_v4i16((LAS s16x4*)p)); }
__device__ __forceinline__ bf16x8 cat8(s16x4 lo, s16x4 hi) { return (bf16x8){lo[0], lo[1], lo[2], lo[3], hi[0], hi[1], hi[2], hi[3]}; }
__device__ __forceinline__ void st_wt(float* p, float v) { __hip_atomic_store(p, v, __ATOMIC_RELAXED, __HIP_MEMORY_SCOPE_AGENT); }
__device__ __forceinline__ void st16_wt(void* p, u32x4 v) { asm volatile("global_store_dwordx4 %0, %1, off sc1\n\ts_nop 1" :: "v"(p), "v"(v) : "memory"); }
__device__ __forceinline__ float wave_sum(float v) {
#pragma unroll
    for (int o = 1; o < 64; o <<= 1) v += __shfl_xor(v, o);
    return v;
}
__device__ __forceinline__ size_t ssq_idx(int pn, int row, int wc) { return ((size_t)pn * M + row) * 4 + wc; }
__device__ __forceinline__ float row_r(const float* ssq, int row) {
    const f32x4 a = *(const f32x4*)(ssq + ssq_idx(0, row, 0)), b = *(const f32x4*)(ssq + ssq_idx(1, row, 0)), c = *(const f32x4*)(ssq + ssq_idx(2, row, 0)), d = *(const f32x4*)(ssq + ssq_idx(3, row, 0));
    const f32x4 s = (a + b) + (c + d);
    return frsq(((s.x + s.y) + (s.z + s.w)) * (1.f / 1024.f) + EPS);
}

namespace pg8 {
constexpr int BM = 256, BK = 64, HALF = 128, HTB = HALF * BK * 2, STAGE_BYTES = 8 * HTB, NXCD = 8, WGM = 8;
__host__ __device__ __forceinline__ int lds_byte(int r, int c) { const int st = (r >> 4) * 2 + (c >> 5), rr = r & 15, cc = c & 31, ob = rr * 64 + cc * 2; return st * 1024 + (ob ^ (((ob >> 9) & 1) << 5)); }
__host__ __device__ __forceinline__ void stage_rc(int b, int& R, int& C) { const int st = b / 1024, sb = b % 1024, swz = sb ^ (((sb >> 9) & 1) << 5); R = (st >> 1) * 16 + swz / 64; C = (st & 1) * 32 + (swz % 64) / 2; }
__host__ __device__ __forceinline__ int perm32(int rho) { const int n = rho >> 4, i = rho & 15; return 8 * (i >> 2) + 4 * n + (i & 3); }
struct Unit { int pm, pn; };
struct Gemm { const bf16_t* A; const bf16_t* A2; int split; const bf16_t* Bt; int M, N, K; };
struct StaticOrder {
    int nM, nN, nwg, G, c;
    __device__ void init(int M_, int N, int G_, int c_) { nM = M_ / BM; nN = N / BM; nwg = nM * nN; G = G_; c = c_; }
    __device__ bool next(int i, Unit& u) const {
        const long L = (long)i * G + c; if (L >= nwg) return false;
        int wgid = (int)L; { const int q = nwg / NXCD, r = nwg % NXCD, xcd = wgid % NXCD, off = wgid / NXCD; wgid = (xcd < r ? xcd * (q + 1) : r * (q + 1) + (xcd - r) * q) + off; }
        const int nig = WGM * nN, gid = wgid / nig, fm = gid * WGM, gsz = (nM - fm) < WGM ? (nM - fm) : WGM;
        u.pm = fm + ((wgid % nig) % gsz); u.pn = (wgid % nig) / gsz; return true;
    }
};

template <class Epi>
__device__ __forceinline__ void gemm_phase(LAS unsigned char* lds, const Gemm g, const StaticOrder& S, const Epi& E) {
    const int tid = threadIdx.x, wid = __builtin_amdgcn_readfirstlane(tid >> 6), lane = tid & 63, wr = wid >> 2, wc = wid & 3, fr = lane & 15, fq = lane >> 4;
    const int K = g.K, nt = K / BK;
    unsigned voffA[2], voffB[2];
#pragma unroll
    for (int i = 0; i < 2; ++i) { int R, C; stage_rc(tid * 16 + i * 8192, R, C); const int Rb = (R & ~31) + perm32(R & 31);
        voffA[i] = (unsigned)(R * K + C) * 2u; voffB[i] = (unsigned)(Rb * K + C) * 2u; }
    const size_t kstep = (size_t)(BK * 2);
    const size_t hstep = (size_t)HALF * K * 2;
    const size_t tstep = 2 * hstep;
    const unsigned ldsw = (unsigned)wid * 1024u;
    const int aoff = lds_byte(wr * 64 + fr, fq * 8), boff = lds_byte(wc * 32 + fr, fq * 8);
#define PG8_APTR(pm) ((pm) < g.split ? (const char*)g.A + (size_t)(pm) * tstep : (const char*)g.A2 + (size_t)((pm) - g.split) * tstep)
#define PG8_SA(b, h) (((b) * 2 + (h)) * HTB)
#define PG8_SB(b, h) ((4 + (b) * 2 + (h)) * HTB)
#define PG8_STAGE(bufoff, gbase, voff) do { _Pragma("unroll") for (int _i = 0; _i < 2; ++_i) \
        __builtin_amdgcn_global_load_lds((const unsigned*)((const char*)(gbase) + (voff)[_i]), (LAS unsigned*)(lds + (bufoff) + ldsw + _i * 8192), 16, 0, 0); } while (0)
#define PG8_LDA(dst, b, h) do { _Pragma("unroll") for (int m = 0; m < 4; ++m) _Pragma("unroll") for (int k = 0; k < 2; ++k) dst[m][k] = *(const LAS bf16x8*)(lds + PG8_SA(b, h) + aoff + m * 2048 + k * 1024); } while (0)
#define PG8_LDB(dst, b, h) do { _Pragma("unroll") for (int n = 0; n < 2; ++n) _Pragma("unroll") for (int k = 0; k < 2; ++k) dst[n][k] = *(const LAS bf16x8*)(lds + PG8_SB(b, h) + boff + n * 2048 + k * 1024); } while (0)
#define PG8_MMA(ai, bj, At, Bt) do { __builtin_amdgcn_s_setprio(1); _Pragma("unroll") for (int m = 0; m < 4; ++m) _Pragma("unroll") for (int n = 0; n < 2; ++n) _Pragma("unroll") for (int k = 0; k < 2; ++k) \
        acc[ai][bj][m][n] = __builtin_amdgcn_mfma_f32_16x16x32_bf16(Bt[n][k], At[m][k], acc[ai][bj][m][n], 0, 0, 0); __builtin_amdgcn_s_setprio(0); } while (0)
#define PG8_WAIT_V(n) asm volatile("s_waitcnt vmcnt(" #n ")" ::: "memory")
#define PG8_WAIT_L(n) asm volatile("s_waitcnt lgkmcnt(" #n ")" ::: "memory")
#define PG8_BAR __builtin_amdgcn_s_barrier()
#define PG8_SCHED __builtin_amdgcn_sched_barrier(0)
    Unit cur, nxt; int ui = 0;
    if (!S.next(0, cur)) return;
    LAS float* rtab_all = (LAS float*)(lds + STAGE_BYTES);
    if (E.rsrc() != nullptr) { Unit uu; for (int i = 0; i < 8 && S.next(i, uu); ++i) if (tid < 256) rtab_all[i * 256 + tid] = row_r(E.rsrc(), uu.pm * BM + tid); }
    f32x4 acc[2][2][4][2];
#pragma unroll
    for (int a = 0; a < 2; ++a)
#pragma unroll
        for (int b = 0; b < 2; ++b)
#pragma unroll
            for (int m = 0; m < 4; ++m)
#pragma unroll
                for (int n = 0; n < 2; ++n) acc[a][b][m][n] = (f32x4){0.f, 0.f, 0.f, 0.f};
    bf16x8 At[4][2], B0[2][2], B1[2][2];
    const char* cA = PG8_APTR(cur.pm); const char* cB = (const char*)g.Bt + (size_t)cur.pn * tstep;
    PG8_STAGE(PG8_SB(0, 0), cB, voffB); PG8_STAGE(PG8_SB(0, 1), cB + hstep, voffB); PG8_STAGE(PG8_SA(0, 0), cA, voffA); PG8_STAGE(PG8_SA(0, 1), cA + hstep, voffA);
    PG8_WAIT_L(0);
    if (wr == 1) PG8_BAR;
    PG8_WAIT_V(2); PG8_BAR;
    PG8_STAGE(PG8_SB(1, 0), cB + kstep, voffB); PG8_STAGE(PG8_SA(1, 0), cA + kstep, voffA); PG8_STAGE(PG8_SB(1, 1), cB + hstep + kstep, voffB);
    PG8_WAIT_V(6); PG8_BAR;
    for (;;) {
        const bool has_next = S.next(ui + 1, nxt);
        const char* nA = has_next ? PG8_APTR(nxt.pm) : cA; const char* nB = has_next ? (const char*)g.Bt + (size_t)nxt.pn * tstep : cB;
#pragma clang loop unroll(disable)
        for (int t = 0; t < nt; t += 2) {
            const bool last = (t == nt - 2);
            const char* a1 = cA + (size_t)(t + 1) * kstep;
            const char* a2 = last ? nA : cA + (size_t)(t + 2) * kstep; const char* b2 = last ? nB : cB + (size_t)(t + 2) * kstep;
            const char* a3 = a2 + kstep; const char* b3 = b2 + kstep;
            PG8_LDB(B0, 0, 0); PG8_LDB(B1, 0, 1); PG8_SCHED; PG8_LDA(At, 0, 0); PG8_STAGE(PG8_SA(1, 1), a1 + hstep, voffA);
            PG8_WAIT_V(8); PG8_WAIT_L(0); PG8_BAR; PG8_MMA(0, 0, At, B0); PG8_MMA(0, 1, At, B1); PG8_BAR; PG8_SCHED;
            PG8_LDA(At, 0, 1); PG8_STAGE(PG8_SB(0, 0), b2, voffB); PG8_STAGE(PG8_SB(0, 1), b2 + hstep, voffB); PG8_STAGE(PG8_SA(0, 0), a2, voffA);
            PG8_WAIT_V(8); PG8_WAIT_L(0); PG8_BAR; PG8_MMA(1, 0, At, B0); PG8_MMA(1, 1, At, B1); PG8_BAR; PG8_SCHED;
            PG8_LDB(B0, 1, 0); PG8_LDB(B1, 1, 1); PG8_SCHED; PG8_LDA(At, 1, 0); PG8_STAGE(PG8_SA(0, 1), a2 + hstep, voffA);
            PG8_WAIT_V(8); PG8_WAIT_L(0); PG8_BAR; PG8_MMA(0, 0, At, B0); PG8_MMA(0, 1, At, B1); PG8_BAR; PG8_SCHED;
            PG8_LDA(At, 1, 1); PG8_STAGE(PG8_SB(1, 0), b3, voffB); PG8_STAGE(PG8_SB(1, 1), b3 + hstep, voffB); PG8_STAGE(PG8_SA(1, 0), a3, voffA);
            PG8_WAIT_V(8); PG8_WAIT_L(0); PG8_BAR; PG8_MMA(1, 0, At, B0); PG8_MMA(1, 1, At, B1); PG8_BAR; PG8_SCHED;
        }
        if (wr == 0) PG8_BAR;
        { int efr = fr, efq = fq, etid = tid; asm volatile("" : "+v"(efr), "+v"(efq), "+v"(etid));
          E(acc, cur, wr, wc, efr, efq, rtab_all + (ui & 7) * 256, etid); }
        if (!has_next) break;
#pragma unroll
        for (int a = 0; a < 2; ++a)
#pragma unroll
            for (int b = 0; b < 2; ++b)
#pragma unroll
                for (int m = 0; m < 4; ++m)
#pragma unroll
                    for (int n = 0; n < 2; ++n) acc[a][b][m][n] = (f32x4){0.f, 0.f, 0.f, 0.f};
        cur = nxt; cA = nA; cB = nB; ++ui;
        if (wr == 1) PG8_BAR;
    }
    PG8_WAIT_V(0);
    PG8_BAR;
#undef PG8_APTR
#undef PG8_SA
#undef PG8_SB
#undef PG8_STAGE
#undef PG8_LDA
#undef PG8_LDB
#undef PG8_MMA
#undef PG8_WAIT_V
#undef PG8_WAIT_L
#undef PG8_BAR
#undef PG8_SCHED
}

#define EPI_ROWLOOP _Pragma("unroll") for (int ai = 0; ai < 2; ++ai) _Pragma("unroll") for (int m = 0; m < 4; ++m)
__device__ __forceinline__ u32x4 pack8(const f32x4 v0, const f32x4 v1) { u32x4 w; w.x = pk2(v0[0], v0[1]); w.y = pk2(v0[2], v0[3]); w.z = pk2(v1[0], v1[1]); w.w = pk2(v1[2], v1[3]); return w; }

struct EpiIn {
    bf16_t *Q, *Kk, *V, *G, *LG; const float* ssq; const float* b_a2;
    __device__ __forceinline__ const float* rsrc() const { return ssq; }
    __device__ __forceinline__ void operator()(const f32x4 (&acc)[2][2][4][2], const Unit& u, int wr, int wc, int fr, int fq, LAS float* rtab, int tid) const {
        const int pn = u.pn; bf16_t* base; int ld, c0;
        if (pn < 2) { base = Q; ld = NQK; c0 = pn * 256; } else if (pn < 4) { base = Kk; ld = NQK; c0 = (pn - 2) * 256; }
        else if (pn < 8) { base = V; ld = NV; c0 = (pn - 4) * 256; } else if (pn < 12) { base = G; ld = NV; c0 = (pn - 8) * 256; }
        else { base = LG; ld = NQK; c0 = (pn - 12) * 256; }
        const bool is_lg = pn >= 12;
        const int col = c0 + wc * 32 + 8 * fq;
        f32x4 bb[2][2];
#pragma unroll
        for (int bj = 0; bj < 2; ++bj)
#pragma unroll
            for (int n = 0; n < 2; ++n) bb[bj][n] = is_lg ? *(const f32x4*)(b_a2 + col + bj * HALF + 4 * n) : (f32x4){0.f, 0.f, 0.f, 0.f};
        EPI_ROWLOOP { const int lr = ai * HALF + wr * 64 + m * 16 + fr, row = u.pm * BM + lr; const float r = rtab[lr];
#pragma unroll
            for (int bj = 0; bj < 2; ++bj) { f32x4 v0 = acc[ai][bj][m][0] * r, v1 = acc[ai][bj][m][1] * r;
                if (is_lg) { v0 += bb[bj][0]; v1 += bb[bj][1];
#pragma unroll
                    for (int e = 0; e < 4; ++e) { v0[e] = logsig(v0[e]) * (1.f / 16.f); v1[e] = logsig(v1[e]) * (1.f / 16.f); } }
                *(u32x4*)(base + (size_t)row * ld + col + bj * HALF) = pack8(v0, v1); } }
    }
};
template <bool FROM_X> struct EpiRes {
    const float* X0; const float* X1; const bf16_t* BB; bf16_t* XO; float* ssq_out; float sc;
    __device__ __forceinline__ const float* rsrc() const { return nullptr; }
    __device__ __forceinline__ void operator()(const f32x4 (&acc)[2][2][4][2], const Unit& u, int wr, int wc, int fr, int fq, LAS float* rtab, int tid) const {
        const int col = u.pn * BM + wc * 32 + 8 * fq;
#pragma unroll
        for (int ai = 0; ai < 2; ++ai) {
            f32x4 b0[4][2], b1[4][2]; u32x4 bw[4][2];
#pragma unroll
            for (int m = 0; m < 4; ++m) { const int row = u.pm * BM + ai * HALF + wr * 64 + m * 16 + fr;
#pragma unroll
                for (int bj = 0; bj < 2; ++bj) {
                    if (FROM_X) { const float* src = (u.pm < MP / 256 ? X0 + (size_t)row * DM : X1 + (size_t)(row - MP) * DM) + col + bj * HALF; b0[m][bj] = *(const f32x4*)src; b1[m][bj] = *(const f32x4*)(src + 4); }
                    else bw[m][bj] = *(const u32x4*)(BB + (size_t)row * DM + col + bj * HALF); } }
            if (!FROM_X) asm volatile("" ::: "memory");
#pragma unroll
            for (int m = 0; m < 4; ++m) { const int row = u.pm * BM + ai * HALF + wr * 64 + m * 16 + fr; float s = 0.f;
#pragma unroll
                for (int bj = 0; bj < 2; ++bj) {
                    if (!FROM_X) { const u32x4 w = bw[m][bj]; b0[m][bj] = (f32x4){bflo(w.x), bfhi(w.x), bflo(w.y), bfhi(w.y)}; b1[m][bj] = (f32x4){bflo(w.z), bfhi(w.z), bflo(w.w), bfhi(w.w)}; }
                    const f32x4 v0 = acc[ai][bj][m][0] * sc + b0[m][bj], v1 = acc[ai][bj][m][1] * sc + b1[m][bj];
                    *(u32x4*)(XO + (size_t)row * DM + col + bj * HALF) = pack8(v0, v1);
                    s += (v0[0] * v0[0] + v0[1] * v0[1]) + (v0[2] * v0[2] + v0[3] * v0[3]) + (v1[0] * v1[0] + v1[1] * v1[1]) + (v1[2] * v1[2] + v1[3] * v1[3]); }
                s += __shfl_xor(s, 16); s += __shfl_xor(s, 32);
                if (fq == 0) ssq_out[ssq_idx(u.pn, row, wc)] = s; }
        }
    }
};
struct EpiUp {
    bf16_t* HA; bf16_t* HB; const float* ssq;
    __device__ __forceinline__ const float* rsrc() const { return ssq; }
    __device__ __forceinline__ void operator()(const f32x4 (&acc)[2][2][4][2], const Unit& u, int wr, int wc, int fr, int fq, LAS float* rtab, int tid) const {
        bf16_t* base = u.pm < HID_SPLIT ? HA + (size_t)u.pm * 256 * FF : HB + (size_t)(u.pm - HID_SPLIT) * 256 * FF;
        const int col = u.pn * BM + wc * 32 + 8 * fq;
        EPI_ROWLOOP { const int lr = ai * HALF + wr * 64 + m * 16 + fr; const float r = rtab[lr];
#pragma unroll
            for (int bj = 0; bj < 2; ++bj) { f32x4 v0 = acc[ai][bj][m][0] * r, v1 = acc[ai][bj][m][1] * r;
#pragma unroll
                for (int e = 0; e < 4; ++e) { const float a = fmaxf(v0[e], 0.f), b = fmaxf(v1[e], 0.f); v0[e] = a * a; v1[e] = b * b; }
                st16_wt(base + (size_t)lr * FF + col + bj * HALF, pack8(v0, v1)); } }
    }
};
struct EpiPl {
    bf16_t* PL;
    __device__ __forceinline__ const float* rsrc() const { return nullptr; }
    __device__ __forceinline__ void operator()(const f32x4 (&acc)[2][2][4][2], const Unit& u, int wr, int wc, int fr, int fq, LAS float* rtab, int tid) const {
        const int col = u.pn * BM + wc * 32 + 8 * fq;
        EPI_ROWLOOP { const int row = u.pm * BM + ai * HALF + wr * 64 + m * 16 + fr;
#pragma unroll
            for (int bj = 0; bj < 2; ++bj) *(u32x4*)(PL + (size_t)row * DM + col + bj * HALF) = pack8(acc[ai][bj][m][0], acc[ai][bj][m][1]); }
    }
};
template <bool LAST> struct EpiGate {
    float* HO; const bf16_t* BB; const bf16_t* PL; bf16_t* OB; const float* ssq_in; float* ssq_out; float sc;
    __device__ __forceinline__ const float* rsrc() const { return ssq_in; }
    __device__ __forceinline__ void operator()(const f32x4 (&acc)[2][2][4][2], const Unit& u, int wr, int wc, int fr, int fq, LAS float* rtab, int tid) const {
        const int col = u.pn * BM + wc * 32 + 8 * fq;
#pragma unroll
        for (int ai = 0; ai < 2; ++ai) {
            u32x4 bw[4][2], pw[4][2];
#pragma unroll
            for (int m = 0; m < 4; ++m) { const size_t off0 = (size_t)(u.pm * BM + ai * HALF + wr * 64 + m * 16 + fr) * DM + col;
#pragma unroll
                for (int bj = 0; bj < 2; ++bj) { bw[m][bj] = *(const u32x4*)(BB + off0 + bj * HALF); pw[m][bj] = *(const u32x4*)(PL + off0 + bj * HALF); } }
#pragma unroll
            for (int m = 0; m < 4; ++m) { const int lr = ai * HALF + wr * 64 + m * 16 + fr, row = u.pm * BM + lr; const float r = rtab[lr];
                float s = 0.f;
#pragma unroll
                for (int bj = 0; bj < 2; ++bj) { const size_t off = (size_t)row * DM + col + bj * HALF; const u32x4 b_ = bw[m][bj], p_ = pw[m][bj];
                    const f32x4 b0 = {bflo(b_.x), bfhi(b_.x), bflo(b_.y), bfhi(b_.y)}, b1 = {bflo(b_.z), bfhi(b_.z), bflo(b_.w), bfhi(b_.w)};
                    const f32x4 p0 = {bflo(p_.x), bfhi(p_.x), bflo(p_.y), bfhi(p_.y)}, p1 = {bflo(p_.z), bfhi(p_.z), bflo(p_.w), bfhi(p_.w)};
                    f32x4 v0 = acc[ai][bj][m][0] * r, v1 = acc[ai][bj][m][1] * r;
#pragma unroll
                    for (int e = 0; e < 4; ++e) { v0[e] = b0[e] + fsigmoid(v0[e]) * p0[e] * sc; v1[e] = b1[e] + fsigmoid(v1[e]) * p1[e] * sc; }
                    if (LAST) { *(f32x4*)(HO + off) = v0; *(f32x4*)(HO + off + 4) = v1; }
                    else { *(u32x4*)(OB + off) = pack8(v0, v1);
                        s += (v0[0] * v0[0] + v0[1] * v0[1]) + (v0[2] * v0[2] + v0[3] * v0[3]) + (v1[0] * v1[0] + v1[1] * v1[1]) + (v1[2] * v1[2] + v1[3] * v1[3]); } }
                if (!LAST) { s += __shfl_xor(s, 16); s += __shfl_xor(s, 32); if (fq == 0) ssq_out[ssq_idx(u.pn, row, wc)] = s; } }
        }
    }
};
struct EpiKvq {
    bf16_t* KV; bf16_t* Qb; const float* ssq; float *CKP, *CVP, *CKS, *CVS;
    __device__ __forceinline__ const float* rsrc() const { return ssq; }
    __device__ __forceinline__ void operator()(const f32x4 (&acc)[2][2][4][2], const Unit& u, int wr, int wc, int fr, int fq, LAS float* rtab, int tid) const {
        const int pn = u.pn, c = wc * 32 + 8 * fq;
        EPI_ROWLOOP { const int lr = ai * HALF + wr * 64 + m * 16 + fr, row = u.pm * BM + lr; const float r = rtab[lr];
            float* cdst = nullptr;
            if (pn < 2) {
                if (row < MP) { const int b = row >> 13, t = row & (SEQ - 1); if (t >= SEQ - 128) cdst = (pn == 0 ? CKP : CVP) + ((size_t)(b * 128 + t - (SEQ - 128)) * 256 + c); }
                else { const int rs = row - MP, sb = rs >> 3, i = rs & 7; cdst = (pn == 0 ? CKS : CVS) + ((size_t)(sb * 128 + 120 + i) * 256 + c); }
            }
            bf16_t* dst = pn < 2 ? KV + (size_t)row * 512 + pn * 256 + c : Qb + (size_t)row * DM + (pn - 2) * 256 + c;
#pragma unroll
            for (int bj = 0; bj < 2; ++bj) { const f32x4 v0 = acc[ai][bj][m][0] * r, v1 = acc[ai][bj][m][1] * r;
                *(u32x4*)(dst + bj * HALF) = pack8(v0, v1);
                if (cdst) { *(f32x4*)(cdst + bj * HALF) = v0; *(f32x4*)(cdst + bj * HALF + 4) = v1; } } }
    }
};
}


namespace mg {
constexpr int KT = 256, LDT = KT + 8, TILE_B = 64 * LDT * 2;
template <class Epi>
__device__ __forceinline__ void mini_gemm(LAS unsigned char* lds, const bf16_t* A  , const bf16_t* Bt  , int N, int K, int G, int bx, const Epi& E) {
    const int tid = threadIdx.x, lane = tid & 63, wave = __builtin_amdgcn_readfirstlane(tid >> 6), l15 = lane & 15, g = lane >> 4;
    const int rt = wave & 3, chh = wave >> 2, nk = K / KT, units = 16 * (N / 64);
    LAS float* red = (LAS float*)(lds + 4 * TILE_B);
    for (int u = bx; u < units; u += G) {
        const int rm = u & 15, cn = u >> 4;
        const bf16_t* Ag = A + (size_t)(rm * 64) * K; const bf16_t* Bg = Bt + (size_t)(cn * 64) * K;
        u32x4 ra0[4], rb0[4], ra1[4], rb1[4];
#define MG_LOAD(ra, rb, kt) do { _Pragma("unroll") for (int i = 0; i < 4; ++i) { const int c = tid + 512 * i, row = c >> 5, ch = c & 31; \
            ra[i] = *(const u32x4*)(Ag + (size_t)row * K + (kt) * KT + ch * 8); rb[i] = *(const u32x4*)(Bg + (size_t)row * K + (kt) * KT + ch * 8); } } while (0)
#define MG_STORE(ra, rb, b) do { _Pragma("unroll") for (int i = 0; i < 4; ++i) { const int c = tid + 512 * i, row = c >> 5, ch = c & 31; \
            *(LAS u32x4*)(lds + (b) * 2 * TILE_B + (row * LDT + ch * 8) * 2) = ra[i]; *(LAS u32x4*)(lds + (b) * 2 * TILE_B + TILE_B + (row * LDT + ch * 8) * 2) = rb[i]; } } while (0)
#define MG_COMPUTE(b) do { const LAS bf16_t* Al = (const LAS bf16_t*)(lds + (b) * 2 * TILE_B); const LAS bf16_t* Bl = (const LAS bf16_t*)(lds + (b) * 2 * TILE_B + TILE_B); \
            _Pragma("unroll") for (int ks = 0; ks < KT / 32; ++ks) { const bf16x8 Af = *(const LAS bf16x8*)(Al + (16 * rt + l15) * LDT + 32 * ks + 8 * g); \
                _Pragma("unroll") for (int t = 0; t < 2; ++t) { const bf16x8 Bf = *(const LAS bf16x8*)(Bl + (16 * (2 * chh + t) + l15) * LDT + 32 * ks + 8 * g); \
                    acc[t] = __builtin_amdgcn_mfma_f32_16x16x32_bf16(Bf, Af, acc[t], 0, 0, 0); } } } while (0)
        f32x4 acc[2] = {(f32x4){0.f, 0.f, 0.f, 0.f}, (f32x4){0.f, 0.f, 0.f, 0.f}};
#define MG_BAR() do { asm volatile("s_waitcnt lgkmcnt(0)" ::: "memory"); __builtin_amdgcn_s_barrier(); asm volatile("" ::: "memory"); } while (0)
        MG_LOAD(ra0, rb0, 0); if (nk > 1) MG_LOAD(ra1, rb1, 1);
        MG_STORE(ra0, rb0, 0); MG_BAR();
        for (int kt = 0; kt < nk; kt += 2) {
            if (kt + 2 < nk) MG_LOAD(ra0, rb0, kt + 2);
            MG_COMPUTE(0);
            if (kt + 1 < nk) MG_STORE(ra1, rb1, 1);
            MG_BAR();
            if (kt + 1 < nk) {
                if (kt + 3 < nk) MG_LOAD(ra1, rb1, kt + 3);
                MG_COMPUTE(1);
                if (kt + 2 < nk) MG_STORE(ra0, rb0, 0);
                MG_BAR();
            }
        }
#undef MG_BAR
        const int row = MP + rm * 64 + 16 * rt + l15; float s = 0.f;
#pragma unroll
        for (int t = 0; t < 2; ++t) { const f32x4 o = E(row, cn * 64 + 16 * (2 * chh + t) + 4 * g, acc[t]); s += (o[0] * o[0] + o[1] * o[1]) + (o[2] * o[2] + o[3] * o[3]); }
        if (Epi::SSQ) { s += __shfl_xor(s, 16); s += __shfl_xor(s, 32); if (g == 0) red[(16 * rt + l15) * 2 + chh] = s;
            __syncthreads();
            if (tid < 64) st_wt(E.ssq_out + ssq_idx(cn >> 2, MP + rm * 64 + tid, cn & 3), red[tid * 2] + red[tid * 2 + 1]);
            __syncthreads(); }
#undef MG_LOAD
#undef MG_STORE
#undef MG_COMPUTE
    }
}
__device__ __forceinline__ u32x2 pack4(const f32x4 v) { u32x2 w; w.x = pk2(v[0], v[1]); w.y = pk2(v[2], v[3]); return w; }
template <bool FROM_X> struct MRes {
    static constexpr bool SSQ = true; const float* X1; const bf16_t* BB; bf16_t* XO; float* ssq_out; float sc;
    __device__ __forceinline__ f32x4 operator()(int row, int col, const f32x4 v) const {
        f32x4 b; if (FROM_X) b = *(const f32x4*)(X1 + (size_t)(row - MP) * DM + col); else { const u32x2 w = *(const u32x2*)(BB + (size_t)row * DM + col); b = (f32x4){bflo(w.x), bfhi(w.x), bflo(w.y), bfhi(w.y)}; }
        const f32x4 o = b + v * sc; *(u32x2*)(XO + (size_t)row * DM + col) = pack4(o); return o; }
};
struct MPl { static constexpr bool SSQ = false; bf16_t* PL; float* ssq_out;
    __device__ __forceinline__ f32x4 operator()(int row, int col, const f32x4 v) const { *(u32x2*)(PL + (size_t)row * DM + col) = pack4(v); return v; } };
struct MUp { static constexpr bool SSQ = false; bf16_t* HS  ; const float* ssq; float* ssq_out;
    __device__ __forceinline__ f32x4 operator()(int row, int col, const f32x4 v) const { const float r = row_r(ssq, row); f32x4 o;
#pragma unroll
        for (int e = 0; e < 4; ++e) { const float a = fmaxf(v[e] * r, 0.f); o[e] = a * a; }
        *(u32x2*)(HS + (size_t)(row - MP) * FF + col) = pack4(o); return o; } };
template <bool LAST> struct MGate { static constexpr bool SSQ = !LAST; float* HO; const bf16_t* BB; const bf16_t* PL; bf16_t* OB; const float* ssq_in; float* ssq_out; float sc;
    __device__ __forceinline__ f32x4 operator()(int row, int col, const f32x4 v) const { const float r = row_r(ssq_in, row); const size_t off = (size_t)row * DM + col;
        const u32x2 bw = *(const u32x2*)(BB + off), pw = *(const u32x2*)(PL + off);
        const f32x4 b = {bflo(bw.x), bfhi(bw.x), bflo(bw.y), bfhi(bw.y)}, p = {bflo(pw.x), bfhi(pw.x), bflo(pw.y), bfhi(pw.y)}; f32x4 o;
#pragma unroll
        for (int e = 0; e < 4; ++e) o[e] = b[e] + fsigmoid(v[e] * r) * p[e] * sc;
        if (LAST) *(f32x4*)(HO + off) = o; else *(u32x2*)(OB + off) = pack4(o); return o; } };
}

constexpr int NWAVES = 8, NTHREADS = 512;
constexpr int RING_BYTES = 131072, LDS_BYTES = 147456;
struct Args { const float* in[26]; float* out; unsigned char* ws; int ph_lo, ph_hi; };

struct TJob { const float* src; int ldw, kk, nblk; bf16_t* dst; const float* gain; float scale; int item; };
__device__ __forceinline__ void p0_tload(const TJob& J, float (&r)[32], int lane) {
    const int kb = J.item / J.nblk, nb = J.item % J.nblk, k0 = 64 * kb, n0 = 32 * nb;
#pragma unroll
    for (int i = 0; i < 32; ++i) r[i] = __builtin_nontemporal_load(J.src + (size_t)(k0 + 2 * i + (lane >> 5)) * J.ldw + n0 + (lane & 31));
}
__device__ __forceinline__ void p0_tfinish(const TJob& J, const float (&r)[32], LAS float* scr, int lane) {
    const int kb = J.item / J.nblk, nb = J.item % J.nblk, k0 = 64 * kb, n0 = 32 * nb, c = lane & 7;
    f32x4 g0 = {1.f, 1.f, 1.f, 1.f}, g1 = g0;
    if (J.gain) { g0 = *(const f32x4*)(J.gain + k0 + 8 * c); g1 = *(const f32x4*)(J.gain + k0 + 8 * c + 4); }
    g0 *= J.scale; g1 *= J.scale;
#pragma unroll
    for (int i = 0; i < 32; ++i) scr[(2 * i + (lane >> 5)) * 33 + (lane & 31)] = r[i];
    asm volatile("s_waitcnt lgkmcnt(0)" ::: "memory");
#pragma unroll
    for (int j = 0; j < 4; ++j) { const int n = (lane >> 3) + 8 * j; const LAS float* sp = scr + (8 * c) * 33 + n;
        u32x4 o; o.x = pk2(sp[0 * 33] * g0.x, sp[1 * 33] * g0.y); o.y = pk2(sp[2 * 33] * g0.z, sp[3 * 33] * g0.w); o.z = pk2(sp[4 * 33] * g1.x, sp[5 * 33] * g1.y); o.w = pk2(sp[6 * 33] * g1.z, sp[7 * 33] * g1.w);
        *(u32x4*)(J.dst + (size_t)(n0 + n) * J.kk + k0 + 8 * c) = o; }
    asm volatile("s_waitcnt lgkmcnt(0)" ::: "memory");
}

constexpr int T128 = 144, T256 = 272, TP = 80;
#define LDS_BAR() do { asm volatile("s_waitcnt lgkmcnt(0)" ::: "memory"); __builtin_amdgcn_s_barrier(); asm volatile("" ::: "memory"); } while (0)
struct GlaRegs { u32x4 lg[2], v[4], k[2], q[2]; };
template <bool WITH_Q, bool DO_LKQ = true, bool DO_V = true>
__device__ __forceinline__ void gla_fetch(GlaRegs& R, int item, const bf16_t* Q1, const bf16_t* K1, const bf16_t* V1, const bf16_t* LGp, int tid) {
    const int bh = item >> 7, c = item & 127, b = bh >> 2, h = bh & 3; const size_t row0 = (size_t)b * SEQ + c * 64;
    if (DO_LKQ) {
#pragma unroll
        for (int i = 0; i < 2; ++i) { const int x = tid + NTHREADS * i, j = x >> 4, d8 = (x & 15) * 8; const size_t off = (row0 + j) * NQK + h * 128 + d8;
            R.lg[i] = *(const u32x4*)(LGp + off); R.k[i] = *(const u32x4*)(K1 + off); if (WITH_Q) R.q[i] = *(const u32x4*)(Q1 + off); } }
    if (DO_V) {
#pragma unroll
        for (int i = 0; i < 4; ++i) { const int x = tid + NTHREADS * i, j = x >> 5, e8 = (x & 31) * 8; R.v[i] = *(const u32x4*)(V1 + (row0 + j) * NV + h * 256 + e8); } }
}
__device__ __forceinline__ void gla_stage_lg_v(const GlaRegs& R, LAS float* bc, LAS bf16_t* vt, int tid) {
#pragma unroll
    for (int i = 0; i < 2; ++i) { const int x = tid + NTHREADS * i, j = x >> 4, d8 = (x & 15) * 8; const u32x4 w = R.lg[i];
        *(LAS f32x4*)(bc + j * 128 + d8) = (f32x4){bflo(w.x), bfhi(w.x), bflo(w.y), bfhi(w.y)}; *(LAS f32x4*)(bc + j * 128 + d8 + 4) = (f32x4){bflo(w.z), bfhi(w.z), bflo(w.w), bfhi(w.w)}; }
#pragma unroll
    for (int i = 0; i < 4; ++i) { const int x = tid + NTHREADS * i, j = x >> 5, e8 = (x & 31) * 8; *(LAS u32x4*)(vt + j * T256 + e8) = R.v[i]; }
    LDS_BAR();
    if (tid < 128) { float s = 0.f;
#pragma unroll 8
        for (int j = 0; j < 64; ++j) { s += bc[j * 128 + tid]; bc[j * 128 + tid] = s; } }
    LDS_BAR();
}
constexpr int NSUP = 32, NSUP_ALL = NBH * NSUP;
template <bool OUT>
__device__ __forceinline__ void gla_super_phase(LAS unsigned char* lds, int G, int bx, const bf16_t* Q1, const bf16_t* K1, const bf16_t* V1, const bf16_t* G1, const bf16_t* LGp, bf16_t* US, float* DVS,
                                                const float* ogain, bf16_t* OG, float* SOUT, int tid, int lane, int wave) {
    LAS float* bc = (LAS float*)lds;
    LAS bf16_t* Pm = (LAS bf16_t*)lds;
    LAS bf16_t* qt = (LAS bf16_t*)(lds + 32768);
    LAS bf16_t* kt = qt + 64 * T128;
    LAS bf16_t* kd = kt + 64 * T128;
    LAS bf16_t* vt = kd + 64 * T128;
    LAS float* red = (LAS float*)(lds + 32768 + 3 * 64 * T128 * 2 + 64 * T256 * 2);
    LAS float* em = red + 512;
    LAS float* dvl = em + 128;
    const int l15 = lane & 15, g = lane >> 4, q = l15 >> 2, p = l15 & 3;
    f32x4 gn[2] = {(f32x4){0.f, 0.f, 0.f, 0.f}, (f32x4){0.f, 0.f, 0.f, 0.f}};
    if (OUT) {
#pragma unroll
        for (int t = 0; t < 2; ++t) gn[t] = *(const f32x4*)(ogain + 16 * (2 * wave + t) + 4 * g); }
    GlaRegs R;
    if (bx < NSUP_ALL) gla_fetch<OUT>(R, (bx >> 5) * NCHUNK + (bx & 31) * 4, Q1, K1, V1, LGp, tid);
    for (int item = bx; item < NSUP_ALL; item += G) {
        const int bh = item >> 5, sc = item & 31, b = bh >> 2, h = bh & 3;
        f32x4 S[8][2];
        if (OUT) {
#pragma unroll
            for (int dt = 0; dt < 8; ++dt)
#pragma unroll
                for (int t = 0; t < 2; ++t) { const u32x2 w = *(const u32x2*)(US + ((size_t)item * 256 + 16 * (2 * wave + t) + l15) * 128 + 16 * dt + 4 * g); S[dt][t] = (f32x4){bflo(w.x), bfhi(w.x), bflo(w.y), bfhi(w.y)}; }
        } else {
#pragma unroll
            for (int dt = 0; dt < 8; ++dt) { S[dt][0] = (f32x4){0.f, 0.f, 0.f, 0.f}; S[dt][1] = (f32x4){0.f, 0.f, 0.f, 0.f}; } }
        float lsum = 0.f;
        for (int cc = 0; cc < 4; ++cc) {
            const int c = sc * 4 + cc; const size_t row0 = (size_t)b * SEQ + c * 64;
            gla_stage_lg_v(R, bc, vt, tid);
#pragma unroll
            for (int i = 0; i < 2; ++i) { const int x = tid + NTHREADS * i, j = x >> 4, d8 = (x & 15) * 8; const u32x4 wk = R.k[i];
                float kv[8] = {bflo(wk.x), bfhi(wk.x), bflo(wk.y), bfhi(wk.y), bflo(wk.z), bfhi(wk.z), bflo(wk.w), bfhi(wk.w)};
                float cur[8], dd[8];
#pragma unroll
                for (int t = 0; t < 8; ++t) { cur[t] = bc[j * 128 + d8 + t]; dd[t] = kv[t] * fexp(bc[63 * 128 + d8 + t] - cur[t]); }
                u32x4 o; o.x = pk2(dd[0], dd[1]); o.y = pk2(dd[2], dd[3]); o.z = pk2(dd[4], dd[5]); o.w = pk2(dd[6], dd[7]); *(LAS u32x4*)(kd + j * T128 + d8) = o;
                if (OUT) { const u32x4 wq = R.q[i];
                    float qv[8] = {bflo(wq.x), bfhi(wq.x), bflo(wq.y), bfhi(wq.y), bflo(wq.z), bfhi(wq.z), bflo(wq.w), bfhi(wq.w)};
                    float a[8], bb[8];
#pragma unroll
                    for (int t = 0; t < 8; ++t) { const float mid = bc[31 * 128 + d8 + t]; a[t] = qv[t] * fexp(cur[t] - mid); bb[t] = kv[t] * fexp(mid - cur[t]); }
                    o.x = pk2(a[0], a[1]); o.y = pk2(a[2], a[3]); o.z = pk2(a[4], a[5]); o.w = pk2(a[6], a[7]); *(LAS u32x4*)(qt + j * T128 + d8) = o;
                    o.x = pk2(bb[0], bb[1]); o.y = pk2(bb[2], bb[3]); o.z = pk2(bb[4], bb[5]); o.w = pk2(bb[6], bb[7]); *(LAS u32x4*)(kt + j * T128 + d8) = o; } }
            if (tid < 128) { const float last = bc[63 * 128 + tid]; dvl[tid] = fexp(last); lsum += last; if (OUT) em[tid] = fexp(bc[31 * 128 + tid]); }
            const int nxt_ = (cc < 3) ? bh * NCHUNK + c + 1 : (item + G < NSUP_ALL ? ((item + G) >> 5) * NCHUNK + ((item + G) & 31) * 4 : -1);
            if (nxt_ >= 0) gla_fetch<OUT, true, false>(R, nxt_, Q1, K1, V1, LGp, tid);
            LDS_BAR();
            if (OUT) {
#pragma unroll
                for (int t = 0; t < 2; ++t) { const int id = 2 * wave + t, ti = id >> 2, tj = id & 3;
                    f32x4 a = {0.f, 0.f, 0.f, 0.f};
                    if (tj <= ti) {
#pragma unroll
                        for (int ks = 0; ks < 4; ++ks) { const bf16x8 Af = *(const LAS bf16x8*)(qt + (16 * ti + l15) * T128 + 32 * ks + 8 * g), Bf = *(const LAS bf16x8*)(kt + (16 * tj + l15) * T128 + 32 * ks + 8 * g);
                            a = __builtin_amdgcn_mfma_f32_16x16x32_bf16(Af, Bf, a, 0, 0, 0); } }
#pragma unroll
                    for (int r = 0; r < 4; ++r) { const int i = 16 * ti + 4 * g + r, j = 16 * tj + l15; const float v = (j <= i) ? a[r] : 0.f; Pm[i * TP + j] = (bf16_t)(pk2(v, 0.f) & 0xffffu); }
                }
                LDS_BAR();
                f32x4 o[4][2];
#pragma unroll
                for (int ti = 0; ti < 4; ++ti) { o[ti][0] = (f32x4){0.f, 0.f, 0.f, 0.f}; o[ti][1] = (f32x4){0.f, 0.f, 0.f, 0.f}; }
#pragma unroll
                for (int ks = 0; ks < 2; ++ks) {
                    bf16x8 Bf[2];
#pragma unroll
                    for (int t = 0; t < 2; ++t) { const LAS bf16_t* a0 = vt + (32 * ks + 8 * g + q) * T256 + 16 * (2 * wave + t) + 4 * p; Bf[t] = cat8(trd(a0), trd(a0 + 4 * T256)); }
#pragma unroll
                    for (int ti = 2 * ks; ti < 4; ++ti) { const bf16x8 Af = *(const LAS bf16x8*)(Pm + (16 * ti + l15) * TP + 32 * ks + 8 * g);
#pragma unroll
                        for (int t = 0; t < 2; ++t) o[ti][t] = __builtin_amdgcn_mfma_f32_16x16x32_bf16(Bf[t], Af, o[ti][t], 0, 0, 0); }
                }
#pragma unroll
                for (int ks = 0; ks < 4; ++ks) {
                    const f32x4 e0 = *(LAS f32x4*)(em + 32 * ks + 4 * g), e1 = *(LAS f32x4*)(em + 32 * ks + 16 + 4 * g);
                    bf16x8 Bf[2];
#pragma unroll
                    for (int t = 0; t < 2; ++t) { const f32x4 s0 = S[2 * ks][t] * e0, s1 = S[2 * ks + 1][t] * e1; u32x4 w; w.x = pk2(s0[0], s0[1]); w.y = pk2(s0[2], s0[3]); w.z = pk2(s1[0], s1[1]); w.w = pk2(s1[2], s1[3]); Bf[t] = __builtin_bit_cast(bf16x8, w); }
#pragma unroll
                    for (int ti = 0; ti < 4; ++ti) { const LAS bf16_t* ap = qt + (16 * ti + l15) * T128 + 32 * ks + 4 * g;
                        const u32x2 a0 = *(const LAS u32x2*)ap, a1 = *(const LAS u32x2*)(ap + 16); u32x4 aw; aw.x = a0.x; aw.y = a0.y; aw.z = a1.x; aw.w = a1.y; const bf16x8 Af = __builtin_bit_cast(bf16x8, aw);
#pragma unroll
                        for (int t = 0; t < 2; ++t) o[ti][t] = __builtin_amdgcn_mfma_f32_16x16x32_bf16(Bf[t], Af, o[ti][t], 0, 0, 0); }
                }
#pragma unroll
                for (int ti = 0; ti < 4; ++ti) { float s = 0.f;
#pragma unroll
                    for (int t = 0; t < 2; ++t) s += (o[ti][t][0] * o[ti][t][0] + o[ti][t][1] * o[ti][t][1]) + (o[ti][t][2] * o[ti][t][2] + o[ti][t][3] * o[ti][t][3]);
                    s += __shfl_xor(s, 16); s += __shfl_xor(s, 32);
                    if (g == 0) red[(16 * ti + l15) * 8 + wave] = s; }
                LDS_BAR();
#pragma unroll
                for (int ti = 0; ti < 4; ++ti) { const int i = 16 * ti + l15; const f32x4 r0 = *(LAS f32x4*)(red + i * 8), r1 = *(LAS f32x4*)(red + i * 8 + 4);
                    const float rms = frsq(((r0.x + r0.y) + (r0.z + r0.w) + (r1.x + r1.y) + (r1.z + r1.w)) * (1.f / 256.f) + EPS);
#pragma unroll
                    for (int t = 0; t < 2; ++t) { const size_t off = (row0 + i) * NV + h * 256 + 16 * (2 * wave + t) + 4 * g; const u32x2 gw_ = *(const u32x2*)(G1 + off);
                        const f32x4 gv = {bflo(gw_.x), bfhi(gw_.x), bflo(gw_.y), bfhi(gw_.y)}; f32x4 ov;
#pragma unroll
                        for (int r = 0; r < 4; ++r) ov[r] = o[ti][t][r] * rms * gn[t][r] * gv[r] * fsigmoid(gv[r]);
                        u32x2 w; w.x = pk2(ov[0], ov[1]); w.y = pk2(ov[2], ov[3]); *(u32x2*)(OG + off) = w; } }
            }
            if (nxt_ >= 0) gla_fetch<OUT, false, true>(R, nxt_, Q1, K1, V1, LGp, tid);
#pragma unroll
            for (int dt = 0; dt < 8; ++dt) { const f32x4 dvv = *(LAS f32x4*)(dvl + 16 * dt + 4 * g); S[dt][0] *= dvv; S[dt][1] *= dvv; }
#pragma unroll
            for (int ks = 0; ks < 2; ++ks) {
                bf16x8 Bf[2];
#pragma unroll
                for (int t = 0; t < 2; ++t) { const LAS bf16_t* a0 = vt + (32 * ks + 8 * g + q) * T256 + 16 * (2 * wave + t) + 4 * p; Bf[t] = cat8(trd(a0), trd(a0 + 4 * T256)); }
#pragma unroll
                for (int dt = 0; dt < 8; ++dt) { const LAS bf16_t* a0 = kd + (32 * ks + 8 * g + q) * T128 + 16 * dt + 4 * p; const bf16x8 Af = cat8(trd(a0), trd(a0 + 4 * T128));
#pragma unroll
                    for (int t = 0; t < 2; ++t) S[dt][t] = __builtin_amdgcn_mfma_f32_16x16x32_bf16(Af, Bf[t], S[dt][t], 0, 0, 0); }
            }
            LDS_BAR();
        }
        if (OUT && sc == NSUP - 1) {
            float* so = SOUT + (size_t)bh * 128 * 256 + (size_t)(4 * g) * 256 + 32 * wave + l15;
#pragma unroll
            for (int dt = 0; dt < 8; ++dt) {
#pragma unroll
                for (int t = 0; t < 2; ++t)
#pragma unroll
                    for (int r = 0; r < 4; ++r) so[r * 256 + 16 * t] = S[dt][t][r];
                so += 16 * 256; asm volatile("" : "+v"(so));
            }
        }
        if (!OUT) {
#pragma unroll
            for (int dt = 0; dt < 8; ++dt)
#pragma unroll
                for (int t = 0; t < 2; ++t) { u32x2 w; w.x = pk2(S[dt][t][0], S[dt][t][1]); w.y = pk2(S[dt][t][2], S[dt][t][3]);
                    *(u32x2*)(US + ((size_t)item * 256 + 16 * (2 * wave + t) + l15) * 128 + 16 * dt + 4 * g) = w; }
            if (tid < 128) DVS[(size_t)item * 128 + tid] = fexp(lsum);
        }
    }
}
template <int NSTEP>
__device__ __forceinline__ void gla_scan(bf16_t* UT, const float* DV, float* state_out, int gtid, int gthreads) {
    for (int idx = gtid; idx < NBH * 256 * 64; idx += gthreads) {
        const int bh = idx >> 14, rem = idx & 16383, e = rem >> 6, dp = rem & 63;
        unsigned* base = (unsigned*)UT + (size_t)bh * NSTEP * 16384 + e * 64 + dp;
        const float* dv = DV + (size_t)bh * NSTEP * 128 + 2 * dp;
        float s0 = 0.f, s1 = 0.f;
        for (int c0 = 0; c0 < NSTEP; c0 += 32) {
            unsigned uu[32]; f32x2 dd[32];
#pragma unroll
            for (int k = 0; k < 32; ++k) { uu[k] = base[(size_t)(c0 + k) * 16384]; dd[k] = *(const f32x2*)(dv + (size_t)(c0 + k) * 128); }
#pragma unroll
            for (int k = 0; k < 32; ++k) { base[(size_t)(c0 + k) * 16384] = pk2(s0, s1); s0 = dd[k].x * s0 + bflo(uu[k]); s1 = dd[k].y * s1 + bfhi(uu[k]); }
        }
        (void)state_out;
    }
}
__device__ __forceinline__ void gla_sample_pair(LAS unsigned char* lds, int base_item, const bf16_t* Q1, const bf16_t* K1, const bf16_t* V1, const bf16_t* G1, const bf16_t* LGp,
                                                const float* S0in, float* Sout, const float* ogain, bf16_t* OG, int tid) {
    const int hb = tid >> 8, t = tid & 255, item = base_item + hb, sb = item >> 2, h = item & 3; const size_t r0 = (size_t)MP + sb * 8;
    LAS float* qaT = (LAS float*)(lds + hb * 16384);
    LAS float* qsT = qaT + 1024, *kdT = qsT + 1024, *dvs = kdT + 1024, *att = dvs + 128, *red = att + 64;
    if (t < 128) { const int d = t; float bcv[8], s = 0.f;
#pragma unroll
        for (int i = 0; i < 8; ++i) { s += bf2f(LGp[(r0 + i) * NQK + h * 128 + d]); bcv[i] = s; }
#pragma unroll
        for (int i = 0; i < 8; ++i) { const float qv = bf2f(Q1[(r0 + i) * NQK + h * 128 + d]), kv = bf2f(K1[(r0 + i) * NQK + h * 128 + d]);
            qaT[d * 8 + i] = qv * fexp(bcv[i] - bcv[7]); qsT[d * 8 + i] = qv * fexp(bcv[i]); kdT[d * 8 + i] = kv * fexp(bcv[7] - bcv[i]); }
        dvs[d] = fexp(bcv[7]); }
    __syncthreads();
    if (t < 64) { const int i = t >> 3, j = t & 7; float s = 0.f;
        for (int d = 0; d < 128; ++d) s += qaT[d * 8 + i] * kdT[d * 8 + j];
        att[t] = (j <= i) ? s : 0.f; }
    __syncthreads();
    const int e = t; float v[8], o[8];
#pragma unroll
    for (int j = 0; j < 8; ++j) { v[j] = bf2f(V1[(r0 + j) * NV + h * 256 + e]); o[j] = 0.f; }
    const float* S0 = S0in + ((size_t)item * 128) * 256 + e; float* SO = Sout + ((size_t)item * 128) * 256 + e;
    for (int d0 = 0; d0 < 128; d0 += 32) { float sv[32];
#pragma unroll
        for (int k = 0; k < 32; ++k) sv[k] = __builtin_nontemporal_load(S0 + (size_t)(d0 + k) * 256);
#pragma unroll
        for (int k = 0; k < 32; ++k) { const int d = d0 + k; const f32x4 qa = *(LAS f32x4*)(qsT + d * 8), qb = *(LAS f32x4*)(qsT + d * 8 + 4), ka = *(LAS f32x4*)(kdT + d * 8), kb = *(LAS f32x4*)(kdT + d * 8 + 4);
            o[0] += qa.x * sv[k]; o[1] += qa.y * sv[k]; o[2] += qa.z * sv[k]; o[3] += qa.w * sv[k]; o[4] += qb.x * sv[k]; o[5] += qb.y * sv[k]; o[6] += qb.z * sv[k]; o[7] += qb.w * sv[k];
            __builtin_nontemporal_store(dvs[d] * sv[k] + ((ka.x * v[0] + ka.y * v[1]) + (ka.z * v[2] + ka.w * v[3])) + ((kb.x * v[4] + kb.y * v[5]) + (kb.z * v[6] + kb.w * v[7])), SO + (size_t)d * 256); }
    }
#pragma unroll
    for (int i = 0; i < 8; ++i)
#pragma unroll
        for (int j = 0; j <= i; ++j) o[i] += att[i * 8 + j] * v[j];
    const int wv = t >> 6;
#pragma unroll
    for (int i = 0; i < 8; ++i) { const float s = wave_sum(o[i] * o[i]); if ((t & 63) == 0) red[i * 4 + wv] = s; }
    __syncthreads();
    const float gn = ogain[e];
#pragma unroll
    for (int i = 0; i < 8; ++i) { const f32x4 rr = *(LAS f32x4*)(red + i * 4); const float rms = frsq(((rr.x + rr.y) + (rr.z + rr.w)) * (1.f / 256.f) + EPS);
        const size_t off = (r0 + i) * NV + h * 256 + e; const float gv = bf2f(G1[off]);
        OG[off] = (bf16_t)(pk2(o[i] * rms * gn * gv * fsigmoid(gv), 0.f) & 0xffffu); }
    __syncthreads();
}

constexpr int VT_LD = 72;
struct AttnP { const bf16_t* KV; const bf16_t* Qb; bf16_t* AO; const float* pk; const float* pv; float* ock; float* ocv; const float* sinks; const float* relb; };
constexpr int ATT_BUF = 32768 + 256 * VT_LD * 2 + 2048;
struct AttnRegs { u32x4 a[12]; };
#define ATT_DECODE(item) const bool smp = (item) >= 512; int b, kh, qblk, sb = 0; \
    if (!smp) { b = (item) >> 8; kh = ((item) >> 6) & 3; qblk = (item) & 63; } else { const int it_ = (item) - 512; sb = it_ >> 2; kh = it_ & 3; b = 0; qblk = 1; } \
    const long s0 = (long)b * SEQ + (long)qblk * 128; (void)s0; (void)sb
__device__ __forceinline__ void attn_load(int item, const AttnP& P, AttnRegs& R, int tid) {
    ATT_DECODE(item);
    if (!smp) {
#pragma unroll
        for (int j = 0; j < 4; ++j) { const int i = tid + NTHREADS * j, row = i >> 3, ch = i & 7; u32x4 wk = {0u, 0u, 0u, 0u}, wv = {0u, 0u, 0u, 0u};
            if (qblk > 0 || row >= 128) { const bf16_t* src = P.KV + (size_t)(s0 - 128 + row) * 512 + kh * 64 + ch * 8; wk = *(const u32x4*)src; wv = *(const u32x4*)(src + 256); }
            R.a[j] = wk; R.a[4 + j] = wv; }
    } else {
#pragma unroll
        for (int j = 0; j < 3; ++j) { const int i = tid + NTHREADS * j, row = i >> 3, ch = i & 7;
            u32x4 z = {0u, 0u, 0u, 0u}; R.a[4 * j] = z; R.a[4 * j + 1] = z; R.a[4 * j + 2] = z; R.a[4 * j + 3] = z;
            if (row < 128) { const size_t so = ((size_t)(sb * 128 + row) * 4 + kh) * 64 + ch * 8;
                R.a[4 * j] = *(const u32x4*)(P.pk + so); R.a[4 * j + 1] = *(const u32x4*)(P.pk + so + 4); R.a[4 * j + 2] = *(const u32x4*)(P.pv + so); R.a[4 * j + 3] = *(const u32x4*)(P.pv + so + 4); }
            else if (row < 136) { const bf16_t* src = P.KV + (size_t)(MP + sb * 8 + row - 128) * 512 + kh * 64 + ch * 8; R.a[4 * j] = *(const u32x4*)src; R.a[4 * j + 1] = *(const u32x4*)(src + 256); } }
    }
}
__device__ __forceinline__ void attn_stage(LAS unsigned char* lds, int item, const AttnP& P, const AttnRegs& R, int tid) {
    LAS unsigned char* Kt = lds; LAS bf16_t* Vt = (LAS bf16_t*)(lds + 32768); LAS float* bias2 = (LAS float*)(lds + 32768 + 256 * VT_LD * 2);
    ATT_DECODE(item);
    if (!smp) {
#pragma unroll
        for (int j = 0; j < 4; ++j) { const int i = tid + NTHREADS * j, row = i >> 3, ch = i & 7;
            *(LAS u32x4*)(Kt + row * 128 + ((ch ^ (row & 7)) << 4)) = R.a[j]; *(LAS u32x4*)(Vt + row * VT_LD + ch * 8) = R.a[4 + j]; }
    } else {
#pragma unroll
        for (int j = 0; j < 3; ++j) { const int i = tid + NTHREADS * j, row = i >> 3, ch = i & 7;
            if (i < 144 * 8) { u32x4 wk = R.a[4 * j], wv = R.a[4 * j + 1];
                if (row < 128) { const f32x4 k0 = __builtin_bit_cast(f32x4, R.a[4 * j]), k1 = __builtin_bit_cast(f32x4, R.a[4 * j + 1]), v0 = __builtin_bit_cast(f32x4, R.a[4 * j + 2]), v1 = __builtin_bit_cast(f32x4, R.a[4 * j + 3]);
                    wk = pg8::pack8(k0, k1); wv = pg8::pack8(v0, v1);
                    if (row >= 8) { const size_t oo = ((size_t)(sb * 128 + row - 8) * 4 + kh) * 64 + ch * 8;
                        __builtin_nontemporal_store(k0, (f32x4*)(P.ock + oo)); __builtin_nontemporal_store(k1, (f32x4*)(P.ock + oo + 4)); __builtin_nontemporal_store(v0, (f32x4*)(P.ocv + oo)); __builtin_nontemporal_store(v1, (f32x4*)(P.ocv + oo + 4)); } }
                *(LAS u32x4*)(Kt + row * 128 + ((ch ^ (row & 7)) << 4)) = wk; *(LAS u32x4*)(Vt + row * VT_LD + ch * 8) = wv; } }
    }
    { const int hl = tid >> 7, dist = tid & 127; int bk = dist;
      if (dist >= 16) { bk = 16 + (int)(__logf((float)dist * (1.f / 16.f)) * (16.f / 2.0794415416798357f)); bk = bk > 31 ? 31 : bk; }
      bias2[tid] = P.relb[bk * 16 + kh * 4 + hl] * LOG2E; }
}
__device__ __forceinline__ void attn_compute(LAS unsigned char* lds, int item, const AttnP& P, int lane, int wave) {
    LAS unsigned char* Kt = lds; LAS bf16_t* Vt = (LAS bf16_t*)(lds + 32768); LAS float* bias2 = (LAS float*)(lds + 32768 + 256 * VT_LD * 2);
    ATT_DECODE(item);
    const int l15 = lane & 15, g = lane >> 4, q = l15 >> 2, p = l15 & 3;
    const int ntq = smp ? (wave < 2 ? 1 : 0) : 4;
    for (int tq = 0; tq < ntq; ++tq) {
        const int qtile = smp ? 0 : (wave & 1) * 4 + tq;
        int hl_q, ioff; size_t qrow;
        if (!smp) { hl_q = wave >> 1; ioff = l15; qrow = (size_t)(s0 + 16 * qtile + l15); }
        else { hl_q = 2 * wave + (l15 >> 3); ioff = l15 & 7; qrow = (size_t)MP + sb * 8 + (l15 & 7); }
        const bf16_t* qp = P.Qb + qrow * DM + (kh * 4 + hl_q) * 64 + 8 * g;
        const bf16x8 Qf0 = *(const bf16x8*)qp, Qf1 = *(const bf16x8*)(qp + 32);
        f32x4 st[9];
#pragma unroll
        for (int j = 0; j < 9; ++j) { const int row = 16 * (qtile + j) + l15; const LAS unsigned char* kr = Kt + row * 128;
            const bf16x8 K0 = *(const LAS bf16x8*)(kr + ((g ^ (row & 7)) << 4)), K1f = *(const LAS bf16x8*)(kr + (((4 + g) ^ (row & 7)) << 4));
            f32x4 a = {0.f, 0.f, 0.f, 0.f};
            a = __builtin_amdgcn_mfma_f32_16x16x32_bf16(K0, Qf0, a, 0, 0, 0); a = __builtin_amdgcn_mfma_f32_16x16x32_bf16(K1f, Qf1, a, 0, 0, 0);
            st[j] = a; }
        const float sink2 = P.sinks[kh * 4 + hl_q] * LOG2E;
        float mx = sink2;
#pragma unroll
        for (int j = 0; j < 9; ++j)
#pragma unroll
            for (int r = 0; r < 4; ++r) { const int dist = 128 + ioff - 16 * j - 4 * g - r; const bool ok = (dist >= 0) && (dist < 128) && (smp || qblk > 0 || (16 * (qtile + j) + 4 * g + r) >= 128);
                const float v = ok ? st[j][r] + bias2[hl_q * 128 + (dist & 127)] : -INFINITY; st[j][r] = v; mx = fmaxf(mx, v); }
        mx = fmaxf(mx, __shfl_xor(mx, 16)); mx = fmaxf(mx, __shfl_xor(mx, 32));
        float sum = 0.f;
#pragma unroll
        for (int j = 0; j < 9; ++j)
#pragma unroll
            for (int r = 0; r < 4; ++r) { const float e = __builtin_amdgcn_exp2f(st[j][r] - mx); st[j][r] = e; sum += e; }
        sum += __shfl_xor(sum, 16); sum += __shfl_xor(sum, 32);
        const float inv = frcp(sum + __builtin_amdgcn_exp2f(sink2 - mx));
        f32x4 o[4];
#pragma unroll
        for (int dt = 0; dt < 4; ++dt) o[dt] = (f32x4){0.f, 0.f, 0.f, 0.f};
#pragma unroll
        for (int kk = 0; kk < 5; ++kk) {
            u32x4 pw; pw.x = pk2(st[2 * kk][0], st[2 * kk][1]); pw.y = pk2(st[2 * kk][2], st[2 * kk][3]);
            if (kk < 4) { pw.z = pk2(st[2 * kk + 1][0], st[2 * kk + 1][1]); pw.w = pk2(st[2 * kk + 1][2], st[2 * kk + 1][3]); } else { pw.z = 0u; pw.w = 0u; }
            const bf16x8 Pf = __builtin_bit_cast(bf16x8, pw);
            const LAS bf16_t* v0p = Vt + (16 * (qtile + 2 * kk) + 4 * g + q) * VT_LD + 4 * p;
#pragma unroll
            for (int dt = 0; dt < 4; ++dt) { const s16x4 lo = trd(v0p + 16 * dt); const s16x4 hi = (kk < 4) ? trd(v0p + 16 * VT_LD + 16 * dt) : (s16x4){0, 0, 0, 0};
                o[dt] = __builtin_amdgcn_mfma_f32_16x16x32_bf16(cat8(lo, hi), Pf, o[dt], 0, 0, 0); }
        }
        { bf16_t* op = P.AO + qrow * DM + (kh * 4 + hl_q) * 64 + 4 * g;
#pragma unroll
          for (int dt = 0; dt < 4; ++dt) { u32x2 w; w.x = pk2(o[dt][0] * inv, o[dt][1] * inv); w.y = pk2(o[dt][2] * inv, o[dt][3] * inv); *(u32x2*)(op + 16 * dt) = w; } }
    }
}


#define XB_TMO      128
#define XB_XCNT(j)  (256  + 64 * (j))
#define XB_XSUB(j)  (1280 + 64 * (j))
#define XB_XGEN(j)  (2304 + 64 * (j))
#define XB_TOP      3328
#define XB_TOPGEN   3392
#define XCD_BAR_WORDS 3456
#define XB_SPIN_CAP (1u << 20)
__device__ __forceinline__ unsigned xb_ld(unsigned* p)              { return __hip_atomic_load(p, __ATOMIC_RELAXED, __HIP_MEMORY_SCOPE_AGENT); }
__device__ __forceinline__ unsigned xb_add(unsigned* p, unsigned v) { return __hip_atomic_fetch_add(p, v, __ATOMIC_RELAXED, __HIP_MEMORY_SCOPE_AGENT); }
__device__ __forceinline__ unsigned xb_xcc_id() { return (unsigned)__builtin_amdgcn_s_getreg((3 << 11) | 20) & 0xFu; }
#define XB_SPIN(cond, bar) do { unsigned _sp = 0; while (cond) { __builtin_amdgcn_s_sleep(1); \
    if ((++_sp & 255u) == 0u) { if (xb_ld(&(bar)[XB_TMO])) break; if (_sp > XB_SPIN_CAP) { atomicAdd(&(bar)[XB_TMO], 1u); break; } } } } while (0)
struct XcdBarrier { unsigned* bar; unsigned x; volatile LAS unsigned* st; };
__device__ __forceinline__ XcdBarrier xcd_barrier_post(unsigned* bar, volatile LAS unsigned* st) {
    XcdBarrier b; b.bar = bar; b.x = xb_xcc_id(); b.st = st;
    if (threadIdx.x == 0) (void)xb_add(&bar[XB_XCNT(b.x)], 1u);
    return b;
}
__device__ __forceinline__ void xcd_barrier_complete(unsigned* bar, unsigned x, unsigned& nloc, unsigned& nx) {
    const unsigned G = gridDim.x * gridDim.y * gridDim.z;
    unsigned sum, cnt, mine, sp = 0u;
    for (;;) {
        sum = 0u; cnt = 0u; mine = 0u;
#pragma unroll
        for (unsigned j = 0; j < 16; ++j) { const unsigned c = xb_ld(&bar[XB_XCNT(j)]); sum += c; cnt += (c > 0u) ? 1u : 0u; mine = (j == x) ? c : mine; }
        if (sum == G) break;
        __builtin_amdgcn_s_sleep(1);
        if ((++sp & 255u) == 0u) { if (xb_ld(&bar[XB_TMO])) break; if (sp > XB_SPIN_CAP) { atomicAdd(&bar[XB_TMO], 1u); break; } }
    }
    nloc = mine > 0u ? mine : 1u; nx = cnt > 0u ? cnt : 1u;
}
__device__ __forceinline__ void xcd_barrier(const XcdBarrier& b) {
    asm volatile("s_waitcnt vmcnt(0)" ::: "memory");
    __syncthreads();
    if (threadIdx.x == 0) {
        unsigned* bar = b.bar;
        __builtin_amdgcn_s_waitcnt(0);
        unsigned nloc = b.st[0], nx = b.st[1];
        if (nloc == 0u) { xcd_barrier_complete(bar, b.x, nloc, nx); b.st[0] = nloc; b.st[1] = nx; }
        const unsigned old = xb_add(&bar[XB_XSUB(b.x)], 1u);
        const unsigned gen = old / nloc;
        if (old + 1u == (gen + 1u) * nloc) {
            __builtin_amdgcn_fence(__ATOMIC_RELEASE, "agent");
            asm volatile("s_waitcnt vmcnt(0)" ::: "memory");
            const unsigned og = xb_add(&bar[XB_TOP], 1u);
            const unsigned tg = og / nx;
            if (og + 1u == (tg + 1u) * nx) xb_add(&bar[XB_TOPGEN], 1u);
            else XB_SPIN(xb_ld(&bar[XB_TOPGEN]) == tg, bar);
            __builtin_amdgcn_fence(__ATOMIC_ACQUIRE, "agent");
            xb_add(&bar[XB_XGEN(b.x)], 1u);
            asm volatile("s_waitcnt vmcnt(0)" ::: "memory");
        } else {
            XB_SPIN(xb_ld(&bar[XB_XGEN(b.x)]) == gen, bar);
            __builtin_amdgcn_fence(__ATOMIC_ACQUIRE, "agent");
            asm volatile("s_waitcnt vmcnt(0)" ::: "memory");
        }
    }
    __syncthreads();
}

__global__ void __launch_bounds__(NTHREADS, 2) yoco_fwd(Args args) {
    extern __shared__ __attribute__((aligned(16))) unsigned char lds_raw[];
    LAS unsigned char* lds = (LAS unsigned char*)lds_raw;
    const int tid = threadIdx.x, lane = tid & 63, wave = __builtin_amdgcn_readfirstlane(tid >> 6), G = gridDim.x, bx = blockIdx.x;
    const int gw = bx * NWAVES + wave, NGW = G * NWAVES;
    typedef const __attribute__((address_space(4))) Args* KArgsP;
    const KArgsP kp0 = (KArgsP)__builtin_amdgcn_kernarg_segment_ptr();
#define KARG(field) ({ KArgsP q_ = kp0; asm volatile("" : "+s"(q_)); q_->field; })
#define ws KARG(ws)
#define out KARG(out)
#define x_prompt KARG(in[0])
#define x_sample KARG(in[1])
#define state_gla KARG(in[2])
#define cache_k KARG(in[3])
#define cache_v KARG(in[4])
#define p_prompt KARG(in[5])
#define p_sample KARG(in[6])
#define norm_mix KARG(in[7])
#define norm_mlp KARG(in[8])
#define norm_ple KARG(in[9])
#define norm_kv KARG(in[10])
#define norm_final KARG(in[11])
#define w_in_a KARG(in[12])
#define w_a2 KARG(in[13])
#define b_a2 KARG(in[14])
#define gla_o_gain KARG(in[15])
#define w_out_a KARG(in[16])
#define w_kv KARG(in[17])
#define w_q_b KARG(in[18])
#define w_o_b KARG(in[19])
#define sinks KARG(in[20])
#define rel_bias KARG(in[21])
#define w_up KARG(in[22])
#define w_down KARG(in[23])
#define w_ple KARG(in[24])
#define w_ple_gate KARG(in[25])
#define W_IN ((bf16_t*)(ws + WS_W_IN))
#define W_OUT ((bf16_t*)(ws + WS_W_OUT))
#define W_KVQ ((bf16_t*)(ws + WS_W_KVQ))
#define W_O ((bf16_t*)(ws + WS_W_O))
#define XB ((bf16_t*)(ws + WS_XB))
#define PB ((bf16_t*)(ws + WS_PB))
#define Q1 ((bf16_t*)(ws + WS_Q1))
#define K1 ((bf16_t*)(ws + WS_K1))
#define V1 ((bf16_t*)(ws + WS_V1))
#define G1 ((bf16_t*)(ws + WS_G1))
#define HIDA ((bf16_t*)(ws + WS_R1))
#define H3B ((bf16_t*)(ws + WS_R1))
#define R3 ((bf16_t*)(ws + WS_R3))
#define HIDS (R3 + (size_t)(64 - HID_SPLIT) * 256 * FF)
#define KVR ((bf16_t*)(ws + WS_KVR))
#define PLQ ((bf16_t*)(ws + WS_PLQ))
#define SSQ0 ((float*)(ws + WS_SSQ))
#define SSQ1 ((float*)(ws + WS_SSQ) + (size_t)M * 16)
#define DV ((float*)(ws + WS_DV))
#define H (out + O_Y)
#define UT ((bf16_t*)(out + O_Y))
    cg::grid_group grid = cg::this_grid();
    volatile LAS unsigned* bst = (volatile LAS unsigned*)(lds + LDS_BYTES - 64);
    if (tid < 2) bst[tid] = 0u;
    __syncthreads();
    XcdBarrier xbar; xbar.bar = nullptr; xbar.x = 0; xbar.st = bst;
#if !MK_SPLIT
    xbar = xcd_barrier_post((unsigned*)(ws + WS_CTL), bst);
#endif
    const int lo = KARG(ph_lo), hi = KARG(ph_hi);
#define IN(k) (lo <= (k) && (k) < hi)
#define SEAM(k) do { if (IN(k) && IN((k) + 1)) { if (MK_SPLIT) grid.sync(); else xcd_barrier(xbar); } } while (0)
    if (lo < 0) grid.sync();

    if (IN(0)) {
        LAS float* scr = (LAS float*)(lds + wave * 16384);
#define TJ_LIST(X) \
        X(w_in_a, IN_A_COLS, DM, 512, W_IN, norm_mix, 0.08838834764831845f)                                     \
        X(w_in_a + 512, IN_A_COLS, DM, 2560, W_IN + (size_t)512 * DM, norm_mix, 1.f)                            \
        X(w_out_a, DM, DM, DM, W_OUT, (const float*)nullptr, 1.f) \
        X(w_up, FF, DM, FF, (bf16_t*)(ws + WS_W_UP0), norm_mlp, 1.f) \
        X(w_up + (size_t)DM * FF, FF, DM, FF, (bf16_t*)(ws + WS_W_UP1), norm_mlp + DM, 1.f) \
        X(w_down, DM, FF, DM, (bf16_t*)(ws + WS_W_DN0), (const float*)nullptr, 1.f) \
        X(w_down + (size_t)DM * FF, DM, FF, DM, (bf16_t*)(ws + WS_W_DN1), (const float*)nullptr, 1.f) \
        X(w_ple_gate, DM, DM, DM, (bf16_t*)(ws + WS_W_G0), norm_ple, 1.f) \
        X(w_ple_gate + (size_t)DM * DM, DM, DM, DM, (bf16_t*)(ws + WS_W_G1), norm_ple + DM, 1.f) \
        X(w_ple, DM, PLE, DM, (bf16_t*)(ws + WS_W_P0), (const float*)nullptr, 1.f) \
        X(w_ple + (size_t)PLE * DM, DM, PLE, DM, (bf16_t*)(ws + WS_W_P1), (const float*)nullptr, 1.f) \
        X(w_kv, 512, DM, 512, W_KVQ, norm_kv, 1.f) \
        X(w_q_b, DM, DM, DM, W_KVQ + (size_t)512 * DM, norm_mix + DM, 0.125f * LOG2E)                          \
        X(w_o_b, DM, DM, DM, W_O, (const float*)nullptr, 1.f)
#define TJ_COUNT(W, LDW, KK, NCOLS, DST, GAIN, SCALE) + ((KK) / 64) * ((NCOLS) / 32)
        constexpr int TJ_TOTAL = 0 TJ_LIST(TJ_COUNT);
#define TJ_DECODE(WP, LDW, KK, NCOLS, DSTP, GAINP, SCALEV) if (!done_ && r_ < ((KK) / 64) * ((NCOLS) / 32)) { jt_.src = (WP); jt_.ldw = (LDW); jt_.kk = (KK); jt_.nblk = (NCOLS) / 32; jt_.dst = (DSTP); jt_.gain = (GAINP); jt_.scale = (SCALEV); jt_.item = r_; done_ = true; } else if (!done_) r_ -= ((KK) / 64) * ((NCOLS) / 32);
#define TJ_GET(JOUT, it) do { int r_ = (it); bool done_ = false; TJob jt_; jt_.src = nullptr; jt_.ldw = 0; jt_.kk = 0; jt_.nblk = 1; jt_.dst = nullptr; jt_.gain = nullptr; jt_.scale = 1.f; jt_.item = 0; TJ_LIST(TJ_DECODE) JOUT = jt_; } while (0)
        { float ra_[32], rb_[32]; TJob Ja, Jb; int it = gw;
          if (it < TJ_TOTAL) { TJ_GET(Ja, it); p0_tload(Ja, ra_, lane); }
          while (it < TJ_TOTAL) {
              const int it1 = it + NGW; if (it1 < TJ_TOTAL) { TJ_GET(Jb, it1); p0_tload(Jb, rb_, lane); }
              p0_tfinish(Ja, ra_, scr, lane);
              if (it1 >= TJ_TOTAL) break;
              const int it2 = it1 + NGW; if (it2 < TJ_TOTAL) { TJ_GET(Ja, it2); p0_tload(Ja, ra_, lane); }
              p0_tfinish(Jb, rb_, scr, lane);
              it = it2; } }
#undef TJ_LIST
#undef TJ_COUNT
#undef TJ_DECODE
#undef TJ_GET
        for (int idx = bx * NTHREADS + tid; idx < 512 * 256; idx += G * NTHREADS) { const int n = idx >> 8, k4 = (idx & 255) * 4; float wa[16];
#pragma unroll
            for (int r = 0; r < 16; ++r) wa[r] = w_a2[r * 512 + n];
            f32x4 wr_[4][4];
#pragma unroll
            for (int kk = 0; kk < 4; ++kk)
#pragma unroll
                for (int q4 = 0; q4 < 4; ++q4) wr_[kk][q4] = *((const f32x4*)(w_in_a + (size_t)(k4 + kk) * IN_A_COLS + 3072) + q4);
            const f32x4 gn4 = *(const f32x4*)(norm_mix + k4);
            float o4[4];
#pragma unroll
            for (int kk = 0; kk < 4; ++kk) { float sacc = 0.f;
#pragma unroll
                for (int q4 = 0; q4 < 4; ++q4) sacc += (wr_[kk][q4].x * wa[4 * q4] + wr_[kk][q4].y * wa[4 * q4 + 1]) + (wr_[kk][q4].z * wa[4 * q4 + 2] + wr_[kk][q4].w * wa[4 * q4 + 3]);
                o4[kk] = sacc * gn4[kk]; }
            u32x2 o; o.x = pk2(o4[0], o4[1]); o.y = pk2(o4[2], o4[3]);
            *(u32x2*)(W_IN + (size_t)(3072 + n) * DM + k4) = o; }
        for (int grp = bx; grp < M / 64; grp += G)
#pragma unroll 1
          for (int half = 0; half < 2; ++half) { const int m0 = 64 * grp + 8 * wave + 4 * half; f32x4 v[4][4]; float s[4];
#pragma unroll
            for (int q = 0; q < 4; ++q) { const int m = m0 + q; const float* xr = m < MP ? x_prompt + (size_t)m * DM : x_sample + (size_t)(m - MP) * DM;
#pragma unroll
                for (int j = 0; j < 4; ++j) v[q][j] = __builtin_nontemporal_load((const f32x4*)xr + lane + 64 * j); }
#pragma unroll
            for (int q = 0; q < 4; ++q) { const int m = m0 + q; float ss = 0.f;
#pragma unroll
                for (int j = 0; j < 4; ++j) { ss += (v[q][j].x * v[q][j].x + v[q][j].y * v[q][j].y) + (v[q][j].z * v[q][j].z + v[q][j].w * v[q][j].w);
                    u32x2 w; w.x = pk2(v[q][j].x, v[q][j].y); w.y = pk2(v[q][j].z, v[q][j].w); *((u32x2*)(XB + (size_t)m * DM) + lane + 64 * j) = w; }
                s[q] = wave_sum(ss);
                if (lane < 4) *(f32x4*)(SSQ0 + ssq_idx(lane, m, 0)) = (f32x4){lane == 0 ? s[q] : 0.f, 0.f, 0.f, 0.f}; } }
        for (int m0 = gw * 8; m0 < M; m0 += NGW * 8) { f32x4 v[8];
#pragma unroll
            for (int q = 0; q < 8; ++q) { const int m = m0 + q; v[q] = *((const f32x4*)(m < MP ? p_prompt + (size_t)m * PLE : p_sample + (size_t)(m - MP) * PLE) + lane); }
#pragma unroll
            for (int q = 0; q < 8; ++q) { u32x2 w; w.x = pk2(v[q].x, v[q].y); w.y = pk2(v[q].z, v[q].w); *((u32x2*)(PB + (size_t)(m0 + q) * PLE) + lane) = w; } }
    }
    SEAM(0);
    if (IN(1)) { pg8::Gemm g{XB, XB, NPAN, W_IN, M, N_IN, DM}; pg8::StaticOrder S; S.init(M, N_IN, G, bx);
        pg8::EpiIn E{Q1, K1, V1, G1, KVR, SSQ0, b_a2}; pg8::gemm_phase(lds, g, S, E); }
    SEAM(1);
    if (IN(2)) {
        for (int base = bx * 2; base < SB * 4; base += G * 2) gla_sample_pair(lds, base, Q1, K1, V1, G1, KVR, state_gla, out + O_SS, gla_o_gain, R3, tid);
        gla_super_phase<false>(lds, G, bx, nullptr, K1, V1, nullptr, KVR, UT, DV, nullptr, nullptr, nullptr, tid, lane, wave);
    }
    SEAM(2);
    if (IN(3)) gla_scan<NSUP>(UT, DV, out + O_SP, bx * NTHREADS + tid, G * NTHREADS);
    SEAM(3);
    if (IN(4)) { gla_super_phase<true>(lds, G, bx, Q1, K1, V1, G1, KVR, UT, nullptr, gla_o_gain, R3, out + O_SP, tid, lane, wave); }
    SEAM(4);
    if (IN(5)) {
        { pg8::Gemm g{R3, R3, NPAN, W_OUT, MP, DM, DM}; pg8::StaticOrder S; S.init(MP, DM, G, bx); pg8::EpiRes<false> E{nullptr, nullptr, XB, XB, SSQ1, 1.f}; pg8::gemm_phase(lds, g, S, E); }
        { pg8::Gemm g{PB, PB, NPAN, (const bf16_t*)(ws + WS_W_P0), MP, DM, PLE}; pg8::StaticOrder S; S.init(MP, DM, G, bx); pg8::EpiPl E{PLQ}; pg8::gemm_phase(lds, g, S, E); }
        { mg::MRes<false> E{nullptr, XB, XB, SSQ1, 1.f}; mg::mini_gemm(lds, R3 + (size_t)MP * DM, W_OUT, DM, DM, G, bx, E); }
        { mg::MPl E{PLQ, nullptr}; mg::mini_gemm(lds, PB + (size_t)MP * PLE, (const bf16_t*)(ws + WS_W_P0), DM, PLE, G, bx, E); }
    }
    SEAM(5);
    if (IN(6)) { { pg8::Gemm g{XB, XB, NPAN, (const bf16_t*)(ws + WS_W_UP0), MP, FF, DM}; pg8::StaticOrder S; S.init(MP, FF, G, bx); pg8::EpiUp E{HIDA, R3, SSQ1}; pg8::gemm_phase(lds, g, S, E); }
        { mg::MUp E{HIDS, SSQ1, nullptr}; mg::mini_gemm(lds, XB + (size_t)MP * DM, (const bf16_t*)(ws + WS_W_UP0), FF, DM, G, bx, E); } }
    SEAM(6);
    if (IN(7)) { { pg8::Gemm g{HIDA, R3, HID_SPLIT, (const bf16_t*)(ws + WS_W_DN0), MP, DM, FF}; pg8::StaticOrder S; S.init(MP, DM, G, bx); pg8::EpiRes<false> E{nullptr, nullptr, XB, XB, SSQ0, 1.f}; pg8::gemm_phase(lds, g, S, E); }
        { mg::MRes<false> E{nullptr, XB, XB, SSQ0, 1.f}; mg::mini_gemm(lds, HIDS, (const bf16_t*)(ws + WS_W_DN0), DM, FF, G, bx, E); } }
    SEAM(7);
    if (IN(8)) { { pg8::Gemm g{XB, XB, NPAN, (const bf16_t*)(ws + WS_W_G0), MP, DM, DM}; pg8::StaticOrder S; S.init(MP, DM, G, bx); pg8::EpiGate<false> E{nullptr, XB, PLQ, H3B, SSQ0, SSQ1, 1.f}; pg8::gemm_phase(lds, g, S, E); }
        { mg::MGate<false> E{nullptr, XB, PLQ, H3B, SSQ0, SSQ1, 1.f}; mg::mini_gemm(lds, XB + (size_t)MP * DM, (const bf16_t*)(ws + WS_W_G0), DM, DM, G, bx, E); } }
    SEAM(8);
    if (IN(9)) { pg8::Gemm g{H3B, H3B, NPAN, W_KVQ, M, NKVQ, DM}; pg8::StaticOrder S; S.init(M, NKVQ, G, bx);
        pg8::EpiKvq E{KVR, PLQ, SSQ1, out + O_CKP, out + O_CVP, out + O_CKS, out + O_CVS}; pg8::gemm_phase(lds, g, S, E); }
    SEAM(9);
    if (IN(10)) {
        const AttnP AP{KVR, PLQ, R3, cache_k, cache_v, out + O_CKS, out + O_CVS, sinks, rel_bias};
        { AttnRegs AR; int buf = 0;
          if (bx < 1024) { attn_load(bx, AP, AR, tid); attn_stage(lds, bx, AP, AR, tid); }
          LDS_BAR();
          for (int it = bx; it < 1024; it += G) { const int nx = it + G;
              if (nx < 1024) attn_load(nx, AP, AR, tid);
              attn_compute(lds + buf * ATT_BUF, it, AP, lane, wave);
              if (nx < 1024) attn_stage(lds + (buf ^ 1) * ATT_BUF, nx, AP, AR, tid);
              LDS_BAR(); buf ^= 1; } }
        for (int m0 = gw * 8; m0 < M; m0 += NGW * 8) { f32x4 v[8];
#pragma unroll
            for (int q = 0; q < 8; ++q) { const int m = m0 + q; v[q] = *((const f32x4*)(m < MP ? p_prompt + (size_t)(MP + m) * PLE : p_sample + (size_t)(MS + m - MP) * PLE) + lane); }
#pragma unroll
            for (int q = 0; q < 8; ++q) { u32x2 w; w.x = pk2(v[q].x, v[q].y); w.y = pk2(v[q].z, v[q].w); *((u32x2*)(PB + (size_t)(m0 + q) * PLE) + lane) = w; } }
    }
    SEAM(10);
    if (IN(11)) {
        { pg8::Gemm g{R3, R3, NPAN, W_O, MP, DM, DM}; pg8::StaticOrder S; S.init(MP, DM, G, bx); pg8::EpiRes<false> E{nullptr, nullptr, H3B, XB, SSQ0, 1.f}; pg8::gemm_phase(lds, g, S, E); }
        { pg8::Gemm g{PB, PB, NPAN, (const bf16_t*)(ws + WS_W_P1), MP, DM, PLE}; pg8::StaticOrder S; S.init(MP, DM, G, bx); pg8::EpiPl E{PLQ}; pg8::gemm_phase(lds, g, S, E); }
        { mg::MRes<false> E{nullptr, H3B, XB, SSQ0, 1.f}; mg::mini_gemm(lds, R3 + (size_t)MP * DM, W_O, DM, DM, G, bx, E); }
        { mg::MPl E{PLQ, nullptr}; mg::mini_gemm(lds, PB + (size_t)MP * PLE, (const bf16_t*)(ws + WS_W_P1), DM, PLE, G, bx, E); }
    }
    SEAM(11);
    if (IN(12)) { { pg8::Gemm g{XB, XB, NPAN, (const bf16_t*)(ws + WS_W_UP1), MP, FF, DM}; pg8::StaticOrder S; S.init(MP, FF, G, bx); pg8::EpiUp E{HIDA, R3, SSQ0}; pg8::gemm_phase(lds, g, S, E); }
        { mg::MUp E{HIDS, SSQ0, nullptr}; mg::mini_gemm(lds, XB + (size_t)MP * DM, (const bf16_t*)(ws + WS_W_UP1), FF, DM, G, bx, E); } }
    SEAM(12);
    if (IN(13)) { { pg8::Gemm g{HIDA, R3, HID_SPLIT, (const bf16_t*)(ws + WS_W_DN1), MP, DM, FF}; pg8::StaticOrder S; S.init(MP, DM, G, bx); pg8::EpiRes<false> E{nullptr, nullptr, XB, XB, SSQ1, 1.f}; pg8::gemm_phase(lds, g, S, E); }
        { mg::MRes<false> E{nullptr, XB, XB, SSQ1, 1.f}; mg::mini_gemm(lds, HIDS, (const bf16_t*)(ws + WS_W_DN1), DM, FF, G, bx, E); } }
    SEAM(13);
    if (IN(14)) { { pg8::Gemm g{XB, XB, NPAN, (const bf16_t*)(ws + WS_W_G1), MP, DM, DM}; pg8::StaticOrder S; S.init(MP, DM, G, bx); pg8::EpiGate<false> E{nullptr, XB, PLQ, H3B, SSQ1, SSQ0, 1.f}; pg8::gemm_phase(lds, g, S, E); }
        { mg::MGate<false> E{nullptr, XB, PLQ, H3B, SSQ1, SSQ0, 1.f}; mg::mini_gemm(lds, XB + (size_t)MP * DM, (const bf16_t*)(ws + WS_W_G1), DM, DM, G, bx, E); } }
    SEAM(14);
    if (IN(15)) {
        f32x4 gn[4];
#pragma unroll
        for (int j = 0; j < 4; ++j) gn[j] = *((const f32x4*)norm_final + lane + 64 * j);
        for (int m0 = gw * 4; m0 < M; m0 += NGW * 4) { u32x2 w[4][4]; float r[4];
#pragma unroll
            for (int q = 0; q < 4; ++q) { r[q] = row_r(SSQ0, m0 + q);
#pragma unroll
                for (int j = 0; j < 4; ++j) w[q][j] = *((const u32x2*)(H3B + (size_t)(m0 + q) * DM) + lane + 64 * j); }
#pragma unroll
            for (int q = 0; q < 4; ++q)
#pragma unroll
                for (int j = 0; j < 4; ++j) { const f32x4 v = {bflo(w[q][j].x), bfhi(w[q][j].x), bflo(w[q][j].y), bfhi(w[q][j].y)};
                    __builtin_nontemporal_store(v * r[q] * gn[j], (f32x4*)(H + (size_t)(m0 + q) * DM) + lane + 64 * j); } }
    }
#undef IN
#undef SEAM
}
#undef ws
#undef out
#undef x_prompt
#undef x_sample
#undef state_gla
#undef cache_k
#undef cache_v
#undef p_prompt
#undef p_sample
#undef norm_mix
#undef norm_mlp
#undef norm_ple
#undef norm_kv
#undef norm_final
#undef w_in_a
#undef w_a2
#undef b_a2
#undef gla_o_gain
#undef w_out_a
#undef w_kv
#undef w_q_b
#undef w_o_b
#undef sinks
#undef rel_bias
#undef w_up
#undef w_down
#undef w_ple
#undef w_ple_gate
#undef W_IN
#undef W_OUT
#undef W_KVQ
#undef W_O
#undef XB
#undef PB
#undef Q1
#undef K1
#undef V1
#undef G1
#undef HIDA
#undef H3B
#undef R3
#undef HIDS
#undef KVR
#undef PLQ
#undef SSQ0
#undef SSQ1
#undef DV
#undef H
#undef UT
#undef KARG

extern "C" void kernel_launch(void* const* d_in, const int* in_sizes, int n_in, void* d_out, int out_size, void* d_ws, size_t ws_size, hipStream_t stream) {
    static int grid = 0;
    if (grid == 0) {
        if (n_in != 26 || (size_t)out_size != O_END || ws_size < WS_END) { fprintf(stderr, "kernel_launch: unexpected shapes (n_in %d out %d ws %zu need %zu)\n", n_in, out_size, ws_size, (size_t)WS_END); grid = -1; return; }
        int dev = 0, cus = 0, per_cu = 0;
        hipGetDevice(&dev); hipDeviceGetAttribute(&cus, hipDeviceAttributeMultiprocessorCount, dev);
        hipFuncSetAttribute((const void*)yoco_fwd, hipFuncAttributeMaxDynamicSharedMemorySize, LDS_BYTES);
        hipOccupancyMaxActiveBlocksPerMultiprocessor(&per_cu, (const void*)yoco_fwd, NTHREADS, LDS_BYTES);
        if (per_cu < 1) { fprintf(stderr, "kernel_launch: occupancy query says %d blocks per CU\n", per_cu); per_cu = 1; }
        (void)hipGetLastError();
        grid = cus * 1;
    }
    if (grid < 0) return;
    if (hipMemsetAsync((char*)d_ws + WS_CTL, 0, 65536, stream) != hipSuccess) { fprintf(stderr, "kernel_launch: memset failed\n"); return; }
    Args a{};
    for (int i = 0; i < 26; ++i) a.in[i] = (const float*)d_in[i];
    a.out = (float*)d_out; a.ws = (unsigned char*)d_ws;
#if MK_SPLIT
    for (int ph = 0; ph < 16; ++ph) { a.ph_lo = ph; a.ph_hi = ph + 1; hipLaunchKernelGGL(yoco_fwd, dim3(grid), dim3(NTHREADS), LDS_BYTES, stream, a); }
#else
    a.ph_lo = 0; a.ph_hi = 16;
    void* kargs[] = {&a};
    hipError_t e = hipLaunchCooperativeKernel((const void*)yoco_fwd, dim3(grid), dim3(NTHREADS), kargs, LDS_BYTES, stream);
    if (e != hipSuccess) fprintf(stderr, "cooperative launch failed: %s (grid %d)\n", hipGetErrorString(e), grid);
#endif
}
```

```cpp
#include <hip/hip_runtime.h>
#include <hip/hip_cooperative_groups.h>
#include <cstdio>
#include <cstdint>
namespace cg = cooperative_groups;

#define LAS __attribute__((address_space(3)))
#define GAS __attribute__((address_space(1)))
typedef unsigned short bf16_t;
typedef short bf16x8 __attribute__((ext_vector_type(8)));
typedef short s16x4 __attribute__((ext_vector_type(4)));
typedef float f32x4 __attribute__((ext_vector_type(4)));
typedef float f32x2 __attribute__((ext_vector_type(2)));
typedef unsigned u32x4 __attribute__((ext_vector_type(4)));
typedef unsigned u32x2 __attribute__((ext_vector_type(2)));

#ifndef MK_SPLIT
#define MK_SPLIT 0
#endif

constexpr int DM = 1024, SEQ = 8192, NBATCH = 2, MP = NBATCH * SEQ, SB = 128, SS = 8, MS = SB * SS, M = MP + MS, NPAN = M / 256;
constexpr int NQK = 512, NV = 1024, N_IN = 3584, FF = 4096, PLE = 256, NKVQ = 1536, IN_A_COLS = 3088;
constexpr int NCHUNK = 128, NBH = 8, NCH_ALL = NBH * NCHUNK;
constexpr float EPS = 1e-6f, LOG2E = 1.4426950408889634f;
constexpr int HID_SPLIT = 51;

constexpr size_t O_Y = 0, O_SP = (size_t)M * DM, O_SS = O_SP + 262144, O_CKP = O_SS + 16777216, O_CVP = O_CKP + 65536, O_CKS = O_CVP + 65536, O_CVS = O_CKS + 4194304, O_END = O_CVS + 4194304;

constexpr size_t al256(size_t x) { return (x + 255) & ~(size_t)255; }
constexpr size_t WS_CTL = 0, CTL_BYTES = 1u << 20;
constexpr size_t WS_W_IN = CTL_BYTES;
constexpr size_t WS_W_OUT = WS_W_IN + (size_t)N_IN * DM * 2;
constexpr size_t WS_W_UP0 = WS_W_OUT + (size_t)DM * DM * 2;
constexpr size_t WS_W_DN0 = WS_W_UP0 + (size_t)FF * DM * 2;
constexpr size_t WS_W_UP1 = WS_W_DN0 + (size_t)FF * DM * 2;
constexpr size_t WS_W_DN1 = WS_W_UP1 + (size_t)FF * DM * 2;
constexpr size_t WS_W_G0 = WS_W_DN1 + (size_t)FF * DM * 2;
constexpr size_t WS_W_G1 = WS_W_G0 + (size_t)DM * DM * 2;
constexpr size_t WS_W_P0 = WS_W_G1 + (size_t)DM * DM * 2;
constexpr size_t WS_W_P1 = WS_W_P0 + (size_t)DM * PLE * 2;
constexpr size_t WS_W_KVQ = WS_W_P1 + (size_t)DM * PLE * 2;
constexpr size_t WS_W_O = WS_W_KVQ + (size_t)NKVQ * DM * 2;
constexpr size_t WS_XB = WS_W_O + (size_t)DM * DM * 2;
constexpr size_t WS_PB = WS_XB + (size_t)M * DM * 2;
constexpr size_t WS_R1 = WS_PB + (size_t)M * PLE * 2;
constexpr size_t R1_BYTES = (size_t)HID_SPLIT * 256 * FF * 2;
constexpr size_t WS_Q1 = WS_R1, WS_K1 = WS_Q1 + (size_t)M * NQK * 2, WS_V1 = WS_K1 + (size_t)M * NQK * 2, WS_G1 = WS_V1 + (size_t)M * NV * 2;
static_assert(WS_G1 + (size_t)M * NV * 2 == WS_R1 + R1_BYTES, "R1 map");
constexpr size_t WS_R3 = WS_R1 + R1_BYTES;
static_assert((size_t)(NPAN - HID_SPLIT) * 256 * FF * 2 == (size_t)M * DM * 2, "R3 map");
constexpr size_t WS_KVR = WS_R3 + (size_t)M * DM * 2;
constexpr size_t WS_PLQ = WS_KVR + (size_t)M * NQK * 2;
constexpr size_t WS_SSQ = WS_PLQ + (size_t)M * DM * 2;
constexpr size_t WS_DV = WS_SSQ + (size_t)2 * M * 16 * 4;
constexpr size_t WS_END = WS_DV + (size_t)NCH_ALL * 128 * 4;

__device__ __forceinline__ float bf2f(unsigned short b) { return __uint_as_float((unsigned)b << 16); }
__device__ __forceinline__ float bflo(unsigned w) { return __uint_as_float(w << 16); }
__device__ __forceinline__ float bfhi(unsigned w) { return __uint_as_float(w & 0xffff0000u); }
typedef __bf16 bf16x2_t __attribute__((ext_vector_type(2)));
__device__ __forceinline__ unsigned pk2(float lo, float hi) { const f32x2 v = {lo, hi}; const bf16x2_t b = __builtin_convertvector(v, bf16x2_t); return __builtin_bit_cast(unsigned, b); }
__device__ __forceinline__ float fexp(float x) { return __builtin_amdgcn_exp2f(x * LOG2E); }
__device__ __forceinline__ float frcp(float x) { return __builtin_amdgcn_rcpf(x); }
__device__ __forceinline__ float frsq(float x) { return __builtin_amdgcn_rsqf(x); }
__device__ __forceinline__ float fsigmoid(float x) { return frcp(1.f + fexp(-x)); }
__device__ __forceinline__ float logsig(float x) { return fminf(x, 0.f) - __logf(1.f + fexp(-fabsf(x))); }
__device__ __forceinline__ s16x4 trd(const LAS bf16_t* p) { return __builtin_bit_cast(s16x4, __builtin_amdgcn_ds_read_tr16_b64_v4i16((LAS s16x4*)p)); }
__device__ __forceinline__ bf16x8 cat8(s16x4 lo, s16x4 hi) { return (bf16x8){lo[0], lo[1], lo[2], lo[3], hi[0], hi[1], hi[2], hi[3]}; }
__device__ __forceinline__ void st_wt(float* p, float v) { __hip_atomic_store(p, v, __ATOMIC_RELAXED, __HIP_MEMORY_SCOPE_AGENT); }
__device__ __forceinline__ void st16_wt(void* p, u32x4 v) { asm volatile("global_store_dwordx4 %0, %1, off sc1\n\ts_nop 1" :: "v"(p), "v"(v) : "memory"); }
__device__ __forceinline__ float wave_sum(float v) {
#pragma unroll
    for (int o = 1; o < 64; o <<= 1) v += __shfl_xor(v, o);
    return v;
}
__device__ __forceinline__ size_t ssq_idx(int pn, int row, int wc) { return ((size_t)pn * M + row) * 4 + wc; }
__device__ __forceinline__ float row_r(const float* ssq, int row) {
    const f32x4 a = *(const f32x4*)(ssq + ssq_idx(0, row, 0)), b = *(const f32x4*)(ssq + ssq_idx(1, row, 0)), c = *(const f32x4*)(ssq + ssq_idx(2, row, 0)), d = *(const f32x4*)(ssq + ssq_idx(3, row, 0));
    const f32x4 s = (a + b) + (c + d);
    return frsq(((s.x + s.y) + (s.z + s.w)) * (1.f / 1024.f) + EPS);
}

namespace pg8 {
constexpr int BM = 256, BK = 64, HALF = 128, HTB = HALF * BK * 2, STAGE_BYTES = 8 * HTB, NXCD = 8, WGM = 8;
__host__ __device__ __forceinline__ int lds_byte(int r, int c) { const int st = (r >> 4) * 2 + (c >> 5), rr = r & 15, cc = c & 31, ob = rr * 64 + cc * 2; return st * 1024 + (ob ^ (((ob >> 9) & 1) << 5)); }
__host__ __device__ __forceinline__ void stage_rc(int b, int& R, int& C) { const int st = b / 1024, sb = b % 1024, swz = sb ^ (((sb >> 9) & 1) << 5); R = (st >> 1) * 16 + swz / 64; C = (st & 1) * 32 + (swz % 64) / 2; }
__host__ __device__ __forceinline__ int perm32(int rho) { const int n = rho >> 4, i = rho & 15; return 8 * (i >> 2) + 4 * n + (i & 3); }
struct Unit { int pm, pn; };
struct Gemm { const bf16_t* A; const bf16_t* A2; int split; const bf16_t* Bt; int M, N, K; };
struct StaticOrder {
    int nM, nN, nwg, G, c;
    __device__ void init(int M_, int N, int G_, int c_) { nM = M_ / BM; nN = N / BM; nwg = nM * nN; G = G_; c = c_; }
    __device__ bool next(int i, Unit& u) const {
        const long L = (long)i * G + c; if (L >= nwg) return false;
        int wgid = (int)L; { const int q = nwg / NXCD, r = nwg % NXCD, xcd = wgid % NXCD, off = wgid / NXCD; wgid = (xcd < r ? xcd * (q + 1) : r * (q + 1) + (xcd - r) * q) + off; }
        const int nig = WGM * nN, gid = wgid / nig, fm = gid * WGM, gsz = (nM - fm) < WGM ? (nM - fm) : WGM;
        u.pm = fm + ((wgid % nig) % gsz); u.pn = (wgid % nig) / gsz; return true;
    }
};

template <class Epi>
__device__ __forceinline__ void gemm_phase(LAS unsigned char* lds, const Gemm g, const StaticOrder& S, const Epi& E) {
    const int tid = threadIdx.x, wid = __builtin_amdgcn_readfirstlane(tid >> 6), lane = tid & 63, wr = wid >> 2, wc = wid & 3, fr = lane & 15, fq = lane >> 4;
    const int K = g.K, nt = K / BK;
    unsigned voffA[2], voffB[2];
#pragma unroll
    for (int i = 0; i < 2; ++i) { int R, C; stage_rc(tid * 16 + i * 8192, R, C); const int Rb = (R & ~31) + perm32(R & 31);
        voffA[i] = (unsigned)(R * K + C) * 2u; voffB[i] = (unsigned)(Rb * K + C) * 2u; }
    const size_t kstep = (size_t)(BK * 2);
    const size_t hstep = (size_t)HALF * K * 2;
    const size_t tstep = 2 * hstep;
    const unsigned ldsw = (unsigned)wid * 1024u;
    const int aoff = lds_byte(wr * 64 + fr, fq * 8), boff = lds_byte(wc * 32 + fr, fq * 8);
#define PG8_APTR(pm) ((pm) < g.split ? (const char*)g.A + (size_t)(pm) * tstep : (const char*)g.A2 + (size_t)((pm) - g.split) * tstep)
#define PG8_SA(b, h) (((b) * 2 + (h)) * HTB)
#define PG8_SB(b, h) ((4 + (b) * 2 + (h)) * HTB)
#define PG8_STAGE(bufoff, gbase, voff) do { _Pragma("unroll") for (int _i = 0; _i < 2; ++_i) \
        __builtin_amdgcn_global_load_lds((const unsigned*)((const char*)(gbase) + (voff)[_i]), (LAS unsigned*)(lds + (bufoff) + ldsw + _i * 8192), 16, 0, 0); } while (0)
#define PG8_LDA(dst, b, h) do { _Pragma("unroll") for (int m = 0; m < 4; ++m) _Pragma("unroll") for (int k = 0; k < 2; ++k) dst[m][k] = *(const LAS bf16x8*)(lds + PG8_SA(b, h) + aoff + m * 2048 + k * 1024); } while (0)
#define PG8_LDB(dst, b, h) do { _Pragma("unroll") for (int n = 0; n < 2; ++n) _Pragma("unroll") for (int k = 0; k < 2; ++k) dst[n][k] = *(const LAS bf16x8*)(lds + PG8_SB(b, h) + boff + n * 2048 + k * 1024); } while (0)
#define PG8_MMA(ai, bj, At, Bt) do { __builtin_amdgcn_s_setprio(1); _Pragma("unroll") for (int m = 0; m < 4; ++m) _Pragma("unroll") for (int n = 0; n < 2; ++n) _Pragma("unroll") for (int k = 0; k < 2; ++k) \
        acc[ai][bj][m][n] = __builtin_amdgcn_mfma_f32_16x16x32_bf16(Bt[n][k], At[m][k], acc[ai][bj][m][n], 0, 0, 0); __builtin_amdgcn_s_setprio(0); } while (0)
#define PG8_WAIT_V(n) asm volatile("s_waitcnt vmcnt(" #n ")" ::: "memory")
#define PG8_WAIT_L(n) asm volatile("s_waitcnt lgkmcnt(" #n ")" ::: "memory")
#define PG8_BAR __builtin_amdgcn_s_barrier()
#define PG8_SCHED __builtin_amdgcn_sched_barrier(0)
    Unit cur, nxt; int ui = 0;
    if (!S.next(0, cur)) return;
    LAS float* rtab_all = (LAS float*)(lds + STAGE_BYTES);
    if (E.rsrc() != nullptr) { Unit uu; for (int i = 0; i < 8 && S.next(i, uu); ++i) if (tid < 256) rtab_all[i * 256 + tid] = row_r(E.rsrc(), uu.pm * BM + tid); }
    f32x4 acc[2][2][4][2];
#pragma unroll
    for (int a = 0; a < 2; ++a)
#pragma unroll
        for (int b = 0; b < 2; ++b)
#pragma unroll
            for (int m = 0; m < 4; ++m)
#pragma unroll
                for (int n = 0; n < 2; ++n) acc[a][b][m][n] = (f32x4){0.f, 0.f, 0.f, 0.f};
    bf16x8 At[4][2], B0[2][2], B1[2][2];
    const char* cA = PG8_APTR(cur.pm); const char* cB = (const char*)g.Bt + (size_t)cur.pn * tstep;
    PG8_STAGE(PG8_SB(0, 0), cB, voffB); PG8_STAGE(PG8_SB(0, 1), cB + hstep, voffB); PG8_STAGE(PG8_SA(0, 0), cA, voffA); PG8_STAGE(PG8_SA(0, 1), cA + hstep, voffA);
    PG8_WAIT_L(0);
    if (wr == 1) PG8_BAR;
    PG8_WAIT_V(2); PG8_BAR;
    PG8_STAGE(PG8_SB(1, 0), cB + kstep, voffB); PG8_STAGE(PG8_SA(1, 0), cA + kstep, voffA); PG8_STAGE(PG8_SB(1, 1), cB + hstep + kstep, voffB);
    PG8_WAIT_V(6); PG8_BAR;
    for (;;) {
        const bool has_next = S.next(ui + 1, nxt);
        const char* nA = has_next ? PG8_APTR(nxt.pm) : cA; const char* nB = has_next ? (const char*)g.Bt + (size_t)nxt.pn * tstep : cB;
#pragma clang loop unroll(disable)
        for (int t = 0; t < nt; t += 2) {
            const bool last = (t == nt - 2);
            const char* a1 = cA + (size_t)(t + 1) * kstep;
            const char* a2 = last ? nA : cA + (size_t)(t + 2) * kstep; const char* b2 = last ? nB : cB + (size_t)(t + 2) * kstep;
            const char* a3 = a2 + kstep; const char* b3 = b2 + kstep;
            PG8_LDB(B0, 0, 0); PG8_LDB(B1, 0, 1); PG8_SCHED; PG8_LDA(At, 0, 0); PG8_STAGE(PG8_SA(1, 1), a1 + hstep, voffA);
            PG8_WAIT_V(8); PG8_WAIT_L(0); PG8_BAR; PG8_MMA(0, 0, At, B0); PG8_MMA(0, 1, At, B1); PG8_BAR; PG8_SCHED;
            PG8_LDA(At, 0, 1); PG8_STAGE(PG8_SB(0, 0), b2, voffB); PG8_STAGE(PG8_SB(0, 1), b2 + hstep, voffB); PG8_STAGE(PG8_SA(0, 0), a2, voffA);
            PG8_WAIT_V(8); PG8_WAIT_L(0); PG8_BAR; PG8_MMA(1, 0, At, B0); PG8_MMA(1, 1, At, B1); PG8_BAR; PG8_SCHED;
            PG8_LDB(B0, 1, 0); PG8_LDB(B1, 1, 1); PG8_SCHED; PG8_LDA(At, 1, 0); PG8_STAGE(PG8_SA(0, 1), a2 + hstep, voffA);
            PG8_WAIT_V(8); PG8_WAIT_L(0); PG8_BAR; PG8_MMA(0, 0, At, B0); PG8_MMA(0, 1, At, B1); PG8_BAR; PG8_SCHED;
            PG8_LDA(At, 1, 1); PG8_STAGE(PG8_SB(1, 0), b3, voffB); PG8_STAGE(PG8_SB(1, 1), b3 + hstep, voffB); PG8_STAGE(PG8_SA(1, 0), a3, voffA);
            PG8_WAIT_V(8); PG8_WAIT_L(0); PG8_BAR; PG8_MMA(1, 0, At, B0); PG8_MMA(1, 1, At, B1); PG8_BAR; PG8_SCHED;
        }
        if (wr == 0) PG8_BAR;
        { int efr = fr, efq = fq, etid = tid; asm volatile("" : "+v"(efr), "+v"(efq), "+v"(etid));
          E(acc, cur, wr, wc, efr, efq, rtab_all + (ui & 7) * 256, etid); }
        if (!has_next) break;
#pragma unroll
        for (int a = 0; a < 2; ++a)
#pragma unroll
            for (int b = 0; b < 2; ++b)
#pragma unroll
                for (int m = 0; m < 4; ++m)
#pragma unroll
                    for (int n = 0; n < 2; ++n) acc[a][b][m][n] = (f32x4){0.f, 0.f, 0.f, 0.f};
        cur = nxt; cA = nA; cB = nB; ++ui;
        if (wr == 1) PG8_BAR;
    }
    PG8_WAIT_V(0);
    PG8_BAR;
#undef PG8_APTR
#undef PG8_SA
#undef PG8_SB
#undef PG8_STAGE
#undef PG8_LDA
#undef PG8_LDB
#undef PG8_MMA
#undef PG8_WAIT_V
#undef PG8_WAIT_L
#undef PG8_BAR
#undef PG8_SCHED
}

#define EPI_ROWLOOP _Pragma("unroll") for (int ai = 0; ai < 2; ++ai) _Pragma("unroll") for (int m = 0; m < 4; ++m)
__device__ __forceinline__ u32x4 pack8(const f32x4 v0, const f32x4 v1) { u32x4 w; w.x = pk2(v0[0], v0[1]); w.y = pk2(v0[2], v0[3]); w.z = pk2(v1[0], v1[1]); w.w = pk2(v1[2], v1[3]); return w; }

struct EpiIn {
    bf16_t *Q, *Kk, *V, *G, *LG; const float* ssq; const float* b_a2;
    __device__ __forceinline__ const float* rsrc() const { return ssq; }
    __device__ __forceinline__ void operator()(const f32x4 (&acc)[2][2][4][2], const Unit& u, int wr, int wc, int fr, int fq, LAS float* rtab, int tid) const {
        const int pn = u.pn; bf16_t* base; int ld, c0;
        if (pn < 2) { base = Q; ld = NQK; c0 = pn * 256; } else if (pn < 4) { base = Kk; ld = NQK; c0 = (pn - 2) * 256; }
        else if (pn < 8) { base = V; ld = NV; c0 = (pn - 4) * 256; } else if (pn < 12) { base = G; ld = NV; c0 = (pn - 8) * 256; }
        else { base = LG; ld = NQK; c0 = (pn - 12) * 256; }
        const bool is_lg = pn >= 12;
        const int col = c0 + wc * 32 + 8 * fq;
        f32x4 bb[2][2];
#pragma unroll
        for (int bj = 0; bj < 2; ++bj)
#pragma unroll
            for (int n = 0; n < 2; ++n) bb[bj][n] = is_lg ? *(const f32x4*)(b_a2 + col + bj * HALF + 4 * n) : (f32x4){0.f, 0.f, 0.f, 0.f};
        EPI_ROWLOOP { const int lr = ai * HALF + wr * 64 + m * 16 + fr, row = u.pm * BM + lr; const float r = rtab[lr];
#pragma unroll
            for (int bj = 0; bj < 2; ++bj) { f32x4 v0 = acc[ai][bj][m][0] * r, v1 = acc[ai][bj][m][1] * r;
                if (is_lg) { v0 += bb[bj][0]; v1 += bb[bj][1];
#pragma unroll
                    for (int e = 0; e < 4; ++e) { v0[e] = logsig(v0[e]) * (1.f / 16.f); v1[e] = logsig(v1[e]) * (1.f / 16.f); } }
                *(u32x4*)(base + (size_t)row * ld + col + bj * HALF) = pack8(v0, v1); } }
    }
};
template <bool FROM_X> struct EpiRes {
    const float* X0; const float* X1; const bf16_t* BB; bf16_t* XO; float* ssq_out; float sc;
    __device__ __forceinline__ const float* rsrc() const { return nullptr; }
    __device__ __forceinline__ void operator()(const f32x4 (&acc)[2][2][4][2], const Unit& u, int wr, int wc, int fr, int fq, LAS float* rtab, int tid) const {
        const int col = u.pn * BM + wc * 32 + 8 * fq;
#pragma unroll
        for (int ai = 0; ai < 2; ++ai) {
            f32x4 b0[4][2], b1[4][2]; u32x4 bw[4][2];
#pragma unroll
            for (int m = 0; m < 4; ++m) { const int row = u.pm * BM + ai * HALF + wr * 64 + m * 16 + fr;
#pragma unroll
                for (int bj = 0; bj < 2; ++bj) {
                    if (FROM_X) { const float* src = (u.pm < MP / 256 ? X0 + (size_t)row * DM : X1 + (size_t)(row - MP) * DM) + col + bj * HALF; b0[m][bj] = *(const f32x4*)src; b1[m][bj] = *(const f32x4*)(src + 4); }
                    else bw[m][bj] = *(const u32x4*)(BB + (size_t)row * DM + col + bj * HALF); } }
            if (!FROM_X) asm volatile("" ::: "memory");
#pragma unroll
            for (int m = 0; m < 4; ++m) { const int row = u.pm * BM + ai * HALF + wr * 64 + m * 16 + fr; float s = 0.f;
#pragma unroll
                for (int bj = 0; bj < 2; ++bj) {
                    if (!FROM_X) { const u32x4 w = bw[m][bj]; b0[m][bj] = (f32x4){bflo(w.x), bfhi(w.x), bflo(w.y), bfhi(w.y)}; b1[m][bj] = (f32x4){bflo(w.z), bfhi(w.z), bflo(w.w), bfhi(w.w)}; }
                    const f32x4 v0 = acc[ai][bj][m][0] * sc + b0[m][bj], v1 = acc[ai][bj][m][1] * sc + b1[m][bj];
                    *(u32x4*)(XO + (size_t)row * DM + col + bj * HALF) = pack8(v0, v1);
                    s += (v0[0] * v0[0] + v0[1] * v0[1]) + (v0[2] * v0[2] + v0[3] * v0[3]) + (v1[0] * v1[0] + v1[1] * v1[1]) + (v1[2] * v1[2] + v1[3] * v1[3]); }
                s += __shfl_xor(s, 16); s += __shfl_xor(s, 32);
                if (fq == 0) ssq_out[ssq_idx(u.pn, row, wc)] = s; }
        }
    }
};
struct EpiUp {
    bf16_t* HA; bf16_t* HB; const float* ssq;
    __device__ __forceinline__ const float* rsrc() const { return ssq; }
    __device__ __forceinline__ void operator()(const f32x4 (&acc)[2][2][4][2], const Unit& u, int wr, int wc, int fr, int fq, LAS float* rtab, int tid) const {
        bf16_t* base = u.pm < HID_SPLIT ? HA + (size_t)u.pm * 256 * FF : HB + (size_t)(u.pm - HID_SPLIT) * 256 * FF;
        const int col = u.pn * BM + wc * 32 + 8 * fq;
        EPI_ROWLOOP { const int lr = ai * HALF + wr * 64 + m * 16 + fr; const float r = rtab[lr];
#pragma unroll
            for (int bj = 0; bj < 2; ++bj) { f32x4 v0 = acc[ai][bj][m][0] * r, v1 = acc[ai][bj][m][1] * r;
#pragma unroll
                for (int e = 0; e < 4; ++e) { const float a = fmaxf(v0[e], 0.f), b = fmaxf(v1[e], 0.f); v0[e] = a * a; v1[e] = b * b; }
                st16_wt(base + (size_t)lr * FF + col + bj * HALF, pack8(v0, v1)); } }
    }
};
struct EpiPl {
    bf16_t* PL;
    __device__ __forceinline__ const float* rsrc() const { return nullptr; }
    __device__ __forceinline__ void operator()(const f32x4 (&acc)[2][2][4][2], const Unit& u, int wr, int wc, int fr, int fq, LAS float* rtab, int tid) const {
        const int col = u.pn * BM + wc * 32 + 8 * fq;
        EPI_ROWLOOP { const int row = u.pm * BM + ai * HALF + wr * 64 + m * 16 + fr;
#pragma unroll
            for (int bj = 0; bj < 2; ++bj) *(u32x4*)(PL + (size_t)row * DM + col + bj * HALF) = pack8(acc[ai][bj][m][0], acc[ai][bj][m][1]); }
    }
};
template <bool LAST> struct EpiGate {
    float* HO; const bf16_t* BB; const bf16_t* PL; bf16_t* OB; const float* ssq_in; float* ssq_out; float sc;
    __device__ __forceinline__ const float* rsrc() const { return ssq_in; }
    __device__ __forceinline__ void operator()(const f32x4 (&acc)[2][2][4][2], const Unit& u, int wr, int wc, int fr, int fq, LAS float* rtab, int tid) const {
        const int col = u.pn * BM + wc * 32 + 8 * fq;
#pragma unroll
        for (int ai = 0; ai < 2; ++ai) {
            u32x4 bw[4][2], pw[4][2];
#pragma unroll
            for (int m = 0; m < 4; ++m) { const size_t off0 = (size_t)(u.pm * BM + ai * HALF + wr * 64 + m * 16 + fr) * DM + col;
#pragma unroll
                for (int bj = 0; bj < 2; ++bj) { bw[m][bj] = *(const u32x4*)(BB + off0 + bj * HALF); pw[m][bj] = *(const u32x4*)(PL + off0 + bj * HALF); } }
#pragma unroll
            for (int m = 0; m < 4; ++m) { const int lr = ai * HALF + wr * 64 + m * 16 + fr, row = u.pm * BM + lr; const float r = rtab[lr];
                float s = 0.f;
#pragma unroll
                for (int bj = 0; bj < 2; ++bj) { const size_t off = (size_t)row * DM + col + bj * HALF; const u32x4 b_ = bw[m][bj], p_ = pw[m][bj];
                    const f32x4 b0 = {bflo(b_.x), bfhi(b_.x), bflo(b_.y), bfhi(b_.y)}, b1 = {bflo(b_.z), bfhi(b_.z), bflo(b_.w), bfhi(b_.w)};
                    const f32x4 p0 = {bflo(p_.x), bfhi(p_.x), bflo(p_.y), bfhi(p_.y)}, p1 = {bflo(p_.z), bfhi(p_.z), bflo(p_.w), bfhi(p_.w)};
                    f32x4 v0 = acc[ai][bj][m][0] * r, v1 = acc[ai][bj][m][1] * r;
#pragma unroll
                    for (int e = 0; e < 4; ++e) { v0[e] = b0[e] + fsigmoid(v0[e]) * p0[e] * sc; v1[e] = b1[e] + fsigmoid(v1[e]) * p1[e] * sc; }
                    if (LAST) { *(f32x4*)(HO + off) = v0; *(f32x4*)(HO + off + 4) = v1; }
                    else { *(u32x4*)(OB + off) = pack8(v0, v1);
                        s += (v0[0] * v0[0] + v0[1] * v0[1]) + (v0[2] * v0[2] + v0[3] * v0[3]) + (v1[0] * v1[0] + v1[1] * v1[1]) + (v1[2] * v1[2] + v1[3] * v1[3]); } }
                if (!LAST) { s += __shfl_xor(s, 16); s += __shfl_xor(s, 32); if (fq == 0) ssq_out[ssq_idx(u.pn, row, wc)] = s; } }
        }
    }
};
struct EpiKvq {
    bf16_t* KV; bf16_t* Qb; const float* ssq; float *CKP, *CVP, *CKS, *CVS;
    __device__ __forceinline__ const float* rsrc() const { return ssq; }
    __device__ __forceinline__ void operator()(const f32x4 (&acc)[2][2][4][2], const Unit& u, int wr, int wc, int fr, int fq, LAS float* rtab, int tid) const {
        const int pn = u.pn, c = wc * 32 + 8 * fq;
        EPI_ROWLOOP { const int lr = ai * HALF + wr * 64 + m * 16 + fr, row = u.pm * BM + lr; const float r = rtab[lr];
            float* cdst = nullptr;
            if (pn < 2) {
                if (row < MP) { const int b = row >> 13, t = row & (SEQ - 1); if (t >= SEQ - 128) cdst = (pn == 0 ? CKP : CVP) + ((size_t)(b * 128 + t - (SEQ - 128)) * 256 + c); }
                else { const int rs = row - MP, sb = rs >> 3, i = rs & 7; cdst = (pn == 0 ? CKS : CVS) + ((size_t)(sb * 128 + 120 + i) * 256 + c); }
            }
            bf16_t* dst = pn < 2 ? KV + (size_t)row * 512 + pn * 256 + c : Qb + (size_t)row * DM + (pn - 2) * 256 + c;
#pragma unroll
            for (int bj = 0; bj < 2; ++bj) { const f32x4 v0 = acc[ai][bj][m][0] * r, v1 = acc[ai][bj][m][1] * r;
                *(u32x4*)(dst + bj * HALF) = pack8(v0, v1);
                if (cdst) { *(f32x4*)(cdst + bj * HALF) = v0; *(f32x4*)(cdst + bj * HALF + 4) = v1; } } }
    }
};
}


namespace mg {
constexpr int KT = 256, LDT = KT + 8, TILE_B = 64 * LDT * 2;
template <class Epi>
__device__ __forceinline__ void mini_gemm(LAS unsigned char* lds, const bf16_t* A  , const bf16_t* Bt  , int N, int K, int G, int bx, const Epi& E) {
    const int tid = threadIdx.x, lane = tid & 63, wave = __builtin_amdgcn_readfirstlane(tid >> 6), l15 = lane & 15, g = lane >> 4;
    const int rt = wave & 3, chh = wave >> 2, nk = K / KT, units = 16 * (N / 64);
    LAS float* red = (LAS float*)(lds + 4 * TILE_B);
    for (int u = bx; u < units; u += G) {
        const int rm = u & 15, cn = u >> 4;
        const bf16_t* Ag = A + (size_t)(rm * 64) * K; const bf16_t* Bg = Bt + (size_t)(cn * 64) * K;
        u32x4 ra0[4], rb0[4], ra1[4], rb1[4];
#define MG_LOAD(ra, rb, kt) do { _Pragma("unroll") for (int i = 0; i < 4; ++i) { const int c = tid + 512 * i, row = c >> 5, ch = c & 31; \
            ra[i] = *(const u32x4*)(Ag + (size_t)row * K + (kt) * KT + ch * 8); rb[i] = *(const u32x4*)(Bg + (size_t)row * K + (kt) * KT + ch * 8); } } while (0)
#define MG_STORE(ra, rb, b) do { _Pragma("unroll") for (int i = 0; i < 4; ++i) { const int c = tid + 512 * i, row = c >> 5, ch = c & 31; \
            *(LAS u32x4*)(lds + (b) * 2 * TILE_B + (row * LDT + ch * 8) * 2) = ra[i]; *(LAS u32x4*)(lds + (b) * 2 * TILE_B + TILE_B + (row * LDT + ch * 8) * 2) = rb[i]; } } while (0)
#define MG_COMPUTE(b) do { const LAS bf16_t* Al = (const LAS bf16_t*)(lds + (b) * 2 * TILE_B); const LAS bf16_t* Bl = (const LAS bf16_t*)(lds + (b) * 2 * TILE_B + TILE_B); \
            _Pragma("unroll") for (int ks = 0; ks < KT / 32; ++ks) { const bf16x8 Af = *(const LAS bf16x8*)(Al + (16 * rt + l15) * LDT + 32 * ks + 8 * g); \
                _Pragma("unroll") for (int t = 0; t < 2; ++t) { const bf16x8 Bf = *(const LAS bf16x8*)(Bl + (16 * (2 * chh + t) + l15) * LDT + 32 * ks + 8 * g); \
                    acc[t] = __builtin_amdgcn_mfma_f32_16x16x32_bf16(Bf, Af, acc[t], 0, 0, 0); } } } while (0)
        f32x4 acc[2] = {(f32x4){0.f, 0.f, 0.f, 0.f}, (f32x4){0.f, 0.f, 0.f, 0.f}};
#define MG_BAR() do { asm volatile("s_waitcnt lgkmcnt(0)" ::: "memory"); __builtin_amdgcn_s_barrier(); asm volatile("" ::: "memory"); } while (0)
        MG_LOAD(ra0, rb0, 0); if (nk > 1) MG_LOAD(ra1, rb1, 1);
        MG_STORE(ra0, rb0, 0); MG_BAR();
        for (int kt = 0; kt < nk; kt += 2) {
            if (kt + 2 < nk) MG_LOAD(ra0, rb0, kt + 2);
            MG_COMPUTE(0);
            if (kt + 1 < nk) MG_STORE(ra1, rb1, 1);
            MG_BAR();
            if (kt + 1 < nk) {
                if (kt + 3 < nk) MG_LOAD(ra1, rb1, kt + 3);
                MG_COMPUTE(1);
                if (kt + 2 < nk) MG_STORE(ra0, rb0, 0);
                MG_BAR();
            }
        }
#undef MG_BAR
        const int row = MP + rm * 64 + 16 * rt + l15; float s = 0.f;
#pragma unroll
        for (int t = 0; t < 2; ++t) { const f32x4 o = E(row, cn * 64 + 16 * (2 * chh + t) + 4 * g, acc[t]); s += (o[0] * o[0] + o[1] * o[1]) + (o[2] * o[2] + o[3] * o[3]); }
        if (Epi::SSQ) { s += __shfl_xor(s, 16); s += __shfl_xor(s, 32); if (g == 0) red[(16 * rt + l15) * 2 + chh] = s;
            __syncthreads();
            if (tid < 64) st_wt(E.ssq_out + ssq_idx(cn >> 2, MP + rm * 64 + tid, cn & 3), red[tid * 2] + red[tid * 2 + 1]);
            __syncthreads(); }
#undef MG_LOAD
#undef MG_STORE
#undef MG_COMPUTE
    }
}
__device__ __forceinline__ u32x2 pack4(const f32x4 v) { u32x2 w; w.x = pk2(v[0], v[1]); w.y = pk2(v[2], v[3]); return w; }
template <bool FROM_X> struct MRes {
    static constexpr bool SSQ = true; const float* X1; const bf16_t* BB; bf16_t* XO; float* ssq_out; float sc;
    __device__ __forceinline__ f32x4 operator()(int row, int col, const f32x4 v) const {
        f32x4 b; if (FROM_X) b = *(const f32x4*)(X1 + (size_t)(row - MP) * DM + col); else { const u32x2 w = *(const u32x2*)(BB + (size_t)row * DM + col); b = (f32x4){bflo(w.x), bfhi(w.x), bflo(w.y), bfhi(w.y)}; }
        const f32x4 o = b + v * sc; *(u32x2*)(XO + (size_t)row * DM + col) = pack4(o); return o; }
};
struct MPl { static constexpr bool SSQ = false; bf16_t* PL; float* ssq_out;
    __device__ __forceinline__ f32x4 operator()(int row, int col, const f32x4 v) const { *(u32x2*)(PL + (size_t)row * DM + col) = pack4(v); return v; } };
struct MUp { static constexpr bool SSQ = false; bf16_t* HS  ; const float* ssq; float* ssq_out;
    __device__ __forceinline__ f32x4 operator()(int row, int col, const f32x4 v) const { const float r = row_r(ssq, row); f32x4 o;
#pragma unroll
        for (int e = 0; e < 4; ++e) { const float a = fmaxf(v[e] * r, 0.f); o[e] = a * a; }
        *(u32x2*)(HS + (size_t)(row - MP) * FF + col) = pack4(o); return o; } };
template <bool LAST> struct MGate { static constexpr bool SSQ = !LAST; float* HO; const bf16_t* BB; const bf16_t* PL; bf16_t* OB; const float* ssq_in; float* ssq_out; float sc;
    __device__ __forceinline__ f32x4 operator()(int row, int col, const f32x4 v) const { const float r = row_r(ssq_in, row); const size_t off = (size_t)row * DM + col;
        const u32x2 bw = *(const u32x2*)(BB + off), pw = *(const u32x2*)(PL + off);
        const f32x4 b = {bflo(bw.x), bfhi(bw.x), bflo(bw.y), bfhi(bw.y)}, p = {bflo(pw.x), bfhi(pw.x), bflo(pw.y), bfhi(pw.y)}; f32x4 o;
#pragma unroll
        for (int e = 0; e < 4; ++e) o[e] = b[e] + fsigmoid(v[e] * r) * p[e] * sc;
        if (LAST) *(f32x4*)(HO + off) = o; else *(u32x2*)(OB + off) = pack4(o); return o; } };
}

constexpr int NWAVES = 8, NTHREADS = 512;
constexpr int RING_BYTES = 131072, LDS_BYTES = 147456;
struct Args { const float* in[26]; float* out; unsigned char* ws; int ph_lo, ph_hi; };

struct TJob { const float* src; int ldw, kk, nblk; bf16_t* dst; const float* gain; float scale; int item; };
__device__ __forceinline__ void p0_tload(const TJob& J, float (&r)[32], int lane) {
    const int kb = J.item / J.nblk, nb = J.item % J.nblk, k0 = 64 * kb, n0 = 32 * nb;
#pragma unroll
    for (int i = 0; i < 32; ++i) r[i] = __builtin_nontemporal_load(J.src + (size_t)(k0 + 2 * i + (lane >> 5)) * J.ldw + n0 + (lane & 31));
}
__device__ __forceinline__ void p0_tfinish(const TJob& J, const float (&r)[32], LAS float* scr, int lane) {
    const int kb = J.item / J.nblk, nb = J.item % J.nblk, k0 = 64 * kb, n0 = 32 * nb, c = lane & 7;
    f32x4 g0 = {1.f, 1.f, 1.f, 1.f}, g1 = g0;
    if (J.gain) { g0 = *(const f32x4*)(J.gain + k0 + 8 * c); g1 = *(const f32x4*)(J.gain + k0 + 8 * c + 4); }
    g0 *= J.scale; g1 *= J.scale;
#pragma unroll
    for (int i = 0; i < 32; ++i) scr[(2 * i + (lane >> 5)) * 33 + (lane & 31)] = r[i];
    asm volatile("s_waitcnt lgkmcnt(0)" ::: "memory");
#pragma unroll
    for (int j = 0; j < 4; ++j) { const int n = (lane >> 3) + 8 * j; const LAS float* sp = scr + (8 * c) * 33 + n;
        u32x4 o; o.x = pk2(sp[0 * 33] * g0.x, sp[1 * 33] * g0.y); o.y = pk2(sp[2 * 33] * g0.z, sp[3 * 33] * g0.w); o.z = pk2(sp[4 * 33] * g1.x, sp[5 * 33] * g1.y); o.w = pk2(sp[6 * 33] * g1.z, sp[7 * 33] * g1.w);
        *(u32x4*)(J.dst + (size_t)(n0 + n) * J.kk + k0 + 8 * c) = o; }
    asm volatile("s_waitcnt lgkmcnt(0)" ::: "memory");
}

constexpr int T128 = 144, T256 = 272, TP = 80;
#define LDS_BAR() do { asm volatile("s_waitcnt lgkmcnt(0)" ::: "memory"); __builtin_amdgcn_s_barrier(); asm volatile("" ::: "memory"); } while (0)
struct GlaRegs { u32x4 lg[2], v[4], k[2], q[2]; };
template <bool WITH_Q, bool DO_LKQ = true, bool DO_V = true>
__device__ __forceinline__ void gla_fetch(GlaRegs& R, int item, const bf16_t* Q1, const bf16_t* K1, const bf16_t* V1, const bf16_t* LGp, int tid) {
    const int bh = item >> 7, c = item & 127, b = bh >> 2, h = bh & 3; const size_t row0 = (size_t)b * SEQ + c * 64;
    if (DO_LKQ) {
#pragma unroll
        for (int i = 0; i < 2; ++i) { const int x = tid + NTHREADS * i, j = x >> 4, d8 = (x & 15) * 8; const size_t off = (row0 + j) * NQK + h * 128 + d8;
            R.lg[i] = *(const u32x4*)(LGp + off); R.k[i] = *(const u32x4*)(K1 + off); if (WITH_Q) R.q[i] = *(const u32x4*)(Q1 + off); } }
    if (DO_V) {
#pragma unroll
        for (int i = 0; i < 4; ++i) { const int x = tid + NTHREADS * i, j = x >> 5, e8 = (x & 31) * 8; R.v[i] = *(const u32x4*)(V1 + (row0 + j) * NV + h * 256 + e8); } }
}
__device__ __forceinline__ void gla_stage_lg_v(const GlaRegs& R, LAS float* bc, LAS bf16_t* vt, int tid) {
#pragma unroll
    for (int i = 0; i < 2; ++i) { const int x = tid + NTHREADS * i, j = x >> 4, d8 = (x & 15) * 8; const u32x4 w = R.lg[i];
        *(LAS f32x4*)(bc + j * 128 + d8) = (f32x4){bflo(w.x), bfhi(w.x), bflo(w.y), bfhi(w.y)}; *(LAS f32x4*)(bc + j * 128 + d8 + 4) = (f32x4){bflo(w.z), bfhi(w.z), bflo(w.w), bfhi(w.w)}; }
#pragma unroll
    for (int i = 0; i < 4; ++i) { const int x = tid + NTHREADS * i, j = x >> 5, e8 = (x & 31) * 8; *(LAS u32x4*)(vt + j * T256 + e8) = R.v[i]; }
    LDS_BAR();
    if (tid < 128) { float s = 0.f;
#pragma unroll 8
        for (int j = 0; j < 64; ++j) { s += bc[j * 128 + tid]; bc[j * 128 + tid] = s; } }
    LDS_BAR();
}
constexpr int NSUP = 32, NSUP_ALL = NBH * NSUP;
template <bool OUT>
__device__ __forceinline__ void gla_super_phase(LAS unsigned char* lds, int G, int bx, const bf16_t* Q1, const bf16_t* K1, const bf16_t* V1, const bf16_t* G1, const bf16_t* LGp, bf16_t* US, float* DVS,
                                                const float* ogain, bf16_t* OG, float* SOUT, int tid, int lane, int wave) {
    LAS float* bc = (LAS float*)lds;
    LAS bf16_t* Pm = (LAS bf16_t*)lds;
    LAS bf16_t* qt = (LAS bf16_t*)(lds + 32768);
    LAS bf16_t* kt = qt + 64 * T128;
    LAS bf16_t* kd = kt + 64 * T128;
    LAS bf16_t* vt = kd + 64 * T128;
    LAS float* red = (LAS float*)(lds + 32768 + 3 * 64 * T128 * 2 + 64 * T256 * 2);
    LAS float* em = red + 512;
    LAS float* dvl = em + 128;
    const int l15 = lane & 15, g = lane >> 4, q = l15 >> 2, p = l15 & 3;
    f32x4 gn[2] = {(f32x4){0.f, 0.f, 0.f, 0.f}, (f32x4){0.f, 0.f, 0.f, 0.f}};
    if (OUT) {
#pragma unroll
        for (int t = 0; t < 2; ++t) gn[t] = *(const f32x4*)(ogain + 16 * (2 * wave + t) + 4 * g); }
    GlaRegs R;
    if (bx < NSUP_ALL) gla_fetch<OUT>(R, (bx >> 5) * NCHUNK + (bx & 31) * 4, Q1, K1, V1, LGp, tid);
    for (int item = bx; item < NSUP_ALL; item += G) {
        const int bh = item >> 5, sc = item & 31, b = bh >> 2, h = bh & 3;
        f32x4 S[8][2];
        if (OUT) {
#pragma unroll
            for (int dt = 0; dt < 8; ++dt)
#pragma unroll
                for (int t = 0; t < 2; ++t) { const u32x2 w = *(const u32x2*)(US + ((size_t)item * 256 + 16 * (2 * wave + t) + l15) * 128 + 16 * dt + 4 * g); S[dt][t] = (f32x4){bflo(w.x), bfhi(w.x), bflo(w.y), bfhi(w.y)}; }
        } else {
#pragma unroll
            for (int dt = 0; dt < 8; ++dt) { S[dt][0] = (f32x4){0.f, 0.f, 0.f, 0.f}; S[dt][1] = (f32x4){0.f, 0.f, 0.f, 0.f}; } }
        float lsum = 0.f;
        for (int cc = 0; cc < 4; ++cc) {
            const int c = sc * 4 + cc; const size_t row0 = (size_t)b * SEQ + c * 64;
            gla_stage_lg_v(R, bc, vt, tid);
#pragma unroll
            for (int i = 0; i < 2; ++i) { const int x = tid + NTHREADS * i, j = x >> 4, d8 = (x & 15) * 8; const u32x4 wk = R.k[i];
                float kv[8] = {bflo(wk.x), bfhi(wk.x), bflo(wk.y), bfhi(wk.y), bflo(wk.z), bfhi(wk.z), bflo(wk.w), bfhi(wk.w)};
                float cur[8], dd[8];
#pragma unroll
                for (int t = 0; t < 8; ++t) { cur[t] = bc[j * 128 + d8 + t]; dd[t] = kv[t] * fexp(bc[63 * 128 + d8 + t] - cur[t]); }
                u32x4 o; o.x = pk2(dd[0], dd[1]); o.y = pk2(dd[2], dd[3]); o.z = pk2(dd[4], dd[5]); o.w = pk2(dd[6], dd[7]); *(LAS u32x4*)(kd + j * T128 + d8) = o;
                if (OUT) { const u32x4 wq = R.q[i];
                    float qv[8] = {bflo(wq.x), bfhi(wq.x), bflo(wq.y), bfhi(wq.y), bflo(wq.z), bfhi(wq.z), bflo(wq.w), bfhi(wq.w)};
                    float a[8], bb[8];
#pragma unroll
                    for (int t = 0; t < 8; ++t) { const float mid = bc[31 * 128 + d8 + t]; a[t] = qv[t] * fexp(cur[t] - mid); bb[t] = kv[t] * fexp(mid - cur[t]); }
                    o.x = pk2(a[0], a[1]); o.y = pk2(a[2], a[3]); o.z = pk2(a[4], a[5]); o.w = pk2(a[6], a[7]); *(LAS u32x4*)(qt + j * T128 + d8) = o;
                    o.x = pk2(bb[0], bb[1]); o.y = pk2(bb[2], bb[3]); o.z = pk2(bb[4], bb[5]); o.w = pk2(bb[6], bb[7]); *(LAS u32x4*)(kt + j * T128 + d8) = o; } }
            if (tid < 128) { const float last = bc[63 * 128 + tid]; dvl[tid] = fexp(last); lsum += last; if (OUT) em[tid] = fexp(bc[31 * 128 + tid]); }
            const int nxt_ = (cc < 3) ? bh * NCHUNK + c + 1 : (item + G < NSUP_ALL ? ((item + G) >> 5) * NCHUNK + ((item + G) & 31) * 4 : -1);
            if (nxt_ >= 0) gla_fetch<OUT, true, false>(R, nxt_, Q1, K1, V1, LGp, tid);
            LDS_BAR();
            if (OUT) {
#pragma unroll
                for (int t = 0; t < 2; ++t) { const int id = 2 * wave + t, ti = id >> 2, tj = id & 3;
                    f32x4 a = {0.f, 0.f, 0.f, 0.f};
                    if (tj <= ti) {
#pragma unroll
                        for (int ks = 0; ks < 4; ++ks) { const bf16x8 Af = *(const LAS bf16x8*)(qt + (16 * ti + l15) * T128 + 32 * ks + 8 * g), Bf = *(const LAS bf16x8*)(kt + (16 * tj + l15) * T128 + 32 * ks + 8 * g);
                            a = __builtin_amdgcn_mfma_f32_16x16x32_bf16(Af, Bf, a, 0, 0, 0); } }
#pragma unroll
                    for (int r = 0; r < 4; ++r) { const int i = 16 * ti + 4 * g + r, j = 16 * tj + l15; const float v = (j <= i) ? a[r] : 0.f; Pm[i * TP + j] = (bf16_t)(pk2(v, 0.f) & 0xffffu); }
                }
                LDS_BAR();
                f32x4 o[4][2];
#pragma unroll
                for (int ti = 0; ti < 4; ++ti) { o[ti][0] = (f32x4){0.f, 0.f, 0.f, 0.f}; o[ti][1] = (f32x4){0.f, 0.f, 0.f, 0.f}; }
#pragma unroll
                for (int ks = 0; ks < 2; ++ks) {
                    bf16x8 Bf[2];
#pragma unroll
                    for (int t = 0; t < 2; ++t) { const LAS bf16_t* a0 = vt + (32 * ks + 8 * g + q) * T256 + 16 * (2 * wave + t) + 4 * p; Bf[t] = cat8(trd(a0), trd(a0 + 4 * T256)); }
#pragma unroll
                    for (int ti = 2 * ks; ti < 4; ++ti) { const bf16x8 Af = *(const LAS bf16x8*)(Pm + (16 * ti + l15) * TP + 32 * ks + 8 * g);
#pragma unroll
                        for (int t = 0; t < 2; ++t) o[ti][t] = __builtin_amdgcn_mfma_f32_16x16x32_bf16(Bf[t], Af, o[ti][t], 0, 0, 0); }
                }
#pragma unroll
                for (int ks = 0; ks < 4; ++ks) {
                    const f32x4 e0 = *(LAS f32x4*)(em + 32 * ks + 4 * g), e1 = *(LAS f32x4*)(em + 32 * ks + 16 + 4 * g);
                    bf16x8 Bf[2];
#pragma unroll
                    for (int t = 0; t < 2; ++t) { const f32x4 s0 = S[2 * ks][t] * e0, s1 = S[2 * ks + 1][t] * e1; u32x4 w; w.x = pk2(s0[0], s0[1]); w.y = pk2(s0[2], s0[3]); w.z = pk2(s1[0], s1[1]); w.w = pk2(s1[2], s1[3]); Bf[t] = __builtin_bit_cast(bf16x8, w); }
#pragma unroll
                    for (int ti = 0; ti < 4; ++ti) { const LAS bf16_t* ap = qt + (16 * ti + l15) * T128 + 32 * ks + 4 * g;
                        const u32x2 a0 = *(const LAS u32x2*)ap, a1 = *(const LAS u32x2*)(ap + 16); u32x4 aw; aw.x = a0.x; aw.y = a0.y; aw.z = a1.x; aw.w = a1.y; const bf16x8 Af = __builtin_bit_cast(bf16x8, aw);
#pragma unroll
                        for (int t = 0; t < 2; ++t) o[ti][t] = __builtin_amdgcn_mfma_f32_16x16x32_bf16(Bf[t], Af, o[ti][t], 0, 0, 0); }
                }
#pragma unroll
                for (int ti = 0; ti < 4; ++ti) { float s = 0.f;
#pragma unroll
                    for (int t = 0; t < 2; ++t) s += (o[ti][t][0] * o[ti][t][0] + o[ti][t][1] * o[ti][t][1]) + (o[ti][t][2] * o[ti][t][2] + o[ti][t][3] * o[ti][t][3]);
                    s += __shfl_xor(s, 16); s += __shfl_xor(s, 32);
                    if (g == 0) red[(16 * ti + l15) * 8 + wave] = s; }
                LDS_BAR();
#pragma unroll
                for (int ti = 0; ti < 4; ++ti) { const int i = 16 * ti + l15; const f32x4 r0 = *(LAS f32x4*)(red + i * 8), r1 = *(LAS f32x4*)(red + i * 8 + 4);
                    const float rms = frsq(((r0.x + r0.y) + (r0.z + r0.w) + (r1.x + r1.y) + (r1.z + r1.w)) * (1.f / 256.f) + EPS);
#pragma unroll
                    for (int t = 0; t < 2; ++t) { const size_t off = (row0 + i) * NV + h * 256 + 16 * (2 * wave + t) + 4 * g; const u32x2 gw_ = *(const u32x2*)(G1 + off);
                        const f32x4 gv = {bflo(gw_.x), bfhi(gw_.x), bflo(gw_.y), bfhi(gw_.y)}; f32x4 ov;
#pragma unroll
                        for (int r = 0; r < 4; ++r) ov[r] = o[ti][t][r] * rms * gn[t][r] * gv[r] * fsigmoid(gv[r]);
                        u32x2 w; w.x = pk2(ov[0], ov[1]); w.y = pk2(ov[2], ov[3]); *(u32x2*)(OG + off) = w; } }
            }
            if (nxt_ >= 0) gla_fetch<OUT, false, true>(R, nxt_, Q1, K1, V1, LGp, tid);
#pragma unroll
            for (int dt = 0; dt < 8; ++dt) { const f32x4 dvv = *(LAS f32x4*)(dvl + 16 * dt + 4 * g); S[dt][0] *= dvv; S[dt][1] *= dvv; }
#pragma unroll
            for (int ks = 0; ks < 2; ++ks) {
                bf16x8 Bf[2];
#pragma unroll
                for (int t = 0; t < 2; ++t) { const LAS bf16_t* a0 = vt + (32 * ks + 8 * g + q) * T256 + 16 * (2 * wave + t) + 4 * p; Bf[t] = cat8(trd(a0), trd(a0 + 4 * T256)); }
#pragma unroll
                for (int dt = 0; dt < 8; ++dt) { const LAS bf16_t* a0 = kd + (32 * ks + 8 * g + q) * T128 + 16 * dt + 4 * p; const bf16x8 Af = cat8(trd(a0), trd(a0 + 4 * T128));
#pragma unroll
                    for (int t = 0; t < 2; ++t) S[dt][t] = __builtin_amdgcn_mfma_f32_16x16x32_bf16(Af, Bf[t], S[dt][t], 0, 0, 0); }
            }
            LDS_BAR();
        }
        if (OUT && sc == NSUP - 1) {
            float* so = SOUT + (size_t)bh * 128 * 256 + (size_t)(4 * g) * 256 + 32 * wave + l15;
#pragma unroll
            for (int dt = 0; dt < 8; ++dt) {
#pragma unroll
                for (int t = 0; t < 2; ++t)
#pragma unroll
                    for (int r = 0; r < 4; ++r) so[r * 256 + 16 * t] = S[dt][t][r];
                so += 16 * 256; asm volatile("" : "+v"(so));
            }
        }
        if (!OUT) {
#pragma unroll
            for (int dt = 0; dt < 8; ++dt)
#pragma unroll
                for (int t = 0; t < 2; ++t) { u32x2 w; w.x = pk2(S[dt][t][0], S[dt][t][1]); w.y = pk2(S[dt][t][2], S[dt][t][3]);
                    *(u32x2*)(US + ((size_t)item * 256 + 16 * (2 * wave + t) + l15) * 128 + 16 * dt + 4 * g) = w; }
            if (tid < 128) DVS[(size_t)item * 128 + tid] = fexp(lsum);
        }
    }
}
template <int NSTEP>
__device__ __forceinline__ void gla_scan(bf16_t* UT, const float* DV, float* state_out, int gtid, int gthreads) {
    for (int idx = gtid; idx < NBH * 256 * 64; idx += gthreads) {
        const int bh = idx >> 14, rem = idx & 16383, e = rem >> 6, dp = rem & 63;
        unsigned* base = (unsigned*)UT + (size_t)bh * NSTEP * 16384 + e * 64 + dp;
        const float* dv = DV + (size_t)bh * NSTEP * 128 + 2 * dp;
        float s0 = 0.f, s1 = 0.f;
        for (int c0 = 0; c0 < NSTEP; c0 += 32) {
            unsigned uu[32]; f32x2 dd[32];
#pragma unroll
            for (int k = 0; k < 32; ++k) { uu[k] = base[(size_t)(c0 + k) * 16384]; dd[k] = *(const f32x2*)(dv + (size_t)(c0 + k) * 128); }
#pragma unroll
            for (int k = 0; k < 32; ++k) { base[(size_t)(c0 + k) * 16384] = pk2(s0, s1); s0 = dd[k].x * s0 + bflo(uu[k]); s1 = dd[k].y * s1 + bfhi(uu[k]); }
        }
        (void)state_out;
    }
}
__device__ __forceinline__ void gla_sample_pair(LAS unsigned char* lds, int base_item, const bf16_t* Q1, const bf16_t* K1, const bf16_t* V1, const bf16_t* G1, const bf16_t* LGp,
                                                const float* S0in, float* Sout, const float* ogain, bf16_t* OG, int tid) {
    const int hb = tid >> 8, t = tid & 255, item = base_item + hb, sb = item >> 2, h = item & 3; const size_t r0 = (size_t)MP + sb * 8;
    LAS float* qaT = (LAS float*)(lds + hb * 16384);
    LAS float* qsT = qaT + 1024, *kdT = qsT + 1024, *dvs = kdT + 1024, *att = dvs + 128, *red = att + 64;
    if (t < 128) { const int d = t; float bcv[8], s = 0.f;
#pragma unroll
        for (int i = 0; i < 8; ++i) { s += bf2f(LGp[(r0 + i) * NQK + h * 128 + d]); bcv[i] = s; }
#pragma unroll
        for (int i = 0; i < 8; ++i) { const float qv = bf2f(Q1[(r0 + i) * NQK + h * 128 + d]), kv = bf2f(K1[(r0 + i) * NQK + h * 128 + d]);
            qaT[d * 8 + i] = qv * fexp(bcv[i] - bcv[7]); qsT[d * 8 + i] = qv * fexp(bcv[i]); kdT[d * 8 + i] = kv * fexp(bcv[7] - bcv[i]); }
        dvs[d] = fexp(bcv[7]); }
    __syncthreads();
    if (t < 64) { const int i = t >> 3, j = t & 7; float s = 0.f;
        for (int d = 0; d < 128; ++d) s += qaT[d * 8 + i] * kdT[d * 8 + j];
        att[t] = (j <= i) ? s : 0.f; }
    __syncthreads();
    const int e = t; float v[8], o[8];
#pragma unroll
    for (int j = 0; j < 8; ++j) { v[j] = bf2f(V1[(r0 + j) * NV + h * 256 + e]); o[j] = 0.f; }
    const float* S0 = S0in + ((size_t)item * 128) * 256 + e; float* SO = Sout + ((size_t)item * 128) * 256 + e;
    for (int d0 = 0; d0 < 128; d0 += 32) { float sv[32];
#pragma unroll
        for (int k = 0; k < 32; ++k) sv[k] = __builtin_nontemporal_load(S0 + (size_t)(d0 + k) * 256);
#pragma unroll
        for (int k = 0; k < 32; ++k) { const int d = d0 + k; const f32x4 qa = *(LAS f32x4*)(qsT + d * 8), qb = *(LAS f32x4*)(qsT + d * 8 + 4), ka = *(LAS f32x4*)(kdT + d * 8), kb = *(LAS f32x4*)(kdT + d * 8 + 4);
            o[0] += qa.x * sv[k]; o[1] += qa.y * sv[k]; o[2] += qa.z * sv[k]; o[3] += qa.w * sv[k]; o[4] += qb.x * sv[k]; o[5] += qb.y * sv[k]; o[6] += qb.z * sv[k]; o[7] += qb.w * sv[k];
            __builtin_nontemporal_store(dvs[d] * sv[k] + ((ka.x * v[0] + ka.y * v[1]) + (ka.z * v[2] + ka.w * v[3])) + ((kb.x * v[4] + kb.y * v[5]) + (kb.z * v[6] + kb.w * v[7])), SO + (size_t)d * 256); }
    }
#pragma unroll
    for (int i = 0; i < 8; ++i)
#pragma unroll
        for (int j = 0; j <= i; ++j) o[i] += att[i * 8 + j] * v[j];
    const int wv = t >> 6;
#pragma unroll
    for (int i = 0; i < 8; ++i) { const float s = wave_sum(o[i] * o[i]); if ((t & 63) == 0) red[i * 4 + wv] = s; }
    __syncthreads();
    const float gn = ogain[e];
#pragma unroll
    for (int i = 0; i < 8; ++i) { const f32x4 rr = *(LAS f32x4*)(red + i * 4); const float rms = frsq(((rr.x + rr.y) + (rr.z + rr.w)) * (1.f / 256.f) + EPS);
        const size_t off = (r0 + i) * NV + h * 256 + e; const float gv = bf2f(G1[off]);
        OG[off] = (bf16_t)(pk2(o[i] * rms * gn * gv * fsigmoid(gv), 0.f) & 0xffffu); }
    __syncthreads();
}

constexpr int VT_LD = 72;
struct AttnP { const bf16_t* KV; const bf16_t* Qb; bf16_t* AO; const float* pk; const float* pv; float* ock; float* ocv; const float* sinks; const float* relb; };
constexpr int ATT_BUF = 32768 + 256 * VT_LD * 2 + 2048;
struct AttnRegs { u32x4 a[12]; };
#define ATT_DECODE(item) const bool smp = (item) >= 512; int b, kh, qblk, sb = 0; \
    if (!smp) { b = (item) >> 8; kh = ((item) >> 6) & 3; qblk = (item) & 63; } else { const int it_ = (item) - 512; sb = it_ >> 2; kh = it_ & 3; b = 0; qblk = 1; } \
    const long s0 = (long)b * SEQ + (long)qblk * 128; (void)s0; (void)sb
__device__ __forceinline__ void attn_load(int item, const AttnP& P, AttnRegs& R, int tid) {
    ATT_DECODE(item);
    if (!smp) {
#pragma unroll
        for (int j = 0; j < 4; ++j) { const int i = tid + NTHREADS * j, row = i >> 3, ch = i & 7; u32x4 wk = {0u, 0u, 0u, 0u}, wv = {0u, 0u, 0u, 0u};
            if (qblk > 0 || row >= 128) { const bf16_t* src = P.KV + (size_t)(s0 - 128 + row) * 512 + kh * 64 + ch * 8; wk = *(const u32x4*)src; wv = *(const u32x4*)(src + 256); }
            R.a[j] = wk; R.a[4 + j] = wv; }
    } else {
#pragma unroll
        for (int j = 0; j < 3; ++j) { const int i = tid + NTHREADS * j, row = i >> 3, ch = i & 7;
            u32x4 z = {0u, 0u, 0u, 0u}; R.a[4 * j] = z; R.a[4 * j + 1] = z; R.a[4 * j + 2] = z; R.a[4 * j + 3] = z;
            if (row < 128) { const size_t so = ((size_t)(sb * 128 + row) * 4 + kh) * 64 + ch * 8;
                R.a[4 * j] = *(const u32x4*)(P.pk + so); R.a[4 * j + 1] = *(const u32x4*)(P.pk + so + 4); R.a[4 * j + 2] = *(const u32x4*)(P.pv + so); R.a[4 * j + 3] = *(const u32x4*)(P.pv + so + 4); }
            else if (row < 136) { const bf16_t* src = P.KV + (size_t)(MP + sb * 8 + row - 128) * 512 + kh * 64 + ch * 8; R.a[4 * j] = *(const u32x4*)src; R.a[4 * j + 1] = *(const u32x4*)(src + 256); } }
    }
}
__device__ __forceinline__ void attn_stage(LAS unsigned char* lds, int item, const AttnP& P, const AttnRegs& R, int tid) {
    LAS unsigned char* Kt = lds; LAS bf16_t* Vt = (LAS bf16_t*)(lds + 32768); LAS float* bias2 = (LAS float*)(lds + 32768 + 256 * VT_LD * 2);
    ATT_DECODE(item);
    if (!smp) {
#pragma unroll
        for (int j = 0; j < 4; ++j) { const int i = tid + NTHREADS * j, row = i >> 3, ch = i & 7;
            *(LAS u32x4*)(Kt + row * 128 + ((ch ^ (row & 7)) << 4)) = R.a[j]; *(LAS u32x4*)(Vt + row * VT_LD + ch * 8) = R.a[4 + j]; }
    } else {
#pragma unroll
        for (int j = 0; j < 3; ++j) { const int i = tid + NTHREADS * j, row = i >> 3, ch = i & 7;
            if (i < 144 * 8) { u32x4 wk = R.a[4 * j], wv = R.a[4 * j + 1];
                if (row < 128) { const f32x4 k0 = __builtin_bit_cast(f32x4, R.a[4 * j]), k1 = __builtin_bit_cast(f32x4, R.a[4 * j + 1]), v0 = __builtin_bit_cast(f32x4, R.a[4 * j + 2]), v1 = __builtin_bit_cast(f32x4, R.a[4 * j + 3]);
                    wk = pg8::pack8(k0, k1); wv = pg8::pack8(v0, v1);
                    if (row >= 8) { const size_t oo = ((size_t)(sb * 128 + row - 8) * 4 + kh) * 64 + ch * 8;
                        __builtin_nontemporal_store(k0, (f32x4*)(P.ock + oo)); __builtin_nontemporal_store(k1, (f32x4*)(P.ock + oo + 4)); __builtin_nontemporal_store(v0, (f32x4*)(P.ocv + oo)); __builtin_nontemporal_store(v1, (f32x4*)(P.ocv + oo + 4)); } }
                *(LAS u32x4*)(Kt + row * 128 + ((ch ^ (row & 7)) << 4)) = wk; *(LAS u32x4*)(Vt + row * VT_LD + ch * 8) = wv; } }
    }
    { const int hl = tid >> 7, dist = tid & 127; int bk = dist;
      if (dist >= 16) { bk = 16 + (int)(__logf((float)dist * (1.f / 16.f)) * (16.f / 2.0794415416798357f)); bk = bk > 31 ? 31 : bk; }
      bias2[tid] = P.relb[bk * 16 + kh * 4 + hl] * LOG2E; }
}
__device__ __forceinline__ void attn_compute(LAS unsigned char* lds, int item, const AttnP& P, int lane, int wave) {
    LAS unsigned char* Kt = lds; LAS bf16_t* Vt = (LAS bf16_t*)(lds + 32768); LAS float* bias2 = (LAS float*)(lds + 32768 + 256 * VT_LD * 2);
    ATT_DECODE(item);
    const int l15 = lane & 15, g = lane >> 4, q = l15 >> 2, p = l15 & 3;
    const int ntq = smp ? (wave < 2 ? 1 : 0) : 4;
    for (int tq = 0; tq < ntq; ++tq) {
        const int qtile = smp ? 0 : (wave & 1) * 4 + tq;
        int hl_q, ioff; size_t qrow;
        if (!smp) { hl_q = wave >> 1; ioff = l15; qrow = (size_t)(s0 + 16 * qtile + l15); }
        else { hl_q = 2 * wave + (l15 >> 3); ioff = l15 & 7; qrow = (size_t)MP + sb * 8 + (l15 & 7); }
        const bf16_t* qp = P.Qb + qrow * DM + (kh * 4 + hl_q) * 64 + 8 * g;
        const bf16x8 Qf0 = *(const bf16x8*)qp, Qf1 = *(const bf16x8*)(qp + 32);
        f32x4 st[9];
#pragma unroll
        for (int j = 0; j < 9; ++j) { const int row = 16 * (qtile + j) + l15; const LAS unsigned char* kr = Kt + row * 128;
            const bf16x8 K0 = *(const LAS bf16x8*)(kr + ((g ^ (row & 7)) << 4)), K1f = *(const LAS bf16x8*)(kr + (((4 + g) ^ (row & 7)) << 4));
            f32x4 a = {0.f, 0.f, 0.f, 0.f};
            a = __builtin_amdgcn_mfma_f32_16x16x32_bf16(K0, Qf0, a, 0, 0, 0); a = __builtin_amdgcn_mfma_f32_16x16x32_bf16(K1f, Qf1, a, 0, 0, 0);
            st[j] = a; }
        const float sink2 = P.sinks[kh * 4 + hl_q] * LOG2E;
        float mx = sink2;
#pragma unroll
        for (int j = 0; j < 9; ++j)
#pragma unroll
            for (int r = 0; r < 4; ++r) { const int dist = 128 + ioff - 16 * j - 4 * g - r; const bool ok = (dist >= 0) && (dist < 128) && (smp || qblk > 0 || (16 * (qtile + j) + 4 * g + r) >= 128);
                const float v = ok ? st[j][r] + bias2[hl_q * 128 + (dist & 127)] : -INFINITY; st[j][r] = v; mx = fmaxf(mx, v); }
        mx = fmaxf(mx, __shfl_xor(mx, 16)); mx = fmaxf(mx, __shfl_xor(mx, 32));
        float sum = 0.f;
#pragma unroll
        for (int j = 0; j < 9; ++j)
#pragma unroll
            for (int r = 0; r < 4; ++r) { const float e = __builtin_amdgcn_exp2f(st[j][r] - mx); st[j][r] = e; sum += e; }
        sum += __shfl_xor(sum, 16); sum += __shfl_xor(sum, 32);
        const float inv = frcp(sum + __builtin_amdgcn_exp2f(sink2 - mx));
        f32x4 o[4];
#pragma unroll
        for (int dt = 0; dt < 4; ++dt) o[dt] = (f32x4){0.f, 0.f, 0.f, 0.f};
#pragma unroll
        for (int kk = 0; kk < 5; ++kk) {
            u32x4 pw; pw.x = pk2(st[2 * kk][0], st[2 * kk][1]); pw.y = pk2(st[2 * kk][2], st[2 * kk][3]);
            if (kk < 4) { pw.z = pk2(st[2 * kk + 1][0], st[2 * kk + 1][1]); pw.w = pk2(st[2 * kk + 1][2], st[2 * kk + 1][3]); } else { pw.z = 0u; pw.w = 0u; }
            const bf16x8 Pf = __builtin_bit_cast(bf16x8, pw);
            const LAS bf16_t* v0p = Vt + (16 * (qtile + 2 * kk) + 4 * g + q) * VT_LD + 4 * p;
#pragma unroll
            for (int dt = 0; dt < 4; ++dt) { const s16x4 lo = trd(v0p + 16 * dt); const s16x4 hi = (kk < 4) ? trd(v0p + 16 * VT_LD + 16 * dt) : (s16x4){0, 0, 0, 0};
                o[dt] = __builtin_amdgcn_mfma_f32_16x16x32_bf16(cat8(lo, hi), Pf, o[dt], 0, 0, 0); }
        }
        { bf16_t* op = P.AO + qrow * DM + (kh * 4 + hl_q) * 64 + 4 * g;
#pragma unroll
          for (int dt = 0; dt < 4; ++dt) { u32x2 w; w.x = pk2(o[dt][0] * inv, o[dt][1] * inv); w.y = pk2(o[dt][2] * inv, o[dt][3] * inv); *(u32x2*)(op + 16 * dt) = w; } }
    }
}


#define XB_TMO      128
#define XB_XCNT(j)  (256  + 64 * (j))
#define XB_XSUB(j)  (1280 + 64 * (j))
#define XB_XGEN(j)  (2304 + 64 * (j))
#define XB_TOP      3328
#define XB_TOPGEN   3392
#define XCD_BAR_WORDS 3456
#define XB_SPIN_CAP (1u << 20)
__device__ __forceinline__ unsigned xb_ld(unsigned* p)              { return __hip_atomic_load(p, __ATOMIC_RELAXED, __HIP_MEMORY_SCOPE_AGENT); }
__device__ __forceinline__ unsigned xb_add(unsigned* p, unsigned v) { return __hip_atomic_fetch_add(p, v, __ATOMIC_RELAXED, __HIP_MEMORY_SCOPE_AGENT); }
__device__ __forceinline__ unsigned xb_xcc_id() { return (unsigned)__builtin_amdgcn_s_getreg((3 << 11) | 20) & 0xFu; }
#define XB_SPIN(cond, bar) do { unsigned _sp = 0; while (cond) { __builtin_amdgcn_s_sleep(1); \
    if ((++_sp & 255u) == 0u) { if (xb_ld(&(bar)[XB_TMO])) break; if (_sp > XB_SPIN_CAP) { atomicAdd(&(bar)[XB_TMO], 1u); break; } } } } while (0)
struct XcdBarrier { unsigned* bar; unsigned x; volatile LAS unsigned* st; };
__device__ __forceinline__ XcdBarrier xcd_barrier_post(unsigned* bar, volatile LAS unsigned* st) {
    XcdBarrier b; b.bar = bar; b.x = xb_xcc_id(); b.st = st;
    if (threadIdx.x == 0) (void)xb_add(&bar[XB_XCNT(b.x)], 1u);
    return b;
}
__device__ __forceinline__ void xcd_barrier_complete(unsigned* bar, unsigned x, unsigned& nloc, unsigned& nx) {
    const unsigned G = gridDim.x * gridDim.y * gridDim.z;
    unsigned sum, cnt, mine, sp = 0u;
    for (;;) {
        sum = 0u; cnt = 0u; mine = 0u;
#pragma unroll
        for (unsigned j = 0; j < 16; ++j) { const unsigned c = xb_ld(&bar[XB_XCNT(j)]); sum += c; cnt += (c > 0u) ? 1u : 0u; mine = (j == x) ? c : mine; }
        if (sum == G) break;
        __builtin_amdgcn_s_sleep(1);
        if ((++sp & 255u) == 0u) { if (xb_ld(&bar[XB_TMO])) break; if (sp > XB_SPIN_CAP) { atomicAdd(&bar[XB_TMO], 1u); break; } }
    }
    nloc = mine > 0u ? mine : 1u; nx = cnt > 0u ? cnt : 1u;
}
__device__ __forceinline__ void xcd_barrier(const XcdBarrier& b) {
    asm volatile("s_waitcnt vmcnt(0)" ::: "memory");
    __syncthreads();
    if (threadIdx.x == 0) {
        unsigned* bar = b.bar;
        __builtin_amdgcn_s_waitcnt(0);
        unsigned nloc = b.st[0], nx = b.st[1];
        if (nloc == 0u) { xcd_barrier_complete(bar, b.x, nloc, nx); b.st[0] = nloc; b.st[1] = nx; }
        const unsigned old = xb_add(&bar[XB_XSUB(b.x)], 1u);
        const unsigned gen = old / nloc;
        if (old + 1u == (gen + 1u) * nloc) {
            __builtin_amdgcn_fence(__ATOMIC_RELEASE, "agent");
            asm volatile("s_waitcnt vmcnt(0)" ::: "memory");
            const unsigned og = xb_add(&bar[XB_TOP], 1u);
            const unsigned tg = og / nx;
            if (og + 1u == (tg + 1u) * nx) xb_add(&bar[XB_TOPGEN], 1u);
            else XB_SPIN(xb_ld(&bar[XB_TOPGEN]) == tg, bar);
            __builtin_amdgcn_fence(__ATOMIC_ACQUIRE, "agent");
            xb_add(&bar[XB_XGEN(b.x)], 1u);
            asm volatile("s_waitcnt vmcnt(0)" ::: "memory");
        } else {
            XB_SPIN(xb_ld(&bar[XB_XGEN(b.x)]) == gen, bar);
            __builtin_amdgcn_fence(__ATOMIC_ACQUIRE, "agent");
            asm volatile("s_waitcnt vmcnt(0)" ::: "memory");
        }
    }
    __syncthreads();
}

__global__ void __launch_bounds__(NTHREADS, 2) yoco_fwd(Args args) {
    extern __shared__ __attribute__((aligned(16))) unsigned char lds_raw[];
    LAS unsigned char* lds = (LAS unsigned char*)lds_raw;
    const int tid = threadIdx.x, lane = tid & 63, wave = __builtin_amdgcn_readfirstlane(tid >> 6), G = gridDim.x, bx = blockIdx.x;
    const int gw = bx * NWAVES + wave, NGW = G * NWAVES;
    typedef const __attribute__((address_space(4))) Args* KArgsP;
    const KArgsP kp0 = (KArgsP)__builtin_amdgcn_kernarg_segment_ptr();
#define KARG(field) ({ KArgsP q_ = kp0; asm volatile("" : "+s"(q_)); q_->field; })
#define ws KARG(ws)
#define out KARG(out)
#define x_prompt KARG(in[0])
#define x_sample KARG(in[1])
#define state_gla KARG(in[2])
#define cache_k KARG(in[3])
#define cache_v KARG(in[4])
#define p_prompt KARG(in[5])
#define p_sample KARG(in[6])
#define norm_mix KARG(in[7])
#define norm_mlp KARG(in[8])
#define norm_ple KARG(in[9])
#define norm_kv KARG(in[10])
#define norm_final KARG(in[11])
#define w_in_a KARG(in[12])
#define w_a2 KARG(in[13])
#define b_a2 KARG(in[14])
#define gla_o_gain KARG(in[15])
#define w_out_a KARG(in[16])
#define w_kv KARG(in[17])
#define w_q_b KARG(in[18])
#define w_o_b KARG(in[19])
#define sinks KARG(in[20])
#define rel_bias KARG(in[21])
#define w_up KARG(in[22])
#define w_down KARG(in[23])
#define w_ple KARG(in[24])
#define w_ple_gate KARG(in[25])
#define W_IN ((bf16_t*)(ws + WS_W_IN))
#define W_OUT ((bf16_t*)(ws + WS_W_OUT))
#define W_KVQ ((bf16_t*)(ws + WS_W_KVQ))
#define W_O ((bf16_t*)(ws + WS_W_O))
#define XB ((bf16_t*)(ws + WS_XB))
#define PB ((bf16_t*)(ws + WS_PB))
#define Q1 ((bf16_t*)(ws + WS_Q1))
#define K1 ((bf16_t*)(ws + WS_K1))
#define V1 ((bf16_t*)(ws + WS_V1))
#define G1 ((bf16_t*)(ws + WS_G1))
#define HIDA ((bf16_t*)(ws + WS_R1))
#define H3B ((bf16_t*)(ws + WS_R1))
#define R3 ((bf16_t*)(ws + WS_R3))
#define HIDS (R3 + (size_t)(64 - HID_SPLIT) * 256 * FF)
#define KVR ((bf16_t*)(ws + WS_KVR))
#define PLQ ((bf16_t*)(ws + WS_PLQ))
#define SSQ0 ((float*)(ws + WS_SSQ))
#define SSQ1 ((float*)(ws + WS_SSQ) + (size_t)M * 16)
#define DV ((float*)(ws + WS_DV))
#define H (out + O_Y)
#define UT ((bf16_t*)(out + O_Y))
    cg::grid_group grid = cg::this_grid();
    volatile LAS unsigned* bst = (volatile LAS unsigned*)(lds + LDS_BYTES - 64);
    if (tid < 2) bst[tid] = 0u;
    __syncthreads();
    XcdBarrier xbar; xbar.bar = nullptr; xbar.x = 0; xbar.st = bst;
#if !MK_SPLIT
    xbar = xcd_barrier_post((unsigned*)(ws + WS_CTL), bst);
#endif
    const int lo = KARG(ph_lo), hi = KARG(ph_hi);
#define IN(k) (lo <= (k) && (k) < hi)
#define SEAM(k) do { if (IN(k) && IN((k) + 1)) { if (MK_SPLIT) grid.sync(); else xcd_barrier(xbar); } } while (0)
    if (lo < 0) grid.sync();

    if (IN(0)) {
        LAS float* scr = (LAS float*)(lds + wave * 16384);
#define TJ_LIST_A(X) \
        X(w_in_a, IN_A_COLS, DM, 512, W_IN, norm_mix, 0.08838834764831845f)                                     \
        X(w_in_a + 512, IN_A_COLS, DM, 2560, W_IN + (size_t)512 * DM, norm_mix, 1.f)                            \
        X(w_up, FF, DM, FF, (bf16_t*)(ws + WS_W_UP0), norm_mlp, 1.f) \
        X(w_down, DM, FF, DM, (bf16_t*)(ws + WS_W_DN0), (const float*)nullptr, 1.f)
#define TJ_LIST_B(X) \
        X(w_out_a, DM, DM, DM, W_OUT, (const float*)nullptr, 1.f) \
        X(w_ple_gate, DM, DM, DM, (bf16_t*)(ws + WS_W_G0), norm_ple, 1.f) \
        X(w_ple, DM, PLE, DM, (bf16_t*)(ws + WS_W_P0), (const float*)nullptr, 1.f) \
        X(w_kv, 512, DM, 512, W_KVQ, norm_kv, 1.f) \
        X(w_q_b, DM, DM, DM, W_KVQ + (size_t)512 * DM, norm_mix + DM, 0.125f * LOG2E)                          \
        X(w_up + (size_t)DM * FF, FF, DM, FF, (bf16_t*)(ws + WS_W_UP1), norm_mlp + DM, 1.f)
#define TJ_LIST_C(X) \
        X(w_o_b, DM, DM, DM, W_O, (const float*)nullptr, 1.f) \
        X(w_ple_gate + (size_t)DM * DM, DM, DM, DM, (bf16_t*)(ws + WS_W_G1), norm_ple + DM, 1.f) \
        X(w_ple + (size_t)PLE * DM, DM, PLE, DM, (bf16_t*)(ws + WS_W_P1), (const float*)nullptr, 1.f) \
        X(w_down + (size_t)DM * FF, DM, FF, DM, (bf16_t*)(ws + WS_W_DN1), (const float*)nullptr, 1.f)
#define TJ_COUNT(WP, LDW, KK, NCOLS, DSTP, GAINP, SCALEV) + ((KK) / 64) * ((NCOLS) / 32)
#define TJ_DECODE(WP, LDW, KK, NCOLS, DSTP, GAINP, SCALEV) if (!done_ && r_ < ((KK) / 64) * ((NCOLS) / 32)) { jt_.src = (WP); jt_.ldw = (LDW); jt_.kk = (KK); jt_.nblk = (NCOLS) / 32; jt_.dst = (DSTP); jt_.gain = (GAINP); jt_.scale = (SCALEV); jt_.item = r_; done_ = true; } else if (!done_) r_ -= ((KK) / 64) * ((NCOLS) / 32);
#define TJ_GET(LIST, JOUT, it) do { int r_ = (it); bool done_ = false; TJob jt_; jt_.src = nullptr; jt_.ldw = 0; jt_.kk = 0; jt_.nblk = 1; jt_.dst = nullptr; jt_.gain = nullptr; jt_.scale = 1.f; jt_.item = 0; LIST(TJ_DECODE) JOUT = jt_; } while (0)
#define TJ_RUN(LIST, w_, nw_) do { constexpr int TOT_ = 0 LIST(TJ_COUNT); LAS float* scr_ = (LAS float*)(lds + wave * 16384); float ra_[32], rb_[32]; TJob Ja, Jb; int it = (w_); \
          if (it >= 0) { if (it < TOT_) { TJ_GET(LIST, Ja, it); p0_tload(Ja, ra_, lane); } \
          while (it < TOT_) { \
              const int it1 = it + (nw_); if (it1 < TOT_) { TJ_GET(LIST, Jb, it1); p0_tload(Jb, rb_, lane); } \
              p0_tfinish(Ja, ra_, scr_, lane); \
              if (it1 >= TOT_) break; \
              const int it2 = it1 + (nw_); if (it2 < TOT_) { TJ_GET(LIST, Ja, it2); p0_tload(Ja, ra_, lane); } \
              p0_tfinish(Jb, rb_, scr_, lane); \
              it = it2; } } } while (0)
        TJ_RUN(TJ_LIST_A, gw, NGW);
        for (int idx = bx * NTHREADS + tid; idx < 512 * 256; idx += G * NTHREADS) { const int n = idx >> 8, k4 = (idx & 255) * 4; float wa[16];
#pragma unroll
            for (int r = 0; r < 16; ++r) wa[r] = w_a2[r * 512 + n];
            f32x4 wr_[4][4];
#pragma unroll
            for (int kk = 0; kk < 4; ++kk)
#pragma unroll
                for (int q4 = 0; q4 < 4; ++q4) wr_[kk][q4] = *((const f32x4*)(w_in_a + (size_t)(k4 + kk) * IN_A_COLS + 3072) + q4);
            const f32x4 gn4 = *(const f32x4*)(norm_mix + k4);
            float o4[4];
#pragma unroll
            for (int kk = 0; kk < 4; ++kk) { float sacc = 0.f;
#pragma unroll
                for (int q4 = 0; q4 < 4; ++q4) sacc += (wr_[kk][q4].x * wa[4 * q4] + wr_[kk][q4].y * wa[4 * q4 + 1]) + (wr_[kk][q4].z * wa[4 * q4 + 2] + wr_[kk][q4].w * wa[4 * q4 + 3]);
                o4[kk] = sacc * gn4[kk]; }
            u32x2 o; o.x = pk2(o4[0], o4[1]); o.y = pk2(o4[2], o4[3]);
            *(u32x2*)(W_IN + (size_t)(3072 + n) * DM + k4) = o; }
        for (int grp = bx; grp < M / 64; grp += G)
#pragma unroll 1
          for (int half = 0; half < 2; ++half) { const int m0 = 64 * grp + 8 * wave + 4 * half; f32x4 v[4][4]; float s[4];
#pragma unroll
            for (int q = 0; q < 4; ++q) { const int m = m0 + q; const float* xr = m < MP ? x_prompt + (size_t)m * DM : x_sample + (size_t)(m - MP) * DM;
#pragma unroll
                for (int j = 0; j < 4; ++j) v[q][j] = __builtin_nontemporal_load((const f32x4*)xr + lane + 64 * j); }
#pragma unroll
            for (int q = 0; q < 4; ++q) { const int m = m0 + q; float ss = 0.f;
#pragma unroll
                for (int j = 0; j < 4; ++j) { ss += (v[q][j].x * v[q][j].x + v[q][j].y * v[q][j].y) + (v[q][j].z * v[q][j].z + v[q][j].w * v[q][j].w);
                    u32x2 w; w.x = pk2(v[q][j].x, v[q][j].y); w.y = pk2(v[q][j].z, v[q][j].w); *((u32x2*)(XB + (size_t)m * DM) + lane + 64 * j) = w; }
                s[q] = wave_sum(ss);
                if (lane < 4) *(f32x4*)(SSQ0 + ssq_idx(lane, m, 0)) = (f32x4){lane == 0 ? s[q] : 0.f, 0.f, 0.f, 0.f}; } }
        for (int m0 = gw * 8; m0 < M; m0 += NGW * 8) { f32x4 v[8];
#pragma unroll
            for (int q = 0; q < 8; ++q) { const int m = m0 + q; v[q] = *((const f32x4*)(m < MP ? p_prompt + (size_t)m * PLE : p_sample + (size_t)(m - MP) * PLE) + lane); }
#pragma unroll
            for (int q = 0; q < 8; ++q) { u32x2 w; w.x = pk2(v[q].x, v[q].y); w.y = pk2(v[q].z, v[q].w); *((u32x2*)(PB + (size_t)(m0 + q) * PLE) + lane) = w; } }
    }
    SEAM(0);
    if (IN(1)) { pg8::Gemm g{XB, XB, NPAN, W_IN, M, N_IN, DM}; pg8::StaticOrder S; S.init(M, N_IN, G, bx);
        pg8::EpiIn E{Q1, K1, V1, G1, KVR, SSQ0, b_a2}; pg8::gemm_phase(lds, g, S, E);
        { const int idle0 = (NPAN * (N_IN / 256)) % G;
          if (idle0 > 0 && G > idle0) TJ_RUN(TJ_LIST_B, bx >= idle0 ? (bx - idle0) * NWAVES + wave : -1, (G - idle0) * NWAVES); else TJ_RUN(TJ_LIST_B, gw, NGW); } }
    SEAM(1);
    if (IN(2)) {
        for (int base = bx * 2; base < SB * 4; base += G * 2) gla_sample_pair(lds, base, Q1, K1, V1, G1, KVR, state_gla, out + O_SS, gla_o_gain, R3, tid);
        gla_super_phase<false>(lds, G, bx, nullptr, K1, V1, nullptr, KVR, UT, DV, nullptr, nullptr, nullptr, tid, lane, wave);
    }
    SEAM(2);
    if (IN(3)) gla_scan<NSUP>(UT, DV, out + O_SP, bx * NTHREADS + tid, G * NTHREADS);
    SEAM(3);
    if (IN(4)) { gla_super_phase<true>(lds, G, bx, Q1, K1, V1, G1, KVR, UT, nullptr, gla_o_gain, R3, out + O_SP, tid, lane, wave); }
    SEAM(4);
    if (IN(5)) {
        { pg8::Gemm g{R3, R3, NPAN, W_OUT, MP, DM, DM}; pg8::StaticOrder S; S.init(MP, DM, G, bx); pg8::EpiRes<false> E{nullptr, nullptr, XB, XB, SSQ1, 1.f}; pg8::gemm_phase(lds, g, S, E); }
        { pg8::Gemm g{PB, PB, NPAN, (const bf16_t*)(ws + WS_W_P0), MP, DM, PLE}; pg8::StaticOrder S; S.init(MP, DM, G, bx); pg8::EpiPl E{PLQ}; pg8::gemm_phase(lds, g, S, E); }
        { mg::MRes<false> E{nullptr, XB, XB, SSQ1, 1.f}; mg::mini_gemm(lds, R3 + (size_t)MP * DM, W_OUT, DM, DM, G, bx, E); }
        { mg::MPl E{PLQ, nullptr}; mg::mini_gemm(lds, PB + (size_t)MP * PLE, (const bf16_t*)(ws + WS_W_P0), DM, PLE, G, bx, E); }
    }
    SEAM(5);
    if (IN(6)) { { pg8::Gemm g{XB, XB, NPAN, (const bf16_t*)(ws + WS_W_UP0), MP, FF, DM}; pg8::StaticOrder S; S.init(MP, FF, G, bx); pg8::EpiUp E{HIDA, R3, SSQ1}; pg8::gemm_phase(lds, g, S, E); }
        { mg::MUp E{HIDS, SSQ1, nullptr}; mg::mini_gemm(lds, XB + (size_t)MP * DM, (const bf16_t*)(ws + WS_W_UP0), FF, DM, G, bx, E); } }
    SEAM(6);
    if (IN(7)) { { pg8::Gemm g{HIDA, R3, HID_SPLIT, (const bf16_t*)(ws + WS_W_DN0), MP, DM, FF}; pg8::StaticOrder S; S.init(MP, DM, G, bx); pg8::EpiRes<false> E{nullptr, nullptr, XB, XB, SSQ0, 1.f}; pg8::gemm_phase(lds, g, S, E); }
        { mg::MRes<false> E{nullptr, XB, XB, SSQ0, 1.f}; mg::mini_gemm(lds, HIDS, (const bf16_t*)(ws + WS_W_DN0), DM, FF, G, bx, E); } }
    SEAM(7);
    if (IN(8)) { { pg8::Gemm g{XB, XB, NPAN, (const bf16_t*)(ws + WS_W_G0), MP, DM, DM}; pg8::StaticOrder S; S.init(MP, DM, G, bx); pg8::EpiGate<false> E{nullptr, XB, PLQ, H3B, SSQ0, SSQ1, 1.f}; pg8::gemm_phase(lds, g, S, E); }
        { mg::MGate<false> E{nullptr, XB, PLQ, H3B, SSQ0, SSQ1, 1.f}; mg::mini_gemm(lds, XB + (size_t)MP * DM, (const bf16_t*)(ws + WS_W_G0), DM, DM, G, bx, E); } }
    SEAM(8);
    if (IN(9)) { pg8::Gemm g{H3B, H3B, NPAN, W_KVQ, M, NKVQ, DM}; pg8::StaticOrder S; S.init(M, NKVQ, G, bx);
        pg8::EpiKvq E{KVR, PLQ, SSQ1, out + O_CKP, out + O_CVP, out + O_CKS, out + O_CVS}; pg8::gemm_phase(lds, g, S, E);
        { const int idle0 = (NPAN * (NKVQ / 256)) % G;
          if (idle0 > 0 && G > idle0) TJ_RUN(TJ_LIST_C, bx >= idle0 ? (bx - idle0) * NWAVES + wave : -1, (G - idle0) * NWAVES); else TJ_RUN(TJ_LIST_C, gw, NGW); } }
    SEAM(9);
    if (IN(10)) {
        const AttnP AP{KVR, PLQ, R3, cache_k, cache_v, out + O_CKS, out + O_CVS, sinks, rel_bias};
        { AttnRegs AR; int buf = 0;
          if (bx < 1024) { attn_load(bx, AP, AR, tid); attn_stage(lds, bx, AP, AR, tid); }
          LDS_BAR();
          for (int it = bx; it < 1024; it += G) { const int nx = it + G;
              if (nx < 1024) attn_load(nx, AP, AR, tid);
              attn_compute(lds + buf * ATT_BUF, it, AP, lane, wave);
              if (nx < 1024) attn_stage(lds + (buf ^ 1) * ATT_BUF, nx, AP, AR, tid);
              LDS_BAR(); buf ^= 1; } }
        for (int m0 = gw * 8; m0 < M; m0 += NGW * 8) { f32x4 v[8];
#pragma unroll
            for (int q = 0; q < 8; ++q) { const int m = m0 + q; v[q] = *((const f32x4*)(m < MP ? p_prompt + (size_t)(MP + m) * PLE : p_sample + (size_t)(MS + m - MP) * PLE) + lane); }
#pragma unroll
            for (int q = 0; q < 8; ++q) { u32x2 w; w.x = pk2(v[q].x, v[q].y); w.y = pk2(v[q].z, v[q].w); *((u32x2*)(PB + (size_t)(m0 + q) * PLE) + lane) = w; } }
    }
    SEAM(10);
    if (IN(11)) {
        { pg8::Gemm g{R3, R3, NPAN, W_O, MP, DM, DM}; pg8::StaticOrder S; S.init(MP, DM, G, bx); pg8::EpiRes<false> E{nullptr, nullptr, H3B, XB, SSQ0, 1.f}; pg8::gemm_phase(lds, g, S, E); }
        { pg8::Gemm g{PB, PB, NPAN, (const bf16_t*)(ws + WS_W_P1), MP, DM, PLE}; pg8::StaticOrder S; S.init(MP, DM, G, bx); pg8::EpiPl E{PLQ}; pg8::gemm_phase(lds, g, S, E); }
        { mg::MRes<false> E{nullptr, H3B, XB, SSQ0, 1.f}; mg::mini_gemm(lds, R3 + (size_t)MP * DM, W_O, DM, DM, G, bx, E); }
        { mg::MPl E{PLQ, nullptr}; mg::mini_gemm(lds, PB + (size_t)MP * PLE, (const bf16_t*)(ws + WS_W_P1), DM, PLE, G, bx, E); }
    }
    SEAM(11);
    if (IN(12)) { { pg8::Gemm g{XB, XB, NPAN, (const bf16_t*)(ws + WS_W_UP1), MP, FF, DM}; pg8::StaticOrder S; S.init(MP, FF, G, bx); pg8::EpiUp E{HIDA, R3, SSQ0}; pg8::gemm_phase(lds, g, S, E); }
        { mg::MUp E{HIDS, SSQ0, nullptr}; mg::mini_gemm(lds, XB + (size_t)MP * DM, (const bf16_t*)(ws + WS_W_UP1), FF, DM, G, bx, E); } }
    SEAM(12);
    if (IN(13)) { { pg8::Gemm g{HIDA, R3, HID_SPLIT, (const bf16_t*)(ws + WS_W_DN1), MP, DM, FF}; pg8::StaticOrder S; S.init(MP, DM, G, bx); pg8::EpiRes<false> E{nullptr, nullptr, XB, XB, SSQ1, 1.f}; pg8::gemm_phase(lds, g, S, E); }
        { mg::MRes<false> E{nullptr, XB, XB, SSQ1, 1.f}; mg::mini_gemm(lds, HIDS, (const bf16_t*)(ws + WS_W_DN1), DM, FF, G, bx, E); } }
    SEAM(13);
    if (IN(14)) { { pg8::Gemm g{XB, XB, NPAN, (const bf16_t*)(ws + WS_W_G1), MP, DM, DM}; pg8::StaticOrder S; S.init(MP, DM, G, bx); pg8::EpiGate<false> E{nullptr, XB, PLQ, H3B, SSQ1, SSQ0, 1.f}; pg8::gemm_phase(lds, g, S, E); }
        { mg::MGate<false> E{nullptr, XB, PLQ, H3B, SSQ1, SSQ0, 1.f}; mg::mini_gemm(lds, XB + (size_t)MP * DM, (const bf16_t*)(ws + WS_W_G1), DM, DM, G, bx, E); } }
    SEAM(14);
    if (IN(15)) {
        f32x4 gn[4];
#pragma unroll
        for (int j = 0; j < 4; ++j) gn[j] = *((const f32x4*)norm_final + lane + 64 * j);
        for (int m0 = gw * 4; m0 < M; m0 += NGW * 4) { u32x2 w[4][4]; float r[4];
#pragma unroll
            for (int q = 0; q < 4; ++q) { r[q] = row_r(SSQ0, m0 + q);
#pragma unroll
                for (int j = 0; j < 4; ++j) w[q][j] = *((const u32x2*)(H3B + (size_t)(m0 + q) * DM) + lane + 64 * j); }
#pragma unroll
            for (int q = 0; q < 4; ++q)
#pragma unroll
                for (int j = 0; j < 4; ++j) { const f32x4 v = {bflo(w[q][j].x), bfhi(w[q][j].x), bflo(w[q][j].y), bfhi(w[q][j].y)};
                    __builtin_nontemporal_store(v * r[q] * gn[j], (f32x4*)(H + (size_t)(m0 + q) * DM) + lane + 64 * j); } }
    }
#undef IN
#undef SEAM
}
#undef ws
#undef out
#undef x_prompt
#undef x_sample
#undef state_gla
#undef cache_k
#undef cache_v
#undef p_prompt
#undef p_sample
#undef norm_mix
#undef norm_mlp
#undef norm_ple
#undef norm_kv
#undef norm_final
#undef w_in_a
#undef w_a2
#undef b_a2
#undef gla_o_gain
#undef w_out_a
#undef w_kv
#undef w_q_b
#undef w_o_b
#undef sinks
#undef rel_bias
#undef w_up
#undef w_down
#undef w_ple
#undef w_ple_gate
#undef W_IN
#undef W_OUT
#undef W_KVQ
#undef W_O
#undef XB
#undef PB
#undef Q1
#undef K1
#undef V1
#undef G1
#undef HIDA
#undef H3B
#undef R3
#undef HIDS
#undef KVR
#undef PLQ
#undef SSQ0
#undef SSQ1
#undef DV
#undef H
#undef UT
#undef KARG

extern "C" void kernel_launch(void* const* d_in, const int* in_sizes, int n_in, void* d_out, int out_size, void* d_ws, size_t ws_size, hipStream_t stream) {
    static int grid = 0;
    if (grid == 0) {
        if (n_in != 26 || (size_t)out_size != O_END || ws_size < WS_END) { fprintf(stderr, "kernel_launch: unexpected shapes (n_in %d out %d ws %zu need %zu)\n", n_in, out_size, ws_size, (size_t)WS_END); grid = -1; return; }
        int dev = 0, cus = 0, per_cu = 0;
        hipGetDevice(&dev); hipDeviceGetAttribute(&cus, hipDeviceAttributeMultiprocessorCount, dev);
        hipFuncSetAttribute((const void*)yoco_fwd, hipFuncAttributeMaxDynamicSharedMemorySize, LDS_BYTES);
        hipOccupancyMaxActiveBlocksPerMultiprocessor(&per_cu, (const void*)yoco_fwd, NTHREADS, LDS_BYTES);
        if (per_cu < 1) { fprintf(stderr, "kernel_launch: occupancy query says %d blocks per CU\n", per_cu); per_cu = 1; }
        (void)hipGetLastError();
        grid = cus * 1;
    }
    if (grid < 0) return;
    if (hipMemsetAsync((char*)d_ws + WS_CTL, 0, 65536, stream) != hipSuccess) { fprintf(stderr, "kernel_launch: memset failed\n"); return; }
    Args a{};
    for (int i = 0; i < 26; ++i) a.in[i] = (const float*)d_in[i];
    a.out = (float*)d_out; a.ws = (unsigned char*)d_ws;
#if MK_SPLIT
    for (int ph = 0; ph < 16; ++ph) { a.ph_lo = ph; a.ph_hi = ph + 1; hipLaunchKernelGGL(yoco_fwd, dim3(grid), dim3(NTHREADS), LDS_BYTES, stream, a); }
#else
    a.ph_lo = 0; a.ph_hi = 16;
    void* kargs[] = {&a};
    hipError_t e = hipLaunchCooperativeKernel((const void*)yoco_fwd, dim3(grid), dim3(NTHREADS), kargs, LDS_BYTES, stream);
    if (e != hipSuccess) fprintf(stderr, "cooperative launch failed: %s (grid %d)\n", hipGetErrorString(e), grid);
#endif
}
```

```cpp
#include <hip/hip_runtime.h>
#include <hip/hip_cooperative_groups.h>
#include <cstdio>
#include <cstdint>
namespace cg = cooperative_groups;

#define LAS __attribute__((address_space(3)))
#define GAS __attribute__((address_space(1)))
typedef unsigned short bf16_t;
typedef short bf16x8 __attribute__((ext_vector_type(8)));
typedef short s16x4 __attribute__((ext_vector_type(4)));
typedef float f32x4 __attribute__((ext_vector_type(4)));
typedef float f32x2 __attribute__((ext_vector_type(2)));
typedef unsigned u32x4 __attribute__((ext_vector_type(4)));
typedef unsigned u32x2 __attribute__((ext_vector_type(2)));

#ifndef MK_SPLIT
#define MK_SPLIT 0
#endif

constexpr int DM = 1024, SEQ = 8192, NBATCH = 2, MP = NBATCH * SEQ, SB = 128, SS = 8, MS = SB * SS, M = MP + MS, NPAN = M / 256;
constexpr int NQK = 512, NV = 1024, N_IN = 3584, FF = 4096, PLE = 256, NKVQ = 1536, IN_A_COLS = 3088;
constexpr int NCHUNK = 128, NBH = 8, NCH_ALL = NBH * NCHUNK;
constexpr float EPS = 1e-6f, LOG2E = 1.4426950408889634f;
constexpr int HID_SPLIT = 51;

constexpr size_t O_Y = 0, O_SP = (size_t)M * DM, O_SS = O_SP + 262144, O_CKP = O_SS + 16777216, O_CVP = O_CKP + 65536, O_CKS = O_CVP + 65536, O_CVS = O_CKS + 4194304, O_END = O_CVS + 4194304;

constexpr size_t al256(size_t x) { return (x + 255) & ~(size_t)255; }
constexpr size_t WS_CTL = 0, CTL_BYTES = 1u << 20;
constexpr size_t WS_W_IN = CTL_BYTES;
constexpr size_t WS_W_OUT = WS_W_IN + (size_t)N_IN * DM * 2;
constexpr size_t WS_W_UP0 = WS_W_OUT + (size_t)DM * DM * 2;
constexpr size_t WS_W_DN0 = WS_W_UP0 + (size_t)FF * DM * 2;
constexpr size_t WS_W_UP1 = WS_W_DN0 + (size_t)FF * DM * 2;
constexpr size_t WS_W_DN1 = WS_W_UP1 + (size_t)FF * DM * 2;
constexpr size_t WS_W_G0 = WS_W_DN1 + (size_t)FF * DM * 2;
constexpr size_t WS_W_G1 = WS_W_G0 + (size_t)DM * DM * 2;
constexpr size_t WS_W_P0 = WS_W_G1 + (size_t)DM * DM * 2;
constexpr size_t WS_W_P1 = WS_W_P0 + (size_t)DM * PLE * 2;
constexpr size_t WS_W_KVQ = WS_W_P1 + (size_t)DM * PLE * 2;
constexpr size_t WS_W_O = WS_W_KVQ + (size_t)NKVQ * DM * 2;
constexpr size_t WS_XB = WS_W_O + (size_t)DM * DM * 2;
constexpr size_t WS_PB = WS_XB + (size_t)M * DM * 2;
constexpr size_t WS_R1 = WS_PB + (size_t)M * PLE * 2;
constexpr size_t R1_BYTES = (size_t)HID_SPLIT * 256 * FF * 2;
constexpr size_t WS_Q1 = WS_R1, WS_K1 = WS_Q1 + (size_t)M * NQK * 2, WS_V1 = WS_K1 + (size_t)M * NQK * 2, WS_G1 = WS_V1 + (size_t)M * NV * 2;
static_assert(WS_G1 + (size_t)M * NV * 2 == WS_R1 + R1_BYTES, "R1 map");
constexpr size_t WS_R3 = WS_R1 + R1_BYTES;
static_assert((size_t)(NPAN - HID_SPLIT) * 256 * FF * 2 == (size_t)M * DM * 2, "R3 map");
constexpr size_t WS_KVR = WS_R3 + (size_t)M * DM * 2;
constexpr size_t WS_PLQ = WS_KVR + (size_t)M * NQK * 2;
constexpr size_t WS_SSQ = WS_PLQ + (size_t)M * DM * 2;
constexpr size_t WS_DV = WS_SSQ + (size_t)2 * M * 16 * 4;
constexpr size_t WS_END = WS_DV + (size_t)NCH_ALL * 128 * 4;

__device__ __forceinline__ float bf2f(unsigned short b) { return __uint_as_float((unsigned)b << 16); }
__device__ __forceinline__ float bflo(unsigned w) { return __uint_as_float(w << 16); }
__device__ __forceinline__ float bfhi(unsigned w) { return __uint_as_float(w & 0xffff0000u); }
typedef __bf16 bf16x2_t __attribute__((ext_vector_type(2)));
__device__ __forceinline__ unsigned pk2(float lo, float hi) { const f32x2 v = {lo, hi}; const bf16x2_t b = __builtin_convertvector(v, bf16x2_t); return __builtin_bit_cast(unsigned, b); }
__device__ __forceinline__ float fexp(float x) { return __builtin_amdgcn_exp2f(x * LOG2E); }
__device__ __forceinline__ float frcp(float x) { return __builtin_amdgcn_rcpf(x); }
__device__ __forceinline__ float frsq(float x) { return __builtin_amdgcn_rsqf(x); }
__device__ __forceinline__ float fsigmoid(float x) { return frcp(1.f + fexp(-x)); }
__device__ __forceinline__ float logsig(float x) { return fminf(x, 0.f) - __logf(1.f + fexp(-fabsf(x))); }
__device__ __forceinline__ s16x4 trd(const LAS bf16_t* p) { return __builtin_bit_cast(s16x4, __builtin_amdgcn_ds_read_tr16_b64_v4i16((LAS s16x4*)p)); }
__device__ __forceinline__ bf16x8 cat8(s16x4 lo, s16x4 hi) { return (bf16x8){lo[0], lo[1], lo[2], lo[3], hi[0], hi[1], hi[2], hi[3]}; }
__device__ __forceinline__ void st_wt(float* p, float v) { __hip_atomic_store(p, v, __ATOMIC_RELAXED, __HIP_MEMORY_SCOPE_AGENT); }
__device__ __forceinline__ void st16_wt(void* p, u32x4 v) { asm volatile("global_store_dwordx4 %0, %1, off sc1\n\ts_nop 1" :: "v"(p), "v"(v) : "memory"); }
__device__ __forceinline__ float wave_sum(float v) {
#pragma unroll
    for (int o = 1; o < 64; o <<= 1) v += __shfl_xor(v, o);
    return v;
}
__device__ __forceinline__ size_t ssq_idx(int pn, int row, int wc) { return ((size_t)pn * M + row) * 4 + wc; }
__device__ __forceinline__ float row_r(const float* ssq, int row) {
    const f32x4 a = *(const f32x4*)(ssq + ssq_idx(0, row, 0)), b = *(const f32x4*)(ssq + ssq_idx(1, row, 0)), c = *(const f32x4*)(ssq + ssq_idx(2, row, 0)), d = *(const f32x4*)(ssq + ssq_idx(3, row, 0));
    const f32x4 s = (a + b) + (c + d);
    return frsq(((s.x + s.y) + (s.z + s.w)) * (1.f / 1024.f) + EPS);
}

namespace pg8 {
constexpr int BM = 256, BK = 64, HALF = 128, HTB = HALF * BK * 2, STAGE_BYTES = 8 * HTB, NXCD = 8, WGM = 8;
__host__ __device__ __forceinline__ int lds_byte(int r, int c) { const int st = (r >> 4) * 2 + (c >> 5), rr = r & 15, cc = c & 31, ob = rr * 64 + cc * 2; return st * 1024 + (ob ^ (((ob >> 9) & 1) << 5)); }
__host__ __device__ __forceinline__ void stage_rc(int b, int& R, int& C) { const int st = b / 1024, sb = b % 1024, swz = sb ^ (((sb >> 9) & 1) << 5); R = (st >> 1) * 16 + swz / 64; C = (st & 1) * 32 + (swz % 64) / 2; }
__host__ __device__ __forceinline__ int perm32(int rho) { const int n = rho >> 4, i = rho & 15; return 8 * (i >> 2) + 4 * n + (i & 3); }
struct Unit { int pm, pn; };
struct Gemm { const bf16_t* A; const bf16_t* A2; int split; const bf16_t* Bt; int M, N, K; };
struct StaticOrder {
    int nM, nN, nwg, G, c;
    __device__ void init(int M_, int N, int G_, int c_) { nM = M_ / BM; nN = N / BM; nwg = nM * nN; G = G_; c = c_; }
    __device__ bool next(int i, Unit& u) const {
        const long L = (long)i * G + c; if (L >= nwg) return false;
        int wgid = (int)L; { const int q = nwg / NXCD, r = nwg % NXCD, xcd = wgid % NXCD, off = wgid / NXCD; wgid = (xcd < r ? xcd * (q + 1) : r * (q + 1) + (xcd - r) * q) + off; }
        const int nig = WGM * nN, gid = wgid / nig, fm = gid * WGM, gsz = (nM - fm) < WGM ? (nM - fm) : WGM;
        u.pm = fm + ((wgid % nig) % gsz); u.pn = (wgid % nig) / gsz; return true;
    }
};

template <class Epi>
__device__ __forceinline__ void gemm_phase(LAS unsigned char* lds, const Gemm g, const StaticOrder& S, const Epi& E) {
    const int tid = threadIdx.x, wid = __builtin_amdgcn_readfirstlane(tid >> 6), lane = tid & 63, wr = wid >> 2, wc = wid & 3, fr = lane & 15, fq = lane >> 4;
    const int K = g.K, nt = K / BK;
    unsigned voffA[2], voffB[2];
#pragma unroll
    for (int i = 0; i < 2; ++i) { int R, C; stage_rc(tid * 16 + i * 8192, R, C); const int Rb = (R & ~31) + perm32(R & 31);
        voffA[i] = (unsigned)(R * K + C) * 2u; voffB[i] = (unsigned)(Rb * K + C) * 2u; }
    const size_t kstep = (size_t)(BK * 2);
    const size_t hstep = (size_t)HALF * K * 2;
    const size_t tstep = 2 * hstep;
    const unsigned ldsw = (unsigned)wid * 1024u;
    const int aoff = lds_byte(wr * 64 + fr, fq * 8), boff = lds_byte(wc * 32 + fr, fq * 8);
#define PG8_APTR(pm) ((pm) < g.split ? (const char*)g.A + (size_t)(pm) * tstep : (const char*)g.A2 + (size_t)((pm) - g.split) * tstep)
#define PG8_SA(b, h) (((b) * 2 + (h)) * HTB)
#define PG8_SB(b, h) ((4 + (b) * 2 + (h)) * HTB)
#define PG8_STAGE(bufoff, gbase, voff) do { _Pragma("unroll") for (int _i = 0; _i < 2; ++_i) \
        __builtin_amdgcn_global_load_lds((const unsigned*)((const char*)(gbase) + (voff)[_i]), (LAS unsigned*)(lds + (bufoff) + ldsw + _i * 8192), 16, 0, 0); } while (0)
#define PG8_LDA(dst, b, h) do { _Pragma("unroll") for (int m = 0; m < 4; ++m) _Pragma("unroll") for (int k = 0; k < 2; ++k) dst[m][k] = *(const LAS bf16x8*)(lds + PG8_SA(b, h) + aoff + m * 2048 + k * 1024); } while (0)
#define PG8_LDB(dst, b, h) do { _Pragma("unroll") for (int n = 0; n < 2; ++n) _Pragma("unroll") for (int k = 0; k < 2; ++k) dst[n][k] = *(const LAS bf16x8*)(lds + PG8_SB(b, h) + boff + n * 2048 + k * 1024); } while (0)
#define PG8_MMA(ai, bj, At, Bt) do { __builtin_amdgcn_s_setprio(1); _Pragma("unroll") for (int m = 0; m < 4; ++m) _Pragma("unroll") for (int n = 0; n < 2; ++n) _Pragma("unroll") for (int k = 0; k < 2; ++k) \
        acc[ai][bj][m][n] = __builtin_amdgcn_mfma_f32_16x16x32_bf16(Bt[n][k], At[m][k], acc[ai][bj][m][n], 0, 0, 0); __builtin_amdgcn_s_setprio(0); } while (0)
#define PG8_WAIT_V(n) asm volatile("s_waitcnt vmcnt(" #n ")" ::: "memory")
#define PG8_WAIT_L(n) asm volatile("s_waitcnt lgkmcnt(" #n ")" ::: "memory")
#define PG8_BAR __builtin_amdgcn_s_barrier()
#define PG8_SCHED __builtin_amdgcn_sched_barrier(0)
    Unit cur, nxt; int ui = 0;
    if (!S.next(0, cur)) return;
    LAS float* rtab_all = (LAS float*)(lds + STAGE_BYTES);
    if (E.rsrc() != nullptr) { Unit uu; for (int i = 0; i < 8 && S.next(i, uu); ++i) if (tid < 256) rtab_all[i * 256 + tid] = row_r(E.rsrc(), uu.pm * BM + tid); }
    f32x4 acc[2][2][4][2];
#pragma unroll
    for (int a = 0; a < 2; ++a)
#pragma unroll
        for (int b = 0; b < 2; ++b)
#pragma unroll
            for (int m = 0; m < 4; ++m)
#pragma unroll
                for (int n = 0; n < 2; ++n) acc[a][b][m][n] = (f32x4){0.f, 0.f, 0.f, 0.f};
    bf16x8 At[4][2], B0[2][2], B1[2][2];
    const char* cA = PG8_APTR(cur.pm); const char* cB = (const char*)g.Bt + (size_t)cur.pn * tstep;
    PG8_STAGE(PG8_SB(0, 0), cB, voffB); PG8_STAGE(PG8_SB(0, 1), cB + hstep, voffB); PG8_STAGE(PG8_SA(0, 0), cA, voffA); PG8_STAGE(PG8_SA(0, 1), cA + hstep, voffA);
    PG8_WAIT_L(0);
    if (wr == 1) PG8_BAR;
    PG8_WAIT_V(2); PG8_BAR;
    PG8_STAGE(PG8_SB(1, 0), cB + kstep, voffB); PG8_STAGE(PG8_SA(1, 0), cA + kstep, voffA); PG8_STAGE(PG8_SB(1, 1), cB + hstep + kstep, voffB);
    PG8_WAIT_V(6); PG8_BAR;
    for (;;) {
        const bool has_next = S.next(ui + 1, nxt);
        const char* nA = has_next ? PG8_APTR(nxt.pm) : cA; const char* nB = has_next ? (const char*)g.Bt + (size_t)nxt.pn * tstep : cB;
#pragma clang loop unroll(disable)
        for (int t = 0; t < nt; t += 2) {
            const bool last = (t == nt - 2);
            const char* a1 = cA + (size_t)(t + 1) * kstep;
            const char* a2 = last ? nA : cA + (size_t)(t + 2) * kstep; const char* b2 = last ? nB : cB + (size_t)(t + 2) * kstep;
            const char* a3 = a2 + kstep; const char* b3 = b2 + kstep;
            PG8_LDB(B0, 0, 0); PG8_LDB(B1, 0, 1); PG8_SCHED; PG8_LDA(At, 0, 0); PG8_STAGE(PG8_SA(1, 1), a1 + hstep, voffA);
            PG8_WAIT_V(8); PG8_WAIT_L(0); PG8_BAR; PG8_MMA(0, 0, At, B0); PG8_MMA(0, 1, At, B1); PG8_BAR; PG8_SCHED;
            PG8_LDA(At, 0, 1); PG8_STAGE(PG8_SB(0, 0), b2, voffB); PG8_STAGE(PG8_SB(0, 1), b2 + hstep, voffB); PG8_STAGE(PG8_SA(0, 0), a2, voffA);
            PG8_WAIT_V(8); PG8_WAIT_L(0); PG8_BAR; PG8_MMA(1, 0, At, B0); PG8_MMA(1, 1, At, B1); PG8_BAR; PG8_SCHED;
            PG8_LDB(B0, 1, 0); PG8_LDB(B1, 1, 1); PG8_SCHED; PG8_LDA(At, 1, 0); PG8_STAGE(PG8_SA(0, 1), a2 + hstep, voffA);
            PG8_WAIT_V(8); PG8_WAIT_L(0); PG8_BAR; PG8_MMA(0, 0, At, B0); PG8_MMA(0, 1, At, B1); PG8_BAR; PG8_SCHED;
            PG8_LDA(At, 1, 1); PG8_STAGE(PG8_SB(1, 0), b3, voffB); PG8_STAGE(PG8_SB(1, 1), b3 + hstep, voffB); PG8_STAGE(PG8_SA(1, 0), a3, voffA);
            PG8_WAIT_V(8); PG8_WAIT_L(0); PG8_BAR; PG8_MMA(1, 0, At, B0); PG8_MMA(1, 1, At, B1); PG8_BAR; PG8_SCHED;
        }
        if (wr == 0) PG8_BAR;
        { int efr = fr, efq = fq, etid = tid; asm volatile("" : "+v"(efr), "+v"(efq), "+v"(etid));
          E(acc, cur, wr, wc, efr, efq, rtab_all + (ui & 7) * 256, etid); }
        if (!has_next) break;
#pragma unroll
        for (int a = 0; a < 2; ++a)
#pragma unroll
            for (int b = 0; b < 2; ++b)
#pragma unroll
                for (int m = 0; m < 4; ++m)
#pragma unroll
                    for (int n = 0; n < 2; ++n) acc[a][b][m][n] = (f32x4){0.f, 0.f, 0.f, 0.f};
        cur = nxt; cA = nA; cB = nB; ++ui;
        if (wr == 1) PG8_BAR;
    }
    PG8_WAIT_V(0);
    PG8_BAR;
#undef PG8_APTR
#undef PG8_SA
#undef PG8_SB
#undef PG8_STAGE
#undef PG8_LDA
#undef PG8_LDB
#undef PG8_MMA
#undef PG8_WAIT_V
#undef PG8_WAIT_L
#undef PG8_BAR
#undef PG8_SCHED
}

#define EPI_ROWLOOP _Pragma("unroll") for (int ai = 0; ai < 2; ++ai) _Pragma("unroll") for (int m = 0; m < 4; ++m)
__device__ __forceinline__ u32x4 pack8(const f32x4 v0, const f32x4 v1) { u32x4 w; w.x = pk2(v0[0], v0[1]); w.y = pk2(v0[2], v0[3]); w.z = pk2(v1[0], v1[1]); w.w = pk2(v1[2], v1[3]); return w; }

struct EpiIn {
    bf16_t *Q, *Kk, *V, *G, *LG; const float* ssq; const float* b_a2;
    __device__ __forceinline__ const float* rsrc() const { return ssq; }
    __device__ __forceinline__ void operator()(const f32x4 (&acc)[2][2][4][2], const Unit& u, int wr, int wc, int fr, int fq, LAS float* rtab, int tid) const {
        const int pn = u.pn; bf16_t* base; int ld, c0;
        if (pn < 2) { base = Q; ld = NQK; c0 = pn * 256; } else if (pn < 4) { base = Kk; ld = NQK; c0 = (pn - 2) * 256; }
        else if (pn < 8) { base = V; ld = NV; c0 = (pn - 4) * 256; } else if (pn < 12) { base = G; ld = NV; c0 = (pn - 8) * 256; }
        else { base = LG; ld = NQK; c0 = (pn - 12) * 256; }
        const bool is_lg = pn >= 12;
        const int col = c0 + wc * 32 + 8 * fq;
        f32x4 bb[2][2];
#pragma unroll
        for (int bj = 0; bj < 2; ++bj)
#pragma unroll
            for (int n = 0; n < 2; ++n) bb[bj][n] = is_lg ? *(const f32x4*)(b_a2 + col + bj * HALF + 4 * n) : (f32x4){0.f, 0.f, 0.f, 0.f};
        EPI_ROWLOOP { const int lr = ai * HALF + wr * 64 + m * 16 + fr, row = u.pm * BM + lr; const float r = rtab[lr];
#pragma unroll
            for (int bj = 0; bj < 2; ++bj) { f32x4 v0 = acc[ai][bj][m][0] * r, v1 = acc[ai][bj][m][1] * r;
                if (is_lg) { v0 += bb[bj][0]; v1 += bb[bj][1];
#pragma unroll
                    for (int e = 0; e < 4; ++e) { v0[e] = logsig(v0[e]) * (1.f / 16.f); v1[e] = logsig(v1[e]) * (1.f / 16.f); } }
                *(u32x4*)(base + (size_t)row * ld + col + bj * HALF) = pack8(v0, v1); } }
    }
};
template <bool FROM_X> struct EpiRes {
    const float* X0; const float* X1; const bf16_t* BB; bf16_t* XO; float* ssq_out; float sc;
    __device__ __forceinline__ const float* rsrc() const { return nullptr; }
    __device__ __forceinline__ void operator()(const f32x4 (&acc)[2][2][4][2], const Unit& u, int wr, int wc, int fr, int fq, LAS float* rtab, int tid) const {
        const int col = u.pn * BM + wc * 32 + 8 * fq;
#pragma unroll
        for (int ai = 0; ai < 2; ++ai) {
            f32x4 b0[4][2], b1[4][2]; u32x4 bw[4][2];
#pragma unroll
            for (int m = 0; m < 4; ++m) { const int row = u.pm * BM + ai * HALF + wr * 64 + m * 16 + fr;
#pragma unroll
                for (int bj = 0; bj < 2; ++bj) {
                    if (FROM_X) { const float* src = (u.pm < MP / 256 ? X0 + (size_t)row * DM : X1 + (size_t)(row - MP) * DM) + col + bj * HALF; b0[m][bj] = *(const f32x4*)src; b1[m][bj] = *(const f32x4*)(src + 4); }
                    else bw[m][bj] = *(const u32x4*)(BB + (size_t)row * DM + col + bj * HALF); } }
            if (!FROM_X) asm volatile("" ::: "memory");
#pragma unroll
            for (int m = 0; m < 4; ++m) { const int row = u.pm * BM + ai * HALF + wr * 64 + m * 16 + fr; float s = 0.f;
#pragma unroll
                for (int bj = 0; bj < 2; ++bj) {
                    if (!FROM_X) { const u32x4 w = bw[m][bj]; b0[m][bj] = (f32x4){bflo(w.x), bfhi(w.x), bflo(w.y), bfhi(w.y)}; b1[m][bj] = (f32x4){bflo(w.z), bfhi(w.z), bflo(w.w), bfhi(w.w)}; }
                    const f32x4 v0 = acc[ai][bj][m][0] * sc + b0[m][bj], v1 = acc[ai][bj][m][1] * sc + b1[m][bj];
                    *(u32x4*)(XO + (size_t)row * DM + col + bj * HALF) = pack8(v0, v1);
                    s += (v0[0] * v0[0] + v0[1] * v0[1]) + (v0[2] * v0[2] + v0[3] * v0[3]) + (v1[0] * v1[0] + v1[1] * v1[1]) + (v1[2] * v1[2] + v1[3] * v1[3]); }
                s += __shfl_xor(s, 16); s += __shfl_xor(s, 32);
                if (fq == 0) ssq_out[ssq_idx(u.pn, row, wc)] = s; }
        }
    }
};
struct EpiUp {
    bf16_t* HA; bf16_t* HB; const float* ssq;
    __device__ __forceinline__ const float* rsrc() const { return ssq; }
    __device__ __forceinline__ void operator()(const f32x4 (&acc)[2][2][4][2], const Unit& u, int wr, int wc, int fr, int fq, LAS float* rtab, int tid) const {
        bf16_t* base = u.pm < HID_SPLIT ? HA + (size_t)u.pm * 256 * FF : HB + (size_t)(u.pm - HID_SPLIT) * 256 * FF;
        const int col = u.pn * BM + wc * 32 + 8 * fq;
        EPI_ROWLOOP { const int lr = ai * HALF + wr * 64 + m * 16 + fr; const float r = rtab[lr];
#pragma unroll
            for (int bj = 0; bj < 2; ++bj) { f32x4 v0 = acc[ai][bj][m][0] * r, v1 = acc[ai][bj][m][1] * r;
#pragma unroll
                for (int e = 0; e < 4; ++e) { const float a = fmaxf(v0[e], 0.f), b = fmaxf(v1[e], 0.f); v0[e] = a * a; v1[e] = b * b; }
                st16_wt(base + (size_t)lr * FF + col + bj * HALF, pack8(v0, v1)); } }
    }
};
struct EpiPl {
    bf16_t* PL;
    __device__ __forceinline__ const float* rsrc() const { return nullptr; }
    __device__ __forceinline__ void operator()(const f32x4 (&acc)[2][2][4][2], const Unit& u, int wr, int wc, int fr, int fq, LAS float* rtab, int tid) const {
        const int col = u.pn * BM + wc * 32 + 8 * fq;
        EPI_ROWLOOP { const int row = u.pm * BM + ai * HALF + wr * 64 + m * 16 + fr;
#pragma unroll
            for (int bj = 0; bj < 2; ++bj) *(u32x4*)(PL + (size_t)row * DM + col + bj * HALF) = pack8(acc[ai][bj][m][0], acc[ai][bj][m][1]); }
    }
};
template <bool LAST> struct EpiGate {
    float* HO; const bf16_t* BB; const bf16_t* PL; bf16_t* OB; const float* ssq_in; float* ssq_out; float sc;
    __device__ __forceinline__ const float* rsrc() const { return ssq_in; }
    __device__ __forceinline__ void operator()(const f32x4 (&acc)[2][2][4][2], const Unit& u, int wr, int wc, int fr, int fq, LAS float* rtab, int tid) const {
        const int col = u.pn * BM + wc * 32 + 8 * fq;
#pragma unroll
        for (int ai = 0; ai < 2; ++ai) {
            u32x4 bw[4][2], pw[4][2];
#pragma unroll
            for (int m = 0; m < 4; ++m) { const size_t off0 = (size_t)(u.pm * BM + ai * HALF + wr * 64 + m * 16 + fr) * DM + col;
#pragma unroll
                for (int bj = 0; bj < 2; ++bj) { bw[m][bj] = *(const u32x4*)(BB + off0 + bj * HALF); pw[m][bj] = *(const u32x4*)(PL + off0 + bj * HALF); } }
#pragma unroll
            for (int m = 0; m < 4; ++m) { const int lr = ai * HALF + wr * 64 + m * 16 + fr, row = u.pm * BM + lr; const float r = rtab[lr];
                float s = 0.f;
#pragma unroll
                for (int bj = 0; bj < 2; ++bj) { const size_t off = (size_t)row * DM + col + bj * HALF; const u32x4 b_ = bw[m][bj], p_ = pw[m][bj];
                    const f32x4 b0 = {bflo(b_.x), bfhi(b_.x), bflo(b_.y), bfhi(b_.y)}, b1 = {bflo(b_.z), bfhi(b_.z), bflo(b_.w), bfhi(b_.w)};
                    const f32x4 p0 = {bflo(p_.x), bfhi(p_.x), bflo(p_.y), bfhi(p_.y)}, p1 = {bflo(p_.z), bfhi(p_.z), bflo(p_.w), bfhi(p_.w)};
                    f32x4 v0 = acc[ai][bj][m][0] * r, v1 = acc[ai][bj][m][1] * r;
#pragma unroll
                    for (int e = 0; e < 4; ++e) { v0[e] = b0[e] + fsigmoid(v0[e]) * p0[e] * sc; v1[e] = b1[e] + fsigmoid(v1[e]) * p1[e] * sc; }
                    if (LAST) { *(f32x4*)(HO + off) = v0; *(f32x4*)(HO + off + 4) = v1; }
                    else { *(u32x4*)(OB + off) = pack8(v0, v1);
                        s += (v0[0] * v0[0] + v0[1] * v0[1]) + (v0[2] * v0[2] + v0[3] * v0[3]) + (v1[0] * v1[0] + v1[1] * v1[1]) + (v1[2] * v1[2] + v1[3] * v1[3]); } }
                if (!LAST) { s += __shfl_xor(s, 16); s += __shfl_xor(s, 32); if (fq == 0) ssq_out[ssq_idx(u.pn, row, wc)] = s; } }
        }
    }
};
struct EpiKvq {
    bf16_t* KV; bf16_t* Qb; const float* ssq; float *CKP, *CVP, *CKS, *CVS;
    __device__ __forceinline__ const float* rsrc() const { return ssq; }
    __device__ __forceinline__ void operator()(const f32x4 (&acc)[2][2][4][2], const Unit& u, int wr, int wc, int fr, int fq, LAS float* rtab, int tid) const {
        const int pn = u.pn, c = wc * 32 + 8 * fq;
        EPI_ROWLOOP { const int lr = ai * HALF + wr * 64 + m * 16 + fr, row = u.pm * BM + lr; const float r = rtab[lr];
            float* cdst = nullptr;
            if (pn < 2) {
                if (row < MP) { const int b = row >> 13, t = row & (SEQ - 1); if (t >= SEQ - 128) cdst = (pn == 0 ? CKP : CVP) + ((size_t)(b * 128 + t - (SEQ - 128)) * 256 + c); }
                else { const int rs = row - MP, sb = rs >> 3, i = rs & 7; cdst = (pn == 0 ? CKS : CVS) + ((size_t)(sb * 128 + 120 + i) * 256 + c); }
            }
            bf16_t* dst = pn < 2 ? KV + (size_t)row * 512 + pn * 256 + c : Qb + (size_t)row * DM + (pn - 2) * 256 + c;
#pragma unroll
            for (int bj = 0; bj < 2; ++bj) { const f32x4 v0 = acc[ai][bj][m][0] * r, v1 = acc[ai][bj][m][1] * r;
                *(u32x4*)(dst + bj * HALF) = pack8(v0, v1);
                if (cdst) { *(f32x4*)(cdst + bj * HALF) = v0; *(f32x4*)(cdst + bj * HALF + 4) = v1; } } }
    }
};
}


namespace mg {
constexpr int KT = 256, LDT = KT + 8, TILE_B = 64 * LDT * 2;
template <class Epi>
__device__ __forceinline__ void mini_gemm(LAS unsigned char* lds, const bf16_t* A  , const bf16_t* Bt  , int N, int K, int G, int bx, const Epi& E) {
    const int tid = threadIdx.x, lane = tid & 63, wave = __builtin_amdgcn_readfirstlane(tid >> 6), l15 = lane & 15, g = lane >> 4;
    const int rt = wave & 3, chh = wave >> 2, nk = K / KT, units = 16 * (N / 64);
    LAS float* red = (LAS float*)(lds + 4 * TILE_B);
    for (int u = bx; u < units; u += G) {
        const int rm = u & 15, cn = u >> 4;
        const bf16_t* Ag = A + (size_t)(rm * 64) * K; const bf16_t* Bg = Bt + (size_t)(cn * 64) * K;
        u32x4 ra0[4], rb0[4], ra1[4], rb1[4];
#define MG_LOAD(ra, rb, kt) do { _Pragma("unroll") for (int i = 0; i < 4; ++i) { const int c = tid + 512 * i, row = c >> 5, ch = c & 31; \
            ra[i] = *(const u32x4*)(Ag + (size_t)row * K + (kt) * KT + ch * 8); rb[i] = *(const u32x4*)(Bg + (size_t)row * K + (kt) * KT + ch * 8); } } while (0)
#define MG_STORE(ra, rb, b) do { _Pragma("unroll") for (int i = 0; i < 4; ++i) { const int c = tid + 512 * i, row = c >> 5, ch = c & 31; \
            *(LAS u32x4*)(lds + (b) * 2 * TILE_B + (row * LDT + ch * 8) * 2) = ra[i]; *(LAS u32x4*)(lds + (b) * 2 * TILE_B + TILE_B + (row * LDT + ch * 8) * 2) = rb[i]; } } while (0)
#define MG_COMPUTE(b) do { const LAS bf16_t* Al = (const LAS bf16_t*)(lds + (b) * 2 * TILE_B); const LAS bf16_t* Bl = (const LAS bf16_t*)(lds + (b) * 2 * TILE_B + TILE_B); \
            _Pragma("unroll") for (int ks = 0; ks < KT / 32; ++ks) { const bf16x8 Af = *(const LAS bf16x8*)(Al + (16 * rt + l15) * LDT + 32 * ks + 8 * g); \
                _Pragma("unroll") for (int t = 0; t < 2; ++t) { const bf16x8 Bf = *(const LAS bf16x8*)(Bl + (16 * (2 * chh + t) + l15) * LDT + 32 * ks + 8 * g); \
                    acc[t] = __builtin_amdgcn_mfma_f32_16x16x32_bf16(Bf, Af, acc[t], 0, 0, 0); } } } while (0)
        f32x4 acc[2] = {(f32x4){0.f, 0.f, 0.f, 0.f}, (f32x4){0.f, 0.f, 0.f, 0.f}};
#define MG_BAR() do { asm volatile("s_waitcnt lgkmcnt(0)" ::: "memory"); __builtin_amdgcn_s_barrier(); asm volatile("" ::: "memory"); } while (0)
        MG_LOAD(ra0, rb0, 0); if (nk > 1) MG_LOAD(ra1, rb1, 1);
        MG_STORE(ra0, rb0, 0); MG_BAR();
        for (int kt = 0; kt < nk; kt += 2) {
            if (kt + 2 < nk) MG_LOAD(ra0, rb0, kt + 2);
            MG_COMPUTE(0);
            if (kt + 1 < nk) MG_STORE(ra1, rb1, 1);
            MG_BAR();
            if (kt + 1 < nk) {
                if (kt + 3 < nk) MG_LOAD(ra1, rb1, kt + 3);
                MG_COMPUTE(1);
                if (kt + 2 < nk) MG_STORE(ra0, rb0, 0);
                MG_BAR();
            }
        }
#undef MG_BAR
        const int row = MP + rm * 64 + 16 * rt + l15; float s = 0.f;
#pragma unroll
        for (int t = 0; t < 2; ++t) { const f32x4 o = E(row, cn * 64 + 16 * (2 * chh + t) + 4 * g, acc[t]); s += (o[0] * o[0] + o[1] * o[1]) + (o[2] * o[2] + o[3] * o[3]); }
        if (Epi::SSQ) { s += __shfl_xor(s, 16); s += __shfl_xor(s, 32); if (g == 0) red[(16 * rt + l15) * 2 + chh] = s;
            __syncthreads();
            if (tid < 64) st_wt(E.ssq_out + ssq_idx(cn >> 2, MP + rm * 64 + tid, cn & 3), red[tid * 2] + red[tid * 2 + 1]);
            __syncthreads(); }
#undef MG_LOAD
#undef MG_STORE
#undef MG_COMPUTE
    }
}
__device__ __forceinline__ u32x2 pack4(const f32x4 v) { u32x2 w; w.x = pk2(v[0], v[1]); w.y = pk2(v[2], v[3]); return w; }
template <bool FROM_X> struct MRes {
    static constexpr bool SSQ = true; const float* X1; const bf16_t* BB; bf16_t* XO; float* ssq_out; float sc;
    __device__ __forceinline__ f32x4 operator()(int row, int col, const f32x4 v) const {
        f32x4 b; if (FROM_X) b = *(const f32x4*)(X1 + (size_t)(row - MP) * DM + col); else { const u32x2 w = *(const u32x2*)(BB + (size_t)row * DM + col); b = (f32x4){bflo(w.x), bfhi(w.x), bflo(w.y), bfhi(w.y)}; }
        const f32x4 o = b + v * sc; *(u32x2*)(XO + (size_t)row * DM + col) = pack4(o); return o; }
};
struct MPl { static constexpr bool SSQ = false; bf16_t* PL; float* ssq_out;
    __device__ __forceinline__ f32x4 operator()(int row, int col, const f32x4 v) const { *(u32x2*)(PL + (size_t)row * DM + col) = pack4(v); return v; } };
struct MUp { static constexpr bool SSQ = false; bf16_t* HS  ; const float* ssq; float* ssq_out;
    __device__ __forceinline__ f32x4 operator()(int row, int col, const f32x4 v) const { const float r = row_r(ssq, row); f32x4 o;
#pragma unroll
        for (int e = 0; e < 4; ++e) { const float a = fmaxf(v[e] * r, 0.f); o[e] = a * a; }
        *(u32x2*)(HS + (size_t)(row - MP) * FF + col) = pack4(o); return o; } };
template <bool LAST> struct MGate { static constexpr bool SSQ = !LAST; float* HO; const bf16_t* BB; const bf16_t* PL; bf16_t* OB; const float* ssq_in; float* ssq_out; float sc;
    __device__ __forceinline__ f32x4 operator()(int row, int col, const f32x4 v) const { const float r = row_r(ssq_in, row); const size_t off = (size_t)row * DM + col;
        const u32x2 bw = *(const u32x2*)(BB + off), pw = *(const u32x2*)(PL + off);
        const f32x4 b = {bflo(bw.x), bfhi(bw.x), bflo(bw.y), bfhi(bw.y)}, p = {bflo(pw.x), bfhi(pw.x), bflo(pw.y), bfhi(pw.y)}; f32x4 o;
#pragma unroll
        for (int e = 0; e < 4; ++e) o[e] = b[e] + fsigmoid(v[e] * r) * p[e] * sc;
        if (LAST) *(f32x4*)(HO + off) = o; else *(u32x2*)(OB + off) = pack4(o); return o; } };
}

constexpr int NWAVES = 8, NTHREADS = 512;
constexpr int RING_BYTES = 131072, LDS_BYTES = 147456;
struct Args { const float* in[26]; float* out; unsigned char* ws; int ph_lo, ph_hi; };

struct TJob { const float* src; int ldw, kk, nblk; bf16_t* dst; const float* gain; float scale; int item; };
__device__ __forceinline__ void p0_tload(const TJob& J, float (&r)[32], int lane) {
    const int kb = J.item / J.nblk, nb = J.item % J.nblk, k0 = 64 * kb, n0 = 32 * nb;
#pragma unroll
    for (int i = 0; i < 32; ++i) r[i] = __builtin_nontemporal_load(J.src + (size_t)(k0 + 2 * i + (lane >> 5)) * J.ldw + n0 + (lane & 31));
}
__device__ __forceinline__ void p0_tfinish(const TJob& J, const float (&r)[32], LAS float* scr, int lane) {
    const int kb = J.item / J.nblk, nb = J.item % J.nblk, k0 = 64 * kb, n0 = 32 * nb, c = lane & 7;
    f32x4 g0 = {1.f, 1.f, 1.f, 1.f}, g1 = g0;
    if (J.gain) { g0 = *(const f32x4*)(J.gain + k0 + 8 * c); g1 = *(const f32x4*)(J.gain + k0 + 8 * c + 4); }
    g0 *= J.scale; g1 *= J.scale;
#pragma unroll
    for (int i = 0; i < 32; ++i) scr[(2 * i + (lane >> 5)) * 33 + (lane & 31)] = r[i];
    asm volatile("s_waitcnt lgkmcnt(0)" ::: "memory");
#pragma unroll
    for (int j = 0; j < 4; ++j) { const int n = (lane >> 3) + 8 * j; const LAS float* sp = scr + (8 * c) * 33 + n;
        u32x4 o; o.x = pk2(sp[0 * 33] * g0.x, sp[1 * 33] * g0.y); o.y = pk2(sp[2 * 33] * g0.z, sp[3 * 33] * g0.w); o.z = pk2(sp[4 * 33] * g1.x, sp[5 * 33] * g1.y); o.w = pk2(sp[6 * 33] * g1.z, sp[7 * 33] * g1.w);
        *(u32x4*)(J.dst + (size_t)(n0 + n) * J.kk + k0 + 8 * c) = o; }
    asm volatile("s_waitcnt lgkmcnt(0)" ::: "memory");
}

constexpr int T128 = 144, T256 = 272, TP = 80;
#define LDS_BAR() do { asm volatile("s_waitcnt lgkmcnt(0)" ::: "memory"); __builtin_amdgcn_s_barrier(); asm volatile("" ::: "memory"); } while (0)
struct GlaRegs { u32x4 lg[2], v[4], k[2], q[2]; };
template <bool WITH_Q, bool DO_LKQ = true, bool DO_V = true>
__device__ __forceinline__ void gla_fetch(GlaRegs& R, int item, const bf16_t* Q1, const bf16_t* K1, const bf16_t* V1, const bf16_t* LGp, int tid) {
    const int bh = item >> 7, c = item & 127, b = bh >> 2, h = bh & 3; const size_t row0 = (size_t)b * SEQ + c * 64;
    if (DO_LKQ) {
#pragma unroll
        for (int i = 0; i < 2; ++i) { const int x = tid + NTHREADS * i, j = x >> 4, d8 = (x & 15) * 8; const size_t off = (row0 + j) * NQK + h * 128 + d8;
            R.lg[i] = *(const u32x4*)(LGp + off); R.k[i] = *(const u32x4*)(K1 + off); if (WITH_Q) R.q[i] = *(const u32x4*)(Q1 + off); } }
    if (DO_V) {
#pragma unroll
        for (int i = 0; i < 4; ++i) { const int x = tid + NTHREADS * i, j = x >> 5, e8 = (x & 31) * 8; R.v[i] = *(const u32x4*)(V1 + (row0 + j) * NV + h * 256 + e8); } }
}
__device__ __forceinline__ void gla_stage_lg_v(const GlaRegs& R, LAS float* bc, LAS bf16_t* vt, int tid) {
#pragma unroll
    for (int i = 0; i < 2; ++i) { const int x = tid + NTHREADS * i, j = x >> 4, d8 = (x & 15) * 8; const u32x4 w = R.lg[i];
        *(LAS f32x4*)(bc + j * 128 + d8) = (f32x4){bflo(w.x), bfhi(w.x), bflo(w.y), bfhi(w.y)}; *(LAS f32x4*)(bc + j * 128 + d8 + 4) = (f32x4){bflo(w.z), bfhi(w.z), bflo(w.w), bfhi(w.w)}; }
#pragma unroll
    for (int i = 0; i < 4; ++i) { const int x = tid + NTHREADS * i, j = x >> 5, e8 = (x & 31) * 8; *(LAS u32x4*)(vt + j * T256 + e8) = R.v[i]; }
    LDS_BAR();
    if (tid < 128) { float s = 0.f;
#pragma unroll 8
        for (int j = 0; j < 64; ++j) { s += bc[j * 128 + tid]; bc[j * 128 + tid] = s; } }
    LDS_BAR();
}
constexpr int NSUP = 32, NSUP_ALL = NBH * NSUP;
template <bool OUT>
__device__ __forceinline__ void gla_super_phase(LAS unsigned char* lds, int G, int bx, const bf16_t* Q1, const bf16_t* K1, const bf16_t* V1, const bf16_t* G1, const bf16_t* LGp, bf16_t* US, float* DVS,
                                                const float* ogain, bf16_t* OG, float* SOUT, int tid, int lane, int wave) {
    LAS float* bc = (LAS float*)lds;
    LAS bf16_t* Pm = (LAS bf16_t*)lds;
    LAS bf16_t* qt = (LAS bf16_t*)(lds + 32768);
    LAS bf16_t* kt = qt + 64 * T128;
    LAS bf16_t* kd = kt + 64 * T128;
    LAS bf16_t* vt = kd + 64 * T128;
    LAS float* red = (LAS float*)(lds + 32768 + 3 * 64 * T128 * 2 + 64 * T256 * 2);
    LAS float* em = red + 512;
    LAS float* dvl = em + 128;
    const int l15 = lane & 15, g = lane >> 4, q = l15 >> 2, p = l15 & 3;
    f32x4 gn[2] = {(f32x4){0.f, 0.f, 0.f, 0.f}, (f32x4){0.f, 0.f, 0.f, 0.f}};
    if (OUT) {
#pragma unroll
        for (int t = 0; t < 2; ++t) gn[t] = *(const f32x4*)(ogain + 16 * (2 * wave + t) + 4 * g); }
    GlaRegs R;
    if (bx < NSUP_ALL) gla_fetch<OUT>(R, (bx >> 5) * NCHUNK + (bx & 31) * 4, Q1, K1, V1, LGp, tid);
    for (int item = bx; item < NSUP_ALL; item += G) {
        const int bh = item >> 5, sc = item & 31, b = bh >> 2, h = bh & 3;
        f32x4 S[8][2];
        if (OUT) {
#pragma unroll
            for (int dt = 0; dt < 8; ++dt)
#pragma unroll
                for (int t = 0; t < 2; ++t) { const u32x2 w = *(const u32x2*)(US + ((size_t)item * 256 + 16 * (2 * wave + t) + l15) * 128 + 16 * dt + 4 * g); S[dt][t] = (f32x4){bflo(w.x), bfhi(w.x), bflo(w.y), bfhi(w.y)}; }
        } else {
#pragma unroll
            for (int dt = 0; dt < 8; ++dt) { S[dt][0] = (f32x4){0.f, 0.f, 0.f, 0.f}; S[dt][1] = (f32x4){0.f, 0.f, 0.f, 0.f}; } }
        float lsum = 0.f;
        for (int cc = 0; cc < 4; ++cc) {
            const int c = sc * 4 + cc; const size_t row0 = (size_t)b * SEQ + c * 64;
            gla_stage_lg_v(R, bc, vt, tid);
#pragma unroll
            for (int i = 0; i < 2; ++i) { const int x = tid + NTHREADS * i, j = x >> 4, d8 = (x & 15) * 8; const u32x4 wk = R.k[i];
                float kv[8] = {bflo(wk.x), bfhi(wk.x), bflo(wk.y), bfhi(wk.y), bflo(wk.z), bfhi(wk.z), bflo(wk.w), bfhi(wk.w)};
                float cur[8], dd[8];
#pragma unroll
                for (int t = 0; t < 8; ++t) { cur[t] = bc[j * 128 + d8 + t]; dd[t] = kv[t] * fexp(bc[63 * 128 + d8 + t] - cur[t]); }
                u32x4 o; o.x = pk2(dd[0], dd[1]); o.y = pk2(dd[2], dd[3]); o.z = pk2(dd[4], dd[5]); o.w = pk2(dd[6], dd[7]); *(LAS u32x4*)(kd + j * T128 + d8) = o;
                if (OUT) { const u32x4 wq = R.q[i];
                    float qv[8] = {bflo(wq.x), bfhi(wq.x), bflo(wq.y), bfhi(wq.y), bflo(wq.z), bfhi(wq.z), bflo(wq.w), bfhi(wq.w)};
                    float a[8], bb[8];
#pragma unroll
                    for (int t = 0; t < 8; ++t) { const float mid = bc[31 * 128 + d8 + t]; a[t] = qv[t] * fexp(cur[t] - mid); bb[t] = kv[t] * fexp(mid - cur[t]); }
                    o.x = pk2(a[0], a[1]); o.y = pk2(a[2], a[3]); o.z = pk2(a[4], a[5]); o.w = pk2(a[6], a[7]); *(LAS u32x4*)(qt + j * T128 + d8) = o;
                    o.x = pk2(bb[0], bb[1]); o.y = pk2(bb[2], bb[3]); o.z = pk2(bb[4], bb[5]); o.w = pk2(bb[6], bb[7]); *(LAS u32x4*)(kt + j * T128 + d8) = o; } }
            if (tid < 128) { const float last = bc[63 * 128 + tid]; dvl[tid] = fexp(last); lsum += last; if (OUT) em[tid] = fexp(bc[31 * 128 + tid]); }
            const int nxt_ = (cc < 3) ? bh * NCHUNK + c + 1 : (item + G < NSUP_ALL ? ((item + G) >> 5) * NCHUNK + ((item + G) & 31) * 4 : -1);
            if (nxt_ >= 0) gla_fetch<OUT, true, false>(R, nxt_, Q1, K1, V1, LGp, tid);
            LDS_BAR();
            if (OUT) {
#pragma unroll
                for (int t = 0; t < 2; ++t) { const int id = 2 * wave + t, ti = id >> 2, tj = id & 3;
                    f32x4 a = {0.f, 0.f, 0.f, 0.f};
                    if (tj <= ti) {
#pragma unroll
                        for (int ks = 0; ks < 4; ++ks) { const bf16x8 Af = *(const LAS bf16x8*)(qt + (16 * ti + l15) * T128 + 32 * ks + 8 * g), Bf = *(const LAS bf16x8*)(kt + (16 * tj + l15) * T128 + 32 * ks + 8 * g);
                            a = __builtin_amdgcn_mfma_f32_16x16x32_bf16(Af, Bf, a, 0, 0, 0); } }
#pragma unroll
                    for (int r = 0; r < 4; ++r) { const int i = 16 * ti + 4 * g + r, j = 16 * tj + l15; const float v = (j <= i) ? a[r] : 0.f; Pm[i * TP + j] = (bf16_t)(pk2(v, 0.f) & 0xffffu); }
                }
                LDS_BAR();
                f32x4 o[4][2];
#pragma unroll
                for (int ti = 0; ti < 4; ++ti) { o[ti][0] = (f32x4){0.f, 0.f, 0.f, 0.f}; o[ti][1] = (f32x4){0.f, 0.f, 0.f, 0.f}; }
#pragma unroll
                for (int ks = 0; ks < 2; ++ks) {
                    bf16x8 Bf[2];
#pragma unroll
                    for (int t = 0; t < 2; ++t) { const LAS bf16_t* a0 = vt + (32 * ks + 8 * g + q) * T256 + 16 * (2 * wave + t) + 4 * p; Bf[t] = cat8(trd(a0), trd(a0 + 4 * T256)); }
#pragma unroll
                    for (int ti = 2 * ks; ti < 4; ++ti) { const bf16x8 Af = *(const LAS bf16x8*)(Pm + (16 * ti + l15) * TP + 32 * ks + 8 * g);
#pragma unroll
                        for (int t = 0; t < 2; ++t) o[ti][t] = __builtin_amdgcn_mfma_f32_16x16x32_bf16(Bf[t], Af, o[ti][t], 0, 0, 0); }
                }
#pragma unroll
                for (int ks = 0; ks < 4; ++ks) {
                    const f32x4 e0 = *(LAS f32x4*)(em + 32 * ks + 4 * g), e1 = *(LAS f32x4*)(em + 32 * ks + 16 + 4 * g);
                    bf16x8 Bf[2];
#pragma unroll
                    for (int t = 0; t < 2; ++t) { const f32x4 s0 = S[2 * ks][t] * e0, s1 = S[2 * ks + 1][t] * e1; u32x4 w; w.x = pk2(s0[0], s0[1]); w.y = pk2(s0[2], s0[3]); w.z = pk2(s1[0], s1[1]); w.w = pk2(s1[2], s1[3]); Bf[t] = __builtin_bit_cast(bf16x8, w); }
#pragma unroll
                    for (int ti = 0; ti < 4; ++ti) { const LAS bf16_t* ap = qt + (16 * ti + l15) * T128 + 32 * ks + 4 * g;
                        const u32x2 a0 = *(const LAS u32x2*)ap, a1 = *(const LAS u32x2*)(ap + 16); u32x4 aw; aw.x = a0.x; aw.y = a0.y; aw.z = a1.x; aw.w = a1.y; const bf16x8 Af = __builtin_bit_cast(bf16x8, aw);
#pragma unroll
                        for (int t = 0; t < 2; ++t) o[ti][t] = __builtin_amdgcn_mfma_f32_16x16x32_bf16(Bf[t], Af, o[ti][t], 0, 0, 0); }
                }
#pragma unroll
                for (int ti = 0; ti < 4; ++ti) { float s = 0.f;
#pragma unroll
                    for (int t = 0; t < 2; ++t) s += (o[ti][t][0] * o[ti][t][0] + o[ti][t][1] * o[ti][t][1]) + (o[ti][t][2] * o[ti][t][2] + o[ti][t][3] * o[ti][t][3]);
                    s += __shfl_xor(s, 16); s += __shfl_xor(s, 32);
                    if (g == 0) red[(16 * ti + l15) * 8 + wave] = s; }
                LDS_BAR();
#pragma unroll
                for (int ti = 0; ti < 4; ++ti) { const int i = 16 * ti + l15; const f32x4 r0 = *(LAS f32x4*)(red + i * 8), r1 = *(LAS f32x4*)(red + i * 8 + 4);
                    const float rms = frsq(((r0.x + r0.y) + (r0.z + r0.w) + (r1.x + r1.y) + (r1.z + r1.w)) * (1.f / 256.f) + EPS);
#pragma unroll
                    for (int t = 0; t < 2; ++t) { const size_t off = (row0 + i) * NV + h * 256 + 16 * (2 * wave + t) + 4 * g; const u32x2 gw_ = *(const u32x2*)(G1 + off);
                        const f32x4 gv = {bflo(gw_.x), bfhi(gw_.x), bflo(gw_.y), bfhi(gw_.y)}; f32x4 ov;
#pragma unroll
                        for (int r = 0; r < 4; ++r) ov[r] = o[ti][t][r] * rms * gn[t][r] * gv[r] * fsigmoid(gv[r]);
                        u32x2 w; w.x = pk2(ov[0], ov[1]); w.y = pk2(ov[2], ov[3]); *(u32x2*)(OG + off) = w; } }
            }
            if (nxt_ >= 0) gla_fetch<OUT, false, true>(R, nxt_, Q1, K1, V1, LGp, tid);
#pragma unroll
            for (int dt = 0; dt < 8; ++dt) { const f32x4 dvv = *(LAS f32x4*)(dvl + 16 * dt + 4 * g); S[dt][0] *= dvv; S[dt][1] *= dvv; }
#pragma unroll
            for (int ks = 0; ks < 2; ++ks) {
                bf16x8 Bf[2];
#pragma unroll
                for (int t = 0; t < 2; ++t) { const LAS bf16_t* a0 = vt + (32 * ks + 8 * g + q) * T256 + 16 * (2 * wave + t) + 4 * p; Bf[t] = cat8(trd(a0), trd(a0 + 4 * T256)); }
#pragma unroll
                for (int dt = 0; dt < 8; ++dt) { const LAS bf16_t* a0 = kd + (32 * ks + 8 * g + q) * T128 + 16 * dt + 4 * p; const bf16x8 Af = cat8(trd(a0), trd(a0 + 4 * T128));
#pragma unroll
                    for (int t = 0; t < 2; ++t) S[dt][t] = __builtin_amdgcn_mfma_f32_16x16x32_bf16(Af, Bf[t], S[dt][t], 0, 0, 0); }
            }
            LDS_BAR();
        }
        if (OUT && sc == NSUP - 1) {
            float* so = SOUT + (size_t)bh * 128 * 256 + (size_t)(4 * g) * 256 + 32 * wave + l15;
#pragma unroll
            for (int dt = 0; dt < 8; ++dt) {
#pragma unroll
                for (int t = 0; t < 2; ++t)
#pragma unroll
                    for (int r = 0; r < 4; ++r) so[r * 256 + 16 * t] = S[dt][t][r];
                so += 16 * 256; asm volatile("" : "+v"(so));
            }
        }
        if (!OUT) {
#pragma unroll
            for (int dt = 0; dt < 8; ++dt)
#pragma unroll
                for (int t = 0; t < 2; ++t) { u32x2 w; w.x = pk2(S[dt][t][0], S[dt][t][1]); w.y = pk2(S[dt][t][2], S[dt][t][3]);
                    *(u32x2*)(US + ((size_t)item * 256 + 16 * (2 * wave + t) + l15) * 128 + 16 * dt + 4 * g) = w; }
            if (tid < 128) DVS[(size_t)item * 128 + tid] = fexp(lsum);
        }
    }
}
template <int NSTEP>
__device__ __forceinline__ void gla_scan(bf16_t* UT, const float* DV, float* state_out, int gtid, int gthreads) {
    for (int idx = gtid; idx < NBH * 256 * 64; idx += gthreads) {
        const int bh = idx >> 14, rem = idx & 16383, e = rem >> 6, dp = rem & 63;
        unsigned* base = (unsigned*)UT + (size_t)bh * NSTEP * 16384 + e * 64 + dp;
        const float* dv = DV + (size_t)bh * NSTEP * 128 + 2 * dp;
        float s0 = 0.f, s1 = 0.f;
        for (int c0 = 0; c0 < NSTEP; c0 += 32) {
            unsigned uu[32]; f32x2 dd[32];
#pragma unroll
            for (int k = 0; k < 32; ++k) { uu[k] = base[(size_t)(c0 + k) * 16384]; dd[k] = *(const f32x2*)(dv + (size_t)(c0 + k) * 128); }
#pragma unroll
            for (int k = 0; k < 32; ++k) { base[(size_t)(c0 + k) * 16384] = pk2(s0, s1); s0 = dd[k].x * s0 + bflo(uu[k]); s1 = dd[k].y * s1 + bfhi(uu[k]); }
        }
        (void)state_out;
    }
}
__device__ __forceinline__ void gla_sample_pair(LAS unsigned char* lds, int base_item, const bf16_t* Q1, const bf16_t* K1, const bf16_t* V1, const bf16_t* G1, const bf16_t* LGp,
                                                const float* S0in, float* Sout, const float* ogain, bf16_t* OG, int tid) {
    const int hb = tid >> 8, t = tid & 255, item = base_item + hb, sb = item >> 2, h = item & 3; const size_t r0 = (size_t)MP + sb * 8;
    LAS float* qaT = (LAS float*)(lds + hb * 16384);
    LAS float* qsT = qaT + 1024, *kdT = qsT + 1024, *dvs = kdT + 1024, *att = dvs + 128, *red = att + 64;
    if (t < 128) { const int d = t; float bcv[8], s = 0.f;
#pragma unroll
        for (int i = 0; i < 8; ++i) { s += bf2f(LGp[(r0 + i) * NQK + h * 128 + d]); bcv[i] = s; }
#pragma unroll
        for (int i = 0; i < 8; ++i) { const float qv = bf2f(Q1[(r0 + i) * NQK + h * 128 + d]), kv = bf2f(K1[(r0 + i) * NQK + h * 128 + d]);
            qaT[d * 8 + i] = qv * fexp(bcv[i] - bcv[7]); qsT[d * 8 + i] = qv * fexp(bcv[i]); kdT[d * 8 + i] = kv * fexp(bcv[7] - bcv[i]); }
        dvs[d] = fexp(bcv[7]); }
    __syncthreads();
    if (t < 64) { const int i = t >> 3, j = t & 7; float s = 0.f;
        for (int d = 0; d < 128; ++d) s += qaT[d * 8 + i] * kdT[d * 8 + j];
        att[t] = (j <= i) ? s : 0.f; }
    __syncthreads();
    const int e = t; float v[8], o[8];
#pragma unroll
    for (int j = 0; j < 8; ++j) { v[j] = bf2f(V1[(r0 + j) * NV + h * 256 + e]); o[j] = 0.f; }
    const float* S0 = S0in + ((size_t)item * 128) * 256 + e; float* SO = Sout + ((size_t)item * 128) * 256 + e;
    for (int d0 = 0; d0 < 128; d0 += 32) { float sv[32];
#pragma unroll
        for (int k = 0; k < 32; ++k) sv[k] = __builtin_nontemporal_load(S0 + (size_t)(d0 + k) * 256);
#pragma unroll
        for (int k = 0; k < 32; ++k) { const int d = d0 + k; const f32x4 qa = *(LAS f32x4*)(qsT + d * 8), qb = *(LAS f32x4*)(qsT + d * 8 + 4), ka = *(LAS f32x4*)(kdT + d * 8), kb = *(LAS f32x4*)(kdT + d * 8 + 4);
            o[0] += qa.x * sv[k]; o[1] += qa.y * sv[k]; o[2] += qa.z * sv[k]; o[3] += qa.w * sv[k]; o[4] += qb.x * sv[k]; o[5] += qb.y * sv[k]; o[6] += qb.z * sv[k]; o[7] += qb.w * sv[k];
            __builtin_nontemporal_store(dvs[d] * sv[k] + ((ka.x * v[0] + ka.y * v[1]) + (ka.z * v[2] + ka.w * v[3])) + ((kb.x * v[4] + kb.y * v[5]) + (kb.z * v[6] + kb.w * v[7])), SO + (size_t)d * 256); }
    }
#pragma unroll
    for (int i = 0; i < 8; ++i)
#pragma unroll
        for (int j = 0; j <= i; ++j) o[i] += att[i * 8 + j] * v[j];
    const int wv = t >> 6;
#pragma unroll
    for (int i = 0; i < 8; ++i) { const float s = wave_sum(o[i] * o[i]); if ((t & 63) == 0) red[i * 4 + wv] = s; }
    __syncthreads();
    const float gn = ogain[e];
#pragma unroll
    for (int i = 0; i < 8; ++i) { const f32x4 rr = *(LAS f32x4*)(red + i * 4); const float rms = frsq(((rr.x + rr.y) + (rr.z + rr.w)) * (1.f / 256.f) + EPS);
        const size_t off = (r0 + i) * NV + h * 256 + e; const float gv = bf2f(G1[off]);
        OG[off] = (bf16_t)(pk2(o[i] * rms * gn * gv * fsigmoid(gv), 0.f) & 0xffffu); }
    __syncthreads();
}

constexpr int VT_LD = 72;
struct AttnP { const bf16_t* KV; const bf16_t* Qb; bf16_t* AO; const float* pk; const float* pv; float* ock; float* ocv; const float* sinks; const float* relb; };
constexpr int ATT_BUF = 32768 + 256 * VT_LD * 2 + 2048;
struct AttnRegs { u32x4 a[12]; bf16x8 q0, q1; };
#define ATT_DECODE(item) const bool smp = (item) >= 512; int b, kh, qblk, sb = 0; \
    if (!smp) { b = (item) >> 8; kh = ((item) >> 6) & 3; qblk = (item) & 63; } else { const int it_ = (item) - 512; sb = it_ >> 2; kh = it_ & 3; b = 0; qblk = 1; } \
    const long s0 = (long)b * SEQ + (long)qblk * 128; (void)s0; (void)sb
__device__ __forceinline__ const bf16_t* attn_qptr(int item, const AttnP& P, int tq, int lane, int wave) {
    ATT_DECODE(item);
    const int l15 = lane & 15, g = lane >> 4;
    const int qtile = smp ? 0 : (wave & 1) * 4 + tq;
    int hl_q; size_t qrow;
    if (!smp) { hl_q = wave >> 1; qrow = (size_t)(s0 + 16 * qtile + l15); }
    else { hl_q = 2 * (wave & 1) + (l15 >> 3); qrow = (size_t)MP + sb * 8 + (l15 & 7); }
    return P.Qb + qrow * DM + (kh * 4 + hl_q) * 64 + 8 * g;
}
__device__ __forceinline__ void attn_load(int item, const AttnP& P, AttnRegs& R, int tid, int lane, int wave) {
    { const bf16_t* qp_ = attn_qptr(item, P, 0, lane, wave); R.q0 = *(const bf16x8*)qp_; R.q1 = *(const bf16x8*)(qp_ + 32); }
    ATT_DECODE(item);
    if (!smp) {
#pragma unroll
        for (int j = 0; j < 4; ++j) { const int i = tid + NTHREADS * j, row = i >> 3, ch = i & 7; u32x4 wk = {0u, 0u, 0u, 0u}, wv = {0u, 0u, 0u, 0u};
            if (qblk > 0 || row >= 128) { const bf16_t* src = P.KV + (size_t)(s0 - 128 + row) * 512 + kh * 64 + ch * 8; wk = *(const u32x4*)src; wv = *(const u32x4*)(src + 256); }
            R.a[j] = wk; R.a[4 + j] = wv; }
    } else {
#pragma unroll
        for (int j = 0; j < 3; ++j) { const int i = tid + NTHREADS * j, row = i >> 3, ch = i & 7;
            u32x4 z = {0u, 0u, 0u, 0u}; R.a[4 * j] = z; R.a[4 * j + 1] = z; R.a[4 * j + 2] = z; R.a[4 * j + 3] = z;
            if (row < 128) { const size_t so = ((size_t)(sb * 128 + row) * 4 + kh) * 64 + ch * 8;
                R.a[4 * j] = *(const u32x4*)(P.pk + so); R.a[4 * j + 1] = *(const u32x4*)(P.pk + so + 4); R.a[4 * j + 2] = *(const u32x4*)(P.pv + so); R.a[4 * j + 3] = *(const u32x4*)(P.pv + so + 4); }
            else if (row < 136) { const bf16_t* src = P.KV + (size_t)(MP + sb * 8 + row - 128) * 512 + kh * 64 + ch * 8; R.a[4 * j] = *(const u32x4*)src; R.a[4 * j + 1] = *(const u32x4*)(src + 256); } }
    }
}
__device__ __forceinline__ void attn_stage(LAS unsigned char* lds, int item, const AttnP& P, const AttnRegs& R, int tid) {
    LAS unsigned char* Kt = lds; LAS bf16_t* Vt = (LAS bf16_t*)(lds + 32768); LAS float* bias2 = (LAS float*)(lds + 32768 + 256 * VT_LD * 2);
    ATT_DECODE(item);
    if (!smp) {
#pragma unroll
        for (int j = 0; j < 4; ++j) { const int i = tid + NTHREADS * j, row = i >> 3, ch = i & 7;
            *(LAS u32x4*)(Kt + row * 128 + ((ch ^ (row & 7)) << 4)) = R.a[j]; *(LAS u32x4*)(Vt + row * VT_LD + ch * 8) = R.a[4 + j]; }
    } else {
#pragma unroll
        for (int j = 0; j < 3; ++j) { const int i = tid + NTHREADS * j, row = i >> 3, ch = i & 7;
            if (i < 144 * 8) { u32x4 wk = R.a[4 * j], wv = R.a[4 * j + 1];
                if (row < 128) { const f32x4 k0 = __builtin_bit_cast(f32x4, R.a[4 * j]), k1 = __builtin_bit_cast(f32x4, R.a[4 * j + 1]), v0 = __builtin_bit_cast(f32x4, R.a[4 * j + 2]), v1 = __builtin_bit_cast(f32x4, R.a[4 * j + 3]);
                    wk = pg8::pack8(k0, k1); wv = pg8::pack8(v0, v1);
                    if (row >= 8) { const size_t oo = ((size_t)(sb * 128 + row - 8) * 4 + kh) * 64 + ch * 8;
                        __builtin_nontemporal_store(k0, (f32x4*)(P.ock + oo)); __builtin_nontemporal_store(k1, (f32x4*)(P.ock + oo + 4)); __builtin_nontemporal_store(v0, (f32x4*)(P.ocv + oo)); __builtin_nontemporal_store(v1, (f32x4*)(P.ocv + oo + 4)); } }
                *(LAS u32x4*)(Kt + row * 128 + ((ch ^ (row & 7)) << 4)) = wk; *(LAS u32x4*)(Vt + row * VT_LD + ch * 8) = wv; } }
    }
    { const int hl = tid >> 7, dist = tid & 127; int bk = dist;
      if (dist >= 16) { bk = 16 + (int)(__logf((float)dist * (1.f / 16.f)) * (16.f / 2.0794415416798357f)); bk = bk > 31 ? 31 : bk; }
      bias2[tid] = P.relb[bk * 16 + kh * 4 + hl] * LOG2E; }
}
__device__ __forceinline__ void attn_compute(LAS unsigned char* lds, int item, const AttnP& P, int lane, int wave, bf16x8 Qn0, bf16x8 Qn1) {
    LAS unsigned char* Kt = lds; LAS bf16_t* Vt = (LAS bf16_t*)(lds + 32768); LAS float* bias2 = (LAS float*)(lds + 32768 + 256 * VT_LD * 2);
    ATT_DECODE(item);
    const int l15 = lane & 15, g = lane >> 4, q = l15 >> 2, p = l15 & 3;
    const int ntq = smp ? (wave < 2 ? 1 : 0) : 4;
    f32x4 mb[9];
    { const int hl0 = smp ? 2 * (wave & 1) + (l15 >> 3) : (wave >> 1), io0 = smp ? (l15 & 7) : l15;
#pragma unroll
      for (int j = 0; j < 9; ++j)
#pragma unroll
          for (int r = 0; r < 4; ++r) { const int dist = 128 + io0 - 16 * j - 4 * g - r; mb[j][r] = (dist >= 0 && dist < 128) ? bias2[hl0 * 128 + (dist & 127)] : -INFINITY; } }
    for (int tq = 0; tq < ntq; ++tq) {
        const int qtile = smp ? 0 : (wave & 1) * 4 + tq;
        int hl_q, ioff; size_t qrow;
        if (!smp) { hl_q = wave >> 1; ioff = l15; qrow = (size_t)(s0 + 16 * qtile + l15); }
        else { hl_q = 2 * wave + (l15 >> 3); ioff = l15 & 7; qrow = (size_t)MP + sb * 8 + (l15 & 7); }
        const bf16x8 Qf0 = Qn0, Qf1 = Qn1;
        if (tq + 1 < ntq) { const bf16_t* qp_ = attn_qptr(item, P, tq + 1, lane, wave); Qn0 = *(const bf16x8*)qp_; Qn1 = *(const bf16x8*)(qp_ + 32); }
        f32x4 st[9];
#pragma unroll
        for (int j = 0; j < 9; ++j) { const int row = 16 * (qtile + j) + l15; const LAS unsigned char* kr = Kt + row * 128;
            const bf16x8 K0 = *(const LAS bf16x8*)(kr + ((g ^ (row & 7)) << 4)), K1f = *(const LAS bf16x8*)(kr + (((4 + g) ^ (row & 7)) << 4));
            f32x4 a = mb[j];
            a = __builtin_amdgcn_mfma_f32_16x16x32_bf16(K0, Qf0, a, 0, 0, 0); a = __builtin_amdgcn_mfma_f32_16x16x32_bf16(K1f, Qf1, a, 0, 0, 0);
            st[j] = a; }
        const float sink2 = P.sinks[kh * 4 + hl_q] * LOG2E;
        float mx = sink2;
#pragma unroll
        for (int j = 0; j < 9; ++j)
#pragma unroll
            for (int r = 0; r < 4; ++r) { float v = st[j][r];
                if (!smp && qblk == 0 && (16 * (qtile + j) + 4 * g + r) < 128) v = -INFINITY;
                st[j][r] = v; mx = fmaxf(mx, v); }
        mx = fmaxf(mx, __shfl_xor(mx, 16)); mx = fmaxf(mx, __shfl_xor(mx, 32));
        float sum = 0.f;
#pragma unroll
        for (int j = 0; j < 9; ++j)
#pragma unroll
            for (int r = 0; r < 4; ++r) { const float e = __builtin_amdgcn_exp2f(st[j][r] - mx); st[j][r] = e; sum += e; }
        sum += __shfl_xor(sum, 16); sum += __shfl_xor(sum, 32);
        const float inv = frcp(sum + __builtin_amdgcn_exp2f(sink2 - mx));
        f32x4 o[4];
#pragma unroll
        for (int dt = 0; dt < 4; ++dt) o[dt] = (f32x4){0.f, 0.f, 0.f, 0.f};
#pragma unroll
        for (int kk = 0; kk < 5; ++kk) {
            u32x4 pw; pw.x = pk2(st[2 * kk][0], st[2 * kk][1]); pw.y = pk2(st[2 * kk][2], st[2 * kk][3]);
            if (kk < 4) { pw.z = pk2(st[2 * kk + 1][0], st[2 * kk + 1][1]); pw.w = pk2(st[2 * kk + 1][2], st[2 * kk + 1][3]); } else { pw.z = 0u; pw.w = 0u; }
            const bf16x8 Pf = __builtin_bit_cast(bf16x8, pw);
            const LAS bf16_t* v0p = Vt + (16 * (qtile + 2 * kk) + 4 * g + q) * VT_LD + 4 * p;
#pragma unroll
            for (int dt = 0; dt < 4; ++dt) { const s16x4 lo = trd(v0p + 16 * dt); const s16x4 hi = (kk < 4) ? trd(v0p + 16 * VT_LD + 16 * dt) : (s16x4){0, 0, 0, 0};
                o[dt] = __builtin_amdgcn_mfma_f32_16x16x32_bf16(cat8(lo, hi), Pf, o[dt], 0, 0, 0); }
        }
        { bf16_t* op = P.AO + qrow * DM + (kh * 4 + hl_q) * 64 + 4 * g;
#pragma unroll
          for (int dt = 0; dt < 4; ++dt) { u32x2 w; w.x = pk2(o[dt][0] * inv, o[dt][1] * inv); w.y = pk2(o[dt][2] * inv, o[dt][3] * inv); *(u32x2*)(op + 16 * dt) = w; } }
    }
}


#define XB_TMO      128
#define XB_XCNT(j)  (256  + 64 * (j))
#define XB_XSUB(j)  (1280 + 64 * (j))
#define XB_XGEN(j)  (2304 + 64 * (j))
#define XB_TOP      3328
#define XB_TOPGEN   3392
#define XCD_BAR_WORDS 3456
#define XB_SPIN_CAP (1u << 20)
__device__ __forceinline__ unsigned xb_ld(unsigned* p)              { return __hip_atomic_load(p, __ATOMIC_RELAXED, __HIP_MEMORY_SCOPE_AGENT); }
__device__ __forceinline__ unsigned xb_add(unsigned* p, unsigned v) { return __hip_atomic_fetch_add(p, v, __ATOMIC_RELAXED, __HIP_MEMORY_SCOPE_AGENT); }
__device__ __forceinline__ unsigned xb_xcc_id() { return (unsigned)__builtin_amdgcn_s_getreg((3 << 11) | 20) & 0xFu; }
#define XB_SPIN(cond, bar) do { unsigned _sp = 0; while (cond) { __builtin_amdgcn_s_sleep(1); \
    if ((++_sp & 255u) == 0u) { if (xb_ld(&(bar)[XB_TMO])) break; if (_sp > XB_SPIN_CAP) { atomicAdd(&(bar)[XB_TMO], 1u); break; } } } } while (0)
struct XcdBarrier { unsigned* bar; unsigned x; volatile LAS unsigned* st; };
__device__ __forceinline__ XcdBarrier xcd_barrier_post(unsigned* bar, volatile LAS unsigned* st) {
    XcdBarrier b; b.bar = bar; b.x = xb_xcc_id(); b.st = st;
    if (threadIdx.x == 0) (void)xb_add(&bar[XB_XCNT(b.x)], 1u);
    return b;
}
__device__ __forceinline__ void xcd_barrier_complete(unsigned* bar, unsigned x, unsigned& nloc, unsigned& nx) {
    const unsigned G = gridDim.x * gridDim.y * gridDim.z;
    unsigned sum, cnt, mine, sp = 0u;
    for (;;) {
        sum = 0u; cnt = 0u; mine = 0u;
#pragma unroll
        for (unsigned j = 0; j < 16; ++j) { const unsigned c = xb_ld(&bar[XB_XCNT(j)]); sum += c; cnt += (c > 0u) ? 1u : 0u; mine = (j == x) ? c : mine; }
        if (sum == G) break;
        __builtin_amdgcn_s_sleep(1);
        if ((++sp & 255u) == 0u) { if (xb_ld(&bar[XB_TMO])) break; if (sp > XB_SPIN_CAP) { atomicAdd(&bar[XB_TMO], 1u); break; } }
    }
    nloc = mine > 0u ? mine : 1u; nx = cnt > 0u ? cnt : 1u;
}
__device__ __forceinline__ void xcd_barrier(const XcdBarrier& b) {
    asm volatile("s_waitcnt vmcnt(0)" ::: "memory");
    __syncthreads();
    if (threadIdx.x == 0) {
        unsigned* bar = b.bar;
        __builtin_amdgcn_s_waitcnt(0);
        unsigned nloc = b.st[0], nx = b.st[1];
        if (nloc == 0u) { xcd_barrier_complete(bar, b.x, nloc, nx); b.st[0] = nloc; b.st[1] = nx; }
        const unsigned old = xb_add(&bar[XB_XSUB(b.x)], 1u);
        const unsigned gen = old / nloc;
        if (old + 1u == (gen + 1u) * nloc) {
            __builtin_amdgcn_fence(__ATOMIC_RELEASE, "agent");
            asm volatile("s_waitcnt vmcnt(0)" ::: "memory");
            const unsigned og = xb_add(&bar[XB_TOP], 1u);
            const unsigned tg = og / nx;
            if (og + 1u == (tg + 1u) * nx) xb_add(&bar[XB_TOPGEN], 1u);
            else XB_SPIN(xb_ld(&bar[XB_TOPGEN]) == tg, bar);
            __builtin_amdgcn_fence(__ATOMIC_ACQUIRE, "agent");
            xb_add(&bar[XB_XGEN(b.x)], 1u);
            asm volatile("s_waitcnt vmcnt(0)" ::: "memory");
        } else {
            XB_SPIN(xb_ld(&bar[XB_XGEN(b.x)]) == gen, bar);
            __builtin_amdgcn_fence(__ATOMIC_ACQUIRE, "agent");
            asm volatile("s_waitcnt vmcnt(0)" ::: "memory");
        }
    }
    __syncthreads();
}

__global__ void __launch_bounds__(NTHREADS, 2) yoco_fwd(Args args) {
    extern __shared__ __attribute__((aligned(16))) unsigned char lds_raw[];
    LAS unsigned char* lds = (LAS unsigned char*)lds_raw;
    const int tid = threadIdx.x, lane = tid & 63, wave = __builtin_amdgcn_readfirstlane(tid >> 6), G = gridDim.x, bx = blockIdx.x;
    const int gw = bx * NWAVES + wave, NGW = G * NWAVES;
    typedef const __attribute__((address_space(4))) Args* KArgsP;
    const KArgsP kp0 = (KArgsP)__builtin_amdgcn_kernarg_segment_ptr();
#define KARG(field) ({ KArgsP q_ = kp0; asm volatile("" : "+s"(q_)); q_->field; })
#define ws KARG(ws)
#define out KARG(out)
#define x_prompt KARG(in[0])
#define x_sample KARG(in[1])
#define state_gla KARG(in[2])
#define cache_k KARG(in[3])
#define cache_v KARG(in[4])
#define p_prompt KARG(in[5])
#define p_sample KARG(in[6])
#define norm_mix KARG(in[7])
#define norm_mlp KARG(in[8])
#define norm_ple KARG(in[9])
#define norm_kv KARG(in[10])
#define norm_final KARG(in[11])
#define w_in_a KARG(in[12])
#define w_a2 KARG(in[13])
#define b_a2 KARG(in[14])
#define gla_o_gain KARG(in[15])
#define w_out_a KARG(in[16])
#define w_kv KARG(in[17])
#define w_q_b KARG(in[18])
#define w_o_b KARG(in[19])
#define sinks KARG(in[20])
#define rel_bias KARG(in[21])
#define w_up KARG(in[22])
#define w_down KARG(in[23])
#define w_ple KARG(in[24])
#define w_ple_gate KARG(in[25])
#define W_IN ((bf16_t*)(ws + WS_W_IN))
#define W_OUT ((bf16_t*)(ws + WS_W_OUT))
#define W_KVQ ((bf16_t*)(ws + WS_W_KVQ))
#define W_O ((bf16_t*)(ws + WS_W_O))
#define XB ((bf16_t*)(ws + WS_XB))
#define PB ((bf16_t*)(ws + WS_PB))
#define Q1 ((bf16_t*)(ws + WS_Q1))
#define K1 ((bf16_t*)(ws + WS_K1))
#define V1 ((bf16_t*)(ws + WS_V1))
#define G1 ((bf16_t*)(ws + WS_G1))
#define HIDA ((bf16_t*)(ws + WS_R1))
#define H3B ((bf16_t*)(ws + WS_R1))
#define R3 ((bf16_t*)(ws + WS_R3))
#define HIDS (R3 + (size_t)(64 - HID_SPLIT) * 256 * FF)
#define KVR ((bf16_t*)(ws + WS_KVR))
#define PLQ ((bf16_t*)(ws + WS_PLQ))
#define SSQ0 ((float*)(ws + WS_SSQ))
#define SSQ1 ((float*)(ws + WS_SSQ) + (size_t)M * 16)
#define DV ((float*)(ws + WS_DV))
#define H (out + O_Y)
#define UT ((bf16_t*)(out + O_Y))
    cg::grid_group grid = cg::this_grid();
    volatile LAS unsigned* bst = (volatile LAS unsigned*)(lds + LDS_BYTES - 64);
    if (tid < 2) bst[tid] = 0u;
    __syncthreads();
    XcdBarrier xbar; xbar.bar = nullptr; xbar.x = 0; xbar.st = bst;
#if !MK_SPLIT
    xbar = xcd_barrier_post((unsigned*)(ws + WS_CTL), bst);
#endif
    const int lo = KARG(ph_lo), hi = KARG(ph_hi);
#define IN(k) (lo <= (k) && (k) < hi)
#define SEAM(k) do { if (IN(k) && IN((k) + 1)) { if (MK_SPLIT) grid.sync(); else xcd_barrier(xbar); } } while (0)
    if (lo < 0) grid.sync();

    if (IN(0)) {
        LAS float* scr = (LAS float*)(lds + wave * 16384);
#define TJ_LIST_A(X) \
        X(w_in_a, IN_A_COLS, DM, 512, W_IN, norm_mix, 0.08838834764831845f)                                     \
        X(w_in_a + 512, IN_A_COLS, DM, 2560, W_IN + (size_t)512 * DM, norm_mix, 1.f)                            \
        X(w_up, FF, DM, FF, (bf16_t*)(ws + WS_W_UP0), norm_mlp, 1.f) \
        X(w_down, DM, FF, DM, (bf16_t*)(ws + WS_W_DN0), (const float*)nullptr, 1.f)
#define TJ_LIST_B(X) \
        X(w_out_a, DM, DM, DM, W_OUT, (const float*)nullptr, 1.f) \
        X(w_ple_gate, DM, DM, DM, (bf16_t*)(ws + WS_W_G0), norm_ple, 1.f) \
        X(w_ple, DM, PLE, DM, (bf16_t*)(ws + WS_W_P0), (const float*)nullptr, 1.f) \
        X(w_kv, 512, DM, 512, W_KVQ, norm_kv, 1.f) \
        X(w_q_b, DM, DM, DM, W_KVQ + (size_t)512 * DM, norm_mix + DM, 0.125f * LOG2E)                          \
        X(w_up + (size_t)DM * FF, FF, DM, FF, (bf16_t*)(ws + WS_W_UP1), norm_mlp + DM, 1.f)
#define TJ_LIST_C(X) \
        X(w_o_b, DM, DM, DM, W_O, (const float*)nullptr, 1.f) \
        X(w_ple_gate + (size_t)DM * DM, DM, DM, DM, (bf16_t*)(ws + WS_W_G1), norm_ple + DM, 1.f) \
        X(w_ple + (size_t)PLE * DM, DM, PLE, DM, (bf16_t*)(ws + WS_W_P1), (const float*)nullptr, 1.f) \
        X(w_down + (size_t)DM * FF, DM, FF, DM, (bf16_t*)(ws + WS_W_DN1), (const float*)nullptr, 1.f)
#define TJ_COUNT(WP, LDW, KK, NCOLS, DSTP, GAINP, SCALEV) + ((KK) / 64) * ((NCOLS) / 32)
#define TJ_DECODE(WP, LDW, KK, NCOLS, DSTP, GAINP, SCALEV) if (!done_ && r_ < ((KK) / 64) * ((NCOLS) / 32)) { jt_.src = (WP); jt_.ldw = (LDW); jt_.kk = (KK); jt_.nblk = (NCOLS) / 32; jt_.dst = (DSTP); jt_.gain = (GAINP); jt_.scale = (SCALEV); jt_.item = r_; done_ = true; } else if (!done_) r_ -= ((KK) / 64) * ((NCOLS) / 32);
#define TJ_GET(LIST, JOUT, it) do { int r_ = (it); bool done_ = false; TJob jt_; jt_.src = nullptr; jt_.ldw = 0; jt_.kk = 0; jt_.nblk = 1; jt_.dst = nullptr; jt_.gain = nullptr; jt_.scale = 1.f; jt_.item = 0; LIST(TJ_DECODE) JOUT = jt_; } while (0)
#define TJ_RUN(LIST, w_, nw_) do { constexpr int TOT_ = 0 LIST(TJ_COUNT); LAS float* scr_ = (LAS float*)(lds + wave * 16384); float ra_[32], rb_[32]; TJob Ja, Jb; int it = (w_); \
          if (it >= 0) { if (it < TOT_) { TJ_GET(LIST, Ja, it); p0_tload(Ja, ra_, lane); } \
          while (it < TOT_) { \
              const int it1 = it + (nw_); if (it1 < TOT_) { TJ_GET(LIST, Jb, it1); p0_tload(Jb, rb_, lane); } \
              p0_tfinish(Ja, ra_, scr_, lane); \
              if (it1 >= TOT_) break; \
              const int it2 = it1 + (nw_); if (it2 < TOT_) { TJ_GET(LIST, Ja, it2); p0_tload(Ja, ra_, lane); } \
              p0_tfinish(Jb, rb_, scr_, lane); \
              it = it2; } } } while (0)
        TJ_RUN(TJ_LIST_A, gw, NGW);
        for (int idx = bx * NTHREADS + tid; idx < 512 * 256; idx += G * NTHREADS) { const int n = idx >> 8, k4 = (idx & 255) * 4; float wa[16];
#pragma unroll
            for (int r = 0; r < 16; ++r) wa[r] = w_a2[r * 512 + n];
            f32x4 wr_[4][4];
#pragma unroll
            for (int kk = 0; kk < 4; ++kk)
#pragma unroll
                for (int q4 = 0; q4 < 4; ++q4) wr_[kk][q4] = *((const f32x4*)(w_in_a + (size_t)(k4 + kk) * IN_A_COLS + 3072) + q4);
            const f32x4 gn4 = *(const f32x4*)(norm_mix + k4);
            float o4[4];
#pragma unroll
            for (int kk = 0; kk < 4; ++kk) { float sacc = 0.f;
#pragma unroll
                for (int q4 = 0; q4 < 4; ++q4) sacc += (wr_[kk][q4].x * wa[4 * q4] + wr_[kk][q4].y * wa[4 * q4 + 1]) + (wr_[kk][q4].z * wa[4 * q4 + 2] + wr_[kk][q4].w * wa[4 * q4 + 3]);
                o4[kk] = sacc * gn4[kk]; }
            u32x2 o; o.x = pk2(o4[0], o4[1]); o.y = pk2(o4[2], o4[3]);
            *(u32x2*)(W_IN + (size_t)(3072 + n) * DM + k4) = o; }
        for (int grp = bx; grp < M / 64; grp += G)
#pragma unroll 1
          for (int half = 0; half < 2; ++half) { const int m0 = 64 * grp + 8 * wave + 4 * half; f32x4 v[4][4]; float s[4];
#pragma unroll
            for (int q = 0; q < 4; ++q) { const int m = m0 + q; const float* xr = m < MP ? x_prompt + (size_t)m * DM : x_sample + (size_t)(m - MP) * DM;
#pragma unroll
                for (int j = 0; j < 4; ++j) v[q][j] = __builtin_nontemporal_load((const f32x4*)xr + lane + 64 * j); }
#pragma unroll
            for (int q = 0; q < 4; ++q) { const int m = m0 + q; float ss = 0.f;
#pragma unroll
                for (int j = 0; j < 4; ++j) { ss += (v[q][j].x * v[q][j].x + v[q][j].y * v[q][j].y) + (v[q][j].z * v[q][j].z + v[q][j].w * v[q][j].w);
                    u32x2 w; w.x = pk2(v[q][j].x, v[q][j].y); w.y = pk2(v[q][j].z, v[q][j].w); *((u32x2*)(XB + (size_t)m * DM) + lane + 64 * j) = w; }
                s[q] = wave_sum(ss);
                if (lane < 4) *(f32x4*)(SSQ0 + ssq_idx(lane, m, 0)) = (f32x4){lane == 0 ? s[q] : 0.f, 0.f, 0.f, 0.f}; } }
        for (int m0 = gw * 8; m0 < M; m0 += NGW * 8) { f32x4 v[8];
#pragma unroll
            for (int q = 0; q < 8; ++q) { const int m = m0 + q; v[q] = *((const f32x4*)(m < MP ? p_prompt + (size_t)m * PLE : p_sample + (size_t)(m - MP) * PLE) + lane); }
#pragma unroll
            for (int q = 0; q < 8; ++q) { u32x2 w; w.x = pk2(v[q].x, v[q].y); w.y = pk2(v[q].z, v[q].w); *((u32x2*)(PB + (size_t)(m0 + q) * PLE) + lane) = w; } }
    }
    SEAM(0);
    if (IN(1)) { pg8::Gemm g{XB, XB, NPAN, W_IN, M, N_IN, DM}; pg8::StaticOrder S; S.init(M, N_IN, G, bx);
        pg8::EpiIn E{Q1, K1, V1, G1, KVR, SSQ0, b_a2}; pg8::gemm_phase(lds, g, S, E);
        { const int idle0 = (NPAN * (N_IN / 256)) % G;
          if (idle0 > 0 && G > idle0) TJ_RUN(TJ_LIST_B, bx >= idle0 ? (bx - idle0) * NWAVES + wave : -1, (G - idle0) * NWAVES); else TJ_RUN(TJ_LIST_B, gw, NGW); } }
    SEAM(1);
    if (IN(2)) {
        for (int base = bx * 2; base < SB * 4; base += G * 2) gla_sample_pair(lds, base, Q1, K1, V1, G1, KVR, state_gla, out + O_SS, gla_o_gain, R3, tid);
        gla_super_phase<false>(lds, G, bx, nullptr, K1, V1, nullptr, KVR, UT, DV, nullptr, nullptr, nullptr, tid, lane, wave);
    }
    SEAM(2);
    if (IN(3)) gla_scan<NSUP>(UT, DV, out + O_SP, bx * NTHREADS + tid, G * NTHREADS);
    SEAM(3);
    if (IN(4)) { gla_super_phase<true>(lds, G, bx, Q1, K1, V1, G1, KVR, UT, nullptr, gla_o_gain, R3, out + O_SP, tid, lane, wave); }
    SEAM(4);
    if (IN(5)) {
        { pg8::Gemm g{R3, R3, NPAN, W_OUT, MP, DM, DM}; pg8::StaticOrder S; S.init(MP, DM, G, bx); pg8::EpiRes<false> E{nullptr, nullptr, XB, XB, SSQ1, 1.f}; pg8::gemm_phase(lds, g, S, E); }
        { pg8::Gemm g{PB, PB, NPAN, (const bf16_t*)(ws + WS_W_P0), MP, DM, PLE}; pg8::StaticOrder S; S.init(MP, DM, G, bx); pg8::EpiPl E{PLQ}; pg8::gemm_phase(lds, g, S, E); }
        { mg::MRes<false> E{nullptr, XB, XB, SSQ1, 1.f}; mg::mini_gemm(lds, R3 + (size_t)MP * DM, W_OUT, DM, DM, G, bx, E); }
        { mg::MPl E{PLQ, nullptr}; mg::mini_gemm(lds, PB + (size_t)MP * PLE, (const bf16_t*)(ws + WS_W_P0), DM, PLE, G, bx, E); }
    }
    SEAM(5);
    if (IN(6)) { { pg8::Gemm g{XB, XB, NPAN, (const bf16_t*)(ws + WS_W_UP0), MP, FF, DM}; pg8::StaticOrder S; S.init(MP, FF, G, bx); pg8::EpiUp E{HIDA, R3, SSQ1}; pg8::gemm_phase(lds, g, S, E); }
        { mg::MUp E{HIDS, SSQ1, nullptr}; mg::mini_gemm(lds, XB + (size_t)MP * DM, (const bf16_t*)(ws + WS_W_UP0), FF, DM, G, bx, E); } }
    SEAM(6);
    if (IN(7)) { { pg8::Gemm g{HIDA, R3, HID_SPLIT, (const bf16_t*)(ws + WS_W_DN0), MP, DM, FF}; pg8::StaticOrder S; S.init(MP, DM, G, bx); pg8::EpiRes<false> E{nullptr, nullptr, XB, XB, SSQ0, 1.f}; pg8::gemm_phase(lds, g, S, E); }
        { mg::MRes<false> E{nullptr, XB, XB, SSQ0, 1.f}; mg::mini_gemm(lds, HIDS, (const bf16_t*)(ws + WS_W_DN0), DM, FF, G, bx, E); } }
    SEAM(7);
    if (IN(8)) { { pg8::Gemm g{XB, XB, NPAN, (const bf16_t*)(ws + WS_W_G0), MP, DM, DM}; pg8::StaticOrder S; S.init(MP, DM, G, bx); pg8::EpiGate<false> E{nullptr, XB, PLQ, H3B, SSQ0, SSQ1, 1.f}; pg8::gemm_phase(lds, g, S, E); }
        { mg::MGate<false> E{nullptr, XB, PLQ, H3B, SSQ0, SSQ1, 1.f}; mg::mini_gemm(lds, XB + (size_t)MP * DM, (const bf16_t*)(ws + WS_W_G0), DM, DM, G, bx, E); } }
    SEAM(8);
    if (IN(9)) { pg8::Gemm g{H3B, H3B, NPAN, W_KVQ, M, NKVQ, DM}; pg8::StaticOrder S; S.init(M, NKVQ, G, bx);
        pg8::EpiKvq E{KVR, PLQ, SSQ1, out + O_CKP, out + O_CVP, out + O_CKS, out + O_CVS}; pg8::gemm_phase(lds, g, S, E);
        { const int idle0 = (NPAN * (NKVQ / 256)) % G;
          if (idle0 > 0 && G > idle0) TJ_RUN(TJ_LIST_C, bx >= idle0 ? (bx - idle0) * NWAVES + wave : -1, (G - idle0) * NWAVES); else TJ_RUN(TJ_LIST_C, gw, NGW); } }
    SEAM(9);
    if (IN(10)) {
        const AttnP AP{KVR, PLQ, R3, cache_k, cache_v, out + O_CKS, out + O_CVS, sinks, rel_bias};
        { AttnRegs AR; int buf = 0;
          if (bx < 1024) { attn_load(bx, AP, AR, tid, lane, wave); attn_stage(lds, bx, AP, AR, tid); }
          LDS_BAR();
          for (int it = bx; it < 1024; it += G) { const int nx = it + G; const bf16x8 cq0 = AR.q0, cq1 = AR.q1;
              if (nx < 1024) attn_load(nx, AP, AR, tid, lane, wave);
              attn_compute(lds + buf * ATT_BUF, it, AP, lane, wave, cq0, cq1);
              if (nx < 1024) attn_stage(lds + (buf ^ 1) * ATT_BUF, nx, AP, AR, tid);
              LDS_BAR(); buf ^= 1; } }
        for (int m0 = gw * 8; m0 < M; m0 += NGW * 8) { f32x4 v[8];
#pragma unroll
            for (int q = 0; q < 8; ++q) { const int m = m0 + q; v[q] = *((const f32x4*)(m < MP ? p_prompt + (size_t)(MP + m) * PLE : p_sample + (size_t)(MS + m - MP) * PLE) + lane); }
#pragma unroll
            for (int q = 0; q < 8; ++q) { u32x2 w; w.x = pk2(v[q].x, v[q].y); w.y = pk2(v[q].z, v[q].w); *((u32x2*)(PB + (size_t)(m0 + q) * PLE) + lane) = w; } }
    }
    SEAM(10);
    if (IN(11)) {
        { pg8::Gemm g{R3, R3, NPAN, W_O, MP, DM, DM}; pg8::StaticOrder S; S.init(MP, DM, G, bx); pg8::EpiRes<false> E{nullptr, nullptr, H3B, XB, SSQ0, 1.f}; pg8::gemm_phase(lds, g, S, E); }
        { pg8::Gemm g{PB, PB, NPAN, (const bf16_t*)(ws + WS_W_P1), MP, DM, PLE}; pg8::StaticOrder S; S.init(MP, DM, G, bx); pg8::EpiPl E{PLQ}; pg8::gemm_phase(lds, g, S, E); }
        { mg::MRes<false> E{nullptr, H3B, XB, SSQ0, 1.f}; mg::mini_gemm(lds, R3 + (size_t)MP * DM, W_O, DM, DM, G, bx, E); }
        { mg::MPl E{PLQ, nullptr}; mg::mini_gemm(lds, PB + (size_t)MP * PLE, (const bf16_t*)(ws + WS_W_P1), DM, PLE, G, bx, E); }
    }
    SEAM(11);
    if (IN(12)) { { pg8::Gemm g{XB, XB, NPAN, (const bf16_t*)(ws + WS_W_UP1), MP, FF, DM}; pg8::StaticOrder S; S.init(MP, FF, G, bx); pg8::EpiUp E{HIDA, R3, SSQ0}; pg8::gemm_phase(lds, g, S, E); }
        { mg::MUp E{HIDS, SSQ0, nullptr}; mg::mini_gemm(lds, XB + (size_t)MP * DM, (const bf16_t*)(ws + WS_W_UP1), FF, DM, G, bx, E); } }
    SEAM(12);
    if (IN(13)) { { pg8::Gemm g{HIDA, R3, HID_SPLIT, (const bf16_t*)(ws + WS_W_DN1), MP, DM, FF}; pg8::StaticOrder S; S.init(MP, DM, G, bx); pg8::EpiRes<false> E{nullptr, nullptr, XB, XB, SSQ1, 1.f}; pg8::gemm_phase(lds, g, S, E); }
        { mg::MRes<false> E{nullptr, XB, XB, SSQ1, 1.f}; mg::mini_gemm(lds, HIDS, (const bf16_t*)(ws + WS_W_DN1), DM, FF, G, bx, E); } }
    SEAM(13);
    if (IN(14)) { { pg8::Gemm g{XB, XB, NPAN, (const bf16_t*)(ws + WS_W_G1), MP, DM, DM}; pg8::StaticOrder S; S.init(MP, DM, G, bx); pg8::EpiGate<false> E{nullptr, XB, PLQ, H3B, SSQ1, SSQ0, 1.f}; pg8::gemm_phase(lds, g, S, E); }
        { mg::MGate<false> E{nullptr, XB, PLQ, H3B, SSQ1, SSQ0, 1.f}; mg::mini_gemm(lds, XB + (size_t)MP * DM, (const bf16_t*)(ws + WS_W_G1), DM, DM, G, bx, E); } }
    SEAM(14);
    if (IN(15)) {
        f32x4 gn[4];
#pragma unroll
        for (int j = 0; j < 4; ++j) gn[j] = *((const f32x4*)norm_final + lane + 64 * j);
        for (int m0 = gw * 4; m0 < M; m0 += NGW * 4) { u32x2 w[4][4]; float r[4];
#pragma unroll
            for (int q = 0; q < 4; ++q) { r[q] = row_r(SSQ0, m0 + q);
#pragma unroll
                for (int j = 0; j < 4; ++j) w[q][j] = *((const u32x2*)(H3B + (size_t)(m0 + q) * DM) + lane + 64 * j); }
#pragma unroll
            for (int q = 0; q < 4; ++q)
#pragma unroll
                for (int j = 0; j < 4; ++j) { const f32x4 v = {bflo(w[q][j].x), bfhi(w[q][j].x), bflo(w[q][j].y), bfhi(w[q][j].y)};
                    __builtin_nontemporal_store(v * r[q] * gn[j], (f32x4*)(H + (size_t)(m0 + q) * DM) + lane + 64 * j); } }
    }
#undef IN
#undef SEAM
}
#undef ws
#undef out
#undef x_prompt
#undef x_sample
#undef state_gla
#undef cache_k
#undef cache_v
#undef p_prompt
#undef p_sample
#undef norm_mix
#undef norm_mlp
#undef norm_ple
#undef norm_kv
#undef norm_final
#undef w_in_a
#undef w_a2
#undef b_a2
#undef gla_o_gain
#undef w_out_a
#undef w_kv
#undef w_q_b
#undef w_o_b
#undef sinks
#undef rel_bias
#undef w_up
#undef w_down
#undef w_ple
#undef w_ple_gate
#undef W_IN
#undef W_OUT
#undef W_KVQ
#undef W_O
#undef XB
#undef PB
#undef Q1
#undef K1
#undef V1
#undef G1
#undef HIDA
#undef H3B
#undef R3
#undef HIDS
#undef KVR
#undef PLQ
#undef SSQ0
#undef SSQ1
#undef DV
#undef H
#undef UT
#undef KARG

extern "C" void kernel_launch(void* const* d_in, const int* in_sizes, int n_in, void* d_out, int out_size, void* d_ws, size_t ws_size, hipStream_t stream) {
    static int grid = 0;
    if (grid == 0) {
        if (n_in != 26 || (size_t)out_size != O_END || ws_size < WS_END) { fprintf(stderr, "kernel_launch: unexpected shapes (n_in %d out %d ws %zu need %zu)\n", n_in, out_size, ws_size, (size_t)WS_END); grid = -1; return; }
        int dev = 0, cus = 0, per_cu = 0;
        hipGetDevice(&dev); hipDeviceGetAttribute(&cus, hipDeviceAttributeMultiprocessorCount, dev);
        hipFuncSetAttribute((const void*)yoco_fwd, hipFuncAttributeMaxDynamicSharedMemorySize, LDS_BYTES);
        hipOccupancyMaxActiveBlocksPerMultiprocessor(&per_cu, (const void*)yoco_fwd, NTHREADS, LDS_BYTES);
        if (per_cu < 1) { fprintf(stderr, "kernel_launch: occupancy query says %d blocks per CU\n", per_cu); per_cu = 1; }
        (void)hipGetLastError();
        grid = cus * 1;
    }
    if (grid < 0) return;
    if (hipMemsetAsync((char*)d_ws + WS_CTL, 0, 65536, stream) != hipSuccess) { fprintf(stderr, "kernel_launch: memset failed\n"); return; }
    Args a{};
    for (int i = 0; i < 26; ++i) a.in[i] = (const float*)d_in[i];
    a.out = (float*)d_out; a.ws = (unsigned char*)d_ws;
#if MK_SPLIT
    for (int ph = 0; ph < 16; ++ph) { a.ph_lo = ph; a.ph_hi = ph + 1; hipLaunchKernelGGL(yoco_fwd, dim3(grid), dim3(NTHREADS), LDS_BYTES, stream, a); }
#else
    a.ph_lo = 0; a.ph_hi = 16;
    void* kargs[] = {&a};
    hipError_t e = hipLaunchCooperativeKernel((const void*)yoco_fwd, dim3(grid), dim3(NTHREADS), kargs, LDS_BYTES, stream);
    if (e != hipSuccess) fprintf(stderr, "cooperative launch failed: %s (grid %d)\n", hipGetErrorString(e), grid);
#endif
}
```
